# Optimizing an MI355X kernel written in HIP

```python
import math
import jax
import jax.numpy as jnp
from jax import lax
import numpy as np


D_MODEL = 1024
BATCH = 8
SEQ = 2048
DEPTH = 4

GRID_W = 64
CTX_LEN = 256
Q_BLOCK = 128
HEAD_DIM = 64
ROPE_BASE = 10000.0
EPS = 1e-6
D_MIX = D_MODEL
GROUP_WIDTH = D_MIX // 4
D_FF = 4 * D_MODEL

SSD_HEAD_DIM = 64
SSD_HEADS = GROUP_WIDTH // SSD_HEAD_DIM
SSD_INNER = SSD_HEADS * SSD_HEAD_DIM
SSD_GROUPS = 2
SSD_STATE = 64
SSD_CONV = 3
SSD_CHUNK = 128
SSD_CONV_CH = SSD_INNER + 2 * SSD_GROUPS * SSD_STATE
SSD_COLS = SSD_INNER + SSD_CONV_CH + 2 * SSD_HEADS

DIFF_V_DIM = HEAD_DIM
DIFF_HEADS = GROUP_WIDTH // DIFF_V_DIM
DIFF_QK_DIM = DIFF_V_DIM // 2
DIFF_WIDTH = DIFF_HEADS * DIFF_V_DIM
DIFF_COLS = 4 * DIFF_HEADS * DIFF_QK_DIM + DIFF_HEADS * DIFF_V_DIM

GQA_HEADS = GROUP_WIDTH // HEAD_DIM
GQA_KV_HEADS = GQA_HEADS // 2
GQA_COLS = (GQA_HEADS + 2 * GQA_KV_HEADS) * HEAD_DIM

MLA_V_DIM = HEAD_DIM
MLA_HEADS = GROUP_WIDTH // MLA_V_DIM
MLA_NOPE = HEAD_DIM
MLA_ROPE = HEAD_DIM // 2
MLA_Q_LORA = 3 * GROUP_WIDTH // 4
MLA_KV_LORA = GROUP_WIDTH // 2
MLA_COLS = MLA_Q_LORA + MLA_KV_LORA + MLA_ROPE

IN_COLS = SSD_COLS + DIFF_COLS + GQA_COLS + MLA_COLS
COL_SPLITS = (SSD_COLS, SSD_COLS + DIFF_COLS, SSD_COLS + DIFF_COLS + GQA_COLS)

kernel_name = "hybrid_parallel_heads_diffusion_block"


def rmsnorm(x, g):
    xf = x.astype(jnp.float32)
    y = xf * lax.rsqrt(jnp.mean(xf * xf, axis=-1, keepdims=True) + EPS)
    return (y * g.astype(jnp.float32)).astype(x.dtype)


def modulate(h, shift, scale):
    return h * (1.0 + scale) + shift


def squared_relu_mlp(h, w1, w2):
    return jnp.square(jax.nn.relu(h @ w1)) @ w2


def axial_rope(seq, rot_dim):
    rows = seq // GRID_W
    row = jnp.repeat(jnp.arange(rows), GRID_W).astype(jnp.float32)
    col = jnp.tile(jnp.arange(GRID_W), rows).astype(jnp.float32)
    n_freq = rot_dim // 4
    inv = ROPE_BASE ** (-jnp.arange(n_freq, dtype=jnp.float32) / n_freq)
    ang = jnp.concatenate([row[:, None] * inv, col[:, None] * inv], axis=-1)
    return jnp.cos(ang), jnp.sin(ang)


def apply_rope(x, cos, sin):
    half = x.shape[-1] // 2
    x1, x2 = x[..., :half], x[..., half:]
    c = cos.astype(x.dtype)
    s = sin.astype(x.dtype)
    return jnp.concatenate([x1 * c - x2 * s, x1 * s + x2 * c], axis=-1)


def attn_probs(q, k, scale):
    s = jnp.einsum('bkgqd,bktd->bkgqt', q, k).astype(jnp.float32) * scale
    return jax.nn.softmax(s, axis=-1)


def softmax_attention(q, k, v, scale):
    p = attn_probs(q, k, scale).astype(v.dtype)
    return jnp.einsum('bkgqt,bktd->bkgqd', p, v)


def differential_attention(q1, q2, k1, k2, v, lam, scale):
    p = attn_probs(q1, k1, scale) - lam * attn_probs(q2, k2, scale)
    return jnp.einsum('bkgqt,bktd->bkgqd', p.astype(v.dtype), v)


def sweep_query_blocks(fn, *qs):
    b, kh, g, s, _ = qs[0].shape
    nb = s // Q_BLOCK
    blocks = tuple(jnp.moveaxis(q.reshape(b, kh, g, nb, Q_BLOCK, q.shape[-1]), 3, 0) for q in qs)
    out = lax.map(lambda blk: fn(*blk), blocks)
    return jnp.moveaxis(out, 0, 3).reshape(b, kh, g, s, out.shape[-1])


def centred_depthwise_conv(x, w, b):
    k = w.shape[-1]
    rhs = jnp.transpose(w)[:, None, :].astype(x.dtype)
    y = lax.conv_general_dilated(x, rhs, window_strides=(1,), padding=[((k - 1) // 2, k // 2)],
                                 dimension_numbers=('NWC', 'WIO', 'NWC'), feature_group_count=x.shape[-1])
    return y + b.astype(x.dtype)


def seq_flip(t, d):
    return jnp.flip(t, axis=1) if d else t


def segsum_exp(a_cs):
    n = a_cs.shape[-1]
    diff = a_cs[..., :, None] - a_cs[..., None, :]
    mask = jnp.tril(jnp.ones((n, n), dtype=bool))
    return jnp.where(mask, jnp.exp(jnp.where(mask, diff, 0.0)), 0.0)


def ssd_chunked_scan(x, a, bm, cm, h0):
    b, s, h, p = x.shape
    n = bm.shape[-1]
    nc = s // SSD_CHUNK
    xc = x.reshape(b, nc, SSD_CHUNK, h, p)
    bc = bm.reshape(b, nc, SSD_CHUNK, h, n)
    cc = cm.reshape(b, nc, SSD_CHUNK, h, n)
    a_cs = jnp.cumsum(jnp.moveaxis(a.reshape(b, nc, SSD_CHUNK, h), -1, 1), axis=-1)
    scores = jnp.einsum('bclhn,bcshn->bhcls', cc, bc) * segsum_exp(a_cs)
    y_diag = jnp.einsum('bhcls,bcshp->bclhp', scores, xc)
    to_end = jnp.exp(a_cs[..., -1:] - a_cs)
    chunk_states = jnp.einsum('bclhn,bhcl,bclhp->bchpn', bc, to_end, xc)
    chunk_decay = jnp.exp(a_cs[..., -1])

    def step(h_prev, inp):
        st, dec = inp
        return h_prev * dec[..., None, None] + st, h_prev

    h_final, h_starts = lax.scan(step, h0, (jnp.moveaxis(chunk_states, 1, 0), jnp.moveaxis(chunk_decay, -1, 0)))
    h_starts = jnp.moveaxis(h_starts, 0, 1)
    y_off = jnp.einsum('bclhn,bchpn,bhcl->bclhp', cc, h_starts, jnp.exp(a_cs))
    return (y_diag + y_off).reshape(b, s, h, p), h_final


def ssd_mixer(u, uc, conv_w, conv_b, dt_bias, a_log, d_skip, norm_g, with_ctx):
    a_neg = -jnp.exp(a_log.astype(jnp.float32))
    d_skip = d_skip.astype(jnp.float32)

    def prep(v):
        bsz, s = v.shape[:2]
        z, xbc, dt = jnp.split(v, [SSD_INNER, SSD_INNER + SSD_CONV_CH], axis=-1)
        xbc = jax.nn.silu(centred_depthwise_conv(xbc, conv_w, conv_b)).astype(jnp.float32)
        xs, bm, cm = jnp.split(xbc, [SSD_INNER, SSD_INNER + SSD_GROUPS * SSD_STATE], axis=-1)
        rep = SSD_HEADS // SSD_GROUPS
        xs = xs.reshape(bsz, s, SSD_HEADS, SSD_HEAD_DIM)
        bm = jnp.repeat(bm.reshape(bsz, s, SSD_GROUPS, SSD_STATE), rep, axis=2)
        cm = jnp.repeat(cm.reshape(bsz, s, SSD_GROUPS, SSD_STATE), rep, axis=2)
        dt = jax.nn.softplus(dt.astype(jnp.float32).reshape(bsz, s, 2, SSD_HEADS) + dt_bias.astype(jnp.float32))
        return z, xs, bm, cm, dt

    z, xs, bm, cm, dt = prep(u)
    zc, xsc, bmc, cmc, dtc = prep(uc)
    bsz = u.shape[0]
    y = jnp.zeros_like(xs)
    yc = jnp.zeros_like(xsc)
    for d in range(2):
        h0 = jnp.zeros((bsz, SSD_HEADS, SSD_HEAD_DIM, SSD_STATE), jnp.float32)
        ycd, h_ctx = ssd_chunked_scan(seq_flip(xsc * dtc[:, :, d, :, None], d), seq_flip(dtc[:, :, d] * a_neg[d], d),
                                      seq_flip(bmc, d), seq_flip(cmc, d), h0)
        yld, _ = ssd_chunked_scan(seq_flip(xs * dt[:, :, d, :, None], d), seq_flip(dt[:, :, d] * a_neg[d], d),
                                  seq_flip(bm, d), seq_flip(cm, d), h_ctx)
        y = y + seq_flip(yld, d) + d_skip[d][:, None] * xs
        if with_ctx:
            yc = yc + seq_flip(ycd, d) + d_skip[d][:, None] * xsc

    def finish(yy, zz):
        b_, s_ = yy.shape[:2]
        gated = yy.reshape(b_, s_, SSD_INNER) * jax.nn.silu(zz.astype(jnp.float32))
        return rmsnorm(gated, norm_g).astype(zz.dtype)

    return finish(y, z), (finish(yc, zc) if with_ctx else None)


def diff_mixer(u, uc, lam_params, norm_g, lam_init, rope, with_ctx):
    qk_cols = 2 * DIFF_HEADS * DIFF_QK_DIM

    def prep(v, positional, need_q):
        bsz, s = v.shape[:2]
        q, k, val = jnp.split(v, [qk_cols, 2 * qk_cols], axis=-1)
        k = k.reshape(bsz, s, DIFF_HEADS, 2, DIFF_QK_DIM).transpose(3, 0, 2, 1, 4)
        q = q.reshape(bsz, s, DIFF_HEADS, 2, DIFF_QK_DIM).transpose(3, 0, 2, 1, 4) if need_q else None
        if positional:
            q = apply_rope(q, *rope)
            k = apply_rope(k, *rope)
        val = val.reshape(bsz, s, DIFF_HEADS, DIFF_V_DIM).transpose(0, 2, 1, 3)
        return q, k, val

    q, k, v = prep(u, True, True)
    qc, kc, vc = prep(uc, False, with_ctx)
    lp = lam_params.astype(jnp.float32)
    lam = jnp.exp(jnp.sum(lp[0] * lp[1])) - jnp.exp(jnp.sum(lp[2] * lp[3])) + lam_init
    scale = DIFF_QK_DIM ** -0.5
    k_all = jnp.concatenate([kc, k], axis=-2)
    v_all = jnp.concatenate([vc, v], axis=-2)

    def core(q1, q2):
        return differential_attention(q1, q2, k_all[0], k_all[1], v_all, lam, scale)

    def finish(o):
        o = rmsnorm(o, norm_g) * (1.0 - lam_init)
        return o.transpose(0, 2, 1, 3).reshape(o.shape[0], o.shape[2], DIFF_WIDTH)

    y = finish(sweep_query_blocks(core, q[0][:, :, None], q[1][:, :, None])[:, :, 0])
    yc = None
    if with_ctx:
        yc = finish(differential_attention(qc[0][:, :, None], qc[1][:, :, None], kc[0], kc[1], vc, lam, scale)[:, :, 0])
    return y, yc


def gqa_mixer(u, uc, q_norm, k_norm, rope, with_ctx):
    grp = GQA_HEADS // GQA_KV_HEADS

    def prep(v, positional, need_q):
        bsz, s = v.shape[:2]
        q, k, val = jnp.split(v, [GQA_HEADS * HEAD_DIM, (GQA_HEADS + GQA_KV_HEADS) * HEAD_DIM], axis=-1)
        k = rmsnorm(k.reshape(bsz, s, GQA_KV_HEADS, HEAD_DIM), k_norm).transpose(0, 2, 1, 3)
        val = val.reshape(bsz, s, GQA_KV_HEADS, HEAD_DIM).transpose(0, 2, 1, 3)
        q = rmsnorm(q.reshape(bsz, s, GQA_KV_HEADS, grp, HEAD_DIM), q_norm).transpose(0, 2, 3, 1, 4) if need_q else None
        if positional:
            q = apply_rope(q, *rope)
            k = apply_rope(k, *rope)
        return q, k, val

    q, k, v = prep(u, True, True)
    qc, kc, vc = prep(uc, False, with_ctx)
    scale = HEAD_DIM ** -0.5
    k_all = jnp.concatenate([kc, k], axis=-2)
    v_all = jnp.concatenate([vc, v], axis=-2)

    def finish(o):
        return o.transpose(0, 3, 1, 2, 4).reshape(o.shape[0], o.shape[3], GQA_HEADS * HEAD_DIM)

    y = finish(sweep_query_blocks(lambda qb: softmax_attention(qb, k_all, v_all, scale), q))
    yc = finish(softmax_attention(qc, kc, vc, scale)) if with_ctx else None
    return y, yc


def mla_mixer(u, uc, q_norm, kv_norm, w_uq, w_ukv, rope, with_ctx):
    def prep(v, positional, need_q):
        bsz, s = v.shape[:2]
        cq, ckv, k_rope = jnp.split(v, [MLA_Q_LORA, MLA_Q_LORA + MLA_KV_LORA], axis=-1)
        kv = (rmsnorm(ckv, kv_norm) @ w_ukv).reshape(bsz, s, MLA_HEADS, MLA_NOPE + MLA_V_DIM).transpose(0, 2, 1, 3)
        k_nope, val = jnp.split(kv, [MLA_NOPE], axis=-1)
        k_rope = k_rope[:, None]
        q = None
        if need_q:
            q = (rmsnorm(cq, q_norm) @ w_uq).reshape(bsz, s, MLA_HEADS, MLA_NOPE + MLA_ROPE).transpose(0, 2, 1, 3)
            q_nope, q_rope = jnp.split(q, [MLA_NOPE], axis=-1)
            if positional:
                q_rope = apply_rope(q_rope, *rope)
            q = jnp.concatenate([q_nope, q_rope], axis=-1)[:, :, None]
        if positional:
            k_rope = apply_rope(k_rope, *rope)
        k = jnp.concatenate([k_nope, jnp.broadcast_to(k_rope, k_nope.shape[:-1] + (MLA_ROPE,))], axis=-1)
        return q, k, val

    q, k, v = prep(u, True, True)
    qc, kc, vc = prep(uc, False, with_ctx)
    scale = (MLA_NOPE + MLA_ROPE) ** -0.5
    k_all = jnp.concatenate([kc, k], axis=-2)
    v_all = jnp.concatenate([vc, v], axis=-2)

    def finish(o):
        o = o[:, :, 0]
        return o.transpose(0, 2, 1, 3).reshape(o.shape[0], o.shape[2], MLA_HEADS * MLA_V_DIM)

    y = finish(sweep_query_blocks(lambda qb: softmax_attention(qb, k_all, v_all, scale), q))
    yc = finish(softmax_attention(qc, kc, vc, scale)) if with_ctx else None
    return y, yc


def setup_inputs(seed: int = 0) -> dict:
    key = jax.random.key(seed)
    ks = jax.random.split(key, 32)
    f32 = jnp.float32

    def nrm(k, shape, scale):
        return jax.random.normal(k, shape, f32) * scale

    def gain(k, shape):
        return 1.0 + 0.05 * jax.random.normal(k, shape, f32)

    dt0 = jnp.exp(jax.random.uniform(ks[11], (DEPTH, 2, SSD_HEADS), f32, math.log(1e-3), math.log(1e-1)))
    return {
        "x": nrm(ks[0], (BATCH, SEQ, D_MODEL), 1.0),
        "c": nrm(ks[1], (BATCH, D_MODEL), 1.0),
        "ctx": nrm(ks[2], (BATCH, CTX_LEN, D_MODEL), 1.0),
        "c_ctx": nrm(ks[3], (D_MODEL,), 1.0),
        "mod_w": nrm(ks[4], (DEPTH, D_MODEL, 6 * D_MODEL), 0.5 * D_MODEL ** -0.5),
        "mod_b": nrm(ks[5], (DEPTH, 6 * D_MODEL), 0.02),
        "norm1_g": gain(ks[6], (DEPTH, D_MODEL)),
        "norm2_g": gain(ks[7], (DEPTH, D_MODEL)),
        "w_in": nrm(ks[8], (DEPTH, D_MODEL, IN_COLS), D_MODEL ** -0.5),
        "ssd_conv_w": nrm(ks[9], (DEPTH, SSD_CONV_CH, SSD_CONV), SSD_CONV ** -0.5),
        "ssd_conv_b": nrm(ks[10], (DEPTH, SSD_CONV_CH), 0.02),
        "ssd_dt_bias": dt0 + jnp.log(-jnp.expm1(-dt0)),
        "ssd_a_log": jnp.log(jax.random.uniform(ks[12], (DEPTH, 2, SSD_HEADS), f32, 1.0, 16.0)),
        "ssd_d": gain(ks[13], (DEPTH, 2, SSD_HEADS)),
        "ssd_norm_g": gain(ks[14], (DEPTH, SSD_INNER)),
        "diff_lambda": nrm(ks[15], (DEPTH, 4, DIFF_QK_DIM), 0.1),
        "diff_norm_g": gain(ks[16], (DEPTH, DIFF_V_DIM)),
        "gqa_q_norm": gain(ks[17], (DEPTH, HEAD_DIM)),
        "gqa_k_norm": gain(ks[18], (DEPTH, HEAD_DIM)),
        "mla_q_norm": gain(ks[19], (DEPTH, MLA_Q_LORA)),
        "mla_kv_norm": gain(ks[20], (DEPTH, MLA_KV_LORA)),
        "mla_w_uq": nrm(ks[21], (DEPTH, MLA_Q_LORA, MLA_HEADS * (MLA_NOPE + MLA_ROPE)), MLA_Q_LORA ** -0.5),
        "mla_w_ukv": nrm(ks[22], (DEPTH, MLA_KV_LORA, MLA_HEADS * (MLA_NOPE + MLA_V_DIM)), MLA_KV_LORA ** -0.5),
        "w_out": nrm(ks[23], (DEPTH, D_MIX, D_MODEL), D_MIX ** -0.5),
        "mlp_w1": nrm(ks[24], (DEPTH, D_MODEL, D_FF), D_MODEL ** -0.5),
        "mlp_w2": nrm(ks[25], (DEPTH, D_FF, D_MODEL), D_FF ** -0.5),
        "final_norm_g": gain(ks[26], (D_MODEL,)),
    }


def reference(x, c, ctx, c_ctx, mod_w, mod_b, norm1_g, norm2_g, w_in, ssd_conv_w, ssd_conv_b, ssd_dt_bias,
              ssd_a_log, ssd_d, ssd_norm_g, diff_lambda, diff_norm_g, gqa_q_norm, gqa_k_norm, mla_q_norm,
              mla_kv_norm, mla_w_uq, mla_w_ukv, w_out, mlp_w1, mlp_w2, final_norm_g):
    seq = x.shape[1]
    rope_head = axial_rope(seq, HEAD_DIM)
    rope_diff = axial_rope(seq, DIFF_QK_DIM)
    rope_mla = axial_rope(seq, MLA_ROPE)
    cond = jax.nn.silu(c)
    cond_ctx = jax.nn.silu(c_ctx)
    h, hc = x, ctx
    for i in range(DEPTH):
        with_ctx = i < DEPTH - 1
        lam_init = 0.8 - 0.6 * math.exp(-0.3 * i)
        mod = (cond @ mod_w[i] + mod_b[i])[:, None, :]
        mod_c = cond_ctx @ mod_w[i] + mod_b[i]
        sh1, sc1, g1, sh2, sc2, g2 = jnp.split(mod, 6, axis=-1)
        csh1, csc1, cg1, csh2, csc2, cg2 = jnp.split(mod_c, 6, axis=-1)

        u = modulate(rmsnorm(h, norm1_g[i]), sh1, sc1) @ w_in[i]
        uc = modulate(rmsnorm(hc, norm1_g[i]), csh1, csc1) @ w_in[i]
        u_ssd, u_diff, u_gqa, u_mla = jnp.split(u, COL_SPLITS, axis=-1)
        uc_ssd, uc_diff, uc_gqa, uc_mla = jnp.split(uc, COL_SPLITS, axis=-1)

        y_a, yc_a = ssd_mixer(u_ssd, uc_ssd, ssd_conv_w[i], ssd_conv_b[i], ssd_dt_bias[i], ssd_a_log[i],
                              ssd_d[i], ssd_norm_g[i], with_ctx)
        y_b, yc_b = diff_mixer(u_diff, uc_diff, diff_lambda[i], diff_norm_g[i], lam_init, rope_diff, with_ctx)
        y_c, yc_c = gqa_mixer(u_gqa, uc_gqa, gqa_q_norm[i], gqa_k_norm[i], rope_head, with_ctx)
        y_d, yc_d = mla_mixer(u_mla, uc_mla, mla_q_norm[i], mla_kv_norm[i], mla_w_uq[i], mla_w_ukv[i],
                              rope_mla, with_ctx)

        h = h + g1 * (jnp.concatenate([y_a, y_b, y_c, y_d], axis=-1) @ w_out[i])
        h = h + g2 * squared_relu_mlp(modulate(rmsnorm(h, norm2_g[i]), sh2, sc2), mlp_w1[i], mlp_w2[i])
        if with_ctx:
            hc = hc + cg1 * (jnp.concatenate([yc_a, yc_b, yc_c, yc_d], axis=-1) @ w_out[i])
            hc = hc + cg2 * squared_relu_mlp(modulate(rmsnorm(hc, norm2_g[i]), csh2, csc2), mlp_w1[i], mlp_w2[i])
    return rmsnorm(h, final_norm_g)
```

```cpp
#include <hip/hip_runtime.h>
#include <hip/hip_cooperative_groups.h>
#include <stdint.h>
#include <cstdio>
namespace cg = cooperative_groups;

typedef unsigned short bf16_t;
typedef short bf16x8 __attribute__((ext_vector_type(8)));
typedef short s16x4 __attribute__((ext_vector_type(4)));
typedef float f32x16 __attribute__((ext_vector_type(16)));
typedef float f32x4 __attribute__((ext_vector_type(4)));
typedef float f32x2 __attribute__((ext_vector_type(2)));
typedef unsigned u32x4 __attribute__((ext_vector_type(4)));
typedef unsigned u32x2 __attribute__((ext_vector_type(2)));
typedef __bf16 bf2_t __attribute__((ext_vector_type(2)));

#define DI __device__ __forceinline__
#define MFMA32(a, b, c) __builtin_amdgcn_mfma_f32_32x32x16_bf16((a), (b), (c), 0, 0, 0)

constexpr int DM = 1024, NB = 8, SEQ = 2048, DEPTH = 4, CT = 256, TT = 2304;
constexpr int MROWS = NB * SEQ, CROWS = NB * CT, ROWS = MROWS + CROWS;
constexpr int INC = 2408, INP = 2432, INPW = 2560, DFF = 4096;
constexpr float EPS = 1e-6f;
constexpr float LOG2E = 1.4426950408889634f;
constexpr int U_Z = 0, U_X = 256, U_B = 512, U_C = 640, U_DT = 768;
constexpr int U_DQ = 776, U_DK = 1032, U_DV = 1288;
constexpr int U_GQ = 1544, U_GK = 1800, U_GV = 1928;
constexpr int U_MQ = 2056, U_MKV = 2248, U_MR = 2376;

constexpr size_t al256(size_t x) { return (x + 255) & ~(size_t)255; }
constexpr size_t SZ_WIN = (size_t)DEPTH * INPW * DM * 2;
constexpr size_t SZ_WOUT = (size_t)DEPTH * DM * DM * 2;
constexpr size_t SZ_W1 = (size_t)DEPTH * DFF * DM * 2;
constexpr size_t SZ_W2 = (size_t)DEPTH * DM * DFF * 2;
constexpr size_t SZ_WUQ = (size_t)DEPTH * 384 * 192 * 2;
constexpr size_t SZ_WUKV = (size_t)DEPTH * 512 * 128 * 2;
constexpr size_t SZ_MOD = (size_t)DEPTH * 9 * 6144 * 4;
constexpr size_t SZ_MISC = 8192;
constexpr size_t SZ_ROPEH = (size_t)SEQ * 32 * 8;
constexpr size_t SZ_ROPED = (size_t)SEQ * 16 * 8;
constexpr size_t SZ_HC = (size_t)CROWS * DM * 4;
constexpr size_t SZ_XN = (size_t)ROWS * DM * 2;
constexpr size_t SZ_U = (size_t)ROWS * INP * 2;
constexpr size_t SZ_QD = (size_t)NB * 8 * TT * 32 * 2;
constexpr size_t SZ_VT4 = (size_t)NB * 4 * 64 * TT * 2;
constexpr size_t SZ_QG = (size_t)NB * 4 * TT * 64 * 2;
constexpr size_t SZ_KG = (size_t)NB * 2 * TT * 64 * 2;
constexpr size_t SZ_QM = (size_t)NB * 4 * TT * 96 * 2;
constexpr size_t SZ_Y = (size_t)ROWS * DM * 2;

constexpr size_t OFF_MOD = 0;
constexpr size_t OFF_MISC = OFF_MOD + al256(SZ_MOD);
constexpr size_t OFF_WIN = OFF_MISC + SZ_MISC;
constexpr size_t OFF_WOUT = OFF_WIN + al256(SZ_WIN);
constexpr size_t OFF_W1 = OFF_WOUT + al256(SZ_WOUT);
constexpr size_t OFF_W2 = OFF_W1 + al256(SZ_W1);
constexpr size_t OFF_WUQ = OFF_W2 + al256(SZ_W2);
constexpr size_t OFF_WUKV = OFF_WUQ + al256(SZ_WUQ);
constexpr size_t OFF_ROPEH = OFF_WUKV + al256(SZ_WUKV);
constexpr size_t OFF_ROPED = OFF_ROPEH + al256(SZ_ROPEH);
constexpr size_t OFF_HC = OFF_ROPED + al256(SZ_ROPED);
constexpr size_t OFF_XN = OFF_HC + al256(SZ_HC);
constexpr size_t OFF_BIG = OFF_XN + al256(SZ_XN);
constexpr size_t OFF_U = OFF_BIG;
constexpr size_t OFF_QD = OFF_U + al256(SZ_U);
constexpr size_t OFF_KD = OFF_QD + al256(SZ_QD);
constexpr size_t OFF_VTD = OFF_KD + al256(SZ_QD);
constexpr size_t OFF_QG = OFF_VTD + al256(SZ_VT4);
constexpr size_t OFF_KG = OFF_QG + al256(SZ_QG);
constexpr size_t OFF_VTG = OFF_KG + al256(SZ_KG);
constexpr size_t OFF_QM = OFF_VTG + al256(SZ_KG);
constexpr size_t OFF_KM = OFF_QM + al256(SZ_QM);
constexpr size_t OFF_VTM = OFF_KM + al256(SZ_QM);
constexpr size_t OFF_Y = OFF_VTM + al256(SZ_VT4);
constexpr size_t SZ_SS = (size_t)64 * 37 * 16384;
constexpr size_t SZ_DEC = (size_t)64 * 36 * 4;
constexpr size_t SZ_ECL = (size_t)8 * ROWS * 4;
constexpr size_t SZ_CB = (size_t)ROWS * 128 * 2;
constexpr size_t OFF_SS = OFF_Y + al256(SZ_Y);
constexpr size_t OFF_DEC = OFF_SS + al256(SZ_SS);
constexpr size_t OFF_ECL = OFF_DEC + al256(SZ_DEC);
constexpr size_t OFF_CB = OFF_ECL + al256(SZ_ECL);
constexpr size_t OFF_END = OFF_CB + al256(SZ_CB);
static_assert(OFF_END <= (size_t)402653184, "workspace budget (4 x mod_w)");
constexpr size_t OFF_HM = OFF_BIG;
static_assert((size_t)ROWS * DFF * 2 <= OFF_Y - OFF_BIG, "HM overlay must not reach Y");
static_assert((size_t)2 * ROWS * 256 * 4 <= SZ_XN, "Yssd overlay");

struct Params {
  const float* in[27];
  float* out;
  char* ws;
};
enum { I_X = 0, I_C, I_CTX, I_CCTX, I_MODW, I_MODB, I_N1G, I_N2G, I_WIN, I_CONVW, I_CONVB, I_DTB, I_ALOG, I_SSDD, I_SSDNG,
       I_DLAM, I_DNG, I_GQN, I_GKN, I_MQN, I_MKVN, I_WUQ, I_WUKV, I_WOUT, I_W1, I_W2, I_FNG };

constexpr int SMEM_BYTES = 65536;
constexpr int LDS_BYTES = 131072, NTHREADS = 512;
#ifndef PROBE_DOWN
#define PROBE_DOWN 0
#endif
#ifndef PROBE_OUT
#define PROBE_OUT 0
#endif
#ifndef PROBE_P0
#define PROBE_P0 1
#endif
#ifndef PROBE_N1
#define PROBE_N1 1
#endif
#ifndef PROBE_FIN
#define PROBE_FIN 1
#endif
#ifndef PROBE_UP
#define PROBE_UP 1
#endif
#ifndef PROBE_PREP
#define PROBE_PREP 1
#endif
#ifndef PROBE_MIX
#define PROBE_MIX 1
#endif
#ifndef PROBE_INPROJ
#define PROBE_INPROJ 1
#endif

DI unsigned pk_bf16(float a, float b) { f32x2 v = {a, b}; bf2_t r = __builtin_convertvector(v, bf2_t); return __builtin_bit_cast(unsigned, r); }
DI bf16_t f2bf(float a) { return (bf16_t)(pk_bf16(a, 0.f) & 0xffffu); }
DI float bf2f(bf16_t v) { return __uint_as_float((unsigned)v << 16); }
DI float bflo(unsigned w) { return __uint_as_float(w << 16); }
DI float bfhi(unsigned w) { return __uint_as_float(w & 0xffff0000u); }
DI float silu_f(float x) { return x / (1.f + __expf(-x)); }
DI float wave_sum(float v) {
#pragma unroll
  for (int o = 32; o >= 1; o >>= 1) v += __shfl_xor(v, o);
  return v;
}
DI int crow(int r, int hi) { return (r & 3) + 8 * (r >> 2) + 4 * hi; }
DI bf16x8 pack8(float a0, float a1, float a2, float a3, float a4, float a5, float a6, float a7) {
  u32x4 p; p.x = pk_bf16(a0, a1); p.y = pk_bf16(a2, a3); p.z = pk_bf16(a4, a5); p.w = pk_bf16(a6, a7);
  return __builtin_bit_cast(bf16x8, p);
}
DI f32x16 zero16() { f32x16 z;
#pragma unroll
  for (int i = 0; i < 16; ++i) z[i] = 0.f;
  return z; }
DI int otid() { int t = threadIdx.x & 255; asm volatile("" : "+v"(t)); return t; }
DI int otid_full() { int t = threadIdx.x; asm volatile("" : "+v"(t)); return t; }
DI int half_id() { return __builtin_amdgcn_readfirstlane((int)threadIdx.x >> 8); }
DI int hrow_of(int b, int pos) { return pos < CT ? (MROWS + b * CT + pos) : (b * SEQ + pos - CT); }

DI void tconv_tile(const float* __restrict__ src, int K, int N, bf16_t* __restrict__ dst, int kt, int nt, unsigned* sT) {
  const int tid = otid();
#pragma unroll
  for (int p = 0; p < 2; ++p) {
    const int idx = tid + 256 * p, kp = idx >> 4, nc = idx & 15;
    const int k = kt * 64 + 2 * kp, n = nt * 64 + nc * 4;
    f32x4 v0 = {0.f, 0.f, 0.f, 0.f}, v1 = {0.f, 0.f, 0.f, 0.f};
    if (n < N) { v0 = *(const f32x4*)(src + (size_t)k * N + n); v1 = *(const f32x4*)(src + (size_t)(k + 1) * N + n); }
#pragma unroll
    for (int e = 0; e < 4; ++e) sT[(nc * 4 + e) * 33 + kp] = pk_bf16(v0[e], v1[e]);
  }
  __syncthreads();
  {
    const int n = tid >> 2, part = tid & 3;
    u32x4 a, b;
    const unsigned* s = sT + n * 33 + part * 8;
    a.x = s[0]; a.y = s[1]; a.z = s[2]; a.w = s[3]; b.x = s[4]; b.y = s[5]; b.z = s[6]; b.w = s[7];
    bf16_t* d = dst + (size_t)(nt * 64 + n) * K + kt * 64 + part * 16;
    *(u32x4*)d = a; *(u32x4*)(d + 8) = b;
  }
  __syncthreads();
}

DI void mod_task(const Params& p, int task, float* sCond) {
  const int tid = otid();
  const int ks = task & 7, cb = (task >> 3) % 24, l = task / 192;
  for (int i = tid; i < 9 * 128; i += 256) {
    const int r = i >> 7, kk = i & 127;
    const float v = (r < 8) ? p.in[I_C][r * DM + ks * 128 + kk] : p.in[I_CCTX][ks * 128 + kk];
    sCond[i] = silu_f(v);
  }
  __syncthreads();
  const int col = cb * 256 + tid;
  const float* w = p.in[I_MODW] + ((size_t)l * DM + ks * 128) * 6144 + col;
  float acc[9];
#pragma unroll
  for (int r = 0; r < 9; ++r) acc[r] = 0.f;
#pragma unroll 8
  for (int kk = 0; kk < 128; ++kk) {
    const float wv = w[(size_t)kk * 6144];
#pragma unroll
    for (int r = 0; r < 9; ++r) acc[r] += sCond[r * 128 + kk] * wv;
  }
  const float bias = (ks == 0) ? p.in[I_MODB][l * 6144 + col] : 0.f;
  float* MODP = (float*)(p.ws + OFF_Y) + (size_t)ks * (DEPTH * 9 * 6144);
#pragma unroll
  for (int r = 0; r < 9; ++r) MODP[(size_t)(l * 9 + r) * 6144 + col] = acc[r] + bias;
  __syncthreads();
}

DI void phase0(const Params& p, char* smem) {
  constexpr int T_WIN = DEPTH * 16 * 38, T_WOUT = DEPTH * 16 * 16, T_W1 = DEPTH * 16 * 64, T_W2 = DEPTH * 64 * 16;
  constexpr int T_UQ = DEPTH * 3 * 6, T_UKV = DEPTH * 2 * 8, T_MOD = 768, T_ROPE = (SEQ * 48) / 256, T_MISC = 1;
  constexpr int E0 = T_WIN, E1 = E0 + T_WOUT, E2 = E1 + T_W1, E3 = E2 + T_W2, E4 = E3 + T_UQ, E5 = E4 + T_UKV, E6 = E5 + T_MOD, E7 = E6 + T_ROPE, E8 = E7 + T_MISC;
  const int tid = otid();
  const int half = half_id(); smem += half * SMEM_BYTES;
  static_assert(E0 % 2 == 0 && E1 % 2 == 0 && E2 % 2 == 0 && E3 % 2 == 0 && E4 % 2 == 0 && E5 % 2 == 0 && E6 % 2 == 0 && E7 % 2 == 0, "half-block pairs must not straddle task types");
  for (int t0 = blockIdx.x * 2; t0 < E8; t0 += gridDim.x * 2) {
    const int t = t0 + half;
    if (t >= E8) break;
    if (t < E0) { const int l = t / (16 * 38), r = t % (16 * 38); tconv_tile(p.in[I_WIN] + (size_t)l * DM * INC, DM, INC, (bf16_t*)(p.ws + OFF_WIN) + (size_t)l * INPW * DM, r / 38, r % 38, (unsigned*)smem); }
    else if (t < E1) { const int u = t - E0, l = u / 256, r = u % 256; tconv_tile(p.in[I_WOUT] + (size_t)l * DM * DM, DM, DM, (bf16_t*)(p.ws + OFF_WOUT) + (size_t)l * DM * DM, r / 16, r % 16, (unsigned*)smem); }
    else if (t < E2) { const int u = t - E1, l = u / 1024, r = u % 1024; tconv_tile(p.in[I_W1] + (size_t)l * DM * DFF, DM, DFF, (bf16_t*)(p.ws + OFF_W1) + (size_t)l * DFF * DM, r / 64, r % 64, (unsigned*)smem); }
    else if (t < E3) { const int u = t - E2, l = u / 1024, r = u % 1024; tconv_tile(p.in[I_W2] + (size_t)l * DFF * DM, DFF, DM, (bf16_t*)(p.ws + OFF_W2) + (size_t)l * DM * DFF, r / 16, r % 16, (unsigned*)smem); }
    else if (t < E4) { const int u = t - E3, l = u / 18, r = u % 18; tconv_tile(p.in[I_WUQ] + (size_t)l * 192 * 384, 192, 384, (bf16_t*)(p.ws + OFF_WUQ) + (size_t)l * 384 * 192, r / 6, r % 6, (unsigned*)smem); }
    else if (t < E5) { const int u = t - E4, l = u / 16, r = u % 16; tconv_tile(p.in[I_WUKV] + (size_t)l * 128 * 512, 128, 512, (bf16_t*)(p.ws + OFF_WUKV) + (size_t)l * 512 * 128, r / 8, r % 8, (unsigned*)smem); }
    else if (t < E6) { mod_task(p, t - E5, (float*)smem); }
    else if (t < E7) {
      const int idx = (t - E6) * 256 + tid;
      int tt, i, nf; f32x2* dst;
      if (idx < SEQ * 32) { tt = idx >> 5; i = idx & 31; nf = 16; dst = (f32x2*)(p.ws + OFF_ROPEH) + idx; }
      else { const int j = idx - SEQ * 32; tt = j >> 4; i = j & 15; nf = 8; dst = (f32x2*)(p.ws + OFF_ROPED) + j; }
      const int f = i & (nf - 1);
      const float pos = (float)((i < nf) ? (tt >> 6) : (tt & 63));
      const float inv = exp2f(-(float)f * (13.287712379549449f / (float)nf));
      float rv = pos * inv * 0.15915494309189535f; rv -= rintf(rv);
      f32x2 cs; cs.x = __builtin_amdgcn_cosf(rv); cs.y = __builtin_amdgcn_sinf(rv);
      *dst = cs;
    } else {
      if (tid < DEPTH) {
        const float* lp = p.in[I_DLAM] + tid * 128;
        float s1 = 0.f, s2 = 0.f;
        for (int i = 0; i < 32; ++i) { s1 += lp[i] * lp[32 + i]; s2 += lp[64 + i] * lp[96 + i]; }
        const float li = 0.8f - 0.6f * expf(-0.3f * (float)tid);
        float* misc = (float*)(p.ws + OFF_MISC);
        misc[128 + tid] = expf(s1) - expf(s2) + li;
        misc[136 + tid] = li;
      }
    }
  }
}

DI void mod_reduce(const Params& p) {
  const float* MODP = (const float*)(p.ws + OFF_Y);
  float* MOD = (float*)(p.ws + OFF_MOD);
  constexpr int NTOT = DEPTH * 9 * 6144;
  for (int i = blockIdx.x * NTHREADS + otid_full(); i < NTOT; i += gridDim.x * NTHREADS) {
    float a = 0.f;
#pragma unroll
    for (int ks = 0; ks < 8; ++ks) a += MODP[(size_t)ks * NTOT + i];
    MOD[i] = a;
  }
}

DI void norm_phase(const Params& p, int layer, int which, int nrows, const float* pend_gate = nullptr, const float* pend_hin = nullptr) {
  constexpr int NR = 3;
  const int tid_ = otid_full(); const int lane = tid_ & 63, wave = tid_ >> 6;
  const int gw = blockIdx.x * 8 + wave, nw = gridDim.x * 8;
  const float* MOD = (const float*)(p.ws + OFF_MOD);
  bf16_t* XN = (bf16_t*)(p.ws + OFF_XN);
  const float* g = (which == 0 ? p.in[I_N1G] : which == 1 ? p.in[I_N2G] : p.in[I_FNG]) + (which == 2 ? 0 : layer * DM);
  f32x4 gv[4];
#pragma unroll
  for (int i = 0; i < 4; ++i) gv[i] = *(const f32x4*)(g + i * 256 + lane * 4);
  for (int row0 = gw; row0 < nrows; row0 += nw * NR) {
    f32x4 v[NR][4];
    float ss[NR];
#pragma unroll
    for (int j = 0; j < NR; ++j) {
      const int row = row0 + j * nw;
      ss[j] = 0.f;
      if (row < nrows) {
        if (pend_gate != nullptr && row >= MROWS) {
          const size_t ro = (size_t)(row - MROWS) * DM;
          const float* P = (const float*)(p.ws + OFF_SS) + ro;
#pragma unroll
          for (int i = 0; i < 4; ++i) {
            const int c = i * 256 + lane * 4;
            const f32x4 a = *(const f32x4*)(P + c), b2 = *(const f32x4*)(P + (size_t)CROWS * DM + c), c2 = *(const f32x4*)(P + (size_t)2 * CROWS * DM + c), d2 = *(const f32x4*)(P + (size_t)3 * CROWS * DM + c);
            v[j][i] = *(const f32x4*)(pend_hin + ro + c) + *(const f32x4*)(pend_gate + c) * (((a + b2) + c2) + d2);
          }
        } else {
          const float* h;
          if (row < MROWS) h = ((which == 0 && layer == 0) ? p.in[I_X] : p.out) + (size_t)row * DM;
          else h = ((which == 0 && layer == 0) ? p.in[I_CTX] : (const float*)(p.ws + OFF_HC)) + (size_t)(row - MROWS) * DM;
#pragma unroll
          for (int i = 0; i < 4; ++i) v[j][i] = *(const f32x4*)(h + i * 256 + lane * 4);
        }
      } else {
#pragma unroll
        for (int i = 0; i < 4; ++i) v[j][i] = (f32x4){0.f, 0.f, 0.f, 0.f};
      }
    }
#pragma unroll
    for (int j = 0; j < NR; ++j) {
      const int row = row0 + j * nw;
      if (row >= nrows) continue;
      if (pend_gate != nullptr && row >= MROWS) {
        float* hc = (float*)(p.ws + OFF_HC) + (size_t)(row - MROWS) * DM;
#pragma unroll
        for (int i = 0; i < 4; ++i) *(f32x4*)(hc + i * 256 + lane * 4) = v[j][i];
      }
#pragma unroll
      for (int i = 0; i < 4; ++i) ss[j] += v[j][i][0] * v[j][i][0] + v[j][i][1] * v[j][i][1] + v[j][i][2] * v[j][i][2] + v[j][i][3] * v[j][i][3];
      const float rstd = rsqrtf(wave_sum(ss[j]) * (1.f / DM) + EPS);
      if (which == 2) {
#pragma unroll
        for (int i = 0; i < 4; ++i) { f32x4 o = v[j][i] * rstd * gv[i]; *(f32x4*)(p.out + (size_t)row * DM + i * 256 + lane * 4) = o; }
      } else {
        const int bidx = row < MROWS ? (row >> 11) : 8;
        const float* sh = MOD + (size_t)(layer * 9 + bidx) * 6144 + which * 3072;
        const float* sc = sh + 1024;
#pragma unroll
        for (int i = 0; i < 4; ++i) {
          const int c = i * 256 + lane * 4;
          const f32x4 shv = *(const f32x4*)(sh + c), scv = *(const f32x4*)(sc + c);
          f32x4 o = v[j][i] * rstd * gv[i] * (1.f + scv) + shv;
          u32x2 w; w.x = pk_bf16(o[0], o[1]); w.y = pk_bf16(o[2], o[3]);
          *(u32x2*)(XN + (size_t)row * DM + c) = w;
        }
      }
    }
  }
}

namespace pg8 {
#define PG8_LAS __attribute__((address_space(3)))
typedef unsigned short bf16_t;
typedef short bf16x8 __attribute__((ext_vector_type(8)));
typedef float f32x4 __attribute__((ext_vector_type(4)));
typedef unsigned u32x4 __attribute__((ext_vector_type(4)));
constexpr int BM = 256, BK = 64, HALF = 128, HTB = HALF * BK * 2  , STAGE_BYTES = 8 * HTB, NXCD = 8, WGM = 8;

__host__ __device__ __forceinline__ int lds_byte(int r, int c) { const int st = (r >> 4) * 2 + (c >> 5), rr = r & 15, cc = c & 31, ob = rr * 64 + cc * 2; return st * 1024 + (ob ^ (((ob >> 9) & 1) << 5)); }
__host__ __device__ __forceinline__ void stage_rc(int b, int& R, int& C) { const int st = b / 1024, sb = b % 1024, swz = sb ^ (((sb >> 9) & 1) << 5); R = (st >> 1) * 16 + swz / 64; C = (st & 1) * 32 + (swz % 64) / 2; }
__host__ __device__ __forceinline__ int perm32(int rho) { const int n = rho >> 4, i = rho & 15; return 8 * (i >> 2) + 4 * n + (i & 3); }

struct Unit { int pm, pn; };
struct Gemm { const bf16_t* A; const bf16_t* Bt; int M, N, K, Kloop; };

struct StaticOrder {
    int nM, nN, nwg, G, c;
    __host__ __device__ void init(int M, int N, int G_, int c_) { nM = M / BM; nN = N / BM; nwg = nM * nN; G = G_; c = c_; }
    __host__ __device__ bool next(int i, Unit& u) const {
        const long L = (long)i * G + c; if (L >= nwg) return false;
        int wgid = (int)L; { const int q = nwg / NXCD, r = nwg % NXCD, xcd = wgid % NXCD, off = wgid / NXCD; wgid = (xcd < r ? xcd * (q + 1) : r * (q + 1) + (xcd - r) * q) + off; }
        const int nig = WGM * nN, gid = wgid / nig, fm = gid * WGM, gsz = (nM - fm) < WGM ? (nM - fm) : WGM;
        u.pm = fm + ((wgid % nig) % gsz); u.pn = (wgid % nig) / gsz; return true;
    }
    __device__ __forceinline__ void a_ready(const Unit&) const {}
    __device__ __forceinline__ void done(const Unit&) const {}
};


struct SplitOrder {
    int c;
    __host__ __device__ bool next(int i, Unit& u) const { if (i != 0 || c >= 128) return false; const int q = c & 31; u.pm = q & 7; u.pn = q >> 3; return true; }
    __device__ __forceinline__ void a_ready(const Unit&) const {}
    __device__ __forceinline__ void done(const Unit&) const {}
};
struct EpiPartial {
    static constexpr bool PERM = false, AFTER_DRAIN = false;
    float* P;
    __device__ __forceinline__ void operator()(const f32x4 (&acc)[2][2][4][2], const Unit& u, int wr, int wc, int fr, int fq) const {
        float* base = P + (size_t)u.pm * BM * 1024;
        const int col0 = u.pn * BM + wc * 32 + 4 * fq;
#pragma unroll
        for (int bj = 0; bj < 2; ++bj)
#pragma unroll
            for (int n = 0; n < 2; ++n)
#pragma unroll
                for (int ai = 0; ai < 2; ++ai)
#pragma unroll
                    for (int m = 0; m < 4; ++m) *(f32x4*)(base + (size_t)(ai * HALF + wr * 64 + m * 16 + fr) * 1024 + col0 + bj * HALF + n * 16) = acc[ai][bj][m][n];
    }
};
template <int ACT> struct EpiStore {
    static constexpr bool PERM = true, AFTER_DRAIN = false;
    bf16_t* O; int ldc; int ncols;
    __device__ __forceinline__ void operator()(const f32x4 (&acc)[2][2][4][2], const Unit& u, int wr, int wc, int fr, int fq) const {
        const int row0 = u.pm * BM + wr * 64 + fr, col0 = u.pn * BM + wc * 32 + 8 * fq;
#pragma unroll
        for (int ai = 0; ai < 2; ++ai)
#pragma unroll
            for (int m = 0; m < 4; ++m) { bf16_t* rowp = O + (size_t)(row0 + ai * HALF + m * 16) * ldc + col0;
#pragma unroll
                for (int bj = 0; bj < 2; ++bj) { if (col0 + bj * HALF < ncols) { f32x4 v0 = acc[ai][bj][m][0], v1 = acc[ai][bj][m][1];
                    if (ACT == 1) { v0 = __builtin_elementwise_max(v0, (f32x4){0.f, 0.f, 0.f, 0.f}); v1 = __builtin_elementwise_max(v1, (f32x4){0.f, 0.f, 0.f, 0.f}); v0 = v0 * v0; v1 = v1 * v1; }
                    u32x4 w; w.x = ::pk_bf16(v0[0], v0[1]); w.y = ::pk_bf16(v0[2], v0[3]); w.z = ::pk_bf16(v1[0], v1[1]); w.w = ::pk_bf16(v1[2], v1[3]);
                    *(u32x4*)(rowp + bj * HALF) = w; } } }
    }
};
struct EpiResid {
    static constexpr bool PERM = false, AFTER_DRAIN = false;
    const float* hin_m; const float* hin_c; float* hout_m; float* hout_c; const float* gate; float gscale;
    __device__ __forceinline__ void operator()(const f32x4 (&acc)[2][2][4][2], const Unit& u, int wr, int wc, int fr, int fq) const {
        const bool ismain = u.pm < 64;
        const float* hin = ismain ? hin_m + (size_t)u.pm * BM * 1024 : hin_c + (size_t)(u.pm - 64) * BM * 1024;
        float* hout = ismain ? hout_m + (size_t)u.pm * BM * 1024 : hout_c + (size_t)(u.pm - 64) * BM * 1024;
        const float* g = gate + (size_t)(ismain ? (u.pm >> 3) : 8) * 6144;
        const int col0 = u.pn * BM + wc * 32 + 4 * fq;
#pragma unroll
        for (int bj = 0; bj < 2; ++bj)
#pragma unroll
            for (int n = 0; n < 2; ++n) { const f32x4 gv = *(const f32x4*)(g + col0 + bj * HALF + n * 16) * gscale;
#pragma unroll
                for (int ai = 0; ai < 2; ++ai)
#pragma unroll
                    for (int m = 0; m < 4; ++m) { const size_t off = (size_t)(ai * HALF + wr * 64 + m * 16 + fr) * 1024 + col0 + bj * HALF + n * 16;
                        *(f32x4*)(hout + off) = *(const f32x4*)(hin + off) + gv * acc[ai][bj][m][n]; } }
    }
};
template <class Epi, class Sched, bool ALIGN_EPI = false, bool SP2 = false>
__device__ __forceinline__ void gemm_phase(PG8_LAS unsigned char* lds, const Gemm g, const Sched& S, const Epi& E) {
    const int tid = ::otid_full(), wid = __builtin_amdgcn_readfirstlane(tid >> 6), lane = tid & 63, wr = wid >> 2, wc = wid & 3, fr = lane & 15, fq = lane >> 4;
    const int K = g.K, nt = g.Kloop / BK;
    unsigned voffA[2], voffB[2];
#pragma unroll
    for (int i = 0; i < 2; ++i) { int R, C; stage_rc(tid * 16 + i * 8192, R, C); const int Rb = Epi::PERM ? ((R & ~31) + perm32(R & 31)) : R;
        voffA[i] = (unsigned)(R * K + C) * 2u; voffB[i] = (unsigned)(Rb * K + C) * 2u; }
    const size_t kstep = (size_t)(BK * 2);
    const size_t hstep = (size_t)HALF * K * 2;
    const size_t tstep = 2 * hstep;
    const unsigned ldsw = (unsigned)wid * 1024u;
    const int aoff = lds_byte(wr * 64 + fr, fq * 8), boff = lds_byte(wc * 32 + fr, fq * 8);
#define PG8_SA(b, h) (((b) * 2 + (h)) * HTB)
#define PG8_SB(b, h) ((4 + (b) * 2 + (h)) * HTB)
#define PG8_STAGE(bufoff, gbase, voff) do { _Pragma("unroll") for (int _i = 0; _i < 2; ++_i) \
        __builtin_amdgcn_global_load_lds((const unsigned*)((const char*)(gbase) + (voff)[_i]), (PG8_LAS unsigned*)(lds + (bufoff) + ldsw + _i * 8192), 16, 0, 0); } while (0)
#define PG8_LDA(dst, b, h) do { _Pragma("unroll") for (int m = 0; m < 4; ++m) _Pragma("unroll") for (int k = 0; k < 2; ++k) dst[m][k] = *(const PG8_LAS bf16x8*)(lds + PG8_SA(b, h) + aoff + m * 2048 + k * 1024); } while (0)
#define PG8_LDB(dst, b, h) do { _Pragma("unroll") for (int n = 0; n < 2; ++n) _Pragma("unroll") for (int k = 0; k < 2; ++k) dst[n][k] = *(const PG8_LAS bf16x8*)(lds + PG8_SB(b, h) + boff + n * 2048 + k * 1024); } while (0)
#define PG8_MMA(ai, bj, At, Bt) do { __builtin_amdgcn_s_setprio(1); _Pragma("unroll") for (int m = 0; m < 4; ++m) _Pragma("unroll") for (int n = 0; n < 2; ++n) _Pragma("unroll") for (int k = 0; k < 2; ++k) \
        acc[ai][bj][m][n] = __builtin_amdgcn_mfma_f32_16x16x32_bf16(Bt[n][k], At[m][k], acc[ai][bj][m][n], 0, 0, 0); __builtin_amdgcn_s_setprio(0); } while (0)
#define PG8_WAIT_V(n) asm volatile("s_waitcnt vmcnt(" #n ")" ::: "memory")
#define PG8_WAIT_L(n) asm volatile("s_waitcnt lgkmcnt(" #n ")" ::: "memory")
#define PG8_BAR __builtin_amdgcn_s_barrier()
#define PG8_SCHED __builtin_amdgcn_sched_barrier(0)
    Unit cur, nxt; int ui = 0;
    if (!S.next(0, cur)) return;
    f32x4 acc[2][2][4][2];
#pragma unroll
    for (int a = 0; a < 2; ++a)
#pragma unroll
        for (int b = 0; b < 2; ++b)
#pragma unroll
            for (int m = 0; m < 4; ++m)
#pragma unroll
                for (int n = 0; n < 2; ++n) acc[a][b][m][n] = (f32x4){0.f, 0.f, 0.f, 0.f};
    bf16x8 At[4][2], B0[2][2], B1[2][2];
    const char* cA = (const char*)g.A + (size_t)cur.pm * tstep; const char* cB = (const char*)g.Bt + (size_t)cur.pn * tstep;
    S.a_ready(cur);
    if constexpr (SP2) {
        PG8_STAGE(PG8_SB(0, 0), cB, voffB); PG8_STAGE(PG8_SB(0, 1), cB + hstep, voffB); PG8_STAGE(PG8_SA(0, 0), cA, voffA); PG8_STAGE(PG8_SA(0, 1), cA + hstep, voffA);
        if (wr == 1) PG8_BAR;
        PG8_WAIT_V(2); PG8_BAR;
        PG8_STAGE(PG8_SB(1, 0), cB + kstep, voffB); PG8_STAGE(PG8_SA(1, 0), cA + kstep, voffA); PG8_STAGE(PG8_SB(1, 1), cB + hstep + kstep, voffB);
        PG8_WAIT_V(6); PG8_BAR;
    } else {
        PG8_STAGE(PG8_SB(0, 0), cB, voffB); PG8_STAGE(PG8_SA(0, 0), cA, voffA); PG8_STAGE(PG8_SB(0, 1), cB + hstep, voffB); PG8_STAGE(PG8_SA(0, 1), cA + hstep, voffA);
        if (wr == 1) PG8_BAR;
        PG8_WAIT_V(4); PG8_BAR;
        PG8_STAGE(PG8_SB(1, 0), cB + kstep, voffB); PG8_STAGE(PG8_SA(1, 0), cA + kstep, voffA); PG8_STAGE(PG8_SB(1, 1), cB + hstep + kstep, voffB);
        PG8_WAIT_V(6); PG8_BAR;
    }
    for (;;) {
        const bool has_next = S.next(ui + 1, nxt);
        const char* nA = has_next ? (const char*)g.A + (size_t)nxt.pm * tstep : cA; const char* nB = has_next ? (const char*)g.Bt + (size_t)nxt.pn * tstep : cB;
        for (int t = 0; t < nt; t += 2) {
            const bool last = (t == nt - 2);
            const char* a1 = cA + (size_t)(t + 1) * kstep;
            const char* a2 = last ? nA : cA + (size_t)(t + 2) * kstep; const char* b2 = last ? nB : cB + (size_t)(t + 2) * kstep;
            const char* a3 = a2 + kstep; const char* b3 = b2 + kstep;
            if (last && has_next) S.a_ready(nxt);
            if constexpr (SP2) {
            PG8_LDB(B0, 0, 0); PG8_LDB(B1, 0, 1); PG8_SCHED; PG8_LDA(At, 0, 0); PG8_STAGE(PG8_SA(1, 1), a1 + hstep, voffA);
            PG8_WAIT_V(8); PG8_WAIT_L(0); PG8_BAR; PG8_MMA(0, 0, At, B0); PG8_MMA(0, 1, At, B1); PG8_BAR; PG8_SCHED;
            PG8_LDA(At, 0, 1); PG8_STAGE(PG8_SB(0, 0), b2, voffB); PG8_STAGE(PG8_SB(0, 1), b2 + hstep, voffB); PG8_STAGE(PG8_SA(0, 0), a2, voffA);
            PG8_WAIT_V(8); PG8_WAIT_L(0); PG8_BAR; PG8_MMA(1, 0, At, B0); PG8_MMA(1, 1, At, B1); PG8_BAR; PG8_SCHED;
            PG8_LDB(B0, 1, 0); PG8_LDB(B1, 1, 1); PG8_SCHED; PG8_LDA(At, 1, 0); PG8_STAGE(PG8_SA(0, 1), a2 + hstep, voffA);
            PG8_WAIT_V(8); PG8_WAIT_L(0); PG8_BAR; PG8_MMA(0, 0, At, B0); PG8_MMA(0, 1, At, B1); PG8_BAR; PG8_SCHED;
            PG8_LDA(At, 1, 1); PG8_STAGE(PG8_SB(1, 0), b3, voffB); PG8_STAGE(PG8_SB(1, 1), b3 + hstep, voffB); PG8_STAGE(PG8_SA(1, 0), a3, voffA);
            PG8_WAIT_V(8); PG8_WAIT_L(0); PG8_BAR; PG8_MMA(1, 0, At, B0); PG8_MMA(1, 1, At, B1); PG8_BAR; PG8_SCHED;
            } else {
            PG8_LDB(B0, 0, 0); PG8_SCHED; PG8_LDA(At, 0, 0); PG8_STAGE(PG8_SA(1, 1), a1 + hstep, voffA);
            PG8_WAIT_L(8); PG8_BAR; PG8_WAIT_L(0); PG8_MMA(0, 0, At, B0); PG8_BAR; PG8_SCHED;
            PG8_LDB(B1, 0, 1); PG8_STAGE(PG8_SB(0, 0), b2, voffB);
            PG8_BAR; PG8_WAIT_L(0); PG8_MMA(0, 1, At, B1); PG8_BAR;
            PG8_LDA(At, 0, 1); PG8_STAGE(PG8_SA(0, 0), a2, voffA);
            PG8_BAR; PG8_WAIT_L(0); PG8_MMA(1, 0, At, B0); PG8_BAR; PG8_SCHED;
            PG8_STAGE(PG8_SB(0, 1), b2 + hstep, voffB);
            PG8_WAIT_V(6); PG8_BAR; PG8_MMA(1, 1, At, B1); PG8_BAR;
            PG8_LDB(B0, 1, 0); PG8_SCHED; PG8_LDA(At, 1, 0); PG8_STAGE(PG8_SA(0, 1), a2 + hstep, voffA);
            PG8_WAIT_L(8); PG8_BAR; PG8_WAIT_L(0); PG8_MMA(0, 0, At, B0); PG8_BAR; PG8_SCHED;
            PG8_LDB(B1, 1, 1); PG8_STAGE(PG8_SB(1, 0), b3, voffB);
            PG8_BAR; PG8_WAIT_L(0); PG8_MMA(0, 1, At, B1); PG8_BAR;
            PG8_LDA(At, 1, 1); PG8_STAGE(PG8_SA(1, 0), a3, voffA);
            PG8_BAR; PG8_WAIT_L(0); PG8_MMA(1, 0, At, B0); PG8_BAR; PG8_SCHED;
            PG8_STAGE(PG8_SB(1, 1), b3 + hstep, voffB);
            PG8_WAIT_V(6); PG8_BAR; PG8_MMA(1, 1, At, B1); PG8_BAR;
            }
        }
        if constexpr (ALIGN_EPI) { if (wr == 0) PG8_BAR; }
        if constexpr (!Epi::AFTER_DRAIN) { E(acc, cur, wr, wc, fr, fq); S.done(cur); }
        if (!has_next) break;
#pragma unroll
        for (int a = 0; a < 2; ++a)
#pragma unroll
            for (int b = 0; b < 2; ++b)
#pragma unroll
                for (int m = 0; m < 4; ++m)
#pragma unroll
                    for (int n = 0; n < 2; ++n) acc[a][b][m][n] = (f32x4){0.f, 0.f, 0.f, 0.f};
        cur = nxt; cA = nA; cB = nB; ++ui;
        if constexpr (ALIGN_EPI) { if (wr == 1) PG8_BAR; }
    }
    PG8_WAIT_V(0);
    if constexpr (!ALIGN_EPI) { if (wr == 0) PG8_BAR; }
    PG8_BAR;
    if constexpr (Epi::AFTER_DRAIN) { E.fused(acc, cur, wr, wc, fr, fq, lds, wid, lane); S.done(cur); }
#undef PG8_SA
#undef PG8_SB
#undef PG8_STAGE
#undef PG8_LDA
#undef PG8_LDB
#undef PG8_MMA
#undef PG8_WAIT_V
#undef PG8_WAIT_L
#undef PG8_BAR
#undef PG8_SCHED
}
}

DI void prep_tile(const Params& p, int layer, int tile, int part, char* smem) {
  const int tid = otid(), lane = tid & 63, wave = tid >> 6, l31 = lane & 31, hi = lane >> 5;
  const int b = tile / 36, tb = tile % 36, p0 = tb * 64;
  const bool isctx = tb < 4;
  const int row0 = isctx ? (MROWS + b * CT + p0) : (b * SEQ + p0 - CT);
  const bf16_t* U = (const bf16_t*)(p.ws + OFF_U);
  const f32x2* ropeH = (const f32x2*)(p.ws + OFF_ROPEH);
  const f32x2* ropeD = (const f32x2*)(p.ws + OFF_ROPED);
  bf16_t* QD = (bf16_t*)(p.ws + OFF_QD); bf16_t* KD = (bf16_t*)(p.ws + OFF_KD); bf16_t* VTD = (bf16_t*)(p.ws + OFF_VTD);
  bf16_t* QG = (bf16_t*)(p.ws + OFF_QG); bf16_t* KG = (bf16_t*)(p.ws + OFF_KG); bf16_t* VTG = (bf16_t*)(p.ws + OFF_VTG);
  bf16_t* QM = (bf16_t*)(p.ws + OFF_QM); bf16_t* KM = (bf16_t*)(p.ws + OFF_KM); bf16_t* VTM = (bf16_t*)(p.ws + OFF_VTM);
  const float qsD = 0.17677669529663687f * LOG2E, qsG = 0.125f * LOG2E, qsM = 0.10206207261596575f * LOG2E;
  bf16_t* sT = (bf16_t*)smem; bf16_t* sCq = (bf16_t*)(smem + 9216); bf16_t* sCkv = (bf16_t*)(smem + 9216 + 25600);

  if (part == 0) {
  for (int tk = wave; tk < 64; tk += 4) {
    const bf16_t* urow = U + (size_t)(row0 + tk) * INP;
    const int pos = p0 + tk, t = pos - CT;
    float xv[15];
#pragma unroll
    for (int g = 0; g < 15; ++g) {
      const int col = g < 4 ? U_DQ + g * 64 + lane : g < 8 ? U_DK + (g - 4) * 64 + lane : g < 12 ? U_GQ + (g - 8) * 64 + lane : g < 14 ? U_GK + (g - 12) * 64 + lane : U_MR + l31;
      xv[g] = bf2f(urow[col]);
    }
    f32x2 csD = {1.f, 0.f}, csH = {1.f, 0.f};
    if (!isctx) { csD = ropeD[t * 16 + (lane & 15)]; csH = ropeH[t * 32 + l31]; }
#pragma unroll
    for (int g = 0; g < 15; ++g) {
      float x = xv[g];
      if (g < 8) {
        const int h = g & 3; const bool isq = g < 4;
        const int d = lane & 31, m = lane >> 5;
        if (!isctx) { const float pr = __shfl_xor(x, 16); x = (d < 16) ? (x * csD.x - pr * csD.y) : (pr * csD.y + x * csD.x); }
        if (isq) x *= qsD;
        (isq ? QD : KD)[(((size_t)b * 8 + h * 2 + m) * TT + pos) * 32 + d] = f2bf(x);
      } else if (g < 14) {
        const bool isq = g < 12; const int h = isq ? g - 8 : g - 12;
        const float ss = wave_sum(x * x);
        x = x * rsqrtf(ss * (1.f / 64.f) + EPS) * (isq ? p.in[I_GQN] : p.in[I_GKN])[layer * 64 + lane];
        if (!isctx) { const float pr = __shfl_xor(x, 32); x = (lane < 32) ? (x * csH.x - pr * csH.y) : (pr * csH.y + x * csH.x); }
        if (isq) { x *= qsG; QG[(((size_t)b * 4 + h) * TT + pos) * 64 + lane] = f2bf(x); }
        else KG[(((size_t)b * 2 + h) * TT + pos) * 64 + lane] = f2bf(x);
      } else {
        const int d = l31;
        if (!isctx) { const float pr = __shfl_xor(x, 16); x = (d < 16) ? (x * csD.x - pr * csD.y) : (pr * csD.y + x * csD.x); }
        const bf16_t v = f2bf(x);
        const int hh = hi * 2;
        KM[(((size_t)b * 4 + hh) * TT + pos) * 96 + 64 + d] = v;
        KM[(((size_t)b * 4 + hh + 1) * TT + pos) * 96 + 64 + d] = v;
      }
    }
  }
  for (int g = 0; g < 6; ++g) {
    const int colbase = g < 4 ? U_DV + g * 64 : U_GV + (g - 4) * 64;
    bf16_t* dst = g < 4 ? VTD + ((size_t)(b * 4 + g) * 64) * TT : VTG + ((size_t)(b * 2 + g - 4) * 64) * TT;
#pragma unroll
    for (int i = 0; i < 2; ++i) {
      const int c = tid + 256 * i, tk = c >> 3, kc = c & 7;
      const u32x4 v = *(const u32x4*)(U + (size_t)(row0 + tk) * INP + colbase + kc * 8);
      sT[(kc * 8 + 0) * 72 + tk] = (bf16_t)(v.x & 0xffff); sT[(kc * 8 + 1) * 72 + tk] = (bf16_t)(v.x >> 16);
      sT[(kc * 8 + 2) * 72 + tk] = (bf16_t)(v.y & 0xffff); sT[(kc * 8 + 3) * 72 + tk] = (bf16_t)(v.y >> 16);
      sT[(kc * 8 + 4) * 72 + tk] = (bf16_t)(v.z & 0xffff); sT[(kc * 8 + 5) * 72 + tk] = (bf16_t)(v.z >> 16);
      sT[(kc * 8 + 6) * 72 + tk] = (bf16_t)(v.w & 0xffff); sT[(kc * 8 + 7) * 72 + tk] = (bf16_t)(v.w >> 16);
    }
    __syncthreads();
    {
      const int dv = tid >> 2, part = tid & 3;
      const u32x4 a = *(const u32x4*)(sT + dv * 72 + part * 16), bq = *(const u32x4*)(sT + dv * 72 + part * 16 + 8);
      bf16_t* d = dst + (size_t)dv * TT + p0 + part * 16;
      *(u32x4*)d = a; *(u32x4*)(d + 8) = bq;
    }
    __syncthreads();
  }
  return;
  }
#pragma unroll 4
  for (int tk = wave; tk < 64; tk += 4) {
    const bf16_t* urow = U + (size_t)(row0 + tk) * INP;
    const float q0 = bf2f(urow[U_MQ + lane]), q1 = bf2f(urow[U_MQ + 64 + lane]), q2 = bf2f(urow[U_MQ + 128 + lane]);
    const float k0 = bf2f(urow[U_MKV + lane]), k1 = bf2f(urow[U_MKV + 64 + lane]);
    const float sq = wave_sum(q0 * q0 + q1 * q1 + q2 * q2), sk = wave_sum(k0 * k0 + k1 * k1);
    const float rq = rsqrtf(sq * (1.f / 192.f) + EPS), rk = rsqrtf(sk * (1.f / 128.f) + EPS);
    const float* gq = p.in[I_MQN] + layer * 192; const float* gk = p.in[I_MKVN] + layer * 128;
    sCq[tk * 200 + lane] = f2bf(q0 * rq * gq[lane]); sCq[tk * 200 + 64 + lane] = f2bf(q1 * rq * gq[64 + lane]); sCq[tk * 200 + 128 + lane] = f2bf(q2 * rq * gq[128 + lane]);
    sCkv[tk * 136 + lane] = f2bf(k0 * rk * gk[lane]); sCkv[tk * 136 + 64 + lane] = f2bf(k1 * rk * gk[64 + lane]);
  }
  __syncthreads();
  const bf16_t* Wkv = (const bf16_t*)(p.ws + OFF_WUKV) + (size_t)layer * 512 * 128;
  const bf16_t* Wq = (const bf16_t*)(p.ws + OFF_WUQ) + (size_t)layer * 384 * 192;
  for (int task = wave; task < 56; task += 4) {
    if (task < 32) {
      const int ct = task >> 1, tt = task & 1, head = ct >> 2, sub = ct & 3, n0 = head * 128 + sub * 32;
      f32x16 acc = zero16();
      const bf16_t* wrow = Wkv + (size_t)(n0 + l31) * 128 + hi * 8;
      const bf16_t* trow = sCkv + (tt * 32 + l31) * 136 + hi * 8;
      if (sub < 2) {
#pragma unroll
        for (int ks = 0; ks < 8; ++ks) acc = MFMA32(*(const bf16x8*)(wrow + ks * 16), *(const bf16x8*)(trow + ks * 16), acc);
        bf16_t* d = KM + (((size_t)b * 4 + head) * TT + p0 + tt * 32 + l31) * 96 + sub * 32 + 4 * hi;
#pragma unroll
        for (int r4 = 0; r4 < 4; ++r4) { u32x2 w; w.x = pk_bf16(acc[4 * r4], acc[4 * r4 + 1]); w.y = pk_bf16(acc[4 * r4 + 2], acc[4 * r4 + 3]); *(u32x2*)(d + 8 * r4) = w; }
      } else {
#pragma unroll
        for (int ks = 0; ks < 8; ++ks) acc = MFMA32(*(const bf16x8*)(trow + ks * 16), *(const bf16x8*)(wrow + ks * 16), acc);
        bf16_t* d = VTM + (((size_t)b * 4 + head) * 64 + (sub - 2) * 32 + l31) * TT + p0 + tt * 32 + 4 * hi;
#pragma unroll
        for (int r4 = 0; r4 < 4; ++r4) { u32x2 w; w.x = pk_bf16(acc[4 * r4], acc[4 * r4 + 1]); w.y = pk_bf16(acc[4 * r4 + 2], acc[4 * r4 + 3]); *(u32x2*)(d + 8 * r4) = w; }
      }
    } else {
      const int t2 = task - 32, ct = t2 >> 1, tt = t2 & 1, head = ct / 3, sub = ct % 3, n0 = head * 96 + sub * 32;
      f32x16 acc = zero16();
      const bf16_t* wrow = Wq + (size_t)(n0 + l31) * 192 + hi * 8;
      const bf16_t* trow = sCq + (tt * 32 + l31) * 200 + hi * 8;
#pragma unroll
      for (int ks = 0; ks < 12; ++ks) acc = MFMA32(*(const bf16x8*)(wrow + ks * 16), *(const bf16x8*)(trow + ks * 16), acc);
      const int pos = p0 + tt * 32 + l31;
      if (sub == 2 && !isctx) {
        const int t = pos - CT;
#pragma unroll
        for (int r = 0; r < 8; ++r) {
          const f32x2 cs = ropeD[t * 16 + crow(r, hi)];
          const float x1 = acc[r], x2 = acc[r + 8];
          acc[r] = x1 * cs.x - x2 * cs.y; acc[r + 8] = x1 * cs.y + x2 * cs.x;
        }
      }
      bf16_t* d = QM + (((size_t)b * 4 + head) * TT + pos) * 96 + sub * 32 + 4 * hi;
#pragma unroll
      for (int r4 = 0; r4 < 4; ++r4) { u32x2 w; w.x = pk_bf16(acc[4 * r4] * qsM, acc[4 * r4 + 1] * qsM); w.y = pk_bf16(acc[4 * r4 + 2] * qsM, acc[4 * r4 + 3] * qsM); *(u32x2*)(d + 8 * r4) = w; }
    }
  }
  __syncthreads();
}

template <int DQK>
DI void attn_core(const bf16_t* __restrict__ Qb, const bf16_t* __restrict__ Kb, const bf16_t* __restrict__ Vt, int q0, int ntiles,
                  f32x16 (&O)[2], float& lsum, char* smem) {
  const int tid = otid_full(), lane = tid & 63, wave = tid >> 6, l31 = lane & 31, hi = lane >> 5;
  constexpr int KS = DQK / 16, KROW = DQK + 8, KCH = DQK / 8;
  constexpr int KBYTES = 64 * KROW * 2, BUFB = KBYTES + 9216;
  constexpr int NK = 64 * KCH, NKC = (NK + NTHREADS - 1) / NTHREADS;
  static_assert(2 * BUFB <= 49152, "attention LDS");
  bf16x8 qf[KS];
#pragma unroll
  for (int ks = 0; ks < KS; ++ks) qf[ks] = *(const bf16x8*)(Qb + (size_t)(q0 + wave * 32 + l31) * DQK + ks * 16 + hi * 8);
  float mrun = -1e30f; lsum = 0.f; O[0] = zero16(); O[1] = zero16();
  const bf16_t* kg[NKC]; int kl[NKC]; bool kok[NKC];
#pragma unroll
  for (int i = 0; i < NKC; ++i) {
    const int c = tid + NTHREADS * i, key = c / KCH, kc = c % KCH;
    kok[i] = c < NK;
    kg[i] = Kb + (size_t)key * DQK + kc * 8;
    kl[i] = (key * KROW + kc * 8) * 2;
  }
  const bf16_t* vg; int vl;
  { const int dv = tid >> 3, kc = tid & 7; vg = Vt + (size_t)dv * TT + kc * 8; vl = KBYTES + (dv * 72 + kc * 8) * 2; }
  u32x4 rk[NKC], rv;
#pragma unroll
  for (int i = 0; i < NKC; ++i) if (kok[i]) rk[i] = *(const u32x4*)(kg[i]);
  rv = *(const u32x4*)(vg);
#pragma unroll
  for (int i = 0; i < NKC; ++i) if (kok[i]) *(u32x4*)(smem + kl[i]) = rk[i];
  *(u32x4*)(smem + vl) = rv;
  __syncthreads();
  for (int kt = 0; kt < ntiles; ++kt) {
    const int cur = kt & 1; const bool more = kt + 1 < ntiles;
    if (more) {
#pragma unroll
      for (int i = 0; i < NKC; ++i) if (kok[i]) rk[i] = *(const u32x4*)(kg[i] + (size_t)(kt + 1) * 64 * DQK);
      rv = *(const u32x4*)(vg + (kt + 1) * 64);
    }
    const char* sb = smem + cur * BUFB;
    f32x16 s[2];
#pragma unroll
    for (int kb = 0; kb < 2; ++kb) {
      s[kb] = zero16();
      const char* kr = sb + ((kb * 32 + l31) * KROW + hi * 8) * 2;
#pragma unroll
      for (int ks = 0; ks < KS; ++ks) s[kb] = MFMA32(*(const bf16x8*)(kr + ks * 32), qf[ks], s[kb]);
    }
    float mx = s[0][0];
#pragma unroll
    for (int r = 0; r < 16; ++r) { mx = fmaxf(mx, s[0][r]); mx = fmaxf(mx, s[1][r]); }
    mx = fmaxf(mx, __shfl_xor(mx, 32));
    const float mnew = fmaxf(mrun, mx);
    const float alpha = __builtin_amdgcn_exp2f(mrun - mnew);
    mrun = mnew;
    float rs = 0.f;
#pragma unroll
    for (int kb = 0; kb < 2; ++kb)
#pragma unroll
      for (int r = 0; r < 16; ++r) { const float e = __builtin_amdgcn_exp2f(s[kb][r] - mnew); s[kb][r] = e; rs += e; }
    lsum = lsum * alpha + rs;
    O[0] *= alpha; O[1] *= alpha;
#pragma unroll
    for (int s4 = 0; s4 < 4; ++s4) {
      const int kb = s4 >> 1, hf = (s4 & 1) * 8;
      const bf16x8 pb = pack8(s[kb][hf + 0], s[kb][hf + 1], s[kb][hf + 2], s[kb][hf + 3], s[kb][hf + 4], s[kb][hf + 5], s[kb][hf + 6], s[kb][hf + 7]);
#pragma unroll
      for (int dvb = 0; dvb < 2; ++dvb) {
        const char* vr = sb + KBYTES + ((dvb * 32 + l31) * 72 + s4 * 16 + hi * 4) * 2;
        const s16x4 lo = *(const s16x4*)vr, h4 = *(const s16x4*)(vr + 16);
        const bf16x8 a = __builtin_shufflevector(lo, h4, 0, 1, 2, 3, 4, 5, 6, 7);
        O[dvb] = MFMA32(a, pb, O[dvb]);
      }
    }
    if (more) {
      char* db = smem + (cur ^ 1) * BUFB;
#pragma unroll
      for (int i = 0; i < NKC; ++i) if (kok[i]) *(u32x4*)(db + kl[i]) = rk[i];
      *(u32x4*)(db + vl) = rv;
    }
    __syncthreads();
  }
  lsum += __shfl_xor(lsum, 32);
}

DI void attn_unit(const Params& p, int layer, int b, int kind, int head, int qb, char* smem) {
  const int tid_ = otid_full(); const int lane = tid_ & 63, wave = tid_ >> 6, l31 = lane & 31, hi = lane >> 5;
  const int q0 = qb * 256;
  const int ntiles = qb == 0 ? 4 : 36;
  bf16_t* Y = (bf16_t*)(p.ws + OFF_Y);
  const int pos = q0 + wave * 32 + l31;
  bf16_t* yrow = Y + (size_t)hrow_of(b, pos) * DM;
  f32x16 O[2]; float ls;
  if (kind == 1) {
    attn_core<32>((const bf16_t*)(p.ws + OFF_QD) + ((size_t)b * 8 + head * 2) * TT * 32, (const bf16_t*)(p.ws + OFF_KD) + ((size_t)b * 8 + head * 2) * TT * 32,
                  (const bf16_t*)(p.ws + OFF_VTD) + ((size_t)b * 4 + head) * 64 * TT, q0, ntiles, O, ls, smem);
    float* st = (float*)(smem + 49152) + tid_;
    {
      const float i0 = 1.f / ls;
#pragma unroll
      for (int dvb = 0; dvb < 2; ++dvb)
#pragma unroll
        for (int r = 0; r < 16; ++r) st[(dvb * 16 + r) * NTHREADS] = O[dvb][r] * i0;
    }
    __syncthreads();
    attn_core<32>((const bf16_t*)(p.ws + OFF_QD) + ((size_t)b * 8 + head * 2 + 1) * TT * 32, (const bf16_t*)(p.ws + OFF_KD) + ((size_t)b * 8 + head * 2 + 1) * TT * 32,
                  (const bf16_t*)(p.ws + OFF_VTD) + ((size_t)b * 4 + head) * 64 * TT, q0, ntiles, O, ls, smem);
    const float* misc = (const float*)(p.ws + OFF_MISC);
    const float lam = misc[128 + layer], li = misc[136 + layer];
    const float i1 = lam / ls;
    float ss = 0.f;
#pragma unroll
    for (int dvb = 0; dvb < 2; ++dvb)
#pragma unroll
      for (int r = 0; r < 16; ++r) { const float o = st[(dvb * 16 + r) * NTHREADS] - O[dvb][r] * i1; O[dvb][r] = o; ss += o * o; }
    ss += __shfl_xor(ss, 32);
    const float rstd = rsqrtf(ss * (1.f / 64.f) + EPS) * (1.f - li);
    const float* g = p.in[I_DNG] + layer * 64;
#pragma unroll
    for (int dvb = 0; dvb < 2; ++dvb)
#pragma unroll
      for (int r4 = 0; r4 < 4; ++r4) {
        const int dv = dvb * 32 + 8 * r4 + 4 * hi;
        const f32x4 gv = *(const f32x4*)(g + dv);
        u32x2 w; w.x = pk_bf16(O[dvb][4 * r4] * rstd * gv[0], O[dvb][4 * r4 + 1] * rstd * gv[1]);
        w.y = pk_bf16(O[dvb][4 * r4 + 2] * rstd * gv[2], O[dvb][4 * r4 + 3] * rstd * gv[3]);
        *(u32x2*)(yrow + 256 + head * 64 + dv) = w;
      }
  } else {
    int ycol;
    if (kind == 2) {
      attn_core<64>((const bf16_t*)(p.ws + OFF_QG) + ((size_t)b * 4 + head) * TT * 64, (const bf16_t*)(p.ws + OFF_KG) + ((size_t)b * 2 + (head >> 1)) * TT * 64,
                    (const bf16_t*)(p.ws + OFF_VTG) + ((size_t)b * 2 + (head >> 1)) * 64 * TT, q0, ntiles, O, ls, smem);
      ycol = 512 + head * 64;
    } else {
      attn_core<96>((const bf16_t*)(p.ws + OFF_QM) + ((size_t)b * 4 + head) * TT * 96, (const bf16_t*)(p.ws + OFF_KM) + ((size_t)b * 4 + head) * TT * 96,
                    (const bf16_t*)(p.ws + OFF_VTM) + ((size_t)b * 4 + head) * 64 * TT, q0, ntiles, O, ls, smem);
      ycol = 768 + head * 64;
    }
    const float inv = 1.f / ls;
#pragma unroll
    for (int dvb = 0; dvb < 2; ++dvb)
#pragma unroll
      for (int r4 = 0; r4 < 4; ++r4) {
        const int dv = dvb * 32 + 8 * r4 + 4 * hi;
        u32x2 w; w.x = pk_bf16(O[dvb][4 * r4] * inv, O[dvb][4 * r4 + 1] * inv); w.y = pk_bf16(O[dvb][4 * r4 + 2] * inv, O[dvb][4 * r4 + 3] * inv);
        *(u32x2*)(yrow + ycol + dv) = w;
      }
  }
}

DI void ssd_chunk(const Params& p, int layer, int item, char* smem) {
  const int tid = otid(), lane = tid & 63, wave = tid >> 6, l31 = lane & 31, hi = lane >> 5;
  const int pi = wave >> 1, li = wave & 1;
  const int ck = item % 36, r_ = item / 36, d = r_ & 1, g = (r_ >> 1) & 1, b = r_ >> 2, h = 2 * g + half_id(), chain = (b * 4 + h) * 2 + d;
  const bf16_t* U = (const bf16_t*)(p.ws + OFF_U);
  float* Yssd = (float*)(p.ws + OFF_XN) + (size_t)d * ROWS * 256;
  bf16_t* sXT = (bf16_t*)smem;
  bf16_t* sB = (bf16_t*)(smem + 9216);
  bf16_t* sC = (bf16_t*)(smem + 18432);
  bf16_t* sBT = (bf16_t*)(smem + 27648);
  float* scs = (float*)(smem + 46080);
  float* sdt = (float*)(smem + 46336);
  float* sW = (float*)(smem + 46592);
  const bool isctx = ck < 4;
  const int Len = isctx ? CT : SEQ, base = isctx ? (MROWS + b * CT) : (b * SEQ), kl = isctx ? ck : ck - 4;
  if (tid < 192) {
    const int cc = tid >> 6, e = tid & 63;
    const int ch = cc == 0 ? (h * 64 + e) : (cc == 1 ? 256 + g * 64 + e : 384 + g * 64 + e);
    const float* cw = p.in[I_CONVW] + ((size_t)layer * 512 + ch) * 3;
    sW[tid * 4 + 0] = cw[0]; sW[tid * 4 + 1] = cw[1]; sW[tid * 4 + 2] = cw[2]; sW[tid * 4 + 3] = p.in[I_CONVB][layer * 512 + ch];
  }
  if (wave == 1) {
    const float dtb = p.in[I_DTB][layer * 8 + d * 4 + h];
    const float aneg = -expf(p.in[I_ALOG][layer * 8 + d * 4 + h]);
    const int posj = kl * 64 + lane, t = d ? (Len - 1 - posj) : posj;
    const float raw = bf2f(U[(size_t)(base + t) * INP + U_DT + d * 4 + h]) + dtb;
    const float e_ = __expf(-fabsf(raw));
    const float dtv = fmaxf(raw, 0.f) + (e_ < 0.03f ? e_ * (1.f - e_ * (0.5f - e_ * 0.33333334f)) : __logf(1.f + e_));
    float c = dtv * aneg;
#pragma unroll
    for (int o = 1; o < 64; o <<= 1) { const float tv = __shfl_up(c, o); if (lane >= o) c += tv; }
    sdt[lane] = dtv; scs[lane] = c;
    ((float*)(p.ws + OFF_ECL))[(size_t)(d * 4 + h) * ROWS + base + t] = __expf(c);
    if (lane == 63) ((float*)(p.ws + OFF_DEC))[chain * 36 + ck] = __expf(c);
  }
  __syncthreads();
  const float c63 = scs[63];
  const bool wrC = ((h & 1) == 0) && (d == 0);
  bf16_t* CB = (bf16_t*)(p.ws + OFF_CB);
#pragma unroll 2
  for (int i = 0; i < 6; ++i) {
    const int task = tid + 256 * i, j = task / 24, cc = task % 24;
    const int posj = kl * 64 + j, t = d ? (Len - 1 - posj) : posj;
    const int grp = cc >> 3, c8 = (cc & 7) * 8;
    const int ucol = grp == 0 ? (U_X + h * 64 + c8) : (grp == 1 ? U_B + g * 64 + c8 : U_C + g * 64 + c8);
    const bf16_t* up = U + (size_t)(base + t) * INP + ucol;
    const u32x4 z4 = {0u, 0u, 0u, 0u};
    const u32x4 vm = (t > 0) ? *(const u32x4*)(up - INP) : z4;
    const u32x4 v0 = *(const u32x4*)up;
    const u32x4 vp = (t < Len - 1) ? *(const u32x4*)(up + INP) : z4;
    float o[8];
#pragma unroll
    for (int e2 = 0; e2 < 4; ++e2) {
      const unsigned wm_ = e2 == 0 ? vm.x : e2 == 1 ? vm.y : e2 == 2 ? vm.z : vm.w;
      const unsigned w0_ = e2 == 0 ? v0.x : e2 == 1 ? v0.y : e2 == 2 ? v0.z : v0.w;
      const unsigned wp_ = e2 == 0 ? vp.x : e2 == 1 ? vp.y : e2 == 2 ? vp.z : vp.w;
      const f32x4 wa = *(const f32x4*)(sW + (grp * 64 + c8 + 2 * e2) * 4), wb = *(const f32x4*)(sW + (grp * 64 + c8 + 2 * e2 + 1) * 4);
      o[2 * e2] = silu_f(wa[0] * bflo(wm_) + wa[1] * bflo(w0_) + wa[2] * bflo(wp_) + wa[3]);
      o[2 * e2 + 1] = silu_f(wb[0] * bfhi(wm_) + wb[1] * bfhi(w0_) + wb[2] * bfhi(wp_) + wb[3]);
    }
    if (grp == 0) {
      const float dtv = sdt[j];
#pragma unroll
      for (int e = 0; e < 8; ++e) sXT[(c8 + e) * 72 + j] = f2bf(o[e] * dtv);
    } else if (grp == 1) {
      const float sc_ = __expf(c63 - scs[j]);
      u32x4 w; w.x = pk_bf16(o[0], o[1]); w.y = pk_bf16(o[2], o[3]); w.z = pk_bf16(o[4], o[5]); w.w = pk_bf16(o[6], o[7]);
      *(u32x4*)(sB + j * 72 + c8) = w;
#pragma unroll
      for (int e = 0; e < 8; ++e) sBT[(c8 + e) * 72 + j] = f2bf(o[e] * sc_);
    } else {
      u32x4 w; w.x = pk_bf16(o[0], o[1]); w.y = pk_bf16(o[2], o[3]); w.z = pk_bf16(o[4], o[5]); w.w = pk_bf16(o[6], o[7]);
      *(u32x4*)(sC + j * 72 + c8) = w;
      if (wrC) *(u32x4*)(CB + (size_t)(base + t) * 128 + g * 64 + c8) = w;
    }
  }
  __syncthreads();
  const int lcol = 32 * li + l31;
  const float cl = scs[lcol];
  f32x16 y = zero16();
#pragma unroll
  for (int si = 0; si < 2; ++si) {
    if (si <= li) {
      f32x16 gt = zero16();
#pragma unroll
      for (int ks = 0; ks < 4; ++ks) gt = MFMA32(*(const bf16x8*)(sB + (32 * si + l31) * 72 + ks * 16 + hi * 8), *(const bf16x8*)(sC + lcol * 72 + ks * 16 + hi * 8), gt);
#pragma unroll
      for (int r = 0; r < 16; ++r) { const int s_ = 32 * si + crow(r, hi); gt[r] = (s_ <= lcol) ? gt[r] * __expf(cl - scs[s_]) : 0.f; }
#pragma unroll
      for (int kk = 0; kk < 2; ++kk) {
        const bf16x8 pb = pack8(gt[8 * kk], gt[8 * kk + 1], gt[8 * kk + 2], gt[8 * kk + 3], gt[8 * kk + 4], gt[8 * kk + 5], gt[8 * kk + 6], gt[8 * kk + 7]);
        const bf16_t* xr = sXT + (32 * pi + l31) * 72 + 32 * si + 16 * kk + 4 * hi;
        const s16x4 lo = *(const s16x4*)xr, h4 = *(const s16x4*)(xr + 8);
        y = MFMA32(__builtin_shufflevector(lo, h4, 0, 1, 2, 3, 4, 5, 6, 7), pb, y);
      }
    }
  }
  {
    const int posl = kl * 64 + lcol, t = d ? (Len - 1 - posl) : posl;
    float* yp = Yssd + (size_t)(base + t) * 256 + h * 64 + 32 * pi + 4 * hi;
#pragma unroll
    for (int r4 = 0; r4 < 4; ++r4) { f32x4 o; o[0] = y[4 * r4]; o[1] = y[4 * r4 + 1]; o[2] = y[4 * r4 + 2]; o[3] = y[4 * r4 + 3]; *(f32x4*)(yp + 8 * r4) = o; }
  }
  f32x16 sacc = zero16();
#pragma unroll
  for (int ks = 0; ks < 4; ++ks) sacc = MFMA32(*(const bf16x8*)(sXT + (32 * pi + l31) * 72 + ks * 16 + hi * 8), *(const bf16x8*)(sBT + (32 * li + l31) * 72 + ks * 16 + hi * 8), sacc);
  float* Sp = (float*)(p.ws + OFF_SS) + ((size_t)chain * 37 + ck + 1) * 4096;
#pragma unroll
  for (int r = 0; r < 16; ++r) Sp[(32 * pi + crow(r, hi)) * 64 + 32 * li + l31] = sacc[r];
  __syncthreads();
}

DI void ssd_scan(const Params& p, int chain) {
  const int tid = otid();
  char* slot0 = p.ws + OFF_SS + (size_t)chain * 37 * 16384 + tid * 64;
  const float* dec = (const float*)(p.ws + OFF_DEC) + chain * 36;
  f32x4 H[4];
#pragma unroll
  for (int i = 0; i < 4; ++i) H[i] = (f32x4){0.f, 0.f, 0.f, 0.f};
#pragma unroll 4
  for (int c = 0; c < 36; ++c) {
    const f32x4* sp = (const f32x4*)(slot0 + (size_t)(c + 1) * 16384);
    const f32x4 s0 = sp[0], s1 = sp[1], s2 = sp[2], s3 = sp[3];
    const float dc = dec[c];
    u32x4 w0, w1;
    w0.x = pk_bf16(H[0][0], H[0][1]); w0.y = pk_bf16(H[0][2], H[0][3]); w0.z = pk_bf16(H[1][0], H[1][1]); w0.w = pk_bf16(H[1][2], H[1][3]);
    w1.x = pk_bf16(H[2][0], H[2][1]); w1.y = pk_bf16(H[2][2], H[2][3]); w1.z = pk_bf16(H[3][0], H[3][1]); w1.w = pk_bf16(H[3][2], H[3][3]);
    u32x4* hp = (u32x4*)(slot0 + (size_t)c * 16384);
    hp[0] = w0; hp[1] = w1;
    H[0] = H[0] * dc + s0; H[1] = H[1] * dc + s1; H[2] = H[2] * dc + s2; H[3] = H[3] * dc + s3;
  }
}

DI void mixer_phase(const Params& p, int layer_c, char* smem, int* s_item) {
  const int layer = layer_c % DEPTH;
  const bool with_ctx = layer < DEPTH - 1;
  const int nqb = with_ctx ? 9 : 8;
  const int nitems = 4 + 12 * nqb;
  unsigned* cnt = (unsigned*)(p.ws + OFF_MISC) + layer_c * 8;
  for (int qq = 0; qq < 8; ++qq) {
    const int q = (blockIdx.x + qq) & 7;
    for (;;) {
      if (threadIdx.x == 0) *s_item = (int)atomicAdd(&cnt[q], 1u);
      __syncthreads();
      const int it = *s_item;
      __syncthreads();
      if (it >= nitems) break;
      if (it < 4) { if (layer_c < DEPTH) ssd_scan(p, q * 8 + it * 2 + half_id()); }
      else {
        const int idx = it - 4;
        int kind, head, qb;
        if (idx < 96) { const int hidx = idx >> 3; qb = (idx & 7) + 1; const int ko = hidx >> 2; kind = ko == 0 ? 1 : (ko == 1 ? 0 : 2); head = hidx & 3; }
        else { const int hidx = idx - 96; qb = 0; const int ko = hidx >> 2; kind = ko == 0 ? 1 : (ko == 1 ? 0 : 2); head = hidx & 3; }
        attn_unit(p, layer, q, kind, head, qb, smem);
      }
      __syncthreads();
    }
  }
}

DI void ssd_finish_tile(const Params& p, int layer, int tile, char* smem) {
  const int tid = otid(), lane = tid & 63, wave = tid >> 6, l31 = lane & 31, hi = lane >> 5;
  const int b = tile / 72, tb = tile % 72, p0 = tb * 32;
  const bool isctx = tb < 8;
  const int row0 = isctx ? (MROWS + b * CT + p0) : (b * SEQ + p0 - CT);
  const int T64 = tb >> 1, nch = isctx ? 4 : 32, Tl = isctx ? T64 : T64 - 4;
  const bf16_t* U = (const bf16_t*)(p.ws + OFF_U);
  const float* Y0 = (const float*)(p.ws + OFF_XN); const float* Y1 = Y0 + (size_t)ROWS * 256;
  const float* ECL = (const float*)(p.ws + OFF_ECL);
  bf16_t* Y = (bf16_t*)(p.ws + OFF_Y);
  bf16_t* sCc = (bf16_t*)smem;
  float* sY = (float*)(smem + 8704);
  {
    const bf16_t* CB = (const bf16_t*)(p.ws + OFF_CB) + (size_t)row0 * 128;
#pragma unroll
    for (int i = 0; i < 2; ++i) { const int c = tid + 256 * i, r = c >> 4, kc = c & 15; *(u32x4*)(sCc + r * 136 + kc * 8) = *(const u32x4*)(CB + r * 128 + kc * 8); }
  }
  __syncthreads();
  {
    const int pi = wave & 1, g = wave >> 1;
    const int row = row0 + l31;
#pragma unroll
    for (int hh = 0; hh < 2; ++hh) {
      const int h = g * 2 + hh;
      f32x16 ys = zero16();
#pragma unroll
      for (int d = 0; d < 2; ++d) {
        const int kl = d ? (nch - 1 - Tl) : Tl, ck = isctx ? kl : 4 + kl, chain = (b * 4 + h) * 2 + d;
        const char* Hs = p.ws + OFF_SS + ((size_t)chain * 37 + ck) * 16384 + (32 * pi + l31) * 256 + hi * 16;
        f32x16 acc = zero16();
#pragma unroll
        for (int ks = 0; ks < 4; ++ks) acc = MFMA32(*(const bf16x8*)(Hs + ks * 64), *(const bf16x8*)(sCc + l31 * 136 + g * 64 + ks * 16 + hi * 8), acc);
        const float e = ECL[(size_t)(d * 4 + h) * ROWS + row];
        ys += acc * e;
      }
      const float* y0p = Y0 + (size_t)row * 256 + h * 64 + 32 * pi + 4 * hi; const float* y1p = Y1 + (size_t)row * 256 + h * 64 + 32 * pi + 4 * hi;
#pragma unroll
      for (int r4 = 0; r4 < 4; ++r4) {
        const f32x4 a = *(const f32x4*)(y0p + 8 * r4), c2 = *(const f32x4*)(y1p + 8 * r4);
        f32x4 o; o[0] = ys[4 * r4] + a[0] + c2[0]; o[1] = ys[4 * r4 + 1] + a[1] + c2[1]; o[2] = ys[4 * r4 + 2] + a[2] + c2[2]; o[3] = ys[4 * r4 + 3] + a[3] + c2[3];
        *(f32x4*)(sY + l31 * 260 + h * 64 + 32 * pi + 8 * r4 + 4 * hi) = o;
      }
    }
  }
  __syncthreads();
  {
    const int ch = lane * 4, hd = lane >> 4;
    const float dsk = p.in[I_SSDD][layer * 8 + hd] + p.in[I_SSDD][layer * 8 + 4 + hd];
    f32x4 cw[3];
    {
      const float* w = p.in[I_CONVW] + ((size_t)layer * 512 + ch) * 3;
      const f32x4 a = *(const f32x4*)w, b2 = *(const f32x4*)(w + 4), c2 = *(const f32x4*)(w + 8);
      cw[0] = (f32x4){a[0], a[3], b2[2], c2[1]}; cw[1] = (f32x4){a[1], b2[0], b2[3], c2[2]}; cw[2] = (f32x4){a[2], b2[1], c2[0], c2[3]};
    }
    const f32x4 cb = *(const f32x4*)(p.in[I_CONVB] + layer * 512 + ch);
    const f32x4 ng = *(const f32x4*)(p.in[I_SSDNG] + layer * 256 + ch);
    const int Len = isctx ? CT : SEQ;
#pragma unroll 2
    for (int rr = wave; rr < 32; rr += 4) {
      const int row = row0 + rr;
      const int t = isctx ? (p0 + rr) : (p0 - CT + rr);
      const bf16_t* up = U + (size_t)row * INP;
      const u32x2 z2 = *(const u32x2*)(up + U_Z + ch);
      const u32x2 zz = {0u, 0u};
      const u32x2 xm = (t > 0) ? *(const u32x2*)(up - INP + U_X + ch) : zz;
      const u32x2 x0 = *(const u32x2*)(up + U_X + ch);
      const u32x2 xp = (t < Len - 1) ? *(const u32x2*)(up + INP + U_X + ch) : zz;
      const f32x4 xmf = {bflo(xm.x), bfhi(xm.x), bflo(xm.y), bfhi(xm.y)}, x0f = {bflo(x0.x), bfhi(x0.x), bflo(x0.y), bfhi(x0.y)}, xpf = {bflo(xp.x), bfhi(xp.x), bflo(xp.y), bfhi(xp.y)};
      const f32x4 zf = {bflo(z2.x), bfhi(z2.x), bflo(z2.y), bfhi(z2.y)};
      const f32x4 cv = cw[0] * xmf + cw[1] * x0f + cw[2] * xpf + cb;
      const f32x4 ya = *(const f32x4*)(sY + rr * 260 + ch);
      f32x4 gz; float ss = 0.f;
#pragma unroll
      for (int e = 0; e < 4; ++e) { const float xs = silu_f(cv[e]); const float yv = ya[e] + dsk * xs; gz[e] = yv * silu_f(zf[e]); ss += gz[e] * gz[e]; }
      ss = wave_sum(ss);
      const float rstd = rsqrtf(ss * (1.f / 256.f) + EPS);
      u32x2 w; w.x = pk_bf16(gz[0] * rstd * ng[0], gz[1] * rstd * ng[1]); w.y = pk_bf16(gz[2] * rstd * ng[2], gz[3] * rstd * ng[3]);
      *(u32x2*)(Y + (size_t)row * DM + ch) = w;
    }
  }
  __syncthreads();
}

DI void gbar(unsigned* bw, unsigned k) {
  asm volatile("s_waitcnt vmcnt(0)" ::: "memory");
  __syncthreads();
  if (threadIdx.x == 0) {
    __builtin_amdgcn_fence(__ATOMIC_RELEASE, "agent");
    asm volatile("s_waitcnt vmcnt(0)" ::: "memory");
    unsigned bx_ = blockIdx.x, gd_ = gridDim.x; asm volatile("" : "+s"(bx_), "+s"(gd_));
    const unsigned x = bx_ & 7u, nloc = (gd_ - x + 7u) >> 3;
    unsigned* sub = bw + 64 * (1 + x); unsigned* gen = bw + 64 * (9 + x); unsigned* top = bw + 64 * 17;
    const unsigned old = __hip_atomic_fetch_add(sub, 1u, __ATOMIC_RELAXED, __HIP_MEMORY_SCOPE_AGENT);
    if (old + 1u == k * nloc) {
      __hip_atomic_fetch_add(top, 1u, __ATOMIC_RELAXED, __HIP_MEMORY_SCOPE_AGENT);
      while (__hip_atomic_load(top, __ATOMIC_RELAXED, __HIP_MEMORY_SCOPE_AGENT) < 8u * k) __builtin_amdgcn_s_sleep(1);
      __hip_atomic_fetch_add(gen, 1u, __ATOMIC_RELAXED, __HIP_MEMORY_SCOPE_AGENT);
    } else {
      while (__hip_atomic_load(gen, __ATOMIC_RELAXED, __HIP_MEMORY_SCOPE_AGENT) < k) __builtin_amdgcn_s_sleep(1);
    }
    __builtin_amdgcn_fence(__ATOMIC_ACQUIRE, "agent");
    asm volatile("s_waitcnt vmcnt(0)" ::: "memory");
  }
  __syncthreads();
}

__global__ void __launch_bounds__(NTHREADS, 2) fwd_megakernel(Params p) {
  cg::grid_group grid = cg::this_grid();
  extern __shared__ __attribute__((aligned(16))) unsigned char lds_dyn[];
  __shared__ int s_item;
  char* smem = (char*)lds_dyn;
  const int half = half_id();
  unsigned* bw = (unsigned*)(p.ws + OFF_MISC) + 256; unsigned bk = 0;
  phase0(p, smem);
  if (p.ws == nullptr) grid.sync();
  gbar(bw, ++bk);
  mod_reduce(p);
  gbar(bw, ++bk);
  const float* MOD = (const float*)(p.ws + OFF_MOD);
  bf16_t* XN = (bf16_t*)(p.ws + OFF_XN);
  bf16_t* U = (bf16_t*)(p.ws + OFF_U);
  bf16_t* Y = (bf16_t*)(p.ws + OFF_Y);
  bf16_t* HM = (bf16_t*)(p.ws + OFF_HM);
  float* HC = (float*)(p.ws + OFF_HC);
  PG8_LAS unsigned char* glds = (PG8_LAS unsigned char*)lds_dyn;
#pragma unroll 1
  for (int layer = 0; layer < DEPTH; ++layer) {
    const bool with_ctx = layer < DEPTH - 1;
    const int mrows = with_ctx ? ROWS : MROWS;
    int bx = (int)blockIdx.x; asm volatile("" : "+s"(bx));
    for (int rep = 0; rep < PROBE_N1; ++rep) { norm_phase(p, layer, 0, ROWS, layer > 0 ? MOD + (size_t)((layer - 1) * 9 + 8) * 6144 + 5120 : nullptr, HC);
    gbar(bw, ++bk); }
    for (int rep = 0; rep < PROBE_INPROJ; ++rep) { pg8::Gemm g{XN, (const bf16_t*)(p.ws + OFF_WIN) + (size_t)layer * INPW * DM, ROWS, INPW, DM, DM}; pg8::StaticOrder S; S.init(ROWS, INPW, (int)gridDim.x, bx);
      pg8::EpiStore<0> E{U, INP, INP};
      pg8::gemm_phase<pg8::EpiStore<0>, pg8::StaticOrder, true, true>(glds, g, S, E);
    gbar(bw, ++bk); }
    for (int rep = 0; rep < PROBE_PREP; ++rep) {
      unsigned* qc = (unsigned*)(p.ws + OFF_MISC) + 64 + layer + rep * DEPTH;
      for (;;) {
        if (threadIdx.x == 0) s_item = (int)atomicAdd(qc, 1u);
        __syncthreads();
        const int it = s_item;
        __syncthreads();
        if (it >= 1152 + 288) break;
        if (it < 144) prep_tile(p, layer, it * 2 + half, 0, smem + half * SMEM_BYTES);
        else if (it < 288) prep_tile(p, layer, (it - 144) * 2 + half, 1, smem + half * SMEM_BYTES);
        else ssd_chunk(p, layer, it - 288, smem + half * SMEM_BYTES);
      }
      gbar(bw, ++bk);
    }
    for (int rep = 0; rep < PROBE_MIX; ++rep) { mixer_phase(p, layer + rep * DEPTH, smem, &s_item);
    gbar(bw, ++bk); }
    for (int rep = 0; rep < PROBE_FIN; ++rep) { for (int t0 = blockIdx.x * 2; t0 < NB * 72; t0 += gridDim.x * 2) { const int t = t0 + half; if (!with_ctx && (t % 72) < 8) continue; ssd_finish_tile(p, layer, t, smem + half * SMEM_BYTES); }
    gbar(bw, ++bk); }
    { const bf16_t* Wt = (const bf16_t*)(p.ws + OFF_WOUT) + (size_t)layer * DM * DM;
      { pg8::Gemm g{Y, Wt, MROWS, DM, DM, DM}; pg8::StaticOrder S; S.init(MROWS, DM, (int)gridDim.x, bx);
        pg8::EpiResid E{layer == 0 ? p.in[I_X] : p.out, nullptr, p.out, nullptr, MOD + (size_t)layer * 9 * 6144 + 2048, 1.f};
        pg8::gemm_phase<pg8::EpiResid, pg8::StaticOrder, true, true>(glds, g, S, E);
        for (int rep = 0; rep < PROBE_OUT; ++rep) { gbar(bw, ++bk); pg8::EpiResid E2{p.out, nullptr, p.out, nullptr, MOD + (size_t)layer * 9 * 6144 + 2048, 0.f}; pg8::gemm_phase<pg8::EpiResid, pg8::StaticOrder, true, true>(glds, g, S, E2); } }
      if (with_ctx) {
        const int ks = (bx >> 5) & 3;
        pg8::Gemm g{Y + (size_t)MROWS * DM + ks * (DM / 4), Wt + ks * (DM / 4), CROWS, DM, DM, DM / 4}; pg8::SplitOrder S{bx};
        pg8::EpiPartial E{(float*)(p.ws + OFF_SS) + (size_t)ks * CROWS * DM};
        pg8::gemm_phase<pg8::EpiPartial, pg8::SplitOrder, true, true>(glds, g, S, E); } }
    gbar(bw, ++bk);
    norm_phase(p, layer, 1, mrows, with_ctx ? MOD + (size_t)(layer * 9 + 8) * 6144 + 2048 : nullptr, layer == 0 ? p.in[I_CTX] : HC);
    gbar(bw, ++bk);
    for (int rep = 0; rep < PROBE_UP; ++rep) { pg8::Gemm g{XN, (const bf16_t*)(p.ws + OFF_W1) + (size_t)layer * DFF * DM, mrows, DFF, DM, DM}; pg8::StaticOrder S; S.init(mrows, DFF, (int)gridDim.x, bx);
      pg8::EpiStore<1> E{HM, DFF, DFF};
      pg8::gemm_phase<pg8::EpiStore<1>, pg8::StaticOrder, true, true>(glds, g, S, E);
    gbar(bw, ++bk); }
    { const bf16_t* Wt = (const bf16_t*)(p.ws + OFF_W2) + (size_t)layer * DM * DFF;
      { pg8::Gemm g{HM, Wt, MROWS, DM, DFF, DFF}; pg8::StaticOrder S; S.init(MROWS, DM, (int)gridDim.x, bx);
        pg8::EpiResid E{p.out, nullptr, p.out, nullptr, MOD + (size_t)layer * 9 * 6144 + 5120, 1.f};
        pg8::gemm_phase<pg8::EpiResid, pg8::StaticOrder, true, true>(glds, g, S, E);
        for (int rep = 0; rep < PROBE_DOWN; ++rep) { gbar(bw, ++bk); pg8::EpiResid E2{p.out, nullptr, p.out, nullptr, MOD + (size_t)layer * 9 * 6144 + 5120, 0.f}; pg8::gemm_phase<pg8::EpiResid, pg8::StaticOrder, true, true>(glds, g, S, E2); } }
      if (with_ctx) {
        const int ks = (bx >> 5) & 3;
        pg8::Gemm g{HM + (size_t)MROWS * DFF + ks * (DFF / 4), Wt + ks * (DFF / 4), CROWS, DM, DFF, DFF / 4}; pg8::SplitOrder S{bx};
        pg8::EpiPartial E{(float*)(p.ws + OFF_SS) + (size_t)ks * CROWS * DM};
        pg8::gemm_phase<pg8::EpiPartial, pg8::SplitOrder, true, true>(glds, g, S, E); } }
    gbar(bw, ++bk);
  }
  norm_phase(p, 0, 2, MROWS);
}

extern "C" void kernel_launch(void* const* d_in, const int* in_sizes, int n_in, void* d_out, int out_size, void* d_ws, size_t ws_size, hipStream_t stream) {
  static int grid_blocks = 0;
  if (!grid_blocks) {
    int dev = 0, cus = 0, per_cu = 0;
    (void)hipGetDevice(&dev);
    (void)hipDeviceGetAttribute(&cus, hipDeviceAttributeMultiprocessorCount, dev);
    if (hipFuncSetAttribute((const void*)fwd_megakernel, hipFuncAttributeMaxDynamicSharedMemorySize, LDS_BYTES) != hipSuccess) fprintf(stderr, "hipFuncSetAttribute(max dynamic LDS) failed\n");
    (void)hipOccupancyMaxActiveBlocksPerMultiprocessor(&per_cu, (const void*)fwd_megakernel, NTHREADS, LDS_BYTES);
    if (per_cu < 1) { fprintf(stderr, "occupancy query says %d blocks/CU\n", per_cu); per_cu = 1; }
    grid_blocks = cus;
  }
  if (ws_size < OFF_END) { fprintf(stderr, "workspace too small: %zu < %zu\n", ws_size, (size_t)OFF_END); return; }
  Params p{};
  for (int i = 0; i < 27; ++i) p.in[i] = (const float*)d_in[i];
  p.out = (float*)d_out;
  p.ws = (char*)d_ws;
  (void)hipMemsetAsync((char*)d_ws + OFF_MISC, 0, SZ_MISC, stream);
  void* args[] = {&p};
  hipError_t e = hipLaunchCooperativeKernel((void*)fwd_megakernel, dim3(grid_blocks), dim3(NTHREADS), args, LDS_BYTES, stream);
  if (e != hipSuccess) fprintf(stderr, "cooperative launch failed: %s (grid %d)\n", hipGetErrorString(e), grid_blocks);
}
```

```cpp
#include <hip/hip_runtime.h>
#include <hip/hip_cooperative_groups.h>
#include <stdint.h>
#include <cstdio>
namespace cg = cooperative_groups;

typedef unsigned short bf16_t;
typedef short bf16x8 __attribute__((ext_vector_type(8)));
typedef short s16x4 __attribute__((ext_vector_type(4)));
typedef float f32x16 __attribute__((ext_vector_type(16)));
typedef float f32x4 __attribute__((ext_vector_type(4)));
typedef float f32x2 __attribute__((ext_vector_type(2)));
typedef unsigned u32x4 __attribute__((ext_vector_type(4)));
typedef unsigned u32x2 __attribute__((ext_vector_type(2)));
typedef __bf16 bf2_t __attribute__((ext_vector_type(2)));

#define DI __device__ __forceinline__
#define MFMA32(a, b, c) __builtin_amdgcn_mfma_f32_32x32x16_bf16((a), (b), (c), 0, 0, 0)

constexpr int DM = 1024, NB = 8, SEQ = 2048, DEPTH = 4, CT = 256, TT = 2304;
constexpr int MROWS = NB * SEQ, CROWS = NB * CT, ROWS = MROWS + CROWS;
constexpr int INC = 2408, INP = 2432, INPW = 2560, DFF = 4096;
constexpr float EPS = 1e-6f;
constexpr float LOG2E = 1.4426950408889634f;
constexpr int U_Z = 0, U_X = 256, U_B = 512, U_C = 640, U_DT = 768;
constexpr int U_DQ = 776, U_DK = 1032, U_DV = 1288;
constexpr int U_GQ = 1544, U_GK = 1800, U_GV = 1928;
constexpr int U_MQ = 2056, U_MKV = 2248, U_MR = 2376;

constexpr size_t al256(size_t x) { return (x + 255) & ~(size_t)255; }
constexpr size_t SZ_WIN = (size_t)DEPTH * INPW * DM * 2;
constexpr size_t SZ_WOUT = (size_t)DEPTH * DM * DM * 2;
constexpr size_t SZ_W1 = (size_t)DEPTH * DFF * DM * 2;
constexpr size_t SZ_W2 = (size_t)DEPTH * DM * DFF * 2;
constexpr size_t SZ_WUQ = (size_t)DEPTH * 384 * 192 * 2;
constexpr size_t SZ_WUKV = (size_t)DEPTH * 512 * 128 * 2;
constexpr size_t SZ_MOD = (size_t)DEPTH * 9 * 6144 * 4;
constexpr size_t SZ_MISC = 8192;
constexpr size_t SZ_ROPEH = (size_t)SEQ * 32 * 8;
constexpr size_t SZ_ROPED = (size_t)SEQ * 16 * 8;
constexpr size_t SZ_HC = (size_t)CROWS * DM * 4;
constexpr size_t SZ_XN = (size_t)ROWS * DM * 2;
constexpr size_t SZ_U = (size_t)ROWS * INP * 2;
constexpr size_t SZ_QD = (size_t)NB * 8 * TT * 32 * 2;
constexpr size_t SZ_VT4 = (size_t)NB * 4 * 64 * TT * 2;
constexpr size_t SZ_QG = (size_t)NB * 4 * TT * 64 * 2;
constexpr size_t SZ_KG = (size_t)NB * 2 * TT * 64 * 2;
constexpr size_t SZ_QM = (size_t)NB * 4 * TT * 96 * 2;
constexpr size_t SZ_Y = (size_t)ROWS * DM * 2;

constexpr size_t OFF_MOD = 0;
constexpr size_t OFF_MISC = OFF_MOD + al256(SZ_MOD);
constexpr size_t OFF_WIN = OFF_MISC + SZ_MISC;
constexpr size_t OFF_WOUT = OFF_WIN + al256(SZ_WIN);
constexpr size_t OFF_W1 = OFF_WOUT + al256(SZ_WOUT);
constexpr size_t OFF_W2 = OFF_W1 + al256(SZ_W1);
constexpr size_t OFF_WUQ = OFF_W2 + al256(SZ_W2);
constexpr size_t OFF_WUKV = OFF_WUQ + al256(SZ_WUQ);
constexpr size_t OFF_ROPEH = OFF_WUKV + al256(SZ_WUKV);
constexpr size_t OFF_ROPED = OFF_ROPEH + al256(SZ_ROPEH);
constexpr size_t OFF_HC = OFF_ROPED + al256(SZ_ROPED);
constexpr size_t OFF_XN = OFF_HC + al256(SZ_HC);
constexpr size_t OFF_BIG = OFF_XN + al256(SZ_XN);
constexpr size_t OFF_U = OFF_BIG;
constexpr size_t OFF_QD = OFF_U + al256(SZ_U);
constexpr size_t OFF_KD = OFF_QD + al256(SZ_QD);
constexpr size_t OFF_VTD = OFF_KD + al256(SZ_QD);
constexpr size_t OFF_QG = OFF_VTD + al256(SZ_VT4);
constexpr size_t OFF_KG = OFF_QG + al256(SZ_QG);
constexpr size_t OFF_VTG = OFF_KG + al256(SZ_KG);
constexpr size_t OFF_QM = OFF_VTG + al256(SZ_KG);
constexpr size_t OFF_KM = OFF_QM + al256(SZ_QM);
constexpr size_t OFF_VTM = OFF_KM + al256(SZ_QM);
constexpr size_t OFF_Y = OFF_VTM + al256(SZ_VT4);
constexpr size_t SZ_SS = (size_t)64 * 37 * 16384;
constexpr size_t SZ_DEC = (size_t)64 * 36 * 4;
constexpr size_t SZ_ECL = (size_t)8 * ROWS * 4;
constexpr size_t SZ_CB = (size_t)ROWS * 128 * 2;
constexpr size_t OFF_SS = OFF_Y + al256(SZ_Y);
constexpr size_t OFF_DEC = OFF_SS + al256(SZ_SS);
constexpr size_t OFF_ECL = OFF_DEC + al256(SZ_DEC);
constexpr size_t OFF_CB = OFF_ECL + al256(SZ_ECL);
constexpr size_t OFF_END = OFF_CB + al256(SZ_CB);
static_assert(OFF_END <= (size_t)402653184, "workspace budget (4 x mod_w)");
constexpr size_t OFF_HM = OFF_BIG;
static_assert((size_t)ROWS * DFF * 2 <= OFF_Y - OFF_BIG, "HM overlay must not reach Y");
static_assert((size_t)2 * ROWS * 256 * 4 <= SZ_XN, "Yssd overlay");

struct Params {
  const float* in[27];
  float* out;
  char* ws;
};
enum { I_X = 0, I_C, I_CTX, I_CCTX, I_MODW, I_MODB, I_N1G, I_N2G, I_WIN, I_CONVW, I_CONVB, I_DTB, I_ALOG, I_SSDD, I_SSDNG,
       I_DLAM, I_DNG, I_GQN, I_GKN, I_MQN, I_MKVN, I_WUQ, I_WUKV, I_WOUT, I_W1, I_W2, I_FNG };

constexpr int SMEM_BYTES = 65536;
constexpr int LDS_BYTES = 131072, NTHREADS = 512;
#ifndef PROBE_DOWN
#define PROBE_DOWN 0
#endif
#ifndef PROBE_OUT
#define PROBE_OUT 0
#endif
#ifndef PROBE_P0
#define PROBE_P0 1
#endif
#ifndef PROBE_N1
#define PROBE_N1 1
#endif
#ifndef PROBE_FIN
#define PROBE_FIN 1
#endif
#ifndef PROBE_UP
#define PROBE_UP 1
#endif
#ifndef PROBE_PREP
#define PROBE_PREP 1
#endif
#ifndef PROBE_MIX
#define PROBE_MIX 1
#endif
#ifndef PROBE_INPROJ
#define PROBE_INPROJ 1
#endif

DI unsigned pk_bf16(float a, float b) { f32x2 v = {a, b}; bf2_t r = __builtin_convertvector(v, bf2_t); return __builtin_bit_cast(unsigned, r); }
DI bf16_t f2bf(float a) { return (bf16_t)(pk_bf16(a, 0.f) & 0xffffu); }
DI float bf2f(bf16_t v) { return __uint_as_float((unsigned)v << 16); }
DI float bflo(unsigned w) { return __uint_as_float(w << 16); }
DI float bfhi(unsigned w) { return __uint_as_float(w & 0xffff0000u); }
DI float silu_f(float x) { return x / (1.f + __expf(-x)); }
DI float wave_sum(float v) {
#pragma unroll
  for (int o = 32; o >= 1; o >>= 1) v += __shfl_xor(v, o);
  return v;
}
DI int crow(int r, int hi) { return (r & 3) + 8 * (r >> 2) + 4 * hi; }
DI bf16x8 pack8(float a0, float a1, float a2, float a3, float a4, float a5, float a6, float a7) {
  u32x4 p; p.x = pk_bf16(a0, a1); p.y = pk_bf16(a2, a3); p.z = pk_bf16(a4, a5); p.w = pk_bf16(a6, a7);
  return __builtin_bit_cast(bf16x8, p);
}
DI f32x16 zero16() { f32x16 z;
#pragma unroll
  for (int i = 0; i < 16; ++i) z[i] = 0.f;
  return z; }
DI int otid() { int t = threadIdx.x & 255; asm volatile("" : "+v"(t)); return t; }
DI int otid_full() { int t = threadIdx.x; asm volatile("" : "+v"(t)); return t; }
DI int half_id() { return __builtin_amdgcn_readfirstlane((int)threadIdx.x >> 8); }
DI int hrow_of(int b, int pos) { return pos < CT ? (MROWS + b * CT + pos) : (b * SEQ + pos - CT); }

DI void tconv_tile(const float* __restrict__ src, int K, int N, bf16_t* __restrict__ dst, int kt, int nt, unsigned* sT) {
  const int tid = otid();
#pragma unroll
  for (int p = 0; p < 2; ++p) {
    const int idx = tid + 256 * p, kp = idx >> 4, nc = idx & 15;
    const int k = kt * 64 + 2 * kp, n = nt * 64 + nc * 4;
    f32x4 v0 = {0.f, 0.f, 0.f, 0.f}, v1 = {0.f, 0.f, 0.f, 0.f};
    if (n < N) { v0 = *(const f32x4*)(src + (size_t)k * N + n); v1 = *(const f32x4*)(src + (size_t)(k + 1) * N + n); }
#pragma unroll
    for (int e = 0; e < 4; ++e) sT[(nc * 4 + e) * 33 + kp] = pk_bf16(v0[e], v1[e]);
  }
  __syncthreads();
  {
    const int n = tid >> 2, part = tid & 3;
    u32x4 a, b;
    const unsigned* s = sT + n * 33 + part * 8;
    a.x = s[0]; a.y = s[1]; a.z = s[2]; a.w = s[3]; b.x = s[4]; b.y = s[5]; b.z = s[6]; b.w = s[7];
    bf16_t* d = dst + (size_t)(nt * 64 + n) * K + kt * 64 + part * 16;
    *(u32x4*)d = a; *(u32x4*)(d + 8) = b;
  }
  __syncthreads();
}

DI void mod_task(const Params& p, int task, float* sCond) {
  const int tid = otid();
  const int ks = task & 7, cb = (task >> 3) % 24, l = task / 192;
  for (int i = tid; i < 9 * 128; i += 256) {
    const int r = i >> 7, kk = i & 127;
    const float v = (r < 8) ? p.in[I_C][r * DM + ks * 128 + kk] : p.in[I_CCTX][ks * 128 + kk];
    sCond[i] = silu_f(v);
  }
  __syncthreads();
  const int col = cb * 256 + tid;
  const float* w = p.in[I_MODW] + ((size_t)l * DM + ks * 128) * 6144 + col;
  float acc[9];
#pragma unroll
  for (int r = 0; r < 9; ++r) acc[r] = 0.f;
#pragma unroll 8
  for (int kk = 0; kk < 128; ++kk) {
    const float wv = w[(size_t)kk * 6144];
#pragma unroll
    for (int r = 0; r < 9; ++r) acc[r] += sCond[r * 128 + kk] * wv;
  }
  const float bias = (ks == 0) ? p.in[I_MODB][l * 6144 + col] : 0.f;
  float* MODP = (float*)(p.ws + OFF_Y) + (size_t)ks * (DEPTH * 9 * 6144);
#pragma unroll
  for (int r = 0; r < 9; ++r) MODP[(size_t)(l * 9 + r) * 6144 + col] = acc[r] + bias;
  __syncthreads();
}

DI void phase0(const Params& p, char* smem) {
  constexpr int T_WIN = DEPTH * 16 * 38, T_WOUT = DEPTH * 16 * 16, T_W1 = DEPTH * 16 * 64, T_W2 = DEPTH * 64 * 16;
  constexpr int T_UQ = DEPTH * 3 * 6, T_UKV = DEPTH * 2 * 8, T_MOD = 768, T_ROPE = (SEQ * 48) / 256, T_MISC = 1;
  constexpr int E0 = T_WIN, E1 = E0 + T_WOUT, E2 = E1 + T_W1, E3 = E2 + T_W2, E4 = E3 + T_UQ, E5 = E4 + T_UKV, E6 = E5 + T_MOD, E7 = E6 + T_ROPE, E8 = E7 + T_MISC;
  const int tid = otid();
  const int half = half_id(); smem += half * SMEM_BYTES;
  static_assert(E0 % 2 == 0 && E1 % 2 == 0 && E2 % 2 == 0 && E3 % 2 == 0 && E4 % 2 == 0 && E5 % 2 == 0 && E6 % 2 == 0 && E7 % 2 == 0, "half-block pairs must not straddle task types");
  for (int t0 = blockIdx.x * 2; t0 < E8; t0 += gridDim.x * 2) {
    const int t = t0 + half;
    if (t >= E8) break;
    if (t < E0) { const int l = t / (16 * 38), r = t % (16 * 38); tconv_tile(p.in[I_WIN] + (size_t)l * DM * INC, DM, INC, (bf16_t*)(p.ws + OFF_WIN) + (size_t)l * INPW * DM, r / 38, r % 38, (unsigned*)smem); }
    else if (t < E1) { const int u = t - E0, l = u / 256, r = u % 256; tconv_tile(p.in[I_WOUT] + (size_t)l * DM * DM, DM, DM, (bf16_t*)(p.ws + OFF_WOUT) + (size_t)l * DM * DM, r / 16, r % 16, (unsigned*)smem); }
    else if (t < E2) { const int u = t - E1, l = u / 1024, r = u % 1024; tconv_tile(p.in[I_W1] + (size_t)l * DM * DFF, DM, DFF, (bf16_t*)(p.ws + OFF_W1) + (size_t)l * DFF * DM, r / 64, r % 64, (unsigned*)smem); }
    else if (t < E3) { const int u = t - E2, l = u / 1024, r = u % 1024; tconv_tile(p.in[I_W2] + (size_t)l * DFF * DM, DFF, DM, (bf16_t*)(p.ws + OFF_W2) + (size_t)l * DM * DFF, r / 16, r % 16, (unsigned*)smem); }
    else if (t < E4) { const int u = t - E3, l = u / 18, r = u % 18; tconv_tile(p.in[I_WUQ] + (size_t)l * 192 * 384, 192, 384, (bf16_t*)(p.ws + OFF_WUQ) + (size_t)l * 384 * 192, r / 6, r % 6, (unsigned*)smem); }
    else if (t < E5) { const int u = t - E4, l = u / 16, r = u % 16; tconv_tile(p.in[I_WUKV] + (size_t)l * 128 * 512, 128, 512, (bf16_t*)(p.ws + OFF_WUKV) + (size_t)l * 512 * 128, r / 8, r % 8, (unsigned*)smem); }
    else if (t < E6) { mod_task(p, t - E5, (float*)smem); }
    else if (t < E7) {
      const int idx = (t - E6) * 256 + tid;
      int tt, i, nf; f32x2* dst;
      if (idx < SEQ * 32) { tt = idx >> 5; i = idx & 31; nf = 16; dst = (f32x2*)(p.ws + OFF_ROPEH) + idx; }
      else { const int j = idx - SEQ * 32; tt = j >> 4; i = j & 15; nf = 8; dst = (f32x2*)(p.ws + OFF_ROPED) + j; }
      const int f = i & (nf - 1);
      const float pos = (float)((i < nf) ? (tt >> 6) : (tt & 63));
      const float inv = exp2f(-(float)f * (13.287712379549449f / (float)nf));
      float rv = pos * inv * 0.15915494309189535f; rv -= rintf(rv);
      f32x2 cs; cs.x = __builtin_amdgcn_cosf(rv); cs.y = __builtin_amdgcn_sinf(rv);
      *dst = cs;
    } else {
      if (tid < DEPTH) {
        const float* lp = p.in[I_DLAM] + tid * 128;
        float s1 = 0.f, s2 = 0.f;
        for (int i = 0; i < 32; ++i) { s1 += lp[i] * lp[32 + i]; s2 += lp[64 + i] * lp[96 + i]; }
        const float li = 0.8f - 0.6f * expf(-0.3f * (float)tid);
        float* misc = (float*)(p.ws + OFF_MISC);
        misc[128 + tid] = expf(s1) - expf(s2) + li;
        misc[136 + tid] = li;
      }
    }
  }
}

DI void mod_reduce(const Params& p) {
  const float* MODP = (const float*)(p.ws + OFF_Y);
  float* MOD = (float*)(p.ws + OFF_MOD);
  constexpr int NTOT = DEPTH * 9 * 6144;
  for (int i = blockIdx.x * NTHREADS + otid_full(); i < NTOT; i += gridDim.x * NTHREADS) {
    float a = 0.f;
#pragma unroll
    for (int ks = 0; ks < 8; ++ks) a += MODP[(size_t)ks * NTOT + i];
    MOD[i] = a;
  }
}

DI void norm_phase(const Params& p, int layer, int which, int nrows, const float* pend_gate = nullptr, const float* pend_hin = nullptr) {
  constexpr int NR = 3;
  const int tid_ = otid_full(); const int lane = tid_ & 63, wave = tid_ >> 6;
  const int gw = blockIdx.x * 8 + wave, nw = gridDim.x * 8;
  const float* MOD = (const float*)(p.ws + OFF_MOD);
  bf16_t* XN = (bf16_t*)(p.ws + OFF_XN);
  const float* g = (which == 0 ? p.in[I_N1G] : which == 1 ? p.in[I_N2G] : p.in[I_FNG]) + (which == 2 ? 0 : layer * DM);
  f32x4 gv[4];
#pragma unroll
  for (int i = 0; i < 4; ++i) gv[i] = *(const f32x4*)(g + i * 256 + lane * 4);
  for (int row0 = gw; row0 < nrows; row0 += nw * NR) {
    f32x4 v[NR][4];
    float ss[NR];
#pragma unroll
    for (int j = 0; j < NR; ++j) {
      const int row = row0 + j * nw;
      ss[j] = 0.f;
      if (row < nrows) {
        if (pend_gate != nullptr && row >= MROWS) {
          const size_t ro = (size_t)(row - MROWS) * DM;
          const float* P = (const float*)(p.ws + OFF_SS) + ro;
#pragma unroll
          for (int i = 0; i < 4; ++i) {
            const int c = i * 256 + lane * 4;
            const f32x4 a = *(const f32x4*)(P + c), b2 = *(const f32x4*)(P + (size_t)CROWS * DM + c), c2 = *(const f32x4*)(P + (size_t)2 * CROWS * DM + c), d2 = *(const f32x4*)(P + (size_t)3 * CROWS * DM + c);
            v[j][i] = *(const f32x4*)(pend_hin + ro + c) + *(const f32x4*)(pend_gate + c) * (((a + b2) + c2) + d2);
          }
        } else {
          const float* h;
          if (row < MROWS) h = ((which == 0 && layer == 0) ? p.in[I_X] : p.out) + (size_t)row * DM;
          else h = ((which == 0 && layer == 0) ? p.in[I_CTX] : (const float*)(p.ws + OFF_HC)) + (size_t)(row - MROWS) * DM;
#pragma unroll
          for (int i = 0; i < 4; ++i) v[j][i] = *(const f32x4*)(h + i * 256 + lane * 4);
        }
      } else {
#pragma unroll
        for (int i = 0; i < 4; ++i) v[j][i] = (f32x4){0.f, 0.f, 0.f, 0.f};
      }
    }
#pragma unroll
    for (int j = 0; j < NR; ++j) {
      const int row = row0 + j * nw;
      if (row >= nrows) continue;
      if (pend_gate != nullptr && row >= MROWS) {
        float* hc = (float*)(p.ws + OFF_HC) + (size_t)(row - MROWS) * DM;
#pragma unroll
        for (int i = 0; i < 4; ++i) *(f32x4*)(hc + i * 256 + lane * 4) = v[j][i];
      }
#pragma unroll
      for (int i = 0; i < 4; ++i) ss[j] += v[j][i][0] * v[j][i][0] + v[j][i][1] * v[j][i][1] + v[j][i][2] * v[j][i][2] + v[j][i][3] * v[j][i][3];
      const float rstd = rsqrtf(wave_sum(ss[j]) * (1.f / DM) + EPS);
      if (which == 2) {
#pragma unroll
        for (int i = 0; i < 4; ++i) { f32x4 o = v[j][i] * rstd * gv[i]; *(f32x4*)(p.out + (size_t)row * DM + i * 256 + lane * 4) = o; }
      } else {
        const int bidx = row < MROWS ? (row >> 11) : 8;
        const float* sh = MOD + (size_t)(layer * 9 + bidx) * 6144 + which * 3072;
        const float* sc = sh + 1024;
#pragma unroll
        for (int i = 0; i < 4; ++i) {
          const int c = i * 256 + lane * 4;
          const f32x4 shv = *(const f32x4*)(sh + c), scv = *(const f32x4*)(sc + c);
          f32x4 o = v[j][i] * rstd * gv[i] * (1.f + scv) + shv;
          u32x2 w; w.x = pk_bf16(o[0], o[1]); w.y = pk_bf16(o[2], o[3]);
          *(u32x2*)(XN + (size_t)row * DM + c) = w;
        }
      }
    }
  }
}

namespace pg8 {
#define PG8_LAS __attribute__((address_space(3)))
typedef unsigned short bf16_t;
typedef short bf16x8 __attribute__((ext_vector_type(8)));
typedef float f32x4 __attribute__((ext_vector_type(4)));
typedef unsigned u32x4 __attribute__((ext_vector_type(4)));
constexpr int BM = 256, BK = 64, HALF = 128, HTB = HALF * BK * 2  , STAGE_BYTES = 8 * HTB, NXCD = 8, WGM = 8;

__host__ __device__ __forceinline__ int lds_byte(int r, int c) { const int st = (r >> 4) * 2 + (c >> 5), rr = r & 15, cc = c & 31, ob = rr * 64 + cc * 2; return st * 1024 + (ob ^ (((ob >> 9) & 1) << 5)); }
__host__ __device__ __forceinline__ void stage_rc(int b, int& R, int& C) { const int st = b / 1024, sb = b % 1024, swz = sb ^ (((sb >> 9) & 1) << 5); R = (st >> 1) * 16 + swz / 64; C = (st & 1) * 32 + (swz % 64) / 2; }
__host__ __device__ __forceinline__ int perm32(int rho) { const int n = rho >> 4, i = rho & 15; return 8 * (i >> 2) + 4 * n + (i & 3); }

struct Unit { int pm, pn; };
struct Gemm { const bf16_t* A; const bf16_t* Bt; int M, N, K, Kloop; };

struct StaticOrder {
    int nM, nN, nwg, G, c;
    __host__ __device__ void init(int M, int N, int G_, int c_) { nM = M / BM; nN = N / BM; nwg = nM * nN; G = G_; c = c_; }
    __host__ __device__ bool next(int i, Unit& u) const {
        const long L = (long)i * G + c; if (L >= nwg) return false;
        int wgid = (int)L; { const int q = nwg / NXCD, r = nwg % NXCD, xcd = wgid % NXCD, off = wgid / NXCD; wgid = (xcd < r ? xcd * (q + 1) : r * (q + 1) + (xcd - r) * q) + off; }
        const int nig = WGM * nN, gid = wgid / nig, fm = gid * WGM, gsz = (nM - fm) < WGM ? (nM - fm) : WGM;
        u.pm = fm + ((wgid % nig) % gsz); u.pn = (wgid % nig) / gsz; return true;
    }
    __device__ __forceinline__ void a_ready(const Unit&) const {}
    __device__ __forceinline__ void done(const Unit&) const {}
};


struct SplitOrder {
    int c;
    __host__ __device__ bool next(int i, Unit& u) const { if (i != 0 || c >= 128) return false; const int q = c & 31; u.pm = q & 7; u.pn = q >> 3; return true; }
    __device__ __forceinline__ void a_ready(const Unit&) const {}
    __device__ __forceinline__ void done(const Unit&) const {}
};
struct EpiPartial {
    static constexpr bool PERM = false, AFTER_DRAIN = false;
    float* P;
    __device__ __forceinline__ void operator()(const f32x4 (&acc)[2][2][4][2], const Unit& u, int wr, int wc, int fr, int fq) const {
        float* base = P + (size_t)u.pm * BM * 1024;
        const int col0 = u.pn * BM + wc * 32 + 4 * fq;
#pragma unroll
        for (int bj = 0; bj < 2; ++bj)
#pragma unroll
            for (int n = 0; n < 2; ++n)
#pragma unroll
                for (int ai = 0; ai < 2; ++ai)
#pragma unroll
                    for (int m = 0; m < 4; ++m) *(f32x4*)(base + (size_t)(ai * HALF + wr * 64 + m * 16 + fr) * 1024 + col0 + bj * HALF + n * 16) = acc[ai][bj][m][n];
    }
};
template <int ACT> struct EpiStore {
    static constexpr bool PERM = true, AFTER_DRAIN = false;
    bf16_t* O; int ldc; int ncols;
    __device__ __forceinline__ void operator()(const f32x4 (&acc)[2][2][4][2], const Unit& u, int wr, int wc, int fr, int fq) const {
        const int row0 = u.pm * BM + wr * 64 + fr, col0 = u.pn * BM + wc * 32 + 8 * fq;
#pragma unroll
        for (int ai = 0; ai < 2; ++ai)
#pragma unroll
            for (int m = 0; m < 4; ++m) { bf16_t* rowp = O + (size_t)(row0 + ai * HALF + m * 16) * ldc + col0;
#pragma unroll
                for (int bj = 0; bj < 2; ++bj) { if (col0 + bj * HALF < ncols) { f32x4 v0 = acc[ai][bj][m][0], v1 = acc[ai][bj][m][1];
                    if (ACT == 1) { v0 = __builtin_elementwise_max(v0, (f32x4){0.f, 0.f, 0.f, 0.f}); v1 = __builtin_elementwise_max(v1, (f32x4){0.f, 0.f, 0.f, 0.f}); v0 = v0 * v0; v1 = v1 * v1; }
                    u32x4 w; w.x = ::pk_bf16(v0[0], v0[1]); w.y = ::pk_bf16(v0[2], v0[3]); w.z = ::pk_bf16(v1[0], v1[1]); w.w = ::pk_bf16(v1[2], v1[3]);
                    *(u32x4*)(rowp + bj * HALF) = w; } } }
    }
};
struct EpiResid {
    static constexpr bool PERM = false, AFTER_DRAIN = false;
    const float* hin_m; const float* hin_c; float* hout_m; float* hout_c; const float* gate; float gscale;
    __device__ __forceinline__ void operator()(const f32x4 (&acc)[2][2][4][2], const Unit& u, int wr, int wc, int fr, int fq) const {
        const bool ismain = u.pm < 64;
        const float* hin = ismain ? hin_m + (size_t)u.pm * BM * 1024 : hin_c + (size_t)(u.pm - 64) * BM * 1024;
        float* hout = ismain ? hout_m + (size_t)u.pm * BM * 1024 : hout_c + (size_t)(u.pm - 64) * BM * 1024;
        const float* g = gate + (size_t)(ismain ? (u.pm >> 3) : 8) * 6144;
        const int col0 = u.pn * BM + wc * 32 + 4 * fq;
#pragma unroll
        for (int bj = 0; bj < 2; ++bj)
#pragma unroll
            for (int n = 0; n < 2; ++n) { const f32x4 gv = *(const f32x4*)(g + col0 + bj * HALF + n * 16) * gscale;
#pragma unroll
                for (int ai = 0; ai < 2; ++ai)
#pragma unroll
                    for (int m = 0; m < 4; ++m) { const size_t off = (size_t)(ai * HALF + wr * 64 + m * 16 + fr) * 1024 + col0 + bj * HALF + n * 16;
                        *(f32x4*)(hout + off) = *(const f32x4*)(hin + off) + gv * acc[ai][bj][m][n]; } }
    }
};
template <class Epi, class Sched, bool ALIGN_EPI = false, bool SP2 = false>
__device__ __forceinline__ void gemm_phase(PG8_LAS unsigned char* lds, const Gemm g, const Sched& S, const Epi& E) {
    const int tid = ::otid_full(), wid = __builtin_amdgcn_readfirstlane(tid >> 6), lane = tid & 63, wr = wid >> 2, wc = wid & 3, fr = lane & 15, fq = lane >> 4;
    const int K = g.K, nt = g.Kloop / BK;
    unsigned voffA[2], voffB[2];
#pragma unroll
    for (int i = 0; i < 2; ++i) { int R, C; stage_rc(tid * 16 + i * 8192, R, C); const int Rb = Epi::PERM ? ((R & ~31) + perm32(R & 31)) : R;
        voffA[i] = (unsigned)(R * K + C) * 2u; voffB[i] = (unsigned)(Rb * K + C) * 2u; }
    const size_t kstep = (size_t)(BK * 2);
    const size_t hstep = (size_t)HALF * K * 2;
    const size_t tstep = 2 * hstep;
    const unsigned ldsw = (unsigned)wid * 1024u;
    const int aoff = lds_byte(wr * 64 + fr, fq * 8), boff = lds_byte(wc * 32 + fr, fq * 8);
#define PG8_SA(b, h) (((b) * 2 + (h)) * HTB)
#define PG8_SB(b, h) ((4 + (b) * 2 + (h)) * HTB)
#define PG8_STAGE(bufoff, gbase, voff) do { _Pragma("unroll") for (int _i = 0; _i < 2; ++_i) \
        __builtin_amdgcn_global_load_lds((const unsigned*)((const char*)(gbase) + (voff)[_i]), (PG8_LAS unsigned*)(lds + (bufoff) + ldsw + _i * 8192), 16, 0, 0); } while (0)
#define PG8_LDA(dst, b, h) do { _Pragma("unroll") for (int m = 0; m < 4; ++m) _Pragma("unroll") for (int k = 0; k < 2; ++k) dst[m][k] = *(const PG8_LAS bf16x8*)(lds + PG8_SA(b, h) + aoff + m * 2048 + k * 1024); } while (0)
#define PG8_LDB(dst, b, h) do { _Pragma("unroll") for (int n = 0; n < 2; ++n) _Pragma("unroll") for (int k = 0; k < 2; ++k) dst[n][k] = *(const PG8_LAS bf16x8*)(lds + PG8_SB(b, h) + boff + n * 2048 + k * 1024); } while (0)
#define PG8_MMA(ai, bj, At, Bt) do { __builtin_amdgcn_s_setprio(1); _Pragma("unroll") for (int m = 0; m < 4; ++m) _Pragma("unroll") for (int n = 0; n < 2; ++n) _Pragma("unroll") for (int k = 0; k < 2; ++k) \
        acc[ai][bj][m][n] = __builtin_amdgcn_mfma_f32_16x16x32_bf16(Bt[n][k], At[m][k], acc[ai][bj][m][n], 0, 0, 0); __builtin_amdgcn_s_setprio(0); } while (0)
#define PG8_WAIT_V(n) asm volatile("s_waitcnt vmcnt(" #n ")" ::: "memory")
#define PG8_WAIT_L(n) asm volatile("s_waitcnt lgkmcnt(" #n ")" ::: "memory")
#define PG8_BAR __builtin_amdgcn_s_barrier()
#define PG8_SCHED __builtin_amdgcn_sched_barrier(0)
    Unit cur, nxt; int ui = 0;
    if (!S.next(0, cur)) return;
    f32x4 acc[2][2][4][2];
#pragma unroll
    for (int a = 0; a < 2; ++a)
#pragma unroll
        for (int b = 0; b < 2; ++b)
#pragma unroll
            for (int m = 0; m < 4; ++m)
#pragma unroll
                for (int n = 0; n < 2; ++n) acc[a][b][m][n] = (f32x4){0.f, 0.f, 0.f, 0.f};
    bf16x8 At[4][2], B0[2][2], B1[2][2];
    const char* cA = (const char*)g.A + (size_t)cur.pm * tstep; const char* cB = (const char*)g.Bt + (size_t)cur.pn * tstep;
    S.a_ready(cur);
    if constexpr (SP2) {
        PG8_STAGE(PG8_SB(0, 0), cB, voffB); PG8_STAGE(PG8_SB(0, 1), cB + hstep, voffB); PG8_STAGE(PG8_SA(0, 0), cA, voffA); PG8_STAGE(PG8_SA(0, 1), cA + hstep, voffA);
        if (wr == 1) PG8_BAR;
        PG8_WAIT_V(2); PG8_BAR;
        PG8_STAGE(PG8_SB(1, 0), cB + kstep, voffB); PG8_STAGE(PG8_SA(1, 0), cA + kstep, voffA); PG8_STAGE(PG8_SB(1, 1), cB + hstep + kstep, voffB);
        PG8_WAIT_V(6); PG8_BAR;
    } else {
        PG8_STAGE(PG8_SB(0, 0), cB, voffB); PG8_STAGE(PG8_SA(0, 0), cA, voffA); PG8_STAGE(PG8_SB(0, 1), cB + hstep, voffB); PG8_STAGE(PG8_SA(0, 1), cA + hstep, voffA);
        if (wr == 1) PG8_BAR;
        PG8_WAIT_V(4); PG8_BAR;
        PG8_STAGE(PG8_SB(1, 0), cB + kstep, voffB); PG8_STAGE(PG8_SA(1, 0), cA + kstep, voffA); PG8_STAGE(PG8_SB(1, 1), cB + hstep + kstep, voffB);
        PG8_WAIT_V(6); PG8_BAR;
    }
    for (;;) {
        const bool has_next = S.next(ui + 1, nxt);
        const char* nA = has_next ? (const char*)g.A + (size_t)nxt.pm * tstep : cA; const char* nB = has_next ? (const char*)g.Bt + (size_t)nxt.pn * tstep : cB;
        for (int t = 0; t < nt; t += 2) {
            const bool last = (t == nt - 2);
            const char* a1 = cA + (size_t)(t + 1) * kstep;
            const char* a2 = last ? nA : cA + (size_t)(t + 2) * kstep; const char* b2 = last ? nB : cB + (size_t)(t + 2) * kstep;
            const char* a3 = a2 + kstep; const char* b3 = b2 + kstep;
            if (last && has_next) S.a_ready(nxt);
            if constexpr (SP2) {
            PG8_LDB(B0, 0, 0); PG8_LDB(B1, 0, 1); PG8_SCHED; PG8_LDA(At, 0, 0); PG8_STAGE(PG8_SA(1, 1), a1 + hstep, voffA);
            PG8_WAIT_V(8); PG8_WAIT_L(0); PG8_BAR; PG8_MMA(0, 0, At, B0); PG8_MMA(0, 1, At, B1); PG8_BAR; PG8_SCHED;
            PG8_LDA(At, 0, 1); PG8_STAGE(PG8_SB(0, 0), b2, voffB); PG8_STAGE(PG8_SB(0, 1), b2 + hstep, voffB); PG8_STAGE(PG8_SA(0, 0), a2, voffA);
            PG8_WAIT_V(8); PG8_WAIT_L(0); PG8_BAR; PG8_MMA(1, 0, At, B0); PG8_MMA(1, 1, At, B1); PG8_BAR; PG8_SCHED;
            PG8_LDB(B0, 1, 0); PG8_LDB(B1, 1, 1); PG8_SCHED; PG8_LDA(At, 1, 0); PG8_STAGE(PG8_SA(0, 1), a2 + hstep, voffA);
            PG8_WAIT_V(8); PG8_WAIT_L(0); PG8_BAR; PG8_MMA(0, 0, At, B0); PG8_MMA(0, 1, At, B1); PG8_BAR; PG8_SCHED;
            PG8_LDA(At, 1, 1); PG8_STAGE(PG8_SB(1, 0), b3, voffB); PG8_STAGE(PG8_SB(1, 1), b3 + hstep, voffB); PG8_STAGE(PG8_SA(1, 0), a3, voffA);
            PG8_WAIT_V(8); PG8_WAIT_L(0); PG8_BAR; PG8_MMA(1, 0, At, B0); PG8_MMA(1, 1, At, B1); PG8_BAR; PG8_SCHED;
            } else {
            PG8_LDB(B0, 0, 0); PG8_SCHED; PG8_LDA(At, 0, 0); PG8_STAGE(PG8_SA(1, 1), a1 + hstep, voffA);
            PG8_WAIT_L(8); PG8_BAR; PG8_WAIT_L(0); PG8_MMA(0, 0, At, B0); PG8_BAR; PG8_SCHED;
            PG8_LDB(B1, 0, 1); PG8_STAGE(PG8_SB(0, 0), b2, voffB);
            PG8_BAR; PG8_WAIT_L(0); PG8_MMA(0, 1, At, B1); PG8_BAR;
            PG8_LDA(At, 0, 1); PG8_STAGE(PG8_SA(0, 0), a2, voffA);
            PG8_BAR; PG8_WAIT_L(0); PG8_MMA(1, 0, At, B0); PG8_BAR; PG8_SCHED;
            PG8_STAGE(PG8_SB(0, 1), b2 + hstep, voffB);
            PG8_WAIT_V(6); PG8_BAR; PG8_MMA(1, 1, At, B1); PG8_BAR;
            PG8_LDB(B0, 1, 0); PG8_SCHED; PG8_LDA(At, 1, 0); PG8_STAGE(PG8_SA(0, 1), a2 + hstep, voffA);
            PG8_WAIT_L(8); PG8_BAR; PG8_WAIT_L(0); PG8_MMA(0, 0, At, B0); PG8_BAR; PG8_SCHED;
            PG8_LDB(B1, 1, 1); PG8_STAGE(PG8_SB(1, 0), b3, voffB);
            PG8_BAR; PG8_WAIT_L(0); PG8_MMA(0, 1, At, B1); PG8_BAR;
            PG8_LDA(At, 1, 1); PG8_STAGE(PG8_SA(1, 0), a3, voffA);
            PG8_BAR; PG8_WAIT_L(0); PG8_MMA(1, 0, At, B0); PG8_BAR; PG8_SCHED;
            PG8_STAGE(PG8_SB(1, 1), b3 + hstep, voffB);
            PG8_WAIT_V(6); PG8_BAR; PG8_MMA(1, 1, At, B1); PG8_BAR;
            }
        }
        if constexpr (ALIGN_EPI) { if (wr == 0) PG8_BAR; }
        if constexpr (!Epi::AFTER_DRAIN) { E(acc, cur, wr, wc, fr, fq); S.done(cur); }
        if (!has_next) break;
#pragma unroll
        for (int a = 0; a < 2; ++a)
#pragma unroll
            for (int b = 0; b < 2; ++b)
#pragma unroll
                for (int m = 0; m < 4; ++m)
#pragma unroll
                    for (int n = 0; n < 2; ++n) acc[a][b][m][n] = (f32x4){0.f, 0.f, 0.f, 0.f};
        cur = nxt; cA = nA; cB = nB; ++ui;
        if constexpr (ALIGN_EPI) { if (wr == 1) PG8_BAR; }
    }
    PG8_WAIT_V(0);
    if constexpr (!ALIGN_EPI) { if (wr == 0) PG8_BAR; }
    PG8_BAR;
    if constexpr (Epi::AFTER_DRAIN) { E.fused(acc, cur, wr, wc, fr, fq, lds, wid, lane); S.done(cur); }
#undef PG8_SA
#undef PG8_SB
#undef PG8_STAGE
#undef PG8_LDA
#undef PG8_LDB
#undef PG8_MMA
#undef PG8_WAIT_V
#undef PG8_WAIT_L
#undef PG8_BAR
#undef PG8_SCHED
}
}

DI void prep_tile(const Params& p, int layer, int tile, int part, char* smem) {
  const int tid = otid(), lane = tid & 63, wave = tid >> 6, l31 = lane & 31, hi = lane >> 5;
  const int b = tile / 36, tb = tile % 36, p0 = tb * 64;
  const bool isctx = tb < 4;
  const int row0 = isctx ? (MROWS + b * CT + p0) : (b * SEQ + p0 - CT);
  const bf16_t* U = (const bf16_t*)(p.ws + OFF_U);
  const f32x2* ropeH = (const f32x2*)(p.ws + OFF_ROPEH);
  const f32x2* ropeD = (const f32x2*)(p.ws + OFF_ROPED);
  bf16_t* QD = (bf16_t*)(p.ws + OFF_QD); bf16_t* KD = (bf16_t*)(p.ws + OFF_KD); bf16_t* VTD = (bf16_t*)(p.ws + OFF_VTD);
  bf16_t* QG = (bf16_t*)(p.ws + OFF_QG); bf16_t* KG = (bf16_t*)(p.ws + OFF_KG); bf16_t* VTG = (bf16_t*)(p.ws + OFF_VTG);
  bf16_t* QM = (bf16_t*)(p.ws + OFF_QM); bf16_t* KM = (bf16_t*)(p.ws + OFF_KM); bf16_t* VTM = (bf16_t*)(p.ws + OFF_VTM);
  const float qsD = 0.17677669529663687f * LOG2E, qsG = 0.125f * LOG2E, qsM = 0.10206207261596575f * LOG2E;
  bf16_t* sT = (bf16_t*)smem; bf16_t* sCq = (bf16_t*)(smem + 9216); bf16_t* sCkv = (bf16_t*)(smem + 9216 + 25600);

  if (part == 0) {
  for (int tk = wave; tk < 64; tk += 4) {
    const bf16_t* urow = U + (size_t)(row0 + tk) * INP;
    const int pos = p0 + tk, t = pos - CT;
    float xv[15];
#pragma unroll
    for (int g = 0; g < 15; ++g) {
      const int col = g < 4 ? U_DQ + g * 64 + lane : g < 8 ? U_DK + (g - 4) * 64 + lane : g < 12 ? U_GQ + (g - 8) * 64 + lane : g < 14 ? U_GK + (g - 12) * 64 + lane : U_MR + l31;
      xv[g] = bf2f(urow[col]);
    }
    f32x2 csD = {1.f, 0.f}, csH = {1.f, 0.f};
    if (!isctx) { csD = ropeD[t * 16 + (lane & 15)]; csH = ropeH[t * 32 + l31]; }
#pragma unroll
    for (int g = 0; g < 15; ++g) {
      float x = xv[g];
      if (g < 8) {
        const int h = g & 3; const bool isq = g < 4;
        const int d = lane & 31, m = lane >> 5;
        if (!isctx) { const float pr = __shfl_xor(x, 16); x = (d < 16) ? (x * csD.x - pr * csD.y) : (pr * csD.y + x * csD.x); }
        if (isq) x *= qsD;
        (isq ? QD : KD)[(((size_t)b * 8 + h * 2 + m) * TT + pos) * 32 + d] = f2bf(x);
      } else if (g < 14) {
        const bool isq = g < 12; const int h = isq ? g - 8 : g - 12;
        const float ss = wave_sum(x * x);
        x = x * rsqrtf(ss * (1.f / 64.f) + EPS) * (isq ? p.in[I_GQN] : p.in[I_GKN])[layer * 64 + lane];
        if (!isctx) { const float pr = __shfl_xor(x, 32); x = (lane < 32) ? (x * csH.x - pr * csH.y) : (pr * csH.y + x * csH.x); }
        if (isq) { x *= qsG; QG[(((size_t)b * 4 + h) * TT + pos) * 64 + lane] = f2bf(x); }
        else KG[(((size_t)b * 2 + h) * TT + pos) * 64 + lane] = f2bf(x);
      } else {
        const int d = l31;
        if (!isctx) { const float pr = __shfl_xor(x, 16); x = (d < 16) ? (x * csD.x - pr * csD.y) : (pr * csD.y + x * csD.x); }
        const bf16_t v = f2bf(x);
        const int hh = hi * 2;
        KM[(((size_t)b * 4 + hh) * TT + pos) * 96 + 64 + d] = v;
        KM[(((size_t)b * 4 + hh + 1) * TT + pos) * 96 + 64 + d] = v;
      }
    }
  }
  for (int g = 0; g < 6; ++g) {
    const int colbase = g < 4 ? U_DV + g * 64 : U_GV + (g - 4) * 64;
    bf16_t* dst = g < 4 ? VTD + ((size_t)(b * 4 + g) * 64) * TT : VTG + ((size_t)(b * 2 + g - 4) * 64) * TT;
#pragma unroll
    for (int i = 0; i < 2; ++i) {
      const int c = tid + 256 * i, tk = c >> 3, kc = c & 7;
      const u32x4 v = *(const u32x4*)(U + (size_t)(row0 + tk) * INP + colbase + kc * 8);
      sT[(kc * 8 + 0) * 72 + tk] = (bf16_t)(v.x & 0xffff); sT[(kc * 8 + 1) * 72 + tk] = (bf16_t)(v.x >> 16);
      sT[(kc * 8 + 2) * 72 + tk] = (bf16_t)(v.y & 0xffff); sT[(kc * 8 + 3) * 72 + tk] = (bf16_t)(v.y >> 16);
      sT[(kc * 8 + 4) * 72 + tk] = (bf16_t)(v.z & 0xffff); sT[(kc * 8 + 5) * 72 + tk] = (bf16_t)(v.z >> 16);
      sT[(kc * 8 + 6) * 72 + tk] = (bf16_t)(v.w & 0xffff); sT[(kc * 8 + 7) * 72 + tk] = (bf16_t)(v.w >> 16);
    }
    __syncthreads();
    {
      const int dv = tid >> 2, part = tid & 3;
      const u32x4 a = *(const u32x4*)(sT + dv * 72 + part * 16), bq = *(const u32x4*)(sT + dv * 72 + part * 16 + 8);
      bf16_t* d = dst + (size_t)dv * TT + p0 + part * 16;
      *(u32x4*)d = a; *(u32x4*)(d + 8) = bq;
    }
    __syncthreads();
  }
  return;
  }
#pragma unroll 4
  for (int tk = wave; tk < 64; tk += 4) {
    const bf16_t* urow = U + (size_t)(row0 + tk) * INP;
    const float q0 = bf2f(urow[U_MQ + lane]), q1 = bf2f(urow[U_MQ + 64 + lane]), q2 = bf2f(urow[U_MQ + 128 + lane]);
    const float k0 = bf2f(urow[U_MKV + lane]), k1 = bf2f(urow[U_MKV + 64 + lane]);
    const float sq = wave_sum(q0 * q0 + q1 * q1 + q2 * q2), sk = wave_sum(k0 * k0 + k1 * k1);
    const float rq = rsqrtf(sq * (1.f / 192.f) + EPS), rk = rsqrtf(sk * (1.f / 128.f) + EPS);
    const float* gq = p.in[I_MQN] + layer * 192; const float* gk = p.in[I_MKVN] + layer * 128;
    sCq[tk * 200 + lane] = f2bf(q0 * rq * gq[lane]); sCq[tk * 200 + 64 + lane] = f2bf(q1 * rq * gq[64 + lane]); sCq[tk * 200 + 128 + lane] = f2bf(q2 * rq * gq[128 + lane]);
    sCkv[tk * 136 + lane] = f2bf(k0 * rk * gk[lane]); sCkv[tk * 136 + 64 + lane] = f2bf(k1 * rk * gk[64 + lane]);
  }
  __syncthreads();
  const bf16_t* Wkv = (const bf16_t*)(p.ws + OFF_WUKV) + (size_t)layer * 512 * 128;
  const bf16_t* Wq = (const bf16_t*)(p.ws + OFF_WUQ) + (size_t)layer * 384 * 192;
  for (int task = wave; task < 56; task += 4) {
    if (task < 32) {
      const int ct = task >> 1, tt = task & 1, head = ct >> 2, sub = ct & 3, n0 = head * 128 + sub * 32;
      f32x16 acc = zero16();
      const bf16_t* wrow = Wkv + (size_t)(n0 + l31) * 128 + hi * 8;
      const bf16_t* trow = sCkv + (tt * 32 + l31) * 136 + hi * 8;
      if (sub < 2) {
#pragma unroll
        for (int ks = 0; ks < 8; ++ks) acc = MFMA32(*(const bf16x8*)(wrow + ks * 16), *(const bf16x8*)(trow + ks * 16), acc);
        bf16_t* d = KM + (((size_t)b * 4 + head) * TT + p0 + tt * 32 + l31) * 96 + sub * 32 + 4 * hi;
#pragma unroll
        for (int r4 = 0; r4 < 4; ++r4) { u32x2 w; w.x = pk_bf16(acc[4 * r4], acc[4 * r4 + 1]); w.y = pk_bf16(acc[4 * r4 + 2], acc[4 * r4 + 3]); *(u32x2*)(d + 8 * r4) = w; }
      } else {
#pragma unroll
        for (int ks = 0; ks < 8; ++ks) acc = MFMA32(*(const bf16x8*)(trow + ks * 16), *(const bf16x8*)(wrow + ks * 16), acc);
        bf16_t* d = VTM + (((size_t)b * 4 + head) * 64 + (sub - 2) * 32 + l31) * TT + p0 + tt * 32 + 4 * hi;
#pragma unroll
        for (int r4 = 0; r4 < 4; ++r4) { u32x2 w; w.x = pk_bf16(acc[4 * r4], acc[4 * r4 + 1]); w.y = pk_bf16(acc[4 * r4 + 2], acc[4 * r4 + 3]); *(u32x2*)(d + 8 * r4) = w; }
      }
    } else {
      const int t2 = task - 32, ct = t2 >> 1, tt = t2 & 1, head = ct / 3, sub = ct % 3, n0 = head * 96 + sub * 32;
      f32x16 acc = zero16();
      const bf16_t* wrow = Wq + (size_t)(n0 + l31) * 192 + hi * 8;
      const bf16_t* trow = sCq + (tt * 32 + l31) * 200 + hi * 8;
#pragma unroll
      for (int ks = 0; ks < 12; ++ks) acc = MFMA32(*(const bf16x8*)(wrow + ks * 16), *(const bf16x8*)(trow + ks * 16), acc);
      const int pos = p0 + tt * 32 + l31;
      if (sub == 2 && !isctx) {
        const int t = pos - CT;
#pragma unroll
        for (int r = 0; r < 8; ++r) {
          const f32x2 cs = ropeD[t * 16 + crow(r, hi)];
          const float x1 = acc[r], x2 = acc[r + 8];
          acc[r] = x1 * cs.x - x2 * cs.y; acc[r + 8] = x1 * cs.y + x2 * cs.x;
        }
      }
      bf16_t* d = QM + (((size_t)b * 4 + head) * TT + pos) * 96 + sub * 32 + 4 * hi;
#pragma unroll
      for (int r4 = 0; r4 < 4; ++r4) { u32x2 w; w.x = pk_bf16(acc[4 * r4] * qsM, acc[4 * r4 + 1] * qsM); w.y = pk_bf16(acc[4 * r4 + 2] * qsM, acc[4 * r4 + 3] * qsM); *(u32x2*)(d + 8 * r4) = w; }
    }
  }
  __syncthreads();
}

template <int DQK>
DI void attn_core(const bf16_t* __restrict__ Qb, const bf16_t* __restrict__ Kb, const bf16_t* __restrict__ Vt, int q0, int ntiles,
                  f32x16 (&O)[2], float& lsum, char* smem) {
  const int tid = otid_full(), lane = tid & 63, wave = tid >> 6, l31 = lane & 31, hi = lane >> 5;
  constexpr int KS = DQK / 16, KROW = DQK + 8, KCH = DQK / 8;
  constexpr int KBYTES = 64 * KROW * 2, BUFB = KBYTES + 9216;
  constexpr int NK = 64 * KCH, NKC = (NK + NTHREADS - 1) / NTHREADS;
  static_assert(2 * BUFB <= 49152, "attention LDS");
  bf16x8 qf[KS];
#pragma unroll
  for (int ks = 0; ks < KS; ++ks) qf[ks] = *(const bf16x8*)(Qb + (size_t)(q0 + wave * 32 + l31) * DQK + ks * 16 + hi * 8);
  float mrun = -1e30f; lsum = 0.f; O[0] = zero16(); O[1] = zero16();
  const bf16_t* kg[NKC]; int kl[NKC]; bool kok[NKC];
#pragma unroll
  for (int i = 0; i < NKC; ++i) {
    const int c = tid + NTHREADS * i, key = c / KCH, kc = c % KCH;
    kok[i] = c < NK;
    kg[i] = Kb + (size_t)key * DQK + kc * 8;
    kl[i] = (key * KROW + kc * 8) * 2;
  }
  const bf16_t* vg; int vl;
  { const int dv = tid >> 3, kc = tid & 7; vg = Vt + (size_t)dv * TT + kc * 8; vl = KBYTES + (dv * 72 + kc * 8) * 2; }
  u32x4 rk[NKC], rv;
#pragma unroll
  for (int i = 0; i < NKC; ++i) if (kok[i]) rk[i] = *(const u32x4*)(kg[i]);
  rv = *(const u32x4*)(vg);
#pragma unroll
  for (int i = 0; i < NKC; ++i) if (kok[i]) *(u32x4*)(smem + kl[i]) = rk[i];
  *(u32x4*)(smem + vl) = rv;
  __syncthreads();
  for (int kt = 0; kt < ntiles; ++kt) {
    const int cur = kt & 1; const bool more = kt + 1 < ntiles;
    if (more) {
#pragma unroll
      for (int i = 0; i < NKC; ++i) if (kok[i]) rk[i] = *(const u32x4*)(kg[i] + (size_t)(kt + 1) * 64 * DQK);
      rv = *(const u32x4*)(vg + (kt + 1) * 64);
    }
    const char* sb = smem + cur * BUFB;
    f32x16 s[2];
#pragma unroll
    for (int kb = 0; kb < 2; ++kb) {
      s[kb] = zero16();
      const char* kr = sb + ((kb * 32 + l31) * KROW + hi * 8) * 2;
#pragma unroll
      for (int ks = 0; ks < KS; ++ks) s[kb] = MFMA32(*(const bf16x8*)(kr + ks * 32), qf[ks], s[kb]);
    }
    float mx = s[0][0];
#pragma unroll
    for (int r = 0; r < 16; ++r) { mx = fmaxf(mx, s[0][r]); mx = fmaxf(mx, s[1][r]); }
    mx = fmaxf(mx, __shfl_xor(mx, 32));
    const float mnew = fmaxf(mrun, mx);
    const float alpha = __builtin_amdgcn_exp2f(mrun - mnew);
    mrun = mnew;
    float rs = 0.f;
#pragma unroll
    for (int kb = 0; kb < 2; ++kb)
#pragma unroll
      for (int r = 0; r < 16; ++r) { const float e = __builtin_amdgcn_exp2f(s[kb][r] - mnew); s[kb][r] = e; rs += e; }
    lsum = lsum * alpha + rs;
    O[0] *= alpha; O[1] *= alpha;
#pragma unroll
    for (int s4 = 0; s4 < 4; ++s4) {
      const int kb = s4 >> 1, hf = (s4 & 1) * 8;
      const bf16x8 pb = pack8(s[kb][hf + 0], s[kb][hf + 1], s[kb][hf + 2], s[kb][hf + 3], s[kb][hf + 4], s[kb][hf + 5], s[kb][hf + 6], s[kb][hf + 7]);
#pragma unroll
      for (int dvb = 0; dvb < 2; ++dvb) {
        const char* vr = sb + KBYTES + ((dvb * 32 + l31) * 72 + s4 * 16 + hi * 4) * 2;
        const s16x4 lo = *(const s16x4*)vr, h4 = *(const s16x4*)(vr + 16);
        const bf16x8 a = __builtin_shufflevector(lo, h4, 0, 1, 2, 3, 4, 5, 6, 7);
        O[dvb] = MFMA32(a, pb, O[dvb]);
      }
    }
    if (more) {
      char* db = smem + (cur ^ 1) * BUFB;
#pragma unroll
      for (int i = 0; i < NKC; ++i) if (kok[i]) *(u32x4*)(db + kl[i]) = rk[i];
      *(u32x4*)(db + vl) = rv;
    }
    __syncthreads();
  }
  lsum += __shfl_xor(lsum, 32);
}

DI void attn_unit(const Params& p, int layer, int b, int kind, int head, int qb, char* smem) {
  const int tid_ = otid_full(); const int lane = tid_ & 63, wave = tid_ >> 6, l31 = lane & 31, hi = lane >> 5;
  const int q0 = qb * 256;
  const int ntiles = qb == 0 ? 4 : 36;
  bf16_t* Y = (bf16_t*)(p.ws + OFF_Y);
  const int pos = q0 + wave * 32 + l31;
  bf16_t* yrow = Y + (size_t)hrow_of(b, pos) * DM;
  f32x16 O[2]; float ls;
  if (kind == 1) {
    attn_core<32>((const bf16_t*)(p.ws + OFF_QD) + ((size_t)b * 8 + head * 2) * TT * 32, (const bf16_t*)(p.ws + OFF_KD) + ((size_t)b * 8 + head * 2) * TT * 32,
                  (const bf16_t*)(p.ws + OFF_VTD) + ((size_t)b * 4 + head) * 64 * TT, q0, ntiles, O, ls, smem);
    float* st = (float*)(smem + 49152) + tid_;
    {
      const float i0 = 1.f / ls;
#pragma unroll
      for (int dvb = 0; dvb < 2; ++dvb)
#pragma unroll
        for (int r = 0; r < 16; ++r) st[(dvb * 16 + r) * NTHREADS] = O[dvb][r] * i0;
    }
    __syncthreads();
    attn_core<32>((const bf16_t*)(p.ws + OFF_QD) + ((size_t)b * 8 + head * 2 + 1) * TT * 32, (const bf16_t*)(p.ws + OFF_KD) + ((size_t)b * 8 + head * 2 + 1) * TT * 32,
                  (const bf16_t*)(p.ws + OFF_VTD) + ((size_t)b * 4 + head) * 64 * TT, q0, ntiles, O, ls, smem);
    const float* misc = (const float*)(p.ws + OFF_MISC);
    const float lam = misc[128 + layer], li = misc[136 + layer];
    const float i1 = lam / ls;
    float ss = 0.f;
#pragma unroll
    for (int dvb = 0; dvb < 2; ++dvb)
#pragma unroll
      for (int r = 0; r < 16; ++r) { const float o = st[(dvb * 16 + r) * NTHREADS] - O[dvb][r] * i1; O[dvb][r] = o; ss += o * o; }
    ss += __shfl_xor(ss, 32);
    const float rstd = rsqrtf(ss * (1.f / 64.f) + EPS) * (1.f - li);
    const float* g = p.in[I_DNG] + layer * 64;
#pragma unroll
    for (int dvb = 0; dvb < 2; ++dvb)
#pragma unroll
      for (int r4 = 0; r4 < 4; ++r4) {
        const int dv = dvb * 32 + 8 * r4 + 4 * hi;
        const f32x4 gv = *(const f32x4*)(g + dv);
        u32x2 w; w.x = pk_bf16(O[dvb][4 * r4] * rstd * gv[0], O[dvb][4 * r4 + 1] * rstd * gv[1]);
        w.y = pk_bf16(O[dvb][4 * r4 + 2] * rstd * gv[2], O[dvb][4 * r4 + 3] * rstd * gv[3]);
        *(u32x2*)(yrow + 256 + head * 64 + dv) = w;
      }
  } else {
    int ycol;
    if (kind == 2) {
      attn_core<64>((const bf16_t*)(p.ws + OFF_QG) + ((size_t)b * 4 + head) * TT * 64, (const bf16_t*)(p.ws + OFF_KG) + ((size_t)b * 2 + (head >> 1)) * TT * 64,
                    (const bf16_t*)(p.ws + OFF_VTG) + ((size_t)b * 2 + (head >> 1)) * 64 * TT, q0, ntiles, O, ls, smem);
      ycol = 512 + head * 64;
    } else {
      attn_core<96>((const bf16_t*)(p.ws + OFF_QM) + ((size_t)b * 4 + head) * TT * 96, (const bf16_t*)(p.ws + OFF_KM) + ((size_t)b * 4 + head) * TT * 96,
                    (const bf16_t*)(p.ws + OFF_VTM) + ((size_t)b * 4 + head) * 64 * TT, q0, ntiles, O, ls, smem);
      ycol = 768 + head * 64;
    }
    const float inv = 1.f / ls;
#pragma unroll
    for (int dvb = 0; dvb < 2; ++dvb)
#pragma unroll
      for (int r4 = 0; r4 < 4; ++r4) {
        const int dv = dvb * 32 + 8 * r4 + 4 * hi;
        u32x2 w; w.x = pk_bf16(O[dvb][4 * r4] * inv, O[dvb][4 * r4 + 1] * inv); w.y = pk_bf16(O[dvb][4 * r4 + 2] * inv, O[dvb][4 * r4 + 3] * inv);
        *(u32x2*)(yrow + ycol + dv) = w;
      }
  }
}

DI void ssd_chunk(const Params& p, int layer, int item, char* smem) {
  const int tid = otid(), lane = tid & 63, wave = tid >> 6, l31 = lane & 31, hi = lane >> 5;
  const int pi = wave >> 1, li = wave & 1;
  const int ck = item % 36, r_ = item / 36, d = r_ & 1, g = (r_ >> 1) & 1, b = r_ >> 2, h = 2 * g + half_id(), chain = (b * 4 + h) * 2 + d;
  const bf16_t* U = (const bf16_t*)(p.ws + OFF_U);
  bf16_t* Yssd = (bf16_t*)(p.ws + OFF_XN) + (size_t)d * ROWS * 256;
  bf16_t* sXT = (bf16_t*)smem;
  bf16_t* sB = (bf16_t*)(smem + 9216);
  bf16_t* sC = (bf16_t*)(smem + 18432);
  bf16_t* sBT = (bf16_t*)(smem + 27648);
  float* scs = (float*)(smem + 46080);
  float* sdt = (float*)(smem + 46336);
  float* sW = (float*)(smem + 46592);
  const bool isctx = ck < 4;
  const int Len = isctx ? CT : SEQ, base = isctx ? (MROWS + b * CT) : (b * SEQ), kl = isctx ? ck : ck - 4;
  if (tid < 192) {
    const int cc = tid >> 6, e = tid & 63;
    const int ch = cc == 0 ? (h * 64 + e) : (cc == 1 ? 256 + g * 64 + e : 384 + g * 64 + e);
    const float* cw = p.in[I_CONVW] + ((size_t)layer * 512 + ch) * 3;
    sW[tid * 4 + 0] = cw[0]; sW[tid * 4 + 1] = cw[1]; sW[tid * 4 + 2] = cw[2]; sW[tid * 4 + 3] = p.in[I_CONVB][layer * 512 + ch];
  }
  const bool wrC = (half_id() == 0) && (d == 0);
  bf16_t* CB = (bf16_t*)(p.ws + OFF_CB);
  float raw_dt = 0.f;
  if (wave == 1) {
    const int posj = kl * 64 + lane, t = d ? (Len - 1 - posj) : posj;
    raw_dt = bf2f(U[(size_t)(base + t) * INP + U_DT + d * 4 + h]);
  }
  u32x4 vm6[6], v06[6], vp6[6];
#pragma unroll
  for (int i = 0; i < 6; ++i) {
    const int task = tid + 256 * i, j = task / 24, cc = task % 24;
    const int posj = kl * 64 + j, t = d ? (Len - 1 - posj) : posj;
    const int grp = cc >> 3, c8 = (cc & 7) * 8;
    const int ucol = grp == 0 ? (U_X + h * 64 + c8) : (grp == 1 ? U_B + g * 64 + c8 : U_C + g * 64 + c8);
    const bf16_t* up = U + (size_t)(base + t) * INP + ucol;
    const u32x4 z4 = {0u, 0u, 0u, 0u};
    vm6[i] = (t > 0) ? *(const u32x4*)(up - INP) : z4;
    v06[i] = *(const u32x4*)up;
    vp6[i] = (t < Len - 1) ? *(const u32x4*)(up + INP) : z4;
  }
  if (wave == 1) {
    const float dtb = p.in[I_DTB][layer * 8 + d * 4 + h];
    const float aneg = -expf(p.in[I_ALOG][layer * 8 + d * 4 + h]);
    const int posj = kl * 64 + lane, t = d ? (Len - 1 - posj) : posj;
    const float raw = raw_dt + dtb;
    const float e_ = __expf(-fabsf(raw));
    const float dtv = fmaxf(raw, 0.f) + (e_ < 0.03f ? e_ * (1.f - e_ * (0.5f - e_ * 0.33333334f)) : __logf(1.f + e_));
    float c = dtv * aneg;
#pragma unroll
    for (int o = 1; o < 64; o <<= 1) { const float tv = __shfl_up(c, o); if (lane >= o) c += tv; }
    sdt[lane] = dtv; scs[lane] = c;
    ((float*)(p.ws + OFF_ECL))[(size_t)(d * 4 + h) * ROWS + base + t] = __expf(c);
    if (lane == 63) ((float*)(p.ws + OFF_DEC))[chain * 36 + ck] = __expf(c);
  }
  __syncthreads();
  const float c63 = scs[63];
#pragma unroll
  for (int i = 0; i < 6; ++i) {
    const int task = tid + 256 * i, j = task / 24, cc = task % 24;
    const int posj = kl * 64 + j, t = d ? (Len - 1 - posj) : posj;
    const int grp = cc >> 3, c8 = (cc & 7) * 8;
    const u32x4 vm = vm6[i], v0 = v06[i], vp = vp6[i];
    float o[8];
#pragma unroll
    for (int e2 = 0; e2 < 4; ++e2) {
      const unsigned wm_ = e2 == 0 ? vm.x : e2 == 1 ? vm.y : e2 == 2 ? vm.z : vm.w;
      const unsigned w0_ = e2 == 0 ? v0.x : e2 == 1 ? v0.y : e2 == 2 ? v0.z : v0.w;
      const unsigned wp_ = e2 == 0 ? vp.x : e2 == 1 ? vp.y : e2 == 2 ? vp.z : vp.w;
      const f32x4 wa = *(const f32x4*)(sW + (grp * 64 + c8 + 2 * e2) * 4), wb = *(const f32x4*)(sW + (grp * 64 + c8 + 2 * e2 + 1) * 4);
      o[2 * e2] = silu_f(wa[0] * bflo(wm_) + wa[1] * bflo(w0_) + wa[2] * bflo(wp_) + wa[3]);
      o[2 * e2 + 1] = silu_f(wb[0] * bfhi(wm_) + wb[1] * bfhi(w0_) + wb[2] * bfhi(wp_) + wb[3]);
    }
    if (grp == 0) {
      const float dtv = sdt[j];
#pragma unroll
      for (int e = 0; e < 8; ++e) sXT[(c8 + e) * 72 + j] = f2bf(o[e] * dtv);
    } else if (grp == 1) {
      const float sc_ = __expf(c63 - scs[j]);
      u32x4 w; w.x = pk_bf16(o[0], o[1]); w.y = pk_bf16(o[2], o[3]); w.z = pk_bf16(o[4], o[5]); w.w = pk_bf16(o[6], o[7]);
      *(u32x4*)(sB + j * 72 + c8) = w;
#pragma unroll
      for (int e = 0; e < 8; ++e) sBT[(c8 + e) * 72 + j] = f2bf(o[e] * sc_);
    } else {
      u32x4 w; w.x = pk_bf16(o[0], o[1]); w.y = pk_bf16(o[2], o[3]); w.z = pk_bf16(o[4], o[5]); w.w = pk_bf16(o[6], o[7]);
      *(u32x4*)(sC + j * 72 + c8) = w;
      if (wrC) *(u32x4*)(CB + (size_t)(base + t) * 128 + g * 64 + c8) = w;
    }
  }
  __syncthreads();
  const int lcol = 32 * li + l31;
  const float cl = scs[lcol];
  f32x16 y = zero16();
#pragma unroll
  for (int si = 0; si < 2; ++si) {
    if (si <= li) {
      f32x16 gt = zero16();
#pragma unroll
      for (int ks = 0; ks < 4; ++ks) gt = MFMA32(*(const bf16x8*)(sB + (32 * si + l31) * 72 + ks * 16 + hi * 8), *(const bf16x8*)(sC + lcol * 72 + ks * 16 + hi * 8), gt);
#pragma unroll
      for (int r = 0; r < 16; ++r) { const int s_ = 32 * si + crow(r, hi); gt[r] = (s_ <= lcol) ? gt[r] * __expf(cl - scs[s_]) : 0.f; }
#pragma unroll
      for (int kk = 0; kk < 2; ++kk) {
        const bf16x8 pb = pack8(gt[8 * kk], gt[8 * kk + 1], gt[8 * kk + 2], gt[8 * kk + 3], gt[8 * kk + 4], gt[8 * kk + 5], gt[8 * kk + 6], gt[8 * kk + 7]);
        const bf16_t* xr = sXT + (32 * pi + l31) * 72 + 32 * si + 16 * kk + 4 * hi;
        const s16x4 lo = *(const s16x4*)xr, h4 = *(const s16x4*)(xr + 8);
        y = MFMA32(__builtin_shufflevector(lo, h4, 0, 1, 2, 3, 4, 5, 6, 7), pb, y);
      }
    }
  }
  {
    const int posl = kl * 64 + lcol, t = d ? (Len - 1 - posl) : posl;
    bf16_t* yp = Yssd + (size_t)(base + t) * 256 + h * 64 + 32 * pi + 4 * hi;
#pragma unroll
    for (int r4 = 0; r4 < 4; ++r4) { u32x2 o; o.x = pk_bf16(y[4 * r4], y[4 * r4 + 1]); o.y = pk_bf16(y[4 * r4 + 2], y[4 * r4 + 3]); *(u32x2*)(yp + 8 * r4) = o; }
  }
  f32x16 sacc = zero16();
#pragma unroll
  for (int ks = 0; ks < 4; ++ks) sacc = MFMA32(*(const bf16x8*)(sXT + (32 * pi + l31) * 72 + ks * 16 + hi * 8), *(const bf16x8*)(sBT + (32 * li + l31) * 72 + ks * 16 + hi * 8), sacc);
  bf16_t* Sp = (bf16_t*)(p.ws + OFF_SS) + ((size_t)chain * 37 + ck + 1) * 4096;
#pragma unroll
  for (int r = 0; r < 16; ++r) Sp[(32 * pi + crow(r, hi)) * 64 + 32 * li + l31] = f2bf(sacc[r]);
  __syncthreads();
}

DI void ssd_scan(const Params& p, int chain) {
  const int tid = otid();
  char* slot0 = p.ws + OFF_SS + (size_t)chain * 37 * 8192 + tid * 32;
  const float* dec = (const float*)(p.ws + OFF_DEC) + chain * 36;
  float H[16];
#pragma unroll
  for (int i = 0; i < 16; ++i) H[i] = 0.f;
#pragma unroll 4
  for (int c = 0; c < 36; ++c) {
    const u32x4* sp = (const u32x4*)(slot0 + (size_t)(c + 1) * 8192);
    const u32x4 s0 = sp[0], s1 = sp[1];
    const float dc = dec[c];
    u32x4 w0, w1;
    w0.x = pk_bf16(H[0], H[1]); w0.y = pk_bf16(H[2], H[3]); w0.z = pk_bf16(H[4], H[5]); w0.w = pk_bf16(H[6], H[7]);
    w1.x = pk_bf16(H[8], H[9]); w1.y = pk_bf16(H[10], H[11]); w1.z = pk_bf16(H[12], H[13]); w1.w = pk_bf16(H[14], H[15]);
    u32x4* hp = (u32x4*)(slot0 + (size_t)c * 8192);
    hp[0] = w0; hp[1] = w1;
    H[0] = H[0] * dc + bflo(s0.x); H[1] = H[1] * dc + bfhi(s0.x); H[2] = H[2] * dc + bflo(s0.y); H[3] = H[3] * dc + bfhi(s0.y);
    H[4] = H[4] * dc + bflo(s0.z); H[5] = H[5] * dc + bfhi(s0.z); H[6] = H[6] * dc + bflo(s0.w); H[7] = H[7] * dc + bfhi(s0.w);
    H[8] = H[8] * dc + bflo(s1.x); H[9] = H[9] * dc + bfhi(s1.x); H[10] = H[10] * dc + bflo(s1.y); H[11] = H[11] * dc + bfhi(s1.y);
    H[12] = H[12] * dc + bflo(s1.z); H[13] = H[13] * dc + bfhi(s1.z); H[14] = H[14] * dc + bflo(s1.w); H[15] = H[15] * dc + bfhi(s1.w);
  }
}

DI void mixer_phase(const Params& p, int layer_c, char* smem, int* s_item) {
  const int layer = layer_c % DEPTH;
  const bool with_ctx = layer < DEPTH - 1;
  const int nqb = with_ctx ? 9 : 8;
  const int nitems = 4 + 12 * nqb;
  unsigned* cnt = (unsigned*)(p.ws + OFF_MISC) + layer_c * 8;
  for (int qq = 0; qq < 8; ++qq) {
    const int q = (blockIdx.x + qq) & 7;
    for (;;) {
      if (threadIdx.x == 0) *s_item = (int)atomicAdd(&cnt[q], 1u);
      __syncthreads();
      const int it = *s_item;
      __syncthreads();
      if (it >= nitems) break;
      if (it < 4) { if (layer_c < DEPTH) ssd_scan(p, q * 8 + it * 2 + half_id()); }
      else {
        const int idx = it - 4;
        int kind, head, qb;
        if (idx < 96) { const int hidx = idx >> 3; qb = (idx & 7) + 1; const int ko = hidx >> 2; kind = ko == 0 ? 1 : (ko == 1 ? 0 : 2); head = hidx & 3; }
        else { const int hidx = idx - 96; qb = 0; const int ko = hidx >> 2; kind = ko == 0 ? 1 : (ko == 1 ? 0 : 2); head = hidx & 3; }
        attn_unit(p, layer, q, kind, head, qb, smem);
      }
      __syncthreads();
    }
  }
}

DI void ssd_finish_tile(const Params& p, int layer, int tile, char* smem) {
  const int tid = otid(), lane = tid & 63, wave = tid >> 6, l31 = lane & 31, hi = lane >> 5;
  const int b = tile / 72, tb = tile % 72, p0 = tb * 32;
  const bool isctx = tb < 8;
  const int row0 = isctx ? (MROWS + b * CT + p0) : (b * SEQ + p0 - CT);
  const int T64 = tb >> 1, nch = isctx ? 4 : 32, Tl = isctx ? T64 : T64 - 4;
  const bf16_t* U = (const bf16_t*)(p.ws + OFF_U);
  const bf16_t* Y0 = (const bf16_t*)(p.ws + OFF_XN); const bf16_t* Y1 = Y0 + (size_t)ROWS * 256;
  const float* ECL = (const float*)(p.ws + OFF_ECL);
  bf16_t* Y = (bf16_t*)(p.ws + OFF_Y);
  bf16_t* sCc = (bf16_t*)smem;
  float* sY = (float*)(smem + 8704);
  {
    const bf16_t* CB = (const bf16_t*)(p.ws + OFF_CB) + (size_t)row0 * 128;
#pragma unroll
    for (int i = 0; i < 2; ++i) { const int c = tid + 256 * i, r = c >> 4, kc = c & 15; *(u32x4*)(sCc + r * 136 + kc * 8) = *(const u32x4*)(CB + r * 128 + kc * 8); }
  }
  __syncthreads();
  {
    const int pi = wave & 1, g = wave >> 1;
    const int row = row0 + l31;
#pragma unroll
    for (int hh = 0; hh < 2; ++hh) {
      const int h = g * 2 + hh;
      f32x16 ys = zero16();
#pragma unroll
      for (int d = 0; d < 2; ++d) {
        const int kl = d ? (nch - 1 - Tl) : Tl, ck = isctx ? kl : 4 + kl, chain = (b * 4 + h) * 2 + d;
        const char* Hs = p.ws + OFF_SS + ((size_t)chain * 37 + ck) * 8192 + (32 * pi + l31) * 128 + hi * 16;
        f32x16 acc = zero16();
#pragma unroll
        for (int ks = 0; ks < 4; ++ks) acc = MFMA32(*(const bf16x8*)(Hs + ks * 32), *(const bf16x8*)(sCc + l31 * 136 + g * 64 + ks * 16 + hi * 8), acc);
        const float e = ECL[(size_t)(d * 4 + h) * ROWS + row];
        ys += acc * e;
      }
      const bf16_t* y0p = Y0 + (size_t)row * 256 + h * 64 + 32 * pi + 4 * hi; const bf16_t* y1p = Y1 + (size_t)row * 256 + h * 64 + 32 * pi + 4 * hi;
#pragma unroll
      for (int r4 = 0; r4 < 4; ++r4) {
        const u32x2 a_ = *(const u32x2*)(y0p + 8 * r4), c_ = *(const u32x2*)(y1p + 8 * r4);
        const f32x4 a = {bflo(a_.x), bfhi(a_.x), bflo(a_.y), bfhi(a_.y)}, c2 = {bflo(c_.x), bfhi(c_.x), bflo(c_.y), bfhi(c_.y)};
        f32x4 o; o[0] = ys[4 * r4] + a[0] + c2[0]; o[1] = ys[4 * r4 + 1] + a[1] + c2[1]; o[2] = ys[4 * r4 + 2] + a[2] + c2[2]; o[3] = ys[4 * r4 + 3] + a[3] + c2[3];
        *(f32x4*)(sY + l31 * 260 + h * 64 + 32 * pi + 8 * r4 + 4 * hi) = o;
      }
    }
  }
  __syncthreads();
  {
    const int ch = lane * 4, hd = lane >> 4;
    const float dsk = p.in[I_SSDD][layer * 8 + hd] + p.in[I_SSDD][layer * 8 + 4 + hd];
    f32x4 cw[3];
    {
      const float* w = p.in[I_CONVW] + ((size_t)layer * 512 + ch) * 3;
      const f32x4 a = *(const f32x4*)w, b2 = *(const f32x4*)(w + 4), c2 = *(const f32x4*)(w + 8);
      cw[0] = (f32x4){a[0], a[3], b2[2], c2[1]}; cw[1] = (f32x4){a[1], b2[0], b2[3], c2[2]}; cw[2] = (f32x4){a[2], b2[1], c2[0], c2[3]};
    }
    const f32x4 cb = *(const f32x4*)(p.in[I_CONVB] + layer * 512 + ch);
    const f32x4 ng = *(const f32x4*)(p.in[I_SSDNG] + layer * 256 + ch);
    const int Len = isctx ? CT : SEQ;
#pragma unroll 2
    for (int rr = wave; rr < 32; rr += 4) {
      const int row = row0 + rr;
      const int t = isctx ? (p0 + rr) : (p0 - CT + rr);
      const bf16_t* up = U + (size_t)row * INP;
      const u32x2 z2 = *(const u32x2*)(up + U_Z + ch);
      const u32x2 zz = {0u, 0u};
      const u32x2 xm = (t > 0) ? *(const u32x2*)(up - INP + U_X + ch) : zz;
      const u32x2 x0 = *(const u32x2*)(up + U_X + ch);
      const u32x2 xp = (t < Len - 1) ? *(const u32x2*)(up + INP + U_X + ch) : zz;
      const f32x4 xmf = {bflo(xm.x), bfhi(xm.x), bflo(xm.y), bfhi(xm.y)}, x0f = {bflo(x0.x), bfhi(x0.x), bflo(x0.y), bfhi(x0.y)}, xpf = {bflo(xp.x), bfhi(xp.x), bflo(xp.y), bfhi(xp.y)};
      const f32x4 zf = {bflo(z2.x), bfhi(z2.x), bflo(z2.y), bfhi(z2.y)};
      const f32x4 cv = cw[0] * xmf + cw[1] * x0f + cw[2] * xpf + cb;
      const f32x4 ya = *(const f32x4*)(sY + rr * 260 + ch);
      f32x4 gz; float ss = 0.f;
#pragma unroll
      for (int e = 0; e < 4; ++e) { const float xs = silu_f(cv[e]); const float yv = ya[e] + dsk * xs; gz[e] = yv * silu_f(zf[e]); ss += gz[e] * gz[e]; }
      ss = wave_sum(ss);
      const float rstd = rsqrtf(ss * (1.f / 256.f) + EPS);
      u32x2 w; w.x = pk_bf16(gz[0] * rstd * ng[0], gz[1] * rstd * ng[1]); w.y = pk_bf16(gz[2] * rstd * ng[2], gz[3] * rstd * ng[3]);
      *(u32x2*)(Y + (size_t)row * DM + ch) = w;
    }
  }
  __syncthreads();
}

DI void gbar(unsigned* bw, unsigned k) {
  asm volatile("s_waitcnt vmcnt(0)" ::: "memory");
  __syncthreads();
  if (threadIdx.x == 0) {
    __builtin_amdgcn_fence(__ATOMIC_RELEASE, "agent");
    asm volatile("s_waitcnt vmcnt(0)" ::: "memory");
    unsigned bx_ = blockIdx.x, gd_ = gridDim.x; asm volatile("" : "+s"(bx_), "+s"(gd_));
    const unsigned x = bx_ & 7u, nloc = (gd_ - x + 7u) >> 3;
    unsigned* sub = bw + 64 * (1 + x); unsigned* gen = bw + 64 * (9 + x); unsigned* top = bw + 64 * 17;
    const unsigned old = __hip_atomic_fetch_add(sub, 1u, __ATOMIC_RELAXED, __HIP_MEMORY_SCOPE_AGENT);
    if (old + 1u == k * nloc) {
      __hip_atomic_fetch_add(top, 1u, __ATOMIC_RELAXED, __HIP_MEMORY_SCOPE_AGENT);
      while (__hip_atomic_load(top, __ATOMIC_RELAXED, __HIP_MEMORY_SCOPE_AGENT) < 8u * k) __builtin_amdgcn_s_sleep(1);
      __hip_atomic_fetch_add(gen, 1u, __ATOMIC_RELAXED, __HIP_MEMORY_SCOPE_AGENT);
    } else {
      while (__hip_atomic_load(gen, __ATOMIC_RELAXED, __HIP_MEMORY_SCOPE_AGENT) < k) __builtin_amdgcn_s_sleep(1);
    }
    __builtin_amdgcn_fence(__ATOMIC_ACQUIRE, "agent");
    asm volatile("s_waitcnt vmcnt(0)" ::: "memory");
  }
  __syncthreads();
}

__global__ void __launch_bounds__(NTHREADS, 2) fwd_megakernel(Params p) {
  cg::grid_group grid = cg::this_grid();
  extern __shared__ __attribute__((aligned(16))) unsigned char lds_dyn[];
  __shared__ int s_item;
  char* smem = (char*)lds_dyn;
  const int half = half_id();
  unsigned* bw = (unsigned*)(p.ws + OFF_MISC) + 256; unsigned bk = 0;
  phase0(p, smem);
  if (p.ws == nullptr) grid.sync();
  gbar(bw, ++bk);
  mod_reduce(p);
  gbar(bw, ++bk);
  const float* MOD = (const float*)(p.ws + OFF_MOD);
  bf16_t* XN = (bf16_t*)(p.ws + OFF_XN);
  bf16_t* U = (bf16_t*)(p.ws + OFF_U);
  bf16_t* Y = (bf16_t*)(p.ws + OFF_Y);
  bf16_t* HM = (bf16_t*)(p.ws + OFF_HM);
  float* HC = (float*)(p.ws + OFF_HC);
  PG8_LAS unsigned char* glds = (PG8_LAS unsigned char*)lds_dyn;
#pragma unroll 1
  for (int layer = 0; layer < DEPTH; ++layer) {
    const bool with_ctx = layer < DEPTH - 1;
    const int mrows = with_ctx ? ROWS : MROWS;
    int bx = (int)blockIdx.x; asm volatile("" : "+s"(bx));
    for (int rep = 0; rep < PROBE_N1; ++rep) { norm_phase(p, layer, 0, ROWS, layer > 0 ? MOD + (size_t)((layer - 1) * 9 + 8) * 6144 + 5120 : nullptr, HC);
    gbar(bw, ++bk); }
    for (int rep = 0; rep < PROBE_INPROJ; ++rep) { pg8::Gemm g{XN, (const bf16_t*)(p.ws + OFF_WIN) + (size_t)layer * INPW * DM, ROWS, INPW, DM, DM}; pg8::StaticOrder S; S.init(ROWS, INPW, (int)gridDim.x, bx);
      pg8::EpiStore<0> E{U, INP, INP};
      pg8::gemm_phase<pg8::EpiStore<0>, pg8::StaticOrder, true, true>(glds, g, S, E);
    gbar(bw, ++bk); }
    for (int rep = 0; rep < PROBE_PREP; ++rep) {
      unsigned* qc = (unsigned*)(p.ws + OFF_MISC) + 64 + layer + rep * DEPTH;
      for (;;) {
        if (threadIdx.x == 0) s_item = (int)atomicAdd(qc, 1u);
        __syncthreads();
        const int it = s_item;
        __syncthreads();
        if (it >= 1152 + 288) break;
        if (it < 144) prep_tile(p, layer, it * 2 + half, 0, smem + half * SMEM_BYTES);
        else if (it < 288) prep_tile(p, layer, (it - 144) * 2 + half, 1, smem + half * SMEM_BYTES);
        else ssd_chunk(p, layer, it - 288, smem + half * SMEM_BYTES);
      }
      gbar(bw, ++bk);
    }
    for (int rep = 0; rep < PROBE_MIX; ++rep) { mixer_phase(p, layer + rep * DEPTH, smem, &s_item);
    gbar(bw, ++bk); }
    for (int rep = 0; rep < PROBE_FIN; ++rep) { for (int t0 = blockIdx.x * 2; t0 < NB * 72; t0 += gridDim.x * 2) { const int t = t0 + half; if (!with_ctx && (t % 72) < 8) continue; ssd_finish_tile(p, layer, t, smem + half * SMEM_BYTES); }
    gbar(bw, ++bk); }
    { const bf16_t* Wt = (const bf16_t*)(p.ws + OFF_WOUT) + (size_t)layer * DM * DM;
      { pg8::Gemm g{Y, Wt, MROWS, DM, DM, DM}; pg8::StaticOrder S; S.init(MROWS, DM, (int)gridDim.x, bx);
        pg8::EpiResid E{layer == 0 ? p.in[I_X] : p.out, nullptr, p.out, nullptr, MOD + (size_t)layer * 9 * 6144 + 2048, 1.f};
        pg8::gemm_phase<pg8::EpiResid, pg8::StaticOrder, true, true>(glds, g, S, E);
        for (int rep = 0; rep < PROBE_OUT; ++rep) { gbar(bw, ++bk); pg8::EpiResid E2{p.out, nullptr, p.out, nullptr, MOD + (size_t)layer * 9 * 6144 + 2048, 0.f}; pg8::gemm_phase<pg8::EpiResid, pg8::StaticOrder, true, true>(glds, g, S, E2); } }
      if (with_ctx) {
        const int ks = (bx >> 5) & 3;
        pg8::Gemm g{Y + (size_t)MROWS * DM + ks * (DM / 4), Wt + ks * (DM / 4), CROWS, DM, DM, DM / 4}; pg8::SplitOrder S{bx};
        pg8::EpiPartial E{(float*)(p.ws + OFF_SS) + (size_t)ks * CROWS * DM};
        pg8::gemm_phase<pg8::EpiPartial, pg8::SplitOrder, true, true>(glds, g, S, E); } }
    gbar(bw, ++bk);
    norm_phase(p, layer, 1, mrows, with_ctx ? MOD + (size_t)(layer * 9 + 8) * 6144 + 2048 : nullptr, layer == 0 ? p.in[I_CTX] : HC);
    gbar(bw, ++bk);
    for (int rep = 0; rep < PROBE_UP; ++rep) { pg8::Gemm g{XN, (const bf16_t*)(p.ws + OFF_W1) + (size_t)layer * DFF * DM, mrows, DFF, DM, DM}; pg8::StaticOrder S; S.init(mrows, DFF, (int)gridDim.x, bx);
      pg8::EpiStore<1> E{HM, DFF, DFF};
      pg8::gemm_phase<pg8::EpiStore<1>, pg8::StaticOrder, true, true>(glds, g, S, E);
    gbar(bw, ++bk); }
    { const bf16_t* Wt = (const bf16_t*)(p.ws + OFF_W2) + (size_t)layer * DM * DFF;
      { pg8::Gemm g{HM, Wt, MROWS, DM, DFF, DFF}; pg8::StaticOrder S; S.init(MROWS, DM, (int)gridDim.x, bx);
        pg8::EpiResid E{p.out, nullptr, p.out, nullptr, MOD + (size_t)layer * 9 * 6144 + 5120, 1.f};
        pg8::gemm_phase<pg8::EpiResid, pg8::StaticOrder, true, true>(glds, g, S, E);
        for (int rep = 0; rep < PROBE_DOWN; ++rep) { gbar(bw, ++bk); pg8::EpiResid E2{p.out, nullptr, p.out, nullptr, MOD + (size_t)layer * 9 * 6144 + 5120, 0.f}; pg8::gemm_phase<pg8::EpiResid, pg8::StaticOrder, true, true>(glds, g, S, E2); } }
      if (with_ctx) {
        const int ks = (bx >> 5) & 3;
        pg8::Gemm g{HM + (size_t)MROWS * DFF + ks * (DFF / 4), Wt + ks * (DFF / 4), CROWS, DM, DFF, DFF / 4}; pg8::SplitOrder S{bx};
        pg8::EpiPartial E{(float*)(p.ws + OFF_SS) + (size_t)ks * CROWS * DM};
        pg8::gemm_phase<pg8::EpiPartial, pg8::SplitOrder, true, true>(glds, g, S, E); } }
    gbar(bw, ++bk);
  }
  norm_phase(p, 0, 2, MROWS);
}

extern "C" void kernel_launch(void* const* d_in, const int* in_sizes, int n_in, void* d_out, int out_size, void* d_ws, size_t ws_size, hipStream_t stream) {
  static int grid_blocks = 0;
  if (!grid_blocks) {
    int dev = 0, cus = 0, per_cu = 0;
    (void)hipGetDevice(&dev);
    (void)hipDeviceGetAttribute(&cus, hipDeviceAttributeMultiprocessorCount, dev);
    if (hipFuncSetAttribute((const void*)fwd_megakernel, hipFuncAttributeMaxDynamicSharedMemorySize, LDS_BYTES) != hipSuccess) fprintf(stderr, "hipFuncSetAttribute(max dynamic LDS) failed\n");
    (void)hipOccupancyMaxActiveBlocksPerMultiprocessor(&per_cu, (const void*)fwd_megakernel, NTHREADS, LDS_BYTES);
    if (per_cu < 1) { fprintf(stderr, "occupancy query says %d blocks/CU\n", per_cu); per_cu = 1; }
    grid_blocks = cus;
  }
  if (ws_size < OFF_END) { fprintf(stderr, "workspace too small: %zu < %zu\n", ws_size, (size_t)OFF_END); return; }
  Params p{};
  for (int i = 0; i < 27; ++i) p.in[i] = (const float*)d_in[i];
  p.out = (float*)d_out;
  p.ws = (char*)d_ws;
  (void)hipMemsetAsync((char*)d_ws + OFF_MISC, 0, SZ_MISC, stream);
  void* args[] = {&p};
  hipError_t e = hipLaunchCooperativeKernel((void*)fwd_megakernel, dim3(grid_blocks), dim3(NTHREADS), args, LDS_BYTES, stream);
  if (e != hipSuccess) fprintf(stderr, "cooperative launch failed: %s (grid %d)\n", hipGetErrorString(e), grid_blocks);
}
```

```cpp
#include <hip/hip_runtime.h>
#include <hip/hip_cooperative_groups.h>
#include <stdint.h>
#include <cstdio>
namespace cg = cooperative_groups;

typedef unsigned short bf16_t;
typedef short bf16x8 __attribute__((ext_vector_type(8)));
typedef short s16x4 __attribute__((ext_vector_type(4)));
typedef float f32x16 __attribute__((ext_vector_type(16)));
typedef float f32x4 __attribute__((ext_vector_type(4)));
typedef float f32x2 __attribute__((ext_vector_type(2)));
typedef unsigned u32x4 __attribute__((ext_vector_type(4)));
typedef unsigned u32x2 __attribute__((ext_vector_type(2)));
typedef __bf16 bf2_t __attribute__((ext_vector_type(2)));

#define DI __device__ __forceinline__
#define MFMA32(a, b, c) __builtin_amdgcn_mfma_f32_32x32x16_bf16((a), (b), (c), 0, 0, 0)

constexpr int DM = 1024, NB = 8, SEQ = 2048, DEPTH = 4, CT = 256, TT = 2304;
constexpr int MROWS = NB * SEQ, CROWS = NB * CT, ROWS = MROWS + CROWS;
constexpr int INC = 2408, INP = 2432, INPW = 2560, DFF = 4096;
constexpr float EPS = 1e-6f;
constexpr float LOG2E = 1.4426950408889634f;
constexpr int U_Z = 0, U_X = 256, U_B = 512, U_C = 640, U_DT = 768;
constexpr int U_DQ = 776, U_DK = 1032, U_DV = 1288;
constexpr int U_GQ = 1544, U_GK = 1800, U_GV = 1928;
constexpr int U_MQ = 2056, U_MKV = 2248, U_MR = 2376;

constexpr size_t al256(size_t x) { return (x + 255) & ~(size_t)255; }
constexpr size_t SZ_WIN = (size_t)DEPTH * INPW * DM * 2;
constexpr size_t SZ_WOUT = (size_t)DEPTH * DM * DM * 2;
constexpr size_t SZ_W1 = (size_t)DEPTH * DFF * DM * 2;
constexpr size_t SZ_W2 = (size_t)DEPTH * DM * DFF * 2;
constexpr size_t SZ_WUQ = (size_t)DEPTH * 384 * 192 * 2;
constexpr size_t SZ_WUKV = (size_t)DEPTH * 512 * 128 * 2;
constexpr size_t SZ_MOD = (size_t)DEPTH * 9 * 6144 * 4;
constexpr size_t SZ_MISC = 32768;
constexpr size_t SZ_ROPEH = (size_t)SEQ * 32 * 8;
constexpr size_t SZ_ROPED = (size_t)SEQ * 16 * 8;
constexpr size_t SZ_HC = (size_t)CROWS * DM * 4;
constexpr size_t SZ_XN = (size_t)ROWS * DM * 2;
constexpr size_t SZ_U = (size_t)ROWS * INP * 2;
constexpr size_t SZ_QD = (size_t)NB * 8 * TT * 32 * 2;
constexpr size_t SZ_VT4 = (size_t)NB * 4 * 64 * TT * 2;
constexpr size_t SZ_QG = (size_t)NB * 4 * TT * 64 * 2;
constexpr size_t SZ_KG = (size_t)NB * 2 * TT * 64 * 2;
constexpr size_t SZ_QM = (size_t)NB * 4 * TT * 96 * 2;
constexpr size_t SZ_Y = (size_t)ROWS * DM * 2;

constexpr size_t OFF_MOD = 0;
constexpr size_t OFF_MISC = OFF_MOD + al256(SZ_MOD);
constexpr size_t OFF_WIN = OFF_MISC + SZ_MISC;
constexpr size_t OFF_WOUT = OFF_WIN + al256(SZ_WIN);
constexpr size_t OFF_W1 = OFF_WOUT + al256(SZ_WOUT);
constexpr size_t OFF_W2 = OFF_W1 + al256(SZ_W1);
constexpr size_t OFF_WUQ = OFF_W2 + al256(SZ_W2);
constexpr size_t OFF_WUKV = OFF_WUQ + al256(SZ_WUQ);
constexpr size_t OFF_ROPEH = OFF_WUKV + al256(SZ_WUKV);
constexpr size_t OFF_ROPED = OFF_ROPEH + al256(SZ_ROPEH);
constexpr size_t OFF_HC = OFF_ROPED + al256(SZ_ROPED);
constexpr size_t OFF_XN = OFF_HC + al256(SZ_HC);
constexpr size_t OFF_BIG = OFF_XN + al256(SZ_XN);
constexpr size_t OFF_U = OFF_BIG;
constexpr size_t OFF_QD = OFF_U + al256(SZ_U);
constexpr size_t OFF_KD = OFF_QD + al256(SZ_QD);
constexpr size_t OFF_VTD = OFF_KD + al256(SZ_QD);
constexpr size_t OFF_QG = OFF_VTD + al256(SZ_VT4);
constexpr size_t OFF_KG = OFF_QG + al256(SZ_QG);
constexpr size_t OFF_VTG = OFF_KG + al256(SZ_KG);
constexpr size_t OFF_QM = OFF_VTG + al256(SZ_KG);
constexpr size_t OFF_KM = OFF_QM + al256(SZ_QM);
constexpr size_t OFF_VTM = OFF_KM + al256(SZ_QM);
constexpr size_t OFF_Y = OFF_VTM + al256(SZ_VT4);
constexpr size_t SZ_SS = (size_t)64 * 37 * 16384;
constexpr size_t SZ_DEC = (size_t)64 * 36 * 4;
constexpr size_t SZ_ECL = (size_t)8 * ROWS * 4;
constexpr size_t SZ_CB = (size_t)ROWS * 128 * 2;
constexpr size_t OFF_SS = OFF_Y + al256(SZ_Y);
constexpr size_t OFF_DEC = OFF_SS + al256(SZ_SS);
constexpr size_t OFF_ECL = OFF_DEC + al256(SZ_DEC);
constexpr size_t OFF_CB = OFF_ECL + al256(SZ_ECL);
constexpr size_t OFF_END = OFF_CB + al256(SZ_CB);
static_assert(OFF_END <= (size_t)402653184, "workspace budget (4 x mod_w)");
constexpr size_t OFF_HM = OFF_BIG;
static_assert((size_t)ROWS * DFF * 2 <= OFF_Y - OFF_BIG, "HM overlay must not reach Y");
static_assert((size_t)2 * ROWS * 256 * 4 <= SZ_XN, "Yssd overlay");

struct Params {
  const float* in[27];
  float* out;
  char* ws;
};
enum { I_X = 0, I_C, I_CTX, I_CCTX, I_MODW, I_MODB, I_N1G, I_N2G, I_WIN, I_CONVW, I_CONVB, I_DTB, I_ALOG, I_SSDD, I_SSDNG,
       I_DLAM, I_DNG, I_GQN, I_GKN, I_MQN, I_MKVN, I_WUQ, I_WUKV, I_WOUT, I_W1, I_W2, I_FNG };

constexpr int SMEM_BYTES = 65536;
constexpr int LDS_BYTES = 131072, NTHREADS = 512;
#ifndef PROBE_DOWN
#define PROBE_DOWN 0
#endif
#ifndef PROBE_OUT
#define PROBE_OUT 0
#endif
#ifndef PROBE_P0
#define PROBE_P0 1
#endif
#ifndef PROBE_N1
#define PROBE_N1 1
#endif
#ifndef PROBE_FIN
#define PROBE_FIN 1
#endif
#ifndef PROBE_UP
#define PROBE_UP 1
#endif
#ifndef PROBE_PREP
#define PROBE_PREP 1
#endif
#ifndef PROBE_MIX
#define PROBE_MIX 1
#endif
#ifndef PROBE_INPROJ
#define PROBE_INPROJ 1
#endif

DI unsigned pk_bf16(float a, float b) { f32x2 v = {a, b}; bf2_t r = __builtin_convertvector(v, bf2_t); return __builtin_bit_cast(unsigned, r); }
DI bf16_t f2bf(float a) { return (bf16_t)(pk_bf16(a, 0.f) & 0xffffu); }
DI float bf2f(bf16_t v) { return __uint_as_float((unsigned)v << 16); }
DI float bflo(unsigned w) { return __uint_as_float(w << 16); }
DI float bfhi(unsigned w) { return __uint_as_float(w & 0xffff0000u); }
DI float silu_f(float x) { return x / (1.f + __expf(-x)); }
DI float wave_sum(float v) {
#pragma unroll
  for (int o = 32; o >= 1; o >>= 1) v += __shfl_xor(v, o);
  return v;
}
DI int crow(int r, int hi) { return (r & 3) + 8 * (r >> 2) + 4 * hi; }
DI bf16x8 pack8(float a0, float a1, float a2, float a3, float a4, float a5, float a6, float a7) {
  u32x4 p; p.x = pk_bf16(a0, a1); p.y = pk_bf16(a2, a3); p.z = pk_bf16(a4, a5); p.w = pk_bf16(a6, a7);
  return __builtin_bit_cast(bf16x8, p);
}
DI f32x16 zero16() { f32x16 z;
#pragma unroll
  for (int i = 0; i < 16; ++i) z[i] = 0.f;
  return z; }
DI int otid() { int t = threadIdx.x & 255; asm volatile("" : "+v"(t)); return t; }
DI int otid_full() { int t = threadIdx.x; asm volatile("" : "+v"(t)); return t; }
DI int half_id() { return __builtin_amdgcn_readfirstlane((int)threadIdx.x >> 8); }
DI int hrow_of(int b, int pos) { return pos < CT ? (MROWS + b * CT + pos) : (b * SEQ + pos - CT); }

DI void tconv_tile(const float* __restrict__ src, int K, int N, bf16_t* __restrict__ dst, int kt, int nt, unsigned* sT) {
  const int tid = otid();
#pragma unroll
  for (int p = 0; p < 2; ++p) {
    const int idx = tid + 256 * p, kp = idx >> 4, nc = idx & 15;
    const int k = kt * 64 + 2 * kp, n = nt * 64 + nc * 4;
    f32x4 v0 = {0.f, 0.f, 0.f, 0.f}, v1 = {0.f, 0.f, 0.f, 0.f};
    if (n < N) { v0 = *(const f32x4*)(src + (size_t)k * N + n); v1 = *(const f32x4*)(src + (size_t)(k + 1) * N + n); }
#pragma unroll
    for (int e = 0; e < 4; ++e) sT[(nc * 4 + e) * 33 + kp] = pk_bf16(v0[e], v1[e]);
  }
  __syncthreads();
  {
    const int n = tid >> 2, part = tid & 3;
    u32x4 a, b;
    const unsigned* s = sT + n * 33 + part * 8;
    a.x = s[0]; a.y = s[1]; a.z = s[2]; a.w = s[3]; b.x = s[4]; b.y = s[5]; b.z = s[6]; b.w = s[7];
    bf16_t* d = dst + (size_t)(nt * 64 + n) * K + kt * 64 + part * 16;
    *(u32x4*)d = a; *(u32x4*)(d + 8) = b;
  }
  __syncthreads();
}

DI void mod_task(const Params& p, int task, float* sCond) {
  const int tid = otid();
  const int ks = task & 7, cb = (task >> 3) % 24, l = task / 192;
  for (int i = tid; i < 9 * 128; i += 256) {
    const int r = i >> 7, kk = i & 127;
    const float v = (r < 8) ? p.in[I_C][r * DM + ks * 128 + kk] : p.in[I_CCTX][ks * 128 + kk];
    sCond[i] = silu_f(v);
  }
  __syncthreads();
  const int col = cb * 256 + tid;
  const float* w = p.in[I_MODW] + ((size_t)l * DM + ks * 128) * 6144 + col;
  float acc[9];
#pragma unroll
  for (int r = 0; r < 9; ++r) acc[r] = 0.f;
#pragma unroll 8
  for (int kk = 0; kk < 128; ++kk) {
    const float wv = w[(size_t)kk * 6144];
#pragma unroll
    for (int r = 0; r < 9; ++r) acc[r] += sCond[r * 128 + kk] * wv;
  }
  const float bias = (ks == 0) ? p.in[I_MODB][l * 6144 + col] : 0.f;
  float* MODP = (float*)(p.ws + OFF_Y) + (size_t)ks * (DEPTH * 9 * 6144);
#pragma unroll
  for (int r = 0; r < 9; ++r) MODP[(size_t)(l * 9 + r) * 6144 + col] = acc[r] + bias;
  __syncthreads();
}

DI void phase0(const Params& p, char* smem) {
  constexpr int T_WIN = DEPTH * 16 * 38, T_WOUT = DEPTH * 16 * 16, T_W1 = DEPTH * 16 * 64, T_W2 = DEPTH * 64 * 16;
  constexpr int T_UQ = DEPTH * 3 * 6, T_UKV = DEPTH * 2 * 8, T_MOD = 768, T_ROPE = (SEQ * 48) / 256, T_MISC = 1;
  constexpr int E0 = T_WIN, E1 = E0 + T_WOUT, E2 = E1 + T_W1, E3 = E2 + T_W2, E4 = E3 + T_UQ, E5 = E4 + T_UKV, E6 = E5 + T_MOD, E7 = E6 + T_ROPE, E8 = E7 + T_MISC;
  const int tid = otid();
  const int half = half_id(); smem += half * SMEM_BYTES;
  static_assert(E0 % 2 == 0 && E1 % 2 == 0 && E2 % 2 == 0 && E3 % 2 == 0 && E4 % 2 == 0 && E5 % 2 == 0 && E6 % 2 == 0 && E7 % 2 == 0, "half-block pairs must not straddle task types");
  for (int t0 = blockIdx.x * 2; t0 < E8; t0 += gridDim.x * 2) {
    const int t = t0 + half;
    if (t >= E8) break;
    if (t < E0) { const int l = t / (16 * 38), r = t % (16 * 38); tconv_tile(p.in[I_WIN] + (size_t)l * DM * INC, DM, INC, (bf16_t*)(p.ws + OFF_WIN) + (size_t)l * INPW * DM, r / 38, r % 38, (unsigned*)smem); }
    else if (t < E1) { const int u = t - E0, l = u / 256, r = u % 256; tconv_tile(p.in[I_WOUT] + (size_t)l * DM * DM, DM, DM, (bf16_t*)(p.ws + OFF_WOUT) + (size_t)l * DM * DM, r / 16, r % 16, (unsigned*)smem); }
    else if (t < E2) { const int u = t - E1, l = u / 1024, r = u % 1024; tconv_tile(p.in[I_W1] + (size_t)l * DM * DFF, DM, DFF, (bf16_t*)(p.ws + OFF_W1) + (size_t)l * DFF * DM, r / 64, r % 64, (unsigned*)smem); }
    else if (t < E3) { const int u = t - E2, l = u / 1024, r = u % 1024; tconv_tile(p.in[I_W2] + (size_t)l * DFF * DM, DFF, DM, (bf16_t*)(p.ws + OFF_W2) + (size_t)l * DM * DFF, r / 16, r % 16, (unsigned*)smem); }
    else if (t < E4) { const int u = t - E3, l = u / 18, r = u % 18; tconv_tile(p.in[I_WUQ] + (size_t)l * 192 * 384, 192, 384, (bf16_t*)(p.ws + OFF_WUQ) + (size_t)l * 384 * 192, r / 6, r % 6, (unsigned*)smem); }
    else if (t < E5) { const int u = t - E4, l = u / 16, r = u % 16; tconv_tile(p.in[I_WUKV] + (size_t)l * 128 * 512, 128, 512, (bf16_t*)(p.ws + OFF_WUKV) + (size_t)l * 512 * 128, r / 8, r % 8, (unsigned*)smem); }
    else if (t < E6) { mod_task(p, t - E5, (float*)smem); }
    else if (t < E7) {
      const int idx = (t - E6) * 256 + tid;
      int tt, i, nf; f32x2* dst;
      if (idx < SEQ * 32) { tt = idx >> 5; i = idx & 31; nf = 16; dst = (f32x2*)(p.ws + OFF_ROPEH) + idx; }
      else { const int j = idx - SEQ * 32; tt = j >> 4; i = j & 15; nf = 8; dst = (f32x2*)(p.ws + OFF_ROPED) + j; }
      const int f = i & (nf - 1);
      const float pos = (float)((i < nf) ? (tt >> 6) : (tt & 63));
      const float inv = exp2f(-(float)f * (13.287712379549449f / (float)nf));
      float rv = pos * inv * 0.15915494309189535f; rv -= rintf(rv);
      f32x2 cs; cs.x = __builtin_amdgcn_cosf(rv); cs.y = __builtin_amdgcn_sinf(rv);
      *dst = cs;
    } else {
      if (tid < DEPTH) {
        const float* lp = p.in[I_DLAM] + tid * 128;
        float s1 = 0.f, s2 = 0.f;
        for (int i = 0; i < 32; ++i) { s1 += lp[i] * lp[32 + i]; s2 += lp[64 + i] * lp[96 + i]; }
        const float li = 0.8f - 0.6f * expf(-0.3f * (float)tid);
        float* misc = (float*)(p.ws + OFF_MISC);
        misc[128 + tid] = expf(s1) - expf(s2) + li;
        misc[136 + tid] = li;
      }
    }
  }
}

DI void mod_reduce(const Params& p) {
  const float* MODP = (const float*)(p.ws + OFF_Y);
  float* MOD = (float*)(p.ws + OFF_MOD);
  constexpr int NTOT = DEPTH * 9 * 6144;
  for (int i = blockIdx.x * NTHREADS + otid_full(); i < NTOT; i += gridDim.x * NTHREADS) {
    float a = 0.f;
#pragma unroll
    for (int ks = 0; ks < 8; ++ks) a += MODP[(size_t)ks * NTOT + i];
    MOD[i] = a;
  }
}

DI void norm_phase(const Params& p, int layer, int which, int nrows, const float* pend_gate = nullptr, const float* pend_hin = nullptr) {
  constexpr int NR = 3;
  const int tid_ = otid_full(); const int lane = tid_ & 63, wave = tid_ >> 6;
  const int gw = blockIdx.x * 8 + wave, nw = gridDim.x * 8;
  const float* MOD = (const float*)(p.ws + OFF_MOD);
  bf16_t* XN = (bf16_t*)(p.ws + OFF_XN);
  const float* g = (which == 0 ? p.in[I_N1G] : which == 1 ? p.in[I_N2G] : p.in[I_FNG]) + (which == 2 ? 0 : layer * DM);
  f32x4 gv[4];
#pragma unroll
  for (int i = 0; i < 4; ++i) gv[i] = *(const f32x4*)(g + i * 256 + lane * 4);
  for (int row0 = gw; row0 < nrows; row0 += nw * NR) {
    f32x4 v[NR][4];
    float ss[NR];
#pragma unroll
    for (int j = 0; j < NR; ++j) {
      const int row = row0 + j * nw;
      ss[j] = 0.f;
      if (row < nrows) {
        if (pend_gate != nullptr && row >= MROWS) {
          const size_t ro = (size_t)(row - MROWS) * DM;
          const float* P = (const float*)(p.ws + OFF_SS) + ro;
#pragma unroll
          for (int i = 0; i < 4; ++i) {
            const int c = i * 256 + lane * 4;
            const f32x4 a = *(const f32x4*)(P + c), b2 = *(const f32x4*)(P + (size_t)CROWS * DM + c), c2 = *(const f32x4*)(P + (size_t)2 * CROWS * DM + c), d2 = *(const f32x4*)(P + (size_t)3 * CROWS * DM + c);
            v[j][i] = *(const f32x4*)(pend_hin + ro + c) + *(const f32x4*)(pend_gate + c) * (((a + b2) + c2) + d2);
          }
        } else {
          const float* h;
          if (row < MROWS) h = ((which == 0 && layer == 0) ? p.in[I_X] : p.out) + (size_t)row * DM;
          else h = ((which == 0 && layer == 0) ? p.in[I_CTX] : (const float*)(p.ws + OFF_HC)) + (size_t)(row - MROWS) * DM;
#pragma unroll
          for (int i = 0; i < 4; ++i) v[j][i] = *(const f32x4*)(h + i * 256 + lane * 4);
        }
      } else {
#pragma unroll
        for (int i = 0; i < 4; ++i) v[j][i] = (f32x4){0.f, 0.f, 0.f, 0.f};
      }
    }
#pragma unroll
    for (int j = 0; j < NR; ++j) {
      const int row = row0 + j * nw;
      if (row >= nrows) continue;
      if (pend_gate != nullptr && row >= MROWS) {
        float* hc = (float*)(p.ws + OFF_HC) + (size_t)(row - MROWS) * DM;
#pragma unroll
        for (int i = 0; i < 4; ++i) *(f32x4*)(hc + i * 256 + lane * 4) = v[j][i];
      }
#pragma unroll
      for (int i = 0; i < 4; ++i) ss[j] += v[j][i][0] * v[j][i][0] + v[j][i][1] * v[j][i][1] + v[j][i][2] * v[j][i][2] + v[j][i][3] * v[j][i][3];
      const float rstd = rsqrtf(wave_sum(ss[j]) * (1.f / DM) + EPS);
      if (which == 2) {
#pragma unroll
        for (int i = 0; i < 4; ++i) { f32x4 o = v[j][i] * rstd * gv[i]; *(f32x4*)(p.out + (size_t)row * DM + i * 256 + lane * 4) = o; }
      } else {
        const int bidx = row < MROWS ? (row >> 11) : 8;
        const float* sh = MOD + (size_t)(layer * 9 + bidx) * 6144 + which * 3072;
        const float* sc = sh + 1024;
#pragma unroll
        for (int i = 0; i < 4; ++i) {
          const int c = i * 256 + lane * 4;
          const f32x4 shv = *(const f32x4*)(sh + c), scv = *(const f32x4*)(sc + c);
          f32x4 o = v[j][i] * rstd * gv[i] * (1.f + scv) + shv;
          u32x2 w; w.x = pk_bf16(o[0], o[1]); w.y = pk_bf16(o[2], o[3]);
          *(u32x2*)(XN + (size_t)row * DM + c) = w;
        }
      }
    }
  }
}

namespace pg8 {
#define PG8_LAS __attribute__((address_space(3)))
typedef unsigned short bf16_t;
typedef short bf16x8 __attribute__((ext_vector_type(8)));
typedef float f32x4 __attribute__((ext_vector_type(4)));
typedef unsigned u32x4 __attribute__((ext_vector_type(4)));
constexpr int BM = 256, BK = 64, HALF = 128, HTB = HALF * BK * 2  , STAGE_BYTES = 8 * HTB, NXCD = 8, WGM = 8;

__host__ __device__ __forceinline__ int lds_byte(int r, int c) { const int st = (r >> 4) * 2 + (c >> 5), rr = r & 15, cc = c & 31, ob = rr * 64 + cc * 2; return st * 1024 + (ob ^ (((ob >> 9) & 1) << 5)); }
__host__ __device__ __forceinline__ void stage_rc(int b, int& R, int& C) { const int st = b / 1024, sb = b % 1024, swz = sb ^ (((sb >> 9) & 1) << 5); R = (st >> 1) * 16 + swz / 64; C = (st & 1) * 32 + (swz % 64) / 2; }
__host__ __device__ __forceinline__ int perm32(int rho) { const int n = rho >> 4, i = rho & 15; return 8 * (i >> 2) + 4 * n + (i & 3); }

struct Unit { int pm, pn; };
struct Gemm { const bf16_t* A; const bf16_t* Bt; int M, N, K, Kloop; };

struct StaticOrder {
    int nM, nN, nwg, G, c;
    __host__ __device__ void init(int M, int N, int G_, int c_) { nM = M / BM; nN = N / BM; nwg = nM * nN; G = G_; c = c_; }
    __host__ __device__ bool next(int i, Unit& u) const {
        const long L = (long)i * G + c; if (L >= nwg) return false;
        int wgid = (int)L; { const int q = nwg / NXCD, r = nwg % NXCD, xcd = wgid % NXCD, off = wgid / NXCD; wgid = (xcd < r ? xcd * (q + 1) : r * (q + 1) + (xcd - r) * q) + off; }
        const int nig = WGM * nN, gid = wgid / nig, fm = gid * WGM, gsz = (nM - fm) < WGM ? (nM - fm) : WGM;
        u.pm = fm + ((wgid % nig) % gsz); u.pn = (wgid % nig) / gsz; return true;
    }
    __device__ __forceinline__ void a_ready(const Unit&) const {}
    __device__ __forceinline__ void done(const Unit&) const {}
};


struct SplitOrder {
    int c;
    __host__ __device__ bool next(int i, Unit& u) const { if (i != 0 || c >= 128) return false; const int q = c & 31; u.pm = q & 7; u.pn = q >> 3; return true; }
    __device__ __forceinline__ void a_ready(const Unit&) const {}
    __device__ __forceinline__ void done(const Unit&) const {}
};
struct EpiPartial {
    static constexpr bool PERM = false, AFTER_DRAIN = false;
    float* P;
    __device__ __forceinline__ void operator()(const f32x4 (&acc)[2][2][4][2], const Unit& u, int wr, int wc, int fr, int fq) const {
        float* base = P + (size_t)u.pm * BM * 1024;
        const int col0 = u.pn * BM + wc * 32 + 4 * fq;
#pragma unroll
        for (int bj = 0; bj < 2; ++bj)
#pragma unroll
            for (int n = 0; n < 2; ++n)
#pragma unroll
                for (int ai = 0; ai < 2; ++ai)
#pragma unroll
                    for (int m = 0; m < 4; ++m) *(f32x4*)(base + (size_t)(ai * HALF + wr * 64 + m * 16 + fr) * 1024 + col0 + bj * HALF + n * 16) = acc[ai][bj][m][n];
    }
};
template <int ACT> struct EpiStore {
    static constexpr bool PERM = true, AFTER_DRAIN = false;
    bf16_t* O; int ldc; int ncols;
    __device__ __forceinline__ void operator()(const f32x4 (&acc)[2][2][4][2], const Unit& u, int wr, int wc, int fr, int fq) const {
        const int row0 = u.pm * BM + wr * 64 + fr, col0 = u.pn * BM + wc * 32 + 8 * fq;
#pragma unroll
        for (int ai = 0; ai < 2; ++ai)
#pragma unroll
            for (int m = 0; m < 4; ++m) { bf16_t* rowp = O + (size_t)(row0 + ai * HALF + m * 16) * ldc + col0;
#pragma unroll
                for (int bj = 0; bj < 2; ++bj) { if (col0 + bj * HALF < ncols) { f32x4 v0 = acc[ai][bj][m][0], v1 = acc[ai][bj][m][1];
                    if (ACT == 1) { v0 = __builtin_elementwise_max(v0, (f32x4){0.f, 0.f, 0.f, 0.f}); v1 = __builtin_elementwise_max(v1, (f32x4){0.f, 0.f, 0.f, 0.f}); v0 = v0 * v0; v1 = v1 * v1; }
                    u32x4 w; w.x = ::pk_bf16(v0[0], v0[1]); w.y = ::pk_bf16(v0[2], v0[3]); w.z = ::pk_bf16(v1[0], v1[1]); w.w = ::pk_bf16(v1[2], v1[3]);
                    *(u32x4*)(rowp + bj * HALF) = w; } } }
    }
};
struct EpiResid {
    static constexpr bool PERM = false, AFTER_DRAIN = false;
    const float* hin_m; const float* hin_c; float* hout_m; float* hout_c; const float* gate; float gscale;
    __device__ __forceinline__ void operator()(const f32x4 (&acc)[2][2][4][2], const Unit& u, int wr, int wc, int fr, int fq) const {
        const bool ismain = u.pm < 64;
        const float* hin = ismain ? hin_m + (size_t)u.pm * BM * 1024 : hin_c + (size_t)(u.pm - 64) * BM * 1024;
        float* hout = ismain ? hout_m + (size_t)u.pm * BM * 1024 : hout_c + (size_t)(u.pm - 64) * BM * 1024;
        const float* g = gate + (size_t)(ismain ? (u.pm >> 3) : 8) * 6144;
        const int col0 = u.pn * BM + wc * 32 + 4 * fq;
#pragma unroll
        for (int bj = 0; bj < 2; ++bj)
#pragma unroll
            for (int n = 0; n < 2; ++n) { const f32x4 gv = *(const f32x4*)(g + col0 + bj * HALF + n * 16) * gscale;
#pragma unroll
                for (int ai = 0; ai < 2; ++ai)
#pragma unroll
                    for (int m = 0; m < 4; ++m) { const size_t off = (size_t)(ai * HALF + wr * 64 + m * 16 + fr) * 1024 + col0 + bj * HALF + n * 16;
                        *(f32x4*)(hout + off) = *(const f32x4*)(hin + off) + gv * acc[ai][bj][m][n]; } }
    }
};
template <class Epi, class Sched, bool ALIGN_EPI = false, bool SP2 = false>
__device__ __forceinline__ void gemm_phase(PG8_LAS unsigned char* lds, const Gemm g, const Sched& S, const Epi& E) {
    const int tid = ::otid_full(), wid = __builtin_amdgcn_readfirstlane(tid >> 6), lane = tid & 63, wr = wid >> 2, wc = wid & 3, fr = lane & 15, fq = lane >> 4;
    const int K = g.K, nt = g.Kloop / BK;
    unsigned voffA[2], voffB[2];
#pragma unroll
    for (int i = 0; i < 2; ++i) { int R, C; stage_rc(tid * 16 + i * 8192, R, C); const int Rb = Epi::PERM ? ((R & ~31) + perm32(R & 31)) : R;
        voffA[i] = (unsigned)(R * K + C) * 2u; voffB[i] = (unsigned)(Rb * K + C) * 2u; }
    const size_t kstep = (size_t)(BK * 2);
    const size_t hstep = (size_t)HALF * K * 2;
    const size_t tstep = 2 * hstep;
    const unsigned ldsw = (unsigned)wid * 1024u;
    const int aoff = lds_byte(wr * 64 + fr, fq * 8), boff = lds_byte(wc * 32 + fr, fq * 8);
#define PG8_SA(b, h) (((b) * 2 + (h)) * HTB)
#define PG8_SB(b, h) ((4 + (b) * 2 + (h)) * HTB)
#define PG8_STAGE(bufoff, gbase, voff) do { _Pragma("unroll") for (int _i = 0; _i < 2; ++_i) \
        __builtin_amdgcn_global_load_lds((const unsigned*)((const char*)(gbase) + (voff)[_i]), (PG8_LAS unsigned*)(lds + (bufoff) + ldsw + _i * 8192), 16, 0, 0); } while (0)
#define PG8_LDA(dst, b, h) do { _Pragma("unroll") for (int m = 0; m < 4; ++m) _Pragma("unroll") for (int k = 0; k < 2; ++k) dst[m][k] = *(const PG8_LAS bf16x8*)(lds + PG8_SA(b, h) + aoff + m * 2048 + k * 1024); } while (0)
#define PG8_LDB(dst, b, h) do { _Pragma("unroll") for (int n = 0; n < 2; ++n) _Pragma("unroll") for (int k = 0; k < 2; ++k) dst[n][k] = *(const PG8_LAS bf16x8*)(lds + PG8_SB(b, h) + boff + n * 2048 + k * 1024); } while (0)
#define PG8_MMA(ai, bj, At, Bt) do { __builtin_amdgcn_s_setprio(1); _Pragma("unroll") for (int m = 0; m < 4; ++m) _Pragma("unroll") for (int n = 0; n < 2; ++n) _Pragma("unroll") for (int k = 0; k < 2; ++k) \
        acc[ai][bj][m][n] = __builtin_amdgcn_mfma_f32_16x16x32_bf16(Bt[n][k], At[m][k], acc[ai][bj][m][n], 0, 0, 0); __builtin_amdgcn_s_setprio(0); } while (0)
#define PG8_WAIT_V(n) asm volatile("s_waitcnt vmcnt(" #n ")" ::: "memory")
#define PG8_WAIT_L(n) asm volatile("s_waitcnt lgkmcnt(" #n ")" ::: "memory")
#define PG8_BAR __builtin_amdgcn_s_barrier()
#define PG8_SCHED __builtin_amdgcn_sched_barrier(0)
    Unit cur, nxt; int ui = 0;
    if (!S.next(0, cur)) return;
    f32x4 acc[2][2][4][2];
#pragma unroll
    for (int a = 0; a < 2; ++a)
#pragma unroll
        for (int b = 0; b < 2; ++b)
#pragma unroll
            for (int m = 0; m < 4; ++m)
#pragma unroll
                for (int n = 0; n < 2; ++n) acc[a][b][m][n] = (f32x4){0.f, 0.f, 0.f, 0.f};
    bf16x8 At[4][2], B0[2][2], B1[2][2];
    const char* cA = (const char*)g.A + (size_t)cur.pm * tstep; const char* cB = (const char*)g.Bt + (size_t)cur.pn * tstep;
    S.a_ready(cur);
    if constexpr (SP2) {
        PG8_STAGE(PG8_SB(0, 0), cB, voffB); PG8_STAGE(PG8_SB(0, 1), cB + hstep, voffB); PG8_STAGE(PG8_SA(0, 0), cA, voffA); PG8_STAGE(PG8_SA(0, 1), cA + hstep, voffA);
        if (wr == 1) PG8_BAR;
        PG8_WAIT_V(2); PG8_BAR;
        PG8_STAGE(PG8_SB(1, 0), cB + kstep, voffB); PG8_STAGE(PG8_SA(1, 0), cA + kstep, voffA); PG8_STAGE(PG8_SB(1, 1), cB + hstep + kstep, voffB);
        PG8_WAIT_V(6); PG8_BAR;
    } else {
        PG8_STAGE(PG8_SB(0, 0), cB, voffB); PG8_STAGE(PG8_SA(0, 0), cA, voffA); PG8_STAGE(PG8_SB(0, 1), cB + hstep, voffB); PG8_STAGE(PG8_SA(0, 1), cA + hstep, voffA);
        if (wr == 1) PG8_BAR;
        PG8_WAIT_V(4); PG8_BAR;
        PG8_STAGE(PG8_SB(1, 0), cB + kstep, voffB); PG8_STAGE(PG8_SA(1, 0), cA + kstep, voffA); PG8_STAGE(PG8_SB(1, 1), cB + hstep + kstep, voffB);
        PG8_WAIT_V(6); PG8_BAR;
    }
    for (;;) {
        const bool has_next = S.next(ui + 1, nxt);
        const char* nA = has_next ? (const char*)g.A + (size_t)nxt.pm * tstep : cA; const char* nB = has_next ? (const char*)g.Bt + (size_t)nxt.pn * tstep : cB;
        for (int t = 0; t < nt; t += 2) {
            const bool last = (t == nt - 2);
            const char* a1 = cA + (size_t)(t + 1) * kstep;
            const char* a2 = last ? nA : cA + (size_t)(t + 2) * kstep; const char* b2 = last ? nB : cB + (size_t)(t + 2) * kstep;
            const char* a3 = a2 + kstep; const char* b3 = b2 + kstep;
            if (last && has_next) S.a_ready(nxt);
            if constexpr (SP2) {
            PG8_LDB(B0, 0, 0); PG8_LDB(B1, 0, 1); PG8_SCHED; PG8_LDA(At, 0, 0); PG8_STAGE(PG8_SA(1, 1), a1 + hstep, voffA);
            PG8_WAIT_V(8); PG8_WAIT_L(0); PG8_BAR; PG8_MMA(0, 0, At, B0); PG8_MMA(0, 1, At, B1); PG8_BAR; PG8_SCHED;
            PG8_LDA(At, 0, 1); PG8_STAGE(PG8_SB(0, 0), b2, voffB); PG8_STAGE(PG8_SB(0, 1), b2 + hstep, voffB); PG8_STAGE(PG8_SA(0, 0), a2, voffA);
            PG8_WAIT_V(8); PG8_WAIT_L(0); PG8_BAR; PG8_MMA(1, 0, At, B0); PG8_MMA(1, 1, At, B1); PG8_BAR; PG8_SCHED;
            PG8_LDB(B0, 1, 0); PG8_LDB(B1, 1, 1); PG8_SCHED; PG8_LDA(At, 1, 0); PG8_STAGE(PG8_SA(0, 1), a2 + hstep, voffA);
            PG8_WAIT_V(8); PG8_WAIT_L(0); PG8_BAR; PG8_MMA(0, 0, At, B0); PG8_MMA(0, 1, At, B1); PG8_BAR; PG8_SCHED;
            PG8_LDA(At, 1, 1); PG8_STAGE(PG8_SB(1, 0), b3, voffB); PG8_STAGE(PG8_SB(1, 1), b3 + hstep, voffB); PG8_STAGE(PG8_SA(1, 0), a3, voffA);
            PG8_WAIT_V(8); PG8_WAIT_L(0); PG8_BAR; PG8_MMA(1, 0, At, B0); PG8_MMA(1, 1, At, B1); PG8_BAR; PG8_SCHED;
            } else {
            PG8_LDB(B0, 0, 0); PG8_SCHED; PG8_LDA(At, 0, 0); PG8_STAGE(PG8_SA(1, 1), a1 + hstep, voffA);
            PG8_WAIT_L(8); PG8_BAR; PG8_WAIT_L(0); PG8_MMA(0, 0, At, B0); PG8_BAR; PG8_SCHED;
            PG8_LDB(B1, 0, 1); PG8_STAGE(PG8_SB(0, 0), b2, voffB);
            PG8_BAR; PG8_WAIT_L(0); PG8_MMA(0, 1, At, B1); PG8_BAR;
            PG8_LDA(At, 0, 1); PG8_STAGE(PG8_SA(0, 0), a2, voffA);
            PG8_BAR; PG8_WAIT_L(0); PG8_MMA(1, 0, At, B0); PG8_BAR; PG8_SCHED;
            PG8_STAGE(PG8_SB(0, 1), b2 + hstep, voffB);
            PG8_WAIT_V(6); PG8_BAR; PG8_MMA(1, 1, At, B1); PG8_BAR;
            PG8_LDB(B0, 1, 0); PG8_SCHED; PG8_LDA(At, 1, 0); PG8_STAGE(PG8_SA(0, 1), a2 + hstep, voffA);
            PG8_WAIT_L(8); PG8_BAR; PG8_WAIT_L(0); PG8_MMA(0, 0, At, B0); PG8_BAR; PG8_SCHED;
            PG8_LDB(B1, 1, 1); PG8_STAGE(PG8_SB(1, 0), b3, voffB);
            PG8_BAR; PG8_WAIT_L(0); PG8_MMA(0, 1, At, B1); PG8_BAR;
            PG8_LDA(At, 1, 1); PG8_STAGE(PG8_SA(1, 0), a3, voffA);
            PG8_BAR; PG8_WAIT_L(0); PG8_MMA(1, 0, At, B0); PG8_BAR; PG8_SCHED;
            PG8_STAGE(PG8_SB(1, 1), b3 + hstep, voffB);
            PG8_WAIT_V(6); PG8_BAR; PG8_MMA(1, 1, At, B1); PG8_BAR;
            }
        }
        if constexpr (ALIGN_EPI) { if (wr == 0) PG8_BAR; }
        if constexpr (!Epi::AFTER_DRAIN) { E(acc, cur, wr, wc, fr, fq); S.done(cur); }
        if (!has_next) break;
#pragma unroll
        for (int a = 0; a < 2; ++a)
#pragma unroll
            for (int b = 0; b < 2; ++b)
#pragma unroll
                for (int m = 0; m < 4; ++m)
#pragma unroll
                    for (int n = 0; n < 2; ++n) acc[a][b][m][n] = (f32x4){0.f, 0.f, 0.f, 0.f};
        cur = nxt; cA = nA; cB = nB; ++ui;
        if constexpr (ALIGN_EPI) { if (wr == 1) PG8_BAR; }
    }
    PG8_WAIT_V(0);
    if constexpr (!ALIGN_EPI) { if (wr == 0) PG8_BAR; }
    PG8_BAR;
    if constexpr (Epi::AFTER_DRAIN) { E.fused(acc, cur, wr, wc, fr, fq, lds, wid, lane); S.done(cur); }
#undef PG8_SA
#undef PG8_SB
#undef PG8_STAGE
#undef PG8_LDA
#undef PG8_LDB
#undef PG8_MMA
#undef PG8_WAIT_V
#undef PG8_WAIT_L
#undef PG8_BAR
#undef PG8_SCHED
}
}

DI void prep_tile(const Params& p, int layer, int tile, int part, char* smem) {
  const int tid = otid(), lane = tid & 63, wave = tid >> 6, l31 = lane & 31, hi = lane >> 5;
  const int b = tile / 36, tb = tile % 36, p0 = tb * 64;
  const bool isctx = tb < 4;
  const int row0 = isctx ? (MROWS + b * CT + p0) : (b * SEQ + p0 - CT);
  const bf16_t* U = (const bf16_t*)(p.ws + OFF_U);
  const f32x2* ropeH = (const f32x2*)(p.ws + OFF_ROPEH);
  const f32x2* ropeD = (const f32x2*)(p.ws + OFF_ROPED);
  bf16_t* QD = (bf16_t*)(p.ws + OFF_QD); bf16_t* KD = (bf16_t*)(p.ws + OFF_KD); bf16_t* VTD = (bf16_t*)(p.ws + OFF_VTD);
  bf16_t* QG = (bf16_t*)(p.ws + OFF_QG); bf16_t* KG = (bf16_t*)(p.ws + OFF_KG); bf16_t* VTG = (bf16_t*)(p.ws + OFF_VTG);
  bf16_t* QM = (bf16_t*)(p.ws + OFF_QM); bf16_t* KM = (bf16_t*)(p.ws + OFF_KM); bf16_t* VTM = (bf16_t*)(p.ws + OFF_VTM);
  const float qsD = 0.17677669529663687f * LOG2E, qsG = 0.125f * LOG2E, qsM = 0.10206207261596575f * LOG2E;
  bf16_t* sT = (bf16_t*)smem; bf16_t* sCq = (bf16_t*)(smem + 9216); bf16_t* sCkv = (bf16_t*)(smem + 9216 + 25600);

  if (part == 0) {
  for (int tk = wave; tk < 64; tk += 4) {
    const bf16_t* urow = U + (size_t)(row0 + tk) * INP;
    const int pos = p0 + tk, t = pos - CT;
    float xv[15];
#pragma unroll
    for (int g = 0; g < 15; ++g) {
      const int col = g < 4 ? U_DQ + g * 64 + lane : g < 8 ? U_DK + (g - 4) * 64 + lane : g < 12 ? U_GQ + (g - 8) * 64 + lane : g < 14 ? U_GK + (g - 12) * 64 + lane : U_MR + l31;
      xv[g] = bf2f(urow[col]);
    }
    f32x2 csD = {1.f, 0.f}, csH = {1.f, 0.f};
    if (!isctx) { csD = ropeD[t * 16 + (lane & 15)]; csH = ropeH[t * 32 + l31]; }
#pragma unroll
    for (int g = 0; g < 15; ++g) {
      float x = xv[g];
      if (g < 8) {
        const int h = g & 3; const bool isq = g < 4;
        const int d = lane & 31, m = lane >> 5;
        if (!isctx) { const float pr = __shfl_xor(x, 16); x = (d < 16) ? (x * csD.x - pr * csD.y) : (pr * csD.y + x * csD.x); }
        if (isq) x *= qsD;
        (isq ? QD : KD)[(((size_t)b * 8 + h * 2 + m) * TT + pos) * 32 + d] = f2bf(x);
      } else if (g < 14) {
        const bool isq = g < 12; const int h = isq ? g - 8 : g - 12;
        const float ss = wave_sum(x * x);
        x = x * rsqrtf(ss * (1.f / 64.f) + EPS) * (isq ? p.in[I_GQN] : p.in[I_GKN])[layer * 64 + lane];
        if (!isctx) { const float pr = __shfl_xor(x, 32); x = (lane < 32) ? (x * csH.x - pr * csH.y) : (pr * csH.y + x * csH.x); }
        if (isq) { x *= qsG; QG[(((size_t)b * 4 + h) * TT + pos) * 64 + lane] = f2bf(x); }
        else KG[(((size_t)b * 2 + h) * TT + pos) * 64 + lane] = f2bf(x);
      } else {
        const int d = l31;
        if (!isctx) { const float pr = __shfl_xor(x, 16); x = (d < 16) ? (x * csD.x - pr * csD.y) : (pr * csD.y + x * csD.x); }
        const bf16_t v = f2bf(x);
        const int hh = hi * 2;
        KM[(((size_t)b * 4 + hh) * TT + pos) * 96 + 64 + d] = v;
        KM[(((size_t)b * 4 + hh + 1) * TT + pos) * 96 + 64 + d] = v;
      }
    }
  }
  for (int g = 0; g < 6; ++g) {
    const int colbase = g < 4 ? U_DV + g * 64 : U_GV + (g - 4) * 64;
    bf16_t* dst = g < 4 ? VTD + ((size_t)(b * 4 + g) * 64) * TT : VTG + ((size_t)(b * 2 + g - 4) * 64) * TT;
#pragma unroll
    for (int i = 0; i < 2; ++i) {
      const int c = tid + 256 * i, tk = c >> 3, kc = c & 7;
      const u32x4 v = *(const u32x4*)(U + (size_t)(row0 + tk) * INP + colbase + kc * 8);
      sT[(kc * 8 + 0) * 72 + tk] = (bf16_t)(v.x & 0xffff); sT[(kc * 8 + 1) * 72 + tk] = (bf16_t)(v.x >> 16);
      sT[(kc * 8 + 2) * 72 + tk] = (bf16_t)(v.y & 0xffff); sT[(kc * 8 + 3) * 72 + tk] = (bf16_t)(v.y >> 16);
      sT[(kc * 8 + 4) * 72 + tk] = (bf16_t)(v.z & 0xffff); sT[(kc * 8 + 5) * 72 + tk] = (bf16_t)(v.z >> 16);
      sT[(kc * 8 + 6) * 72 + tk] = (bf16_t)(v.w & 0xffff); sT[(kc * 8 + 7) * 72 + tk] = (bf16_t)(v.w >> 16);
    }
    __syncthreads();
    {
      const int dv = tid >> 2, part = tid & 3;
      const u32x4 a = *(const u32x4*)(sT + dv * 72 + part * 16), bq = *(const u32x4*)(sT + dv * 72 + part * 16 + 8);
      bf16_t* d = dst + (size_t)dv * TT + p0 + part * 16;
      *(u32x4*)d = a; *(u32x4*)(d + 8) = bq;
    }
    __syncthreads();
  }
  return;
  }
#pragma unroll 4
  for (int tk = wave; tk < 64; tk += 4) {
    const bf16_t* urow = U + (size_t)(row0 + tk) * INP;
    const float q0 = bf2f(urow[U_MQ + lane]), q1 = bf2f(urow[U_MQ + 64 + lane]), q2 = bf2f(urow[U_MQ + 128 + lane]);
    const float k0 = bf2f(urow[U_MKV + lane]), k1 = bf2f(urow[U_MKV + 64 + lane]);
    const float sq = wave_sum(q0 * q0 + q1 * q1 + q2 * q2), sk = wave_sum(k0 * k0 + k1 * k1);
    const float rq = rsqrtf(sq * (1.f / 192.f) + EPS), rk = rsqrtf(sk * (1.f / 128.f) + EPS);
    const float* gq = p.in[I_MQN] + layer * 192; const float* gk = p.in[I_MKVN] + layer * 128;
    sCq[tk * 200 + lane] = f2bf(q0 * rq * gq[lane]); sCq[tk * 200 + 64 + lane] = f2bf(q1 * rq * gq[64 + lane]); sCq[tk * 200 + 128 + lane] = f2bf(q2 * rq * gq[128 + lane]);
    sCkv[tk * 136 + lane] = f2bf(k0 * rk * gk[lane]); sCkv[tk * 136 + 64 + lane] = f2bf(k1 * rk * gk[64 + lane]);
  }
  __syncthreads();
  const bf16_t* Wkv = (const bf16_t*)(p.ws + OFF_WUKV) + (size_t)layer * 512 * 128;
  const bf16_t* Wq = (const bf16_t*)(p.ws + OFF_WUQ) + (size_t)layer * 384 * 192;
  for (int task = wave; task < 56; task += 4) {
    if (task < 32) {
      const int ct = task >> 1, tt = task & 1, head = ct >> 2, sub = ct & 3, n0 = head * 128 + sub * 32;
      f32x16 acc = zero16();
      const bf16_t* wrow = Wkv + (size_t)(n0 + l31) * 128 + hi * 8;
      const bf16_t* trow = sCkv + (tt * 32 + l31) * 136 + hi * 8;
      if (sub < 2) {
#pragma unroll
        for (int ks = 0; ks < 8; ++ks) acc = MFMA32(*(const bf16x8*)(wrow + ks * 16), *(const bf16x8*)(trow + ks * 16), acc);
        bf16_t* d = KM + (((size_t)b * 4 + head) * TT + p0 + tt * 32 + l31) * 96 + sub * 32 + 4 * hi;
#pragma unroll
        for (int r4 = 0; r4 < 4; ++r4) { u32x2 w; w.x = pk_bf16(acc[4 * r4], acc[4 * r4 + 1]); w.y = pk_bf16(acc[4 * r4 + 2], acc[4 * r4 + 3]); *(u32x2*)(d + 8 * r4) = w; }
      } else {
#pragma unroll
        for (int ks = 0; ks < 8; ++ks) acc = MFMA32(*(const bf16x8*)(trow + ks * 16), *(const bf16x8*)(wrow + ks * 16), acc);
        bf16_t* d = VTM + (((size_t)b * 4 + head) * 64 + (sub - 2) * 32 + l31) * TT + p0 + tt * 32 + 4 * hi;
#pragma unroll
        for (int r4 = 0; r4 < 4; ++r4) { u32x2 w; w.x = pk_bf16(acc[4 * r4], acc[4 * r4 + 1]); w.y = pk_bf16(acc[4 * r4 + 2], acc[4 * r4 + 3]); *(u32x2*)(d + 8 * r4) = w; }
      }
    } else {
      const int t2 = task - 32, ct = t2 >> 1, tt = t2 & 1, head = ct / 3, sub = ct % 3, n0 = head * 96 + sub * 32;
      f32x16 acc = zero16();
      const bf16_t* wrow = Wq + (size_t)(n0 + l31) * 192 + hi * 8;
      const bf16_t* trow = sCq + (tt * 32 + l31) * 200 + hi * 8;
#pragma unroll
      for (int ks = 0; ks < 12; ++ks) acc = MFMA32(*(const bf16x8*)(wrow + ks * 16), *(const bf16x8*)(trow + ks * 16), acc);
      const int pos = p0 + tt * 32 + l31;
      if (sub == 2 && !isctx) {
        const int t = pos - CT;
#pragma unroll
        for (int r = 0; r < 8; ++r) {
          const f32x2 cs = ropeD[t * 16 + crow(r, hi)];
          const float x1 = acc[r], x2 = acc[r + 8];
          acc[r] = x1 * cs.x - x2 * cs.y; acc[r + 8] = x1 * cs.y + x2 * cs.x;
        }
      }
      bf16_t* d = QM + (((size_t)b * 4 + head) * TT + pos) * 96 + sub * 32 + 4 * hi;
#pragma unroll
      for (int r4 = 0; r4 < 4; ++r4) { u32x2 w; w.x = pk_bf16(acc[4 * r4] * qsM, acc[4 * r4 + 1] * qsM); w.y = pk_bf16(acc[4 * r4 + 2] * qsM, acc[4 * r4 + 3] * qsM); *(u32x2*)(d + 8 * r4) = w; }
    }
  }
  __syncthreads();
}

template <int DQK>
DI void attn_core(const bf16_t* __restrict__ Qb, const bf16_t* __restrict__ Kb, const bf16_t* __restrict__ Vt, int q0, int ntiles,
                  f32x16 (&O)[2], float& lsum, char* smem) {
  const int tid = otid_full(), lane = tid & 63, wave = tid >> 6, l31 = lane & 31, hi = lane >> 5;
  constexpr int KS = DQK / 16, KROW = DQK + 8, KCH = DQK / 8;
  constexpr int KBYTES = 64 * KROW * 2, BUFB = KBYTES + 9216;
  constexpr int NK = 64 * KCH, NKC = (NK + NTHREADS - 1) / NTHREADS;
  static_assert(2 * BUFB <= 49152, "attention LDS");
  bf16x8 qf[KS];
#pragma unroll
  for (int ks = 0; ks < KS; ++ks) qf[ks] = *(const bf16x8*)(Qb + (size_t)(q0 + wave * 32 + l31) * DQK + ks * 16 + hi * 8);
  float mrun = -1e30f; lsum = 0.f; O[0] = zero16(); O[1] = zero16();
  const bf16_t* kg[NKC]; int kl[NKC]; bool kok[NKC];
#pragma unroll
  for (int i = 0; i < NKC; ++i) {
    const int c = tid + NTHREADS * i, key = c / KCH, kc = c % KCH;
    kok[i] = c < NK;
    kg[i] = Kb + (size_t)key * DQK + kc * 8;
    kl[i] = (key * KROW + kc * 8) * 2;
  }
  const bf16_t* vg; int vl;
  { const int dv = tid >> 3, kc = tid & 7; vg = Vt + (size_t)dv * TT + kc * 8; vl = KBYTES + (dv * 72 + kc * 8) * 2; }
  u32x4 rk[NKC], rv;
#pragma unroll
  for (int i = 0; i < NKC; ++i) if (kok[i]) rk[i] = *(const u32x4*)(kg[i]);
  rv = *(const u32x4*)(vg);
#pragma unroll
  for (int i = 0; i < NKC; ++i) if (kok[i]) *(u32x4*)(smem + kl[i]) = rk[i];
  *(u32x4*)(smem + vl) = rv;
  __syncthreads();
  for (int kt = 0; kt < ntiles; ++kt) {
    const int cur = kt & 1; const bool more = kt + 1 < ntiles;
    if (more) {
#pragma unroll
      for (int i = 0; i < NKC; ++i) if (kok[i]) rk[i] = *(const u32x4*)(kg[i] + (size_t)(kt + 1) * 64 * DQK);
      rv = *(const u32x4*)(vg + (kt + 1) * 64);
    }
    const char* sb = smem + cur * BUFB;
    f32x16 s[2];
#pragma unroll
    for (int kb = 0; kb < 2; ++kb) {
      s[kb] = zero16();
      const char* kr = sb + ((kb * 32 + l31) * KROW + hi * 8) * 2;
#pragma unroll
      for (int ks = 0; ks < KS; ++ks) s[kb] = MFMA32(*(const bf16x8*)(kr + ks * 32), qf[ks], s[kb]);
    }
    float mx = s[0][0];
#pragma unroll
    for (int r = 0; r < 16; ++r) { mx = fmaxf(mx, s[0][r]); mx = fmaxf(mx, s[1][r]); }
    mx = fmaxf(mx, __shfl_xor(mx, 32));
    const float mnew = fmaxf(mrun, mx);
    const float alpha = __builtin_amdgcn_exp2f(mrun - mnew);
    mrun = mnew;
    float rs = 0.f;
#pragma unroll
    for (int kb = 0; kb < 2; ++kb)
#pragma unroll
      for (int r = 0; r < 16; ++r) { const float e = __builtin_amdgcn_exp2f(s[kb][r] - mnew); s[kb][r] = e; rs += e; }
    lsum = lsum * alpha + rs;
    O[0] *= alpha; O[1] *= alpha;
#pragma unroll
    for (int s4 = 0; s4 < 4; ++s4) {
      const int kb = s4 >> 1, hf = (s4 & 1) * 8;
      const bf16x8 pb = pack8(s[kb][hf + 0], s[kb][hf + 1], s[kb][hf + 2], s[kb][hf + 3], s[kb][hf + 4], s[kb][hf + 5], s[kb][hf + 6], s[kb][hf + 7]);
#pragma unroll
      for (int dvb = 0; dvb < 2; ++dvb) {
        const char* vr = sb + KBYTES + ((dvb * 32 + l31) * 72 + s4 * 16 + hi * 4) * 2;
        const s16x4 lo = *(const s16x4*)vr, h4 = *(const s16x4*)(vr + 16);
        const bf16x8 a = __builtin_shufflevector(lo, h4, 0, 1, 2, 3, 4, 5, 6, 7);
        O[dvb] = MFMA32(a, pb, O[dvb]);
      }
    }
    if (more) {
      char* db = smem + (cur ^ 1) * BUFB;
#pragma unroll
      for (int i = 0; i < NKC; ++i) if (kok[i]) *(u32x4*)(db + kl[i]) = rk[i];
      *(u32x4*)(db + vl) = rv;
    }
    __syncthreads();
  }
  lsum += __shfl_xor(lsum, 32);
}

DI void attn_unit(const Params& p, int layer, int b, int kind, int head, int qb, char* smem) {
  const int tid_ = otid_full(); const int lane = tid_ & 63, wave = tid_ >> 6, l31 = lane & 31, hi = lane >> 5;
  const int q0 = qb * 256;
  const int ntiles = qb == 0 ? 4 : 36;
  bf16_t* Y = (bf16_t*)(p.ws + OFF_Y);
  const int pos = q0 + wave * 32 + l31;
  bf16_t* yrow = Y + (size_t)hrow_of(b, pos) * DM;
  f32x16 O[2]; float ls;
  if (kind == 1) {
    attn_core<32>((const bf16_t*)(p.ws + OFF_QD) + ((size_t)b * 8 + head * 2) * TT * 32, (const bf16_t*)(p.ws + OFF_KD) + ((size_t)b * 8 + head * 2) * TT * 32,
                  (const bf16_t*)(p.ws + OFF_VTD) + ((size_t)b * 4 + head) * 64 * TT, q0, ntiles, O, ls, smem);
    float* st = (float*)(smem + 49152) + tid_;
    {
      const float i0 = 1.f / ls;
#pragma unroll
      for (int dvb = 0; dvb < 2; ++dvb)
#pragma unroll
        for (int r = 0; r < 16; ++r) st[(dvb * 16 + r) * NTHREADS] = O[dvb][r] * i0;
    }
    __syncthreads();
    attn_core<32>((const bf16_t*)(p.ws + OFF_QD) + ((size_t)b * 8 + head * 2 + 1) * TT * 32, (const bf16_t*)(p.ws + OFF_KD) + ((size_t)b * 8 + head * 2 + 1) * TT * 32,
                  (const bf16_t*)(p.ws + OFF_VTD) + ((size_t)b * 4 + head) * 64 * TT, q0, ntiles, O, ls, smem);
    const float* misc = (const float*)(p.ws + OFF_MISC);
    const float lam = misc[128 + layer], li = misc[136 + layer];
    const float i1 = lam / ls;
    float ss = 0.f;
#pragma unroll
    for (int dvb = 0; dvb < 2; ++dvb)
#pragma unroll
      for (int r = 0; r < 16; ++r) { const float o = st[(dvb * 16 + r) * NTHREADS] - O[dvb][r] * i1; O[dvb][r] = o; ss += o * o; }
    ss += __shfl_xor(ss, 32);
    const float rstd = rsqrtf(ss * (1.f / 64.f) + EPS) * (1.f - li);
    const float* g = p.in[I_DNG] + layer * 64;
#pragma unroll
    for (int dvb = 0; dvb < 2; ++dvb)
#pragma unroll
      for (int r4 = 0; r4 < 4; ++r4) {
        const int dv = dvb * 32 + 8 * r4 + 4 * hi;
        const f32x4 gv = *(const f32x4*)(g + dv);
        u32x2 w; w.x = pk_bf16(O[dvb][4 * r4] * rstd * gv[0], O[dvb][4 * r4 + 1] * rstd * gv[1]);
        w.y = pk_bf16(O[dvb][4 * r4 + 2] * rstd * gv[2], O[dvb][4 * r4 + 3] * rstd * gv[3]);
        *(u32x2*)(yrow + 256 + head * 64 + dv) = w;
      }
  } else {
    int ycol;
    if (kind == 2) {
      attn_core<64>((const bf16_t*)(p.ws + OFF_QG) + ((size_t)b * 4 + head) * TT * 64, (const bf16_t*)(p.ws + OFF_KG) + ((size_t)b * 2 + (head >> 1)) * TT * 64,
                    (const bf16_t*)(p.ws + OFF_VTG) + ((size_t)b * 2 + (head >> 1)) * 64 * TT, q0, ntiles, O, ls, smem);
      ycol = 512 + head * 64;
    } else {
      attn_core<96>((const bf16_t*)(p.ws + OFF_QM) + ((size_t)b * 4 + head) * TT * 96, (const bf16_t*)(p.ws + OFF_KM) + ((size_t)b * 4 + head) * TT * 96,
                    (const bf16_t*)(p.ws + OFF_VTM) + ((size_t)b * 4 + head) * 64 * TT, q0, ntiles, O, ls, smem);
      ycol = 768 + head * 64;
    }
    const float inv = 1.f / ls;
#pragma unroll
    for (int dvb = 0; dvb < 2; ++dvb)
#pragma unroll
      for (int r4 = 0; r4 < 4; ++r4) {
        const int dv = dvb * 32 + 8 * r4 + 4 * hi;
        u32x2 w; w.x = pk_bf16(O[dvb][4 * r4] * inv, O[dvb][4 * r4 + 1] * inv); w.y = pk_bf16(O[dvb][4 * r4 + 2] * inv, O[dvb][4 * r4 + 3] * inv);
        *(u32x2*)(yrow + ycol + dv) = w;
      }
  }
}

DI void ssd_chunk(const Params& p, int layer, int item, char* smem) {
  const int tid = otid(), lane = tid & 63, wave = tid >> 6, l31 = lane & 31, hi = lane >> 5;
  const int pi = wave >> 1, li = wave & 1;
  const int ck = item % 36, r_ = item / 36, d = r_ & 1, g = (r_ >> 1) & 1, b = r_ >> 2, h = 2 * g + half_id(), chain = (b * 4 + h) * 2 + d;
  const bf16_t* U = (const bf16_t*)(p.ws + OFF_U);
  bf16_t* Yssd = (bf16_t*)(p.ws + OFF_XN) + (size_t)d * ROWS * 256;
  bf16_t* sXT = (bf16_t*)smem;
  bf16_t* sB = (bf16_t*)(smem + 9216);
  bf16_t* sC = (bf16_t*)(smem + 18432);
  bf16_t* sBT = (bf16_t*)(smem + 27648);
  float* scs = (float*)(smem + 46080);
  float* sdt = (float*)(smem + 46336);
  float* sW = (float*)(smem + 46592);
  const bool isctx = ck < 4;
  const int Len = isctx ? CT : SEQ, base = isctx ? (MROWS + b * CT) : (b * SEQ), kl = isctx ? ck : ck - 4;
  if (tid < 192) {
    const int cc = tid >> 6, e = tid & 63;
    const int ch = cc == 0 ? (h * 64 + e) : (cc == 1 ? 256 + g * 64 + e : 384 + g * 64 + e);
    const float* cw = p.in[I_CONVW] + ((size_t)layer * 512 + ch) * 3;
    sW[tid * 4 + 0] = cw[0]; sW[tid * 4 + 1] = cw[1]; sW[tid * 4 + 2] = cw[2]; sW[tid * 4 + 3] = p.in[I_CONVB][layer * 512 + ch];
  }
  const bool wrC = (half_id() == 0) && (d == 0);
  bf16_t* CB = (bf16_t*)(p.ws + OFF_CB);
  float raw_dt = 0.f;
  if (wave == 1) {
    const int posj = kl * 64 + lane, t = d ? (Len - 1 - posj) : posj;
    raw_dt = bf2f(U[(size_t)(base + t) * INP + U_DT + d * 4 + h]);
  }
  u32x4 vm6[6], v06[6], vp6[6];
#pragma unroll
  for (int i = 0; i < 6; ++i) {
    const int task = tid + 256 * i, j = task / 24, cc = task % 24;
    const int posj = kl * 64 + j, t = d ? (Len - 1 - posj) : posj;
    const int grp = cc >> 3, c8 = (cc & 7) * 8;
    const int ucol = grp == 0 ? (U_X + h * 64 + c8) : (grp == 1 ? U_B + g * 64 + c8 : U_C + g * 64 + c8);
    const bf16_t* up = U + (size_t)(base + t) * INP + ucol;
    const u32x4 z4 = {0u, 0u, 0u, 0u};
    vm6[i] = (t > 0) ? *(const u32x4*)(up - INP) : z4;
    v06[i] = *(const u32x4*)up;
    vp6[i] = (t < Len - 1) ? *(const u32x4*)(up + INP) : z4;
  }
  if (wave == 1) {
    const float dtb = p.in[I_DTB][layer * 8 + d * 4 + h];
    const float aneg = -expf(p.in[I_ALOG][layer * 8 + d * 4 + h]);
    const int posj = kl * 64 + lane, t = d ? (Len - 1 - posj) : posj;
    const float raw = raw_dt + dtb;
    const float e_ = __expf(-fabsf(raw));
    const float dtv = fmaxf(raw, 0.f) + (e_ < 0.03f ? e_ * (1.f - e_ * (0.5f - e_ * 0.33333334f)) : __logf(1.f + e_));
    float c = dtv * aneg;
#pragma unroll
    for (int o = 1; o < 64; o <<= 1) { const float tv = __shfl_up(c, o); if (lane >= o) c += tv; }
    sdt[lane] = dtv; scs[lane] = c;
    ((float*)(p.ws + OFF_ECL))[(size_t)(d * 4 + h) * ROWS + base + t] = __expf(c);
    if (lane == 63) ((float*)(p.ws + OFF_DEC))[chain * 36 + ck] = __expf(c);
  }
  __syncthreads();
  const float c63 = scs[63];
#pragma unroll
  for (int i = 0; i < 6; ++i) {
    const int task = tid + 256 * i, j = task / 24, cc = task % 24;
    const int posj = kl * 64 + j, t = d ? (Len - 1 - posj) : posj;
    const int grp = cc >> 3, c8 = (cc & 7) * 8;
    const u32x4 vm = vm6[i], v0 = v06[i], vp = vp6[i];
    float o[8];
#pragma unroll
    for (int e2 = 0; e2 < 4; ++e2) {
      const unsigned wm_ = e2 == 0 ? vm.x : e2 == 1 ? vm.y : e2 == 2 ? vm.z : vm.w;
      const unsigned w0_ = e2 == 0 ? v0.x : e2 == 1 ? v0.y : e2 == 2 ? v0.z : v0.w;
      const unsigned wp_ = e2 == 0 ? vp.x : e2 == 1 ? vp.y : e2 == 2 ? vp.z : vp.w;
      const f32x4 wa = *(const f32x4*)(sW + (grp * 64 + c8 + 2 * e2) * 4), wb = *(const f32x4*)(sW + (grp * 64 + c8 + 2 * e2 + 1) * 4);
      o[2 * e2] = silu_f(wa[0] * bflo(wm_) + wa[1] * bflo(w0_) + wa[2] * bflo(wp_) + wa[3]);
      o[2 * e2 + 1] = silu_f(wb[0] * bfhi(wm_) + wb[1] * bfhi(w0_) + wb[2] * bfhi(wp_) + wb[3]);
    }
    if (grp == 0) {
      const float dtv = sdt[j];
#pragma unroll
      for (int e = 0; e < 8; ++e) sXT[(c8 + e) * 72 + j] = f2bf(o[e] * dtv);
    } else if (grp == 1) {
      const float sc_ = __expf(c63 - scs[j]);
      u32x4 w; w.x = pk_bf16(o[0], o[1]); w.y = pk_bf16(o[2], o[3]); w.z = pk_bf16(o[4], o[5]); w.w = pk_bf16(o[6], o[7]);
      *(u32x4*)(sB + j * 72 + c8) = w;
#pragma unroll
      for (int e = 0; e < 8; ++e) sBT[(c8 + e) * 72 + j] = f2bf(o[e] * sc_);
    } else {
      u32x4 w; w.x = pk_bf16(o[0], o[1]); w.y = pk_bf16(o[2], o[3]); w.z = pk_bf16(o[4], o[5]); w.w = pk_bf16(o[6], o[7]);
      *(u32x4*)(sC + j * 72 + c8) = w;
      if (wrC) *(u32x4*)(CB + (size_t)(base + t) * 128 + g * 64 + c8) = w;
    }
  }
  __syncthreads();
  const int lcol = 32 * li + l31;
  const float cl = scs[lcol];
  f32x16 y = zero16();
#pragma unroll
  for (int si = 0; si < 2; ++si) {
    if (si <= li) {
      f32x16 gt = zero16();
#pragma unroll
      for (int ks = 0; ks < 4; ++ks) gt = MFMA32(*(const bf16x8*)(sB + (32 * si + l31) * 72 + ks * 16 + hi * 8), *(const bf16x8*)(sC + lcol * 72 + ks * 16 + hi * 8), gt);
#pragma unroll
      for (int r = 0; r < 16; ++r) { const int s_ = 32 * si + crow(r, hi); gt[r] = (s_ <= lcol) ? gt[r] * __expf(cl - scs[s_]) : 0.f; }
#pragma unroll
      for (int kk = 0; kk < 2; ++kk) {
        const bf16x8 pb = pack8(gt[8 * kk], gt[8 * kk + 1], gt[8 * kk + 2], gt[8 * kk + 3], gt[8 * kk + 4], gt[8 * kk + 5], gt[8 * kk + 6], gt[8 * kk + 7]);
        const bf16_t* xr = sXT + (32 * pi + l31) * 72 + 32 * si + 16 * kk + 4 * hi;
        const s16x4 lo = *(const s16x4*)xr, h4 = *(const s16x4*)(xr + 8);
        y = MFMA32(__builtin_shufflevector(lo, h4, 0, 1, 2, 3, 4, 5, 6, 7), pb, y);
      }
    }
  }
  {
    const int posl = kl * 64 + lcol, t = d ? (Len - 1 - posl) : posl;
    bf16_t* yp = Yssd + (size_t)(base + t) * 256 + h * 64 + 32 * pi + 4 * hi;
#pragma unroll
    for (int r4 = 0; r4 < 4; ++r4) { u32x2 o; o.x = pk_bf16(y[4 * r4], y[4 * r4 + 1]); o.y = pk_bf16(y[4 * r4 + 2], y[4 * r4 + 3]); *(u32x2*)(yp + 8 * r4) = o; }
  }
  f32x16 sacc = zero16();
#pragma unroll
  for (int ks = 0; ks < 4; ++ks) sacc = MFMA32(*(const bf16x8*)(sXT + (32 * pi + l31) * 72 + ks * 16 + hi * 8), *(const bf16x8*)(sBT + (32 * li + l31) * 72 + ks * 16 + hi * 8), sacc);
  bf16_t* Sp = (bf16_t*)(p.ws + OFF_SS) + ((size_t)chain * 37 + ck + 1) * 4096;
#pragma unroll
  for (int r = 0; r < 16; ++r) Sp[(32 * pi + crow(r, hi)) * 64 + 32 * li + l31] = f2bf(sacc[r]);
  __syncthreads();
}

DI void ssd_scan(const Params& p, int chain) {
  const int tid = otid();
  char* slot0 = p.ws + OFF_SS + (size_t)chain * 37 * 8192 + tid * 32;
  const float* dec = (const float*)(p.ws + OFF_DEC) + chain * 36;
  float H[16];
#pragma unroll
  for (int i = 0; i < 16; ++i) H[i] = 0.f;
#pragma unroll 4
  for (int c = 0; c < 36; ++c) {
    const u32x4* sp = (const u32x4*)(slot0 + (size_t)(c + 1) * 8192);
    const u32x4 s0 = sp[0], s1 = sp[1];
    const float dc = dec[c];
    u32x4 w0, w1;
    w0.x = pk_bf16(H[0], H[1]); w0.y = pk_bf16(H[2], H[3]); w0.z = pk_bf16(H[4], H[5]); w0.w = pk_bf16(H[6], H[7]);
    w1.x = pk_bf16(H[8], H[9]); w1.y = pk_bf16(H[10], H[11]); w1.z = pk_bf16(H[12], H[13]); w1.w = pk_bf16(H[14], H[15]);
    u32x4* hp = (u32x4*)(slot0 + (size_t)c * 8192);
    hp[0] = w0; hp[1] = w1;
    H[0] = H[0] * dc + bflo(s0.x); H[1] = H[1] * dc + bfhi(s0.x); H[2] = H[2] * dc + bflo(s0.y); H[3] = H[3] * dc + bfhi(s0.y);
    H[4] = H[4] * dc + bflo(s0.z); H[5] = H[5] * dc + bfhi(s0.z); H[6] = H[6] * dc + bflo(s0.w); H[7] = H[7] * dc + bfhi(s0.w);
    H[8] = H[8] * dc + bflo(s1.x); H[9] = H[9] * dc + bfhi(s1.x); H[10] = H[10] * dc + bflo(s1.y); H[11] = H[11] * dc + bfhi(s1.y);
    H[12] = H[12] * dc + bflo(s1.z); H[13] = H[13] * dc + bfhi(s1.z); H[14] = H[14] * dc + bflo(s1.w); H[15] = H[15] * dc + bfhi(s1.w);
  }
}

DI void mixer_phase(const Params& p, int layer_c, char* smem, int* s_item) {
  const int layer = layer_c % DEPTH;
  const bool with_ctx = layer < DEPTH - 1;
  const int nqb = with_ctx ? 9 : 8;
  const int nitems = 4 + 12 * nqb;
  unsigned* cnt = (unsigned*)(p.ws + OFF_MISC) + layer_c * 8;
  for (int qq = 0; qq < 8; ++qq) {
    const int q = (blockIdx.x + qq) & 7;
    for (;;) {
      if (threadIdx.x == 0) *s_item = (int)atomicAdd(&cnt[q], 1u);
      __syncthreads();
      const int it = *s_item;
      __syncthreads();
      if (it >= nitems) break;
      if (it < 4) { if (layer_c < DEPTH) ssd_scan(p, q * 8 + it * 2 + half_id()); }
      else {
        const int idx = it - 4;
        int kind, head, qb;
        if (idx < 96) { const int hidx = idx >> 3; qb = (idx & 7) + 1; const int ko = hidx >> 2; kind = ko == 0 ? 1 : (ko == 1 ? 0 : 2); head = hidx & 3; }
        else { const int hidx = idx - 96; qb = 0; const int ko = hidx >> 2; kind = ko == 0 ? 1 : (ko == 1 ? 0 : 2); head = hidx & 3; }
        attn_unit(p, layer, q, kind, head, qb, smem);
      }
      __syncthreads();
    }
  }
}

DI void ssd_finish_tile(const Params& p, int layer, int tile, char* smem) {
  const int tid = otid(), lane = tid & 63, wave = tid >> 6, l31 = lane & 31, hi = lane >> 5;
  const int b = tile / 72, tb = tile % 72, p0 = tb * 32;
  const bool isctx = tb < 8;
  const int row0 = isctx ? (MROWS + b * CT + p0) : (b * SEQ + p0 - CT);
  const int T64 = tb >> 1, nch = isctx ? 4 : 32, Tl = isctx ? T64 : T64 - 4;
  const bf16_t* U = (const bf16_t*)(p.ws + OFF_U);
  const bf16_t* Y0 = (const bf16_t*)(p.ws + OFF_XN); const bf16_t* Y1 = Y0 + (size_t)ROWS * 256;
  const float* ECL = (const float*)(p.ws + OFF_ECL);
  bf16_t* Y = (bf16_t*)(p.ws + OFF_Y);
  bf16_t* sCc = (bf16_t*)smem;
  float* sY = (float*)(smem + 8704);
  {
    const bf16_t* CB = (const bf16_t*)(p.ws + OFF_CB) + (size_t)row0 * 128;
#pragma unroll
    for (int i = 0; i < 2; ++i) { const int c = tid + 256 * i, r = c >> 4, kc = c & 15; *(u32x4*)(sCc + r * 136 + kc * 8) = *(const u32x4*)(CB + r * 128 + kc * 8); }
  }
  __syncthreads();
  {
    const int pi = wave & 1, g = wave >> 1;
    const int row = row0 + l31;
#pragma unroll
    for (int hh = 0; hh < 2; ++hh) {
      const int h = g * 2 + hh;
      f32x16 ys = zero16();
#pragma unroll
      for (int d = 0; d < 2; ++d) {
        const int kl = d ? (nch - 1 - Tl) : Tl, ck = isctx ? kl : 4 + kl, chain = (b * 4 + h) * 2 + d;
        const char* Hs = p.ws + OFF_SS + ((size_t)chain * 37 + ck) * 8192 + (32 * pi + l31) * 128 + hi * 16;
        f32x16 acc = zero16();
#pragma unroll
        for (int ks = 0; ks < 4; ++ks) acc = MFMA32(*(const bf16x8*)(Hs + ks * 32), *(const bf16x8*)(sCc + l31 * 136 + g * 64 + ks * 16 + hi * 8), acc);
        const float e = ECL[(size_t)(d * 4 + h) * ROWS + row];
        ys += acc * e;
      }
      const bf16_t* y0p = Y0 + (size_t)row * 256 + h * 64 + 32 * pi + 4 * hi; const bf16_t* y1p = Y1 + (size_t)row * 256 + h * 64 + 32 * pi + 4 * hi;
#pragma unroll
      for (int r4 = 0; r4 < 4; ++r4) {
        const u32x2 a_ = *(const u32x2*)(y0p + 8 * r4), c_ = *(const u32x2*)(y1p + 8 * r4);
        const f32x4 a = {bflo(a_.x), bfhi(a_.x), bflo(a_.y), bfhi(a_.y)}, c2 = {bflo(c_.x), bfhi(c_.x), bflo(c_.y), bfhi(c_.y)};
        f32x4 o; o[0] = ys[4 * r4] + a[0] + c2[0]; o[1] = ys[4 * r4 + 1] + a[1] + c2[1]; o[2] = ys[4 * r4 + 2] + a[2] + c2[2]; o[3] = ys[4 * r4 + 3] + a[3] + c2[3];
        *(f32x4*)(sY + l31 * 260 + h * 64 + 32 * pi + 8 * r4 + 4 * hi) = o;
      }
    }
  }
  __syncthreads();
  {
    const int ch = lane * 4, hd = lane >> 4;
    const float dsk = p.in[I_SSDD][layer * 8 + hd] + p.in[I_SSDD][layer * 8 + 4 + hd];
    f32x4 cw[3];
    {
      const float* w = p.in[I_CONVW] + ((size_t)layer * 512 + ch) * 3;
      const f32x4 a = *(const f32x4*)w, b2 = *(const f32x4*)(w + 4), c2 = *(const f32x4*)(w + 8);
      cw[0] = (f32x4){a[0], a[3], b2[2], c2[1]}; cw[1] = (f32x4){a[1], b2[0], b2[3], c2[2]}; cw[2] = (f32x4){a[2], b2[1], c2[0], c2[3]};
    }
    const f32x4 cb = *(const f32x4*)(p.in[I_CONVB] + layer * 512 + ch);
    const f32x4 ng = *(const f32x4*)(p.in[I_SSDNG] + layer * 256 + ch);
    const int Len = isctx ? CT : SEQ;
#pragma unroll 2
    for (int rr = wave; rr < 32; rr += 4) {
      const int row = row0 + rr;
      const int t = isctx ? (p0 + rr) : (p0 - CT + rr);
      const bf16_t* up = U + (size_t)row * INP;
      const u32x2 z2 = *(const u32x2*)(up + U_Z + ch);
      const u32x2 zz = {0u, 0u};
      const u32x2 xm = (t > 0) ? *(const u32x2*)(up - INP + U_X + ch) : zz;
      const u32x2 x0 = *(const u32x2*)(up + U_X + ch);
      const u32x2 xp = (t < Len - 1) ? *(const u32x2*)(up + INP + U_X + ch) : zz;
      const f32x4 xmf = {bflo(xm.x), bfhi(xm.x), bflo(xm.y), bfhi(xm.y)}, x0f = {bflo(x0.x), bfhi(x0.x), bflo(x0.y), bfhi(x0.y)}, xpf = {bflo(xp.x), bfhi(xp.x), bflo(xp.y), bfhi(xp.y)};
      const f32x4 zf = {bflo(z2.x), bfhi(z2.x), bflo(z2.y), bfhi(z2.y)};
      const f32x4 cv = cw[0] * xmf + cw[1] * x0f + cw[2] * xpf + cb;
      const f32x4 ya = *(const f32x4*)(sY + rr * 260 + ch);
      f32x4 gz; float ss = 0.f;
#pragma unroll
      for (int e = 0; e < 4; ++e) { const float xs = silu_f(cv[e]); const float yv = ya[e] + dsk * xs; gz[e] = yv * silu_f(zf[e]); ss += gz[e] * gz[e]; }
      ss = wave_sum(ss);
      const float rstd = rsqrtf(ss * (1.f / 256.f) + EPS);
      u32x2 w; w.x = pk_bf16(gz[0] * rstd * ng[0], gz[1] * rstd * ng[1]); w.y = pk_bf16(gz[2] * rstd * ng[2], gz[3] * rstd * ng[3]);
      *(u32x2*)(Y + (size_t)row * DM + ch) = w;
    }
  }
  __syncthreads();
}

#define XB_TMO      128
#define XB_XCNT(j)  (256  + 64 * (j))
#define XB_XSUB(j)  (1280 + 64 * (j))
#define XB_XGEN(j)  (2304 + 64 * (j))
#define XB_TOP      3328
#define XB_TOPGEN   3392
#define XCD_BAR_WORDS 3456
#define XB_SPIN_CAP (1u << 18)
#define LAS __attribute__((address_space(3)))

__device__ __forceinline__ unsigned xb_ld(unsigned* p)              { return __hip_atomic_load(p, __ATOMIC_RELAXED, __HIP_MEMORY_SCOPE_AGENT); }
__device__ __forceinline__ unsigned xb_add(unsigned* p, unsigned v) { return __hip_atomic_fetch_add(p, v, __ATOMIC_RELAXED, __HIP_MEMORY_SCOPE_AGENT); }
__device__ __forceinline__ unsigned xb_xcc_id() { return (unsigned)__builtin_amdgcn_s_getreg((3 << 11) | 20) & 0xFu; }
#define XB_SPIN(cond, bar) do { unsigned _sp = 0; while (cond) { __builtin_amdgcn_s_sleep(1); \
    if ((++_sp & 255u) == 0u) { if (xb_ld(&(bar)[XB_TMO])) break; if (_sp > XB_SPIN_CAP) { atomicAdd(&(bar)[XB_TMO], 1u); break; } } } } while (0)

struct XcdBarrier {
    unsigned* bar; unsigned x;
    volatile LAS unsigned* st;
};

__device__ __forceinline__ XcdBarrier xcd_barrier_post(unsigned* bar, volatile LAS unsigned* st) {
    XcdBarrier b; b.bar = bar; b.x = xb_xcc_id(); b.st = st;
    if (threadIdx.x == 0) (void)xb_add(&bar[XB_XCNT(b.x)], 1u);
    return b;
}
__device__ __forceinline__ void xcd_barrier_complete(unsigned* bar, unsigned x, unsigned& nloc, unsigned& nx) {
    const unsigned G = gridDim.x * gridDim.y * gridDim.z;
    unsigned sum, cnt, mine, sp = 0u;
    for (;;) {
        sum = 0u; cnt = 0u; mine = 0u;
#pragma unroll
        for (unsigned j = 0; j < 16; ++j) { const unsigned c = xb_ld(&bar[XB_XCNT(j)]); sum += c; cnt += (c > 0u) ? 1u : 0u; mine = (j == x) ? c : mine; }
        if (sum == G) break;
        __builtin_amdgcn_s_sleep(1);
        if ((++sp & 255u) == 0u) { if (xb_ld(&bar[XB_TMO])) break; if (sp > XB_SPIN_CAP) { atomicAdd(&bar[XB_TMO], 1u); break; } }
    }
    nloc = mine > 0u ? mine : 1u; nx = cnt > 0u ? cnt : 1u;
}

__device__ __forceinline__ void xcd_barrier(const XcdBarrier& b) {
    asm volatile("s_waitcnt vmcnt(0)" ::: "memory");
    __syncthreads();
    if (threadIdx.x == 0) {
        unsigned* bar = b.bar;
        __builtin_amdgcn_s_waitcnt(0);
        unsigned nloc = b.st[0], nx = b.st[1];
        if (nloc == 0u) { xcd_barrier_complete(bar, b.x, nloc, nx); b.st[0] = nloc; b.st[1] = nx; }
        const unsigned old = xb_add(&bar[XB_XSUB(b.x)], 1u);
        const unsigned gen = old / nloc;
        if (old + 1u == (gen + 1u) * nloc) {
            __builtin_amdgcn_fence(__ATOMIC_RELEASE, "agent");
            asm volatile("s_waitcnt vmcnt(0)" ::: "memory");
            const unsigned og = xb_add(&bar[XB_TOP], 1u);
            const unsigned tg = og / nx;
            if (og + 1u == (tg + 1u) * nx) xb_add(&bar[XB_TOPGEN], 1u);
            else XB_SPIN(xb_ld(&bar[XB_TOPGEN]) == tg, bar);
            __builtin_amdgcn_fence(__ATOMIC_ACQUIRE, "agent");
            xb_add(&bar[XB_XGEN(b.x)], 1u);
            asm volatile("s_waitcnt vmcnt(0)" ::: "memory");
        } else {
            XB_SPIN(xb_ld(&bar[XB_XGEN(b.x)]) == gen, bar);
            __builtin_amdgcn_fence(__ATOMIC_ACQUIRE, "agent");
            asm volatile("s_waitcnt vmcnt(0)" ::: "memory");
        }
    }
    __syncthreads();
}

DI void gbar(unsigned* bw, unsigned k) {
  asm volatile("s_waitcnt vmcnt(0)" ::: "memory");
  __syncthreads();
  if (threadIdx.x == 0) {
    __builtin_amdgcn_fence(__ATOMIC_RELEASE, "agent");
    asm volatile("s_waitcnt vmcnt(0)" ::: "memory");
    unsigned bx_ = blockIdx.x, gd_ = gridDim.x; asm volatile("" : "+s"(bx_), "+s"(gd_));
    const unsigned x = bx_ & 7u, nloc = (gd_ - x + 7u) >> 3;
    unsigned* sub = bw + 64 * (1 + x); unsigned* gen = bw + 64 * (9 + x); unsigned* top = bw + 64 * 17;
    const unsigned old = __hip_atomic_fetch_add(sub, 1u, __ATOMIC_RELAXED, __HIP_MEMORY_SCOPE_AGENT);
    if (old + 1u == k * nloc) {
      __hip_atomic_fetch_add(top, 1u, __ATOMIC_RELAXED, __HIP_MEMORY_SCOPE_AGENT);
      while (__hip_atomic_load(top, __ATOMIC_RELAXED, __HIP_MEMORY_SCOPE_AGENT) < 8u * k) __builtin_amdgcn_s_sleep(1);
      __hip_atomic_fetch_add(gen, 1u, __ATOMIC_RELAXED, __HIP_MEMORY_SCOPE_AGENT);
    } else {
      while (__hip_atomic_load(gen, __ATOMIC_RELAXED, __HIP_MEMORY_SCOPE_AGENT) < k) __builtin_amdgcn_s_sleep(1);
    }
    __builtin_amdgcn_fence(__ATOMIC_ACQUIRE, "agent");
    asm volatile("s_waitcnt vmcnt(0)" ::: "memory");
  }
  __syncthreads();
}

__global__ void __launch_bounds__(NTHREADS, 2) fwd_megakernel(Params p) {
  cg::grid_group grid = cg::this_grid();
  extern __shared__ __attribute__((aligned(16))) unsigned char lds_dyn[];
  __shared__ uint4 s_misc[2];
  int& s_item = *(int*)&s_misc[1];
  if (threadIdx.x == 0) s_misc[0] = make_uint4(0u, 0u, 0u, 0u);
  __syncthreads();
  (void)xcd_barrier_post((unsigned*)(p.ws + OFF_MISC + 16384), (volatile LAS unsigned*)&s_misc[0]);
#define GBAR() do { XcdBarrier xb_; xb_.bar = (unsigned*)(p.ws + OFF_MISC + 16384); xb_.x = xb_xcc_id(); xb_.st = (volatile LAS unsigned*)&s_misc[0]; xcd_barrier(xb_); } while (0)
  char* smem = (char*)lds_dyn;
  const int half = half_id();
  unsigned* bw = (unsigned*)(p.ws + OFF_MISC) + 256; unsigned bk = 0;
  phase0(p, smem);
  if (p.ws == nullptr) grid.sync();
  GBAR();
  mod_reduce(p);
  GBAR();
  const float* MOD = (const float*)(p.ws + OFF_MOD);
  bf16_t* XN = (bf16_t*)(p.ws + OFF_XN);
  bf16_t* U = (bf16_t*)(p.ws + OFF_U);
  bf16_t* Y = (bf16_t*)(p.ws + OFF_Y);
  bf16_t* HM = (bf16_t*)(p.ws + OFF_HM);
  float* HC = (float*)(p.ws + OFF_HC);
  PG8_LAS unsigned char* glds = (PG8_LAS unsigned char*)lds_dyn;
#pragma unroll 1
  for (int layer = 0; layer < DEPTH; ++layer) {
    const bool with_ctx = layer < DEPTH - 1;
    const int mrows = with_ctx ? ROWS : MROWS;
    int bx = (int)blockIdx.x; asm volatile("" : "+s"(bx));
    for (int rep = 0; rep < PROBE_N1; ++rep) { norm_phase(p, layer, 0, ROWS, layer > 0 ? MOD + (size_t)((layer - 1) * 9 + 8) * 6144 + 5120 : nullptr, HC);
    GBAR(); }
    for (int rep = 0; rep < PROBE_INPROJ; ++rep) { pg8::Gemm g{XN, (const bf16_t*)(p.ws + OFF_WIN) + (size_t)layer * INPW * DM, ROWS, INPW, DM, DM}; pg8::StaticOrder S; S.init(ROWS, INPW, (int)gridDim.x, bx);
      pg8::EpiStore<0> E{U, INP, INP};
      pg8::gemm_phase<pg8::EpiStore<0>, pg8::StaticOrder, true, true>(glds, g, S, E);
    GBAR(); }
    for (int rep = 0; rep < PROBE_PREP; ++rep) {
      unsigned* qc = (unsigned*)(p.ws + OFF_MISC) + 64 + layer + rep * DEPTH;
      for (;;) {
        if (threadIdx.x == 0) s_item = (int)atomicAdd(qc, 1u);
        __syncthreads();
        const int it = s_item;
        __syncthreads();
        if (it >= 1152 + 288) break;
        if (it < 144) prep_tile(p, layer, it * 2 + half, 0, smem + half * SMEM_BYTES);
        else if (it < 288) prep_tile(p, layer, (it - 144) * 2 + half, 1, smem + half * SMEM_BYTES);
        else ssd_chunk(p, layer, it - 288, smem + half * SMEM_BYTES);
      }
      GBAR();
    }
    for (int rep = 0; rep < PROBE_MIX; ++rep) { mixer_phase(p, layer + rep * DEPTH, smem, &s_item);
    GBAR(); }
    for (int rep = 0; rep < PROBE_FIN; ++rep) { for (int t0 = blockIdx.x * 2; t0 < NB * 72; t0 += gridDim.x * 2) { const int t = t0 + half; if (!with_ctx && (t % 72) < 8) continue; ssd_finish_tile(p, layer, t, smem + half * SMEM_BYTES); }
    GBAR(); }
    { const bf16_t* Wt = (const bf16_t*)(p.ws + OFF_WOUT) + (size_t)layer * DM * DM;
      { pg8::Gemm g{Y, Wt, MROWS, DM, DM, DM}; pg8::StaticOrder S; S.init(MROWS, DM, (int)gridDim.x, bx);
        pg8::EpiResid E{layer == 0 ? p.in[I_X] : p.out, nullptr, p.out, nullptr, MOD + (size_t)layer * 9 * 6144 + 2048, 1.f};
        pg8::gemm_phase<pg8::EpiResid, pg8::StaticOrder, true, true>(glds, g, S, E);
        for (int rep = 0; rep < PROBE_OUT; ++rep) { GBAR(); pg8::EpiResid E2{p.out, nullptr, p.out, nullptr, MOD + (size_t)layer * 9 * 6144 + 2048, 0.f}; pg8::gemm_phase<pg8::EpiResid, pg8::StaticOrder, true, true>(glds, g, S, E2); } }
      if (with_ctx) {
        const int ks = (bx >> 5) & 3;
        pg8::Gemm g{Y + (size_t)MROWS * DM + ks * (DM / 4), Wt + ks * (DM / 4), CROWS, DM, DM, DM / 4}; pg8::SplitOrder S{bx};
        pg8::EpiPartial E{(float*)(p.ws + OFF_SS) + (size_t)ks * CROWS * DM};
        pg8::gemm_phase<pg8::EpiPartial, pg8::SplitOrder, true, true>(glds, g, S, E); } }
    GBAR();
    norm_phase(p, layer, 1, mrows, with_ctx ? MOD + (size_t)(layer * 9 + 8) * 6144 + 2048 : nullptr, layer == 0 ? p.in[I_CTX] : HC);
    GBAR();
    for (int rep = 0; rep < PROBE_UP; ++rep) { pg8::Gemm g{XN, (const bf16_t*)(p.ws + OFF_W1) + (size_t)layer * DFF * DM, mrows, DFF, DM, DM}; pg8::StaticOrder S; S.init(mrows, DFF, (int)gridDim.x, bx);
      pg8::EpiStore<1> E{HM, DFF, DFF};
      pg8::gemm_phase<pg8::EpiStore<1>, pg8::StaticOrder, true, true>(glds, g, S, E);
    GBAR(); }
    { const bf16_t* Wt = (const bf16_t*)(p.ws + OFF_W2) + (size_t)layer * DM * DFF;
      { pg8::Gemm g{HM, Wt, MROWS, DM, DFF, DFF}; pg8::StaticOrder S; S.init(MROWS, DM, (int)gridDim.x, bx);
        pg8::EpiResid E{p.out, nullptr, p.out, nullptr, MOD + (size_t)layer * 9 * 6144 + 5120, 1.f};
        pg8::gemm_phase<pg8::EpiResid, pg8::StaticOrder, true, true>(glds, g, S, E);
        for (int rep = 0; rep < PROBE_DOWN; ++rep) { GBAR(); pg8::EpiResid E2{p.out, nullptr, p.out, nullptr, MOD + (size_t)layer * 9 * 6144 + 5120, 0.f}; pg8::gemm_phase<pg8::EpiResid, pg8::StaticOrder, true, true>(glds, g, S, E2); } }
      if (with_ctx) {
        const int ks = (bx >> 5) & 3;
        pg8::Gemm g{HM + (size_t)MROWS * DFF + ks * (DFF / 4), Wt + ks * (DFF / 4), CROWS, DM, DFF, DFF / 4}; pg8::SplitOrder S{bx};
        pg8::EpiPartial E{(float*)(p.ws + OFF_SS) + (size_t)ks * CROWS * DM};
        pg8::gemm_phase<pg8::EpiPartial, pg8::SplitOrder, true, true>(glds, g, S, E); } }
    GBAR();
  }
  norm_phase(p, 0, 2, MROWS);
}

extern "C" void kernel_launch(void* const* d_in, const int* in_sizes, int n_in, void* d_out, int out_size, void* d_ws, size_t ws_size, hipStream_t stream) {
  static int grid_blocks = 0;
  if (!grid_blocks) {
    int dev = 0, cus = 0, per_cu = 0;
    (void)hipGetDevice(&dev);
    (void)hipDeviceGetAttribute(&cus, hipDeviceAttributeMultiprocessorCount, dev);
    if (hipFuncSetAttribute((const void*)fwd_megakernel, hipFuncAttributeMaxDynamicSharedMemorySize, LDS_BYTES) != hipSuccess) fprintf(stderr, "hipFuncSetAttribute(max dynamic LDS) failed\n");
    (void)hipOccupancyMaxActiveBlocksPerMultiprocessor(&per_cu, (const void*)fwd_megakernel, NTHREADS, LDS_BYTES);
    if (per_cu < 1) { fprintf(stderr, "occupancy query says %d blocks/CU\n", per_cu); per_cu = 1; }
    grid_blocks = cus;
  }
  if (ws_size < OFF_END) { fprintf(stderr, "workspace too small: %zu < %zu\n", ws_size, (size_t)OFF_END); return; }
  Params p{};
  for (int i = 0; i < 27; ++i) p.in[i] = (const float*)d_in[i];
  p.out = (float*)d_out;
  p.ws = (char*)d_ws;
  (void)hipMemsetAsync((char*)d_ws + OFF_MISC, 0, SZ_MISC, stream);
  void* args[] = {&p};
  hipError_t e = hipLaunchCooperativeKernel((void*)fwd_megakernel, dim3(grid_blocks), dim3(NTHREADS), args, LDS_BYTES, stream);
  if (e != hipSuccess) fprintf(stderr, "cooperative launch failed: %s (grid %d)\n", hipGetErrorString(e), grid_blocks);
}
```

```cpp
#include <hip/hip_runtime.h>
#include <hip/hip_cooperative_groups.h>
#include <stdint.h>
#include <cstdio>
namespace cg = cooperative_groups;

typedef unsigned short bf16_t;
typedef short bf16x8 __attribute__((ext_vector_type(8)));
typedef short s16x4 __attribute__((ext_vector_type(4)));
typedef float f32x16 __attribute__((ext_vector_type(16)));
typedef float f32x4 __attribute__((ext_vector_type(4)));
typedef float f32x2 __attribute__((ext_vector_type(2)));
typedef unsigned u32x4 __attribute__((ext_vector_type(4)));
typedef unsigned u32x2 __attribute__((ext_vector_type(2)));
typedef __bf16 bf2_t __attribute__((ext_vector_type(2)));

#define DI __device__ __forceinline__
#define MFMA32(a, b, c) __builtin_amdgcn_mfma_f32_32x32x16_bf16((a), (b), (c), 0, 0, 0)

constexpr int DM = 1024, NB = 8, SEQ = 2048, DEPTH = 4, CT = 256, TT = 2304;
constexpr int MROWS = NB * SEQ, CROWS = NB * CT, ROWS = MROWS + CROWS;
constexpr int INC = 2408, INP = 2432, INPW = 2560, DFF = 4096;
constexpr float EPS = 1e-6f;
constexpr float LOG2E = 1.4426950408889634f;
constexpr int U_Z = 0, U_X = 256, U_B = 512, U_C = 640, U_DT = 768;
constexpr int U_DQ = 776, U_DK = 1032, U_DV = 1288;
constexpr int U_GQ = 1544, U_GK = 1800, U_GV = 1928;
constexpr int U_MQ = 2056, U_MKV = 2248, U_MR = 2376;

constexpr size_t al256(size_t x) { return (x + 255) & ~(size_t)255; }
constexpr size_t SZ_WIN = (size_t)DEPTH * INPW * DM * 2;
constexpr size_t SZ_WOUT = (size_t)DEPTH * DM * DM * 2;
constexpr size_t SZ_W1 = (size_t)DEPTH * DFF * DM * 2;
constexpr size_t SZ_W2 = (size_t)DEPTH * DM * DFF * 2;
constexpr size_t SZ_WUQ = (size_t)DEPTH * 384 * 192 * 2;
constexpr size_t SZ_WUKV = (size_t)DEPTH * 512 * 128 * 2;
constexpr size_t SZ_MOD = (size_t)DEPTH * 9 * 6144 * 4;
constexpr size_t SZ_MISC = 32768;
constexpr size_t SZ_ROPEH = (size_t)SEQ * 32 * 8;
constexpr size_t SZ_ROPED = (size_t)SEQ * 16 * 8;
constexpr size_t SZ_HC = (size_t)CROWS * DM * 4;
constexpr size_t SZ_XN = (size_t)ROWS * DM * 2;
constexpr size_t SZ_U = (size_t)ROWS * INP * 2;
constexpr size_t SZ_QD = (size_t)NB * 8 * TT * 32 * 2;
constexpr size_t SZ_VT4 = (size_t)NB * 4 * 64 * TT * 2;
constexpr size_t SZ_QG = (size_t)NB * 4 * TT * 64 * 2;
constexpr size_t SZ_KG = (size_t)NB * 2 * TT * 64 * 2;
constexpr size_t SZ_QM = (size_t)NB * 4 * TT * 96 * 2;
constexpr size_t SZ_Y = (size_t)ROWS * DM * 2;

constexpr size_t OFF_MOD = 0;
constexpr size_t OFF_MISC = OFF_MOD + al256(SZ_MOD);
constexpr size_t OFF_WIN = OFF_MISC + SZ_MISC;
constexpr size_t OFF_WOUT = OFF_WIN + al256(SZ_WIN);
constexpr size_t OFF_W1 = OFF_WOUT + al256(SZ_WOUT);
constexpr size_t OFF_W2 = OFF_W1 + al256(SZ_W1);
constexpr size_t OFF_WUQ = OFF_W2 + al256(SZ_W2);
constexpr size_t OFF_WUKV = OFF_WUQ + al256(SZ_WUQ);
constexpr size_t OFF_ROPEH = OFF_WUKV + al256(SZ_WUKV);
constexpr size_t OFF_ROPED = OFF_ROPEH + al256(SZ_ROPEH);
constexpr size_t OFF_HC = OFF_ROPED + al256(SZ_ROPED);
constexpr size_t OFF_XN = OFF_HC + al256(SZ_HC);
constexpr size_t OFF_BIG = OFF_XN + al256(SZ_XN);
constexpr size_t OFF_U = OFF_BIG;
constexpr size_t OFF_QD = OFF_U + al256(SZ_U);
constexpr size_t OFF_KD = OFF_QD + al256(SZ_QD);
constexpr size_t OFF_VTD = OFF_KD + al256(SZ_QD);
constexpr size_t OFF_QG = OFF_VTD + al256(SZ_VT4);
constexpr size_t OFF_KG = OFF_QG + al256(SZ_QG);
constexpr size_t OFF_VTG = OFF_KG + al256(SZ_KG);
constexpr size_t OFF_QM = OFF_VTG + al256(SZ_KG);
constexpr size_t OFF_KM = OFF_QM + al256(SZ_QM);
constexpr size_t OFF_VTM = OFF_KM + al256(SZ_QM);
constexpr size_t OFF_Y = OFF_VTM + al256(SZ_VT4);
constexpr size_t SZ_SS = (size_t)64 * 37 * 16384;
constexpr size_t SZ_DEC = (size_t)64 * 36 * 4;
constexpr size_t SZ_ECL = (size_t)8 * ROWS * 4;
constexpr size_t SZ_CB = (size_t)ROWS * 128 * 2;
constexpr size_t OFF_SS = OFF_Y + al256(SZ_Y);
constexpr size_t OFF_DEC = OFF_SS + al256(SZ_SS);
constexpr size_t OFF_ECL = OFF_DEC + al256(SZ_DEC);
constexpr size_t OFF_CB = OFF_ECL + al256(SZ_ECL);
constexpr size_t OFF_END = OFF_CB + al256(SZ_CB);
static_assert(OFF_END <= (size_t)402653184, "workspace budget (4 x mod_w)");
constexpr size_t OFF_HM = OFF_BIG;
static_assert((size_t)ROWS * DFF * 2 <= OFF_Y - OFF_BIG, "HM overlay must not reach Y");
static_assert((size_t)2 * ROWS * 256 * 4 <= SZ_XN, "Yssd overlay");

struct Params {
  const float* in[27];
  float* out;
  char* ws;
};
enum { I_X = 0, I_C, I_CTX, I_CCTX, I_MODW, I_MODB, I_N1G, I_N2G, I_WIN, I_CONVW, I_CONVB, I_DTB, I_ALOG, I_SSDD, I_SSDNG,
       I_DLAM, I_DNG, I_GQN, I_GKN, I_MQN, I_MKVN, I_WUQ, I_WUKV, I_WOUT, I_W1, I_W2, I_FNG };

constexpr int SMEM_BYTES = 65536;
constexpr int LDS_BYTES = 131072, NTHREADS = 512;
#ifndef PROBE_DOWN
#define PROBE_DOWN 0
#endif
#ifndef PROBE_OUT
#define PROBE_OUT 0
#endif
#ifndef PROBE_P0
#define PROBE_P0 1
#endif
#ifndef PROBE_N1
#define PROBE_N1 1
#endif
#ifndef PROBE_FIN
#define PROBE_FIN 1
#endif
#ifndef PROBE_UP
#define PROBE_UP 1
#endif
#ifndef PROBE_PREP
#define PROBE_PREP 1
#endif
#ifndef PROBE_MIX
#define PROBE_MIX 1
#endif
#ifndef PROBE_INPROJ
#define PROBE_INPROJ 1
#endif

DI unsigned pk_bf16(float a, float b) { f32x2 v = {a, b}; bf2_t r = __builtin_convertvector(v, bf2_t); return __builtin_bit_cast(unsigned, r); }
DI bf16_t f2bf(float a) { return (bf16_t)(pk_bf16(a, 0.f) & 0xffffu); }
DI float bf2f(bf16_t v) { return __uint_as_float((unsigned)v << 16); }
DI float bflo(unsigned w) { return __uint_as_float(w << 16); }
DI float bfhi(unsigned w) { return __uint_as_float(w & 0xffff0000u); }
DI float silu_f(float x) { return x / (1.f + __expf(-x)); }
DI float wave_sum(float v) {
#pragma unroll
  for (int o = 32; o >= 1; o >>= 1) v += __shfl_xor(v, o);
  return v;
}
DI int crow(int r, int hi) { return (r & 3) + 8 * (r >> 2) + 4 * hi; }
DI bf16x8 pack8(float a0, float a1, float a2, float a3, float a4, float a5, float a6, float a7) {
  u32x4 p; p.x = pk_bf16(a0, a1); p.y = pk_bf16(a2, a3); p.z = pk_bf16(a4, a5); p.w = pk_bf16(a6, a7);
  return __builtin_bit_cast(bf16x8, p);
}
DI f32x16 zero16() { f32x16 z;
#pragma unroll
  for (int i = 0; i < 16; ++i) z[i] = 0.f;
  return z; }
DI int otid() { int t = threadIdx.x & 255; asm volatile("" : "+v"(t)); return t; }
DI int otid_full() { int t = threadIdx.x; asm volatile("" : "+v"(t)); return t; }
DI int half_id() { return __builtin_amdgcn_readfirstlane((int)threadIdx.x >> 8); }
DI int hrow_of(int b, int pos) { return pos < CT ? (MROWS + b * CT + pos) : (b * SEQ + pos - CT); }

DI void tconv_tile(const float* __restrict__ src, int K, int N, bf16_t* __restrict__ dst, int kt, int nt, unsigned* sT) {
  const int tid = otid();
#pragma unroll
  for (int p = 0; p < 2; ++p) {
    const int idx = tid + 256 * p, kp = idx >> 4, nc = idx & 15;
    const int k = kt * 64 + 2 * kp, n = nt * 64 + nc * 4;
    f32x4 v0 = {0.f, 0.f, 0.f, 0.f}, v1 = {0.f, 0.f, 0.f, 0.f};
    if (n < N) { v0 = *(const f32x4*)(src + (size_t)k * N + n); v1 = *(const f32x4*)(src + (size_t)(k + 1) * N + n); }
#pragma unroll
    for (int e = 0; e < 4; ++e) sT[(nc * 4 + e) * 33 + kp] = pk_bf16(v0[e], v1[e]);
  }
  __syncthreads();
  {
    const int n = tid >> 2, part = tid & 3;
    u32x4 a, b;
    const unsigned* s = sT + n * 33 + part * 8;
    a.x = s[0]; a.y = s[1]; a.z = s[2]; a.w = s[3]; b.x = s[4]; b.y = s[5]; b.z = s[6]; b.w = s[7];
    bf16_t* d = dst + (size_t)(nt * 64 + n) * K + kt * 64 + part * 16;
    *(u32x4*)d = a; *(u32x4*)(d + 8) = b;
  }
  __syncthreads();
}

DI void mod_task(const Params& p, int task, float* sCond) {
  const int tid = otid();
  const int ks = task & 7, cb = (task >> 3) % 24, l = task / 192;
  for (int i = tid; i < 9 * 128; i += 256) {
    const int r = i >> 7, kk = i & 127;
    const float v = (r < 8) ? p.in[I_C][r * DM + ks * 128 + kk] : p.in[I_CCTX][ks * 128 + kk];
    sCond[i] = silu_f(v);
  }
  __syncthreads();
  const int col = cb * 256 + tid;
  const float* w = p.in[I_MODW] + ((size_t)l * DM + ks * 128) * 6144 + col;
  float acc[9];
#pragma unroll
  for (int r = 0; r < 9; ++r) acc[r] = 0.f;
#pragma unroll 8
  for (int kk = 0; kk < 128; ++kk) {
    const float wv = w[(size_t)kk * 6144];
#pragma unroll
    for (int r = 0; r < 9; ++r) acc[r] += sCond[r * 128 + kk] * wv;
  }
  const float bias = (ks == 0) ? p.in[I_MODB][l * 6144 + col] : 0.f;
  float* MODP = (float*)(p.ws + OFF_Y) + (size_t)ks * (DEPTH * 9 * 6144);
#pragma unroll
  for (int r = 0; r < 9; ++r) MODP[(size_t)(l * 9 + r) * 6144 + col] = acc[r] + bias;
  __syncthreads();
}

DI void phase0(const Params& p, char* smem) {
  constexpr int T_WIN = DEPTH * 16 * 38, T_WOUT = DEPTH * 16 * 16, T_W1 = DEPTH * 16 * 64, T_W2 = DEPTH * 64 * 16;
  constexpr int T_UQ = DEPTH * 3 * 6, T_UKV = DEPTH * 2 * 8, T_MOD = 768, T_ROPE = (SEQ * 48) / 256, T_MISC = 1;
  constexpr int E0 = T_WIN, E1 = E0 + T_WOUT, E2 = E1 + T_W1, E3 = E2 + T_W2, E4 = E3 + T_UQ, E5 = E4 + T_UKV, E6 = E5 + T_MOD, E7 = E6 + T_ROPE, E8 = E7 + T_MISC;
  const int tid = otid();
  const int half = half_id(); smem += half * SMEM_BYTES;
  static_assert(E0 % 2 == 0 && E1 % 2 == 0 && E2 % 2 == 0 && E3 % 2 == 0 && E4 % 2 == 0 && E5 % 2 == 0 && E6 % 2 == 0 && E7 % 2 == 0, "half-block pairs must not straddle task types");
  for (int t0 = blockIdx.x * 2; t0 < E8; t0 += gridDim.x * 2) {
    const int t = t0 + half;
    if (t >= E8) break;
    if (t < E0) { const int l = t / (16 * 38), r = t % (16 * 38); tconv_tile(p.in[I_WIN] + (size_t)l * DM * INC, DM, INC, (bf16_t*)(p.ws + OFF_WIN) + (size_t)l * INPW * DM, r / 38, r % 38, (unsigned*)smem); }
    else if (t < E1) { const int u = t - E0, l = u / 256, r = u % 256; tconv_tile(p.in[I_WOUT] + (size_t)l * DM * DM, DM, DM, (bf16_t*)(p.ws + OFF_WOUT) + (size_t)l * DM * DM, r / 16, r % 16, (unsigned*)smem); }
    else if (t < E2) { const int u = t - E1, l = u / 1024, r = u % 1024; tconv_tile(p.in[I_W1] + (size_t)l * DM * DFF, DM, DFF, (bf16_t*)(p.ws + OFF_W1) + (size_t)l * DFF * DM, r / 64, r % 64, (unsigned*)smem); }
    else if (t < E3) { const int u = t - E2, l = u / 1024, r = u % 1024; tconv_tile(p.in[I_W2] + (size_t)l * DFF * DM, DFF, DM, (bf16_t*)(p.ws + OFF_W2) + (size_t)l * DM * DFF, r / 16, r % 16, (unsigned*)smem); }
    else if (t < E4) { const int u = t - E3, l = u / 18, r = u % 18; tconv_tile(p.in[I_WUQ] + (size_t)l * 192 * 384, 192, 384, (bf16_t*)(p.ws + OFF_WUQ) + (size_t)l * 384 * 192, r / 6, r % 6, (unsigned*)smem); }
    else if (t < E5) { const int u = t - E4, l = u / 16, r = u % 16; tconv_tile(p.in[I_WUKV] + (size_t)l * 128 * 512, 128, 512, (bf16_t*)(p.ws + OFF_WUKV) + (size_t)l * 512 * 128, r / 8, r % 8, (unsigned*)smem); }
    else if (t < E6) { mod_task(p, t - E5, (float*)smem); }
    else if (t < E7) {
      const int idx = (t - E6) * 256 + tid;
      int tt, i, nf; f32x2* dst;
      if (idx < SEQ * 32) { tt = idx >> 5; i = idx & 31; nf = 16; dst = (f32x2*)(p.ws + OFF_ROPEH) + idx; }
      else { const int j = idx - SEQ * 32; tt = j >> 4; i = j & 15; nf = 8; dst = (f32x2*)(p.ws + OFF_ROPED) + j; }
      const int f = i & (nf - 1);
      const float pos = (float)((i < nf) ? (tt >> 6) : (tt & 63));
      const float inv = exp2f(-(float)f * (13.287712379549449f / (float)nf));
      float rv = pos * inv * 0.15915494309189535f; rv -= rintf(rv);
      f32x2 cs; cs.x = __builtin_amdgcn_cosf(rv); cs.y = __builtin_amdgcn_sinf(rv);
      *dst = cs;
    } else {
      if (tid < DEPTH) {
        const float* lp = p.in[I_DLAM] + tid * 128;
        float s1 = 0.f, s2 = 0.f;
        for (int i = 0; i < 32; ++i) { s1 += lp[i] * lp[32 + i]; s2 += lp[64 + i] * lp[96 + i]; }
        const float li = 0.8f - 0.6f * expf(-0.3f * (float)tid);
        float* misc = (float*)(p.ws + OFF_MISC);
        misc[128 + tid] = expf(s1) - expf(s2) + li;
        misc[136 + tid] = li;
      }
    }
  }
}

DI void mod_reduce(const Params& p) {
  const float* MODP = (const float*)(p.ws + OFF_Y);
  float* MOD = (float*)(p.ws + OFF_MOD);
  constexpr int NTOT = DEPTH * 9 * 6144;
  for (int i = blockIdx.x * NTHREADS + otid_full(); i < NTOT; i += gridDim.x * NTHREADS) {
    float a = 0.f;
#pragma unroll
    for (int ks = 0; ks < 8; ++ks) a += MODP[(size_t)ks * NTOT + i];
    MOD[i] = a;
  }
}

DI void norm_phase(const Params& p, int layer, int which, int nrows, const float* pend_gate = nullptr, const float* pend_hin = nullptr) {
  constexpr int NR = 3;
  const int tid_ = otid_full(); const int lane = tid_ & 63, wave = tid_ >> 6;
  const int gw = blockIdx.x * 8 + wave, nw = gridDim.x * 8;
  const float* MOD = (const float*)(p.ws + OFF_MOD);
  bf16_t* XN = (bf16_t*)(p.ws + OFF_XN);
  const float* g = (which == 0 ? p.in[I_N1G] : which == 1 ? p.in[I_N2G] : p.in[I_FNG]) + (which == 2 ? 0 : layer * DM);
  f32x4 gv[4];
#pragma unroll
  for (int i = 0; i < 4; ++i) gv[i] = *(const f32x4*)(g + i * 256 + lane * 4);
  for (int row0 = gw; row0 < nrows; row0 += nw * NR) {
    f32x4 v[NR][4];
    float ss[NR];
#pragma unroll
    for (int j = 0; j < NR; ++j) {
      const int row = row0 + j * nw;
      ss[j] = 0.f;
      if (row < nrows) {
        if (pend_gate != nullptr && row >= MROWS) {
          const size_t ro = (size_t)(row - MROWS) * DM;
          const float* P = (const float*)(p.ws + OFF_SS) + ro;
#pragma unroll
          for (int i = 0; i < 4; ++i) {
            const int c = i * 256 + lane * 4;
            const f32x4 a = *(const f32x4*)(P + c), b2 = *(const f32x4*)(P + (size_t)CROWS * DM + c), c2 = *(const f32x4*)(P + (size_t)2 * CROWS * DM + c), d2 = *(const f32x4*)(P + (size_t)3 * CROWS * DM + c);
            v[j][i] = *(const f32x4*)(pend_hin + ro + c) + *(const f32x4*)(pend_gate + c) * (((a + b2) + c2) + d2);
          }
        } else {
          const float* h;
          if (row < MROWS) h = ((which == 0 && layer == 0) ? p.in[I_X] : p.out) + (size_t)row * DM;
          else h = ((which == 0 && layer == 0) ? p.in[I_CTX] : (const float*)(p.ws + OFF_HC)) + (size_t)(row - MROWS) * DM;
#pragma unroll
          for (int i = 0; i < 4; ++i) v[j][i] = *(const f32x4*)(h + i * 256 + lane * 4);
        }
      } else {
#pragma unroll
        for (int i = 0; i < 4; ++i) v[j][i] = (f32x4){0.f, 0.f, 0.f, 0.f};
      }
    }
#pragma unroll
    for (int j = 0; j < NR; ++j) {
      const int row = row0 + j * nw;
      if (row >= nrows) continue;
      if (pend_gate != nullptr && row >= MROWS) {
        float* hc = (float*)(p.ws + OFF_HC) + (size_t)(row - MROWS) * DM;
#pragma unroll
        for (int i = 0; i < 4; ++i) *(f32x4*)(hc + i * 256 + lane * 4) = v[j][i];
      }
#pragma unroll
      for (int i = 0; i < 4; ++i) ss[j] += v[j][i][0] * v[j][i][0] + v[j][i][1] * v[j][i][1] + v[j][i][2] * v[j][i][2] + v[j][i][3] * v[j][i][3];
      const float rstd = rsqrtf(wave_sum(ss[j]) * (1.f / DM) + EPS);
      if (which == 2) {
#pragma unroll
        for (int i = 0; i < 4; ++i) { f32x4 o = v[j][i] * rstd * gv[i]; *(f32x4*)(p.out + (size_t)row * DM + i * 256 + lane * 4) = o; }
      } else {
        const int bidx = row < MROWS ? (row >> 11) : 8;
        const float* sh = MOD + (size_t)(layer * 9 + bidx) * 6144 + which * 3072;
        const float* sc = sh + 1024;
#pragma unroll
        for (int i = 0; i < 4; ++i) {
          const int c = i * 256 + lane * 4;
          const f32x4 shv = *(const f32x4*)(sh + c), scv = *(const f32x4*)(sc + c);
          f32x4 o = v[j][i] * rstd * gv[i] * (1.f + scv) + shv;
          u32x2 w; w.x = pk_bf16(o[0], o[1]); w.y = pk_bf16(o[2], o[3]);
          *(u32x2*)(XN + (size_t)row * DM + c) = w;
        }
      }
    }
  }
}

namespace pg8 {
#define PG8_LAS __attribute__((address_space(3)))
typedef unsigned short bf16_t;
typedef short bf16x8 __attribute__((ext_vector_type(8)));
typedef float f32x4 __attribute__((ext_vector_type(4)));
typedef unsigned u32x4 __attribute__((ext_vector_type(4)));
constexpr int BM = 256, BK = 64, HALF = 128, HTB = HALF * BK * 2  , STAGE_BYTES = 8 * HTB, NXCD = 8, WGM = 8;

__host__ __device__ __forceinline__ int lds_byte(int r, int c) { const int st = (r >> 4) * 2 + (c >> 5), rr = r & 15, cc = c & 31, ob = rr * 64 + cc * 2; return st * 1024 + (ob ^ (((ob >> 9) & 1) << 5)); }
__host__ __device__ __forceinline__ void stage_rc(int b, int& R, int& C) { const int st = b / 1024, sb = b % 1024, swz = sb ^ (((sb >> 9) & 1) << 5); R = (st >> 1) * 16 + swz / 64; C = (st & 1) * 32 + (swz % 64) / 2; }
__host__ __device__ __forceinline__ int perm32(int rho) { const int n = rho >> 4, i = rho & 15; return 8 * (i >> 2) + 4 * n + (i & 3); }

struct Unit { int pm, pn; };
struct Gemm { const bf16_t* A; const bf16_t* Bt; int M, N, K, Kloop; };

struct StaticOrder {
    int nM, nN, nwg, G, c;
    __host__ __device__ void init(int M, int N, int G_, int c_) { nM = M / BM; nN = N / BM; nwg = nM * nN; G = G_; c = c_; }
    __host__ __device__ bool next(int i, Unit& u) const {
        const long L = (long)i * G + c; if (L >= nwg) return false;
        int wgid = (int)L; { const int q = nwg / NXCD, r = nwg % NXCD, xcd = wgid % NXCD, off = wgid / NXCD; wgid = (xcd < r ? xcd * (q + 1) : r * (q + 1) + (xcd - r) * q) + off; }
        const int nig = WGM * nN, gid = wgid / nig, fm = gid * WGM, gsz = (nM - fm) < WGM ? (nM - fm) : WGM;
        u.pm = fm + ((wgid % nig) % gsz); u.pn = (wgid % nig) / gsz; return true;
    }
    __device__ __forceinline__ void a_ready(const Unit&) const {}
    __device__ __forceinline__ void done(const Unit&) const {}
};


struct SplitOrder {
    int c;
    __host__ __device__ bool next(int i, Unit& u) const { if (i != 0 || c >= 128) return false; const int q = c & 31; u.pm = q & 7; u.pn = q >> 3; return true; }
    __device__ __forceinline__ void a_ready(const Unit&) const {}
    __device__ __forceinline__ void done(const Unit&) const {}
};
struct EpiPartial {
    static constexpr bool PERM = false, AFTER_DRAIN = false;
    float* P;
    __device__ __forceinline__ void operator()(const f32x4 (&acc)[2][2][4][2], const Unit& u, int wr, int wc, int fr, int fq) const {
        float* base = P + (size_t)u.pm * BM * 1024;
        const int col0 = u.pn * BM + wc * 32 + 4 * fq;
#pragma unroll
        for (int bj = 0; bj < 2; ++bj)
#pragma unroll
            for (int n = 0; n < 2; ++n)
#pragma unroll
                for (int ai = 0; ai < 2; ++ai)
#pragma unroll
                    for (int m = 0; m < 4; ++m) *(f32x4*)(base + (size_t)(ai * HALF + wr * 64 + m * 16 + fr) * 1024 + col0 + bj * HALF + n * 16) = acc[ai][bj][m][n];
    }
};
template <int ACT> struct EpiStore {
    static constexpr bool PERM = true, AFTER_DRAIN = false;
    bf16_t* O; int ldc; int ncols;
    __device__ __forceinline__ void operator()(const f32x4 (&acc)[2][2][4][2], const Unit& u, int wr, int wc, int fr, int fq) const {
        const int row0 = u.pm * BM + wr * 64 + fr, col0 = u.pn * BM + wc * 32 + 8 * fq;
#pragma unroll
        for (int ai = 0; ai < 2; ++ai)
#pragma unroll
            for (int m = 0; m < 4; ++m) { bf16_t* rowp = O + (size_t)(row0 + ai * HALF + m * 16) * ldc + col0;
#pragma unroll
                for (int bj = 0; bj < 2; ++bj) { if (col0 + bj * HALF < ncols) { f32x4 v0 = acc[ai][bj][m][0], v1 = acc[ai][bj][m][1];
                    if (ACT == 1) { v0 = __builtin_elementwise_max(v0, (f32x4){0.f, 0.f, 0.f, 0.f}); v1 = __builtin_elementwise_max(v1, (f32x4){0.f, 0.f, 0.f, 0.f}); v0 = v0 * v0; v1 = v1 * v1; }
                    u32x4 w; w.x = ::pk_bf16(v0[0], v0[1]); w.y = ::pk_bf16(v0[2], v0[3]); w.z = ::pk_bf16(v1[0], v1[1]); w.w = ::pk_bf16(v1[2], v1[3]);
                    *(u32x4*)(rowp + bj * HALF) = w; } } }
    }
};
struct EpiResid {
    static constexpr bool PERM = false, AFTER_DRAIN = false;
    const float* hin_m; const float* hin_c; float* hout_m; float* hout_c; const float* gate; float gscale;
    __device__ __forceinline__ void operator()(const f32x4 (&acc)[2][2][4][2], const Unit& u, int wr, int wc, int fr, int fq) const {
        const bool ismain = u.pm < 64;
        const float* hin = ismain ? hin_m + (size_t)u.pm * BM * 1024 : hin_c + (size_t)(u.pm - 64) * BM * 1024;
        float* hout = ismain ? hout_m + (size_t)u.pm * BM * 1024 : hout_c + (size_t)(u.pm - 64) * BM * 1024;
        const float* g = gate + (size_t)(ismain ? (u.pm >> 3) : 8) * 6144;
        const int col0 = u.pn * BM + wc * 32 + 4 * fq;
#pragma unroll
        for (int bj = 0; bj < 2; ++bj)
#pragma unroll
            for (int n = 0; n < 2; ++n) { const f32x4 gv = *(const f32x4*)(g + col0 + bj * HALF + n * 16) * gscale;
#pragma unroll
                for (int ai = 0; ai < 2; ++ai)
#pragma unroll
                    for (int m = 0; m < 4; ++m) { const size_t off = (size_t)(ai * HALF + wr * 64 + m * 16 + fr) * 1024 + col0 + bj * HALF + n * 16;
                        *(f32x4*)(hout + off) = *(const f32x4*)(hin + off) + gv * acc[ai][bj][m][n]; } }
    }
};
template <class Epi, class Sched, bool ALIGN_EPI = false, bool SP2 = false>
__device__ __forceinline__ void gemm_phase(PG8_LAS unsigned char* lds, const Gemm g, const Sched& S, const Epi& E) {
    const int tid = ::otid_full(), wid = __builtin_amdgcn_readfirstlane(tid >> 6), lane = tid & 63, wr = wid >> 2, wc = wid & 3, fr = lane & 15, fq = lane >> 4;
    const int K = g.K, nt = g.Kloop / BK;
    unsigned voffA[2], voffB[2];
#pragma unroll
    for (int i = 0; i < 2; ++i) { int R, C; stage_rc(tid * 16 + i * 8192, R, C); const int Rb = Epi::PERM ? ((R & ~31) + perm32(R & 31)) : R;
        voffA[i] = (unsigned)(R * K + C) * 2u; voffB[i] = (unsigned)(Rb * K + C) * 2u; }
    const size_t kstep = (size_t)(BK * 2);
    const size_t hstep = (size_t)HALF * K * 2;
    const size_t tstep = 2 * hstep;
    const unsigned ldsw = (unsigned)wid * 1024u;
    const int aoff = lds_byte(wr * 64 + fr, fq * 8), boff = lds_byte(wc * 32 + fr, fq * 8);
#define PG8_SA(b, h) (((b) * 2 + (h)) * HTB)
#define PG8_SB(b, h) ((4 + (b) * 2 + (h)) * HTB)
#define PG8_STAGE(bufoff, gbase, voff) do { _Pragma("unroll") for (int _i = 0; _i < 2; ++_i) \
        __builtin_amdgcn_global_load_lds((const unsigned*)((const char*)(gbase) + (voff)[_i]), (PG8_LAS unsigned*)(lds + (bufoff) + ldsw + _i * 8192), 16, 0, 0); } while (0)
#define PG8_LDA(dst, b, h) do { _Pragma("unroll") for (int m = 0; m < 4; ++m) _Pragma("unroll") for (int k = 0; k < 2; ++k) dst[m][k] = *(const PG8_LAS bf16x8*)(lds + PG8_SA(b, h) + aoff + m * 2048 + k * 1024); } while (0)
#define PG8_LDB(dst, b, h) do { _Pragma("unroll") for (int n = 0; n < 2; ++n) _Pragma("unroll") for (int k = 0; k < 2; ++k) dst[n][k] = *(const PG8_LAS bf16x8*)(lds + PG8_SB(b, h) + boff + n * 2048 + k * 1024); } while (0)
#define PG8_MMA(ai, bj, At, Bt) do { __builtin_amdgcn_s_setprio(1); _Pragma("unroll") for (int m = 0; m < 4; ++m) _Pragma("unroll") for (int n = 0; n < 2; ++n) _Pragma("unroll") for (int k = 0; k < 2; ++k) \
        acc[ai][bj][m][n] = __builtin_amdgcn_mfma_f32_16x16x32_bf16(Bt[n][k], At[m][k], acc[ai][bj][m][n], 0, 0, 0); __builtin_amdgcn_s_setprio(0); } while (0)
#define PG8_WAIT_V(n) asm volatile("s_waitcnt vmcnt(" #n ")" ::: "memory")
#define PG8_WAIT_L(n) asm volatile("s_waitcnt lgkmcnt(" #n ")" ::: "memory")
#define PG8_BAR __builtin_amdgcn_s_barrier()
#define PG8_SCHED __builtin_amdgcn_sched_barrier(0)
    Unit cur, nxt; int ui = 0;
    if (!S.next(0, cur)) return;
    f32x4 acc[2][2][4][2];
#pragma unroll
    for (int a = 0; a < 2; ++a)
#pragma unroll
        for (int b = 0; b < 2; ++b)
#pragma unroll
            for (int m = 0; m < 4; ++m)
#pragma unroll
                for (int n = 0; n < 2; ++n) acc[a][b][m][n] = (f32x4){0.f, 0.f, 0.f, 0.f};
    bf16x8 At[4][2], B0[2][2], B1[2][2];
    const char* cA = (const char*)g.A + (size_t)cur.pm * tstep; const char* cB = (const char*)g.Bt + (size_t)cur.pn * tstep;
    S.a_ready(cur);
    if constexpr (SP2) {
        PG8_STAGE(PG8_SB(0, 0), cB, voffB); PG8_STAGE(PG8_SB(0, 1), cB + hstep, voffB); PG8_STAGE(PG8_SA(0, 0), cA, voffA); PG8_STAGE(PG8_SA(0, 1), cA + hstep, voffA);
        if (wr == 1) PG8_BAR;
        PG8_WAIT_V(2); PG8_BAR;
        PG8_STAGE(PG8_SB(1, 0), cB + kstep, voffB); PG8_STAGE(PG8_SA(1, 0), cA + kstep, voffA); PG8_STAGE(PG8_SB(1, 1), cB + hstep + kstep, voffB);
        PG8_WAIT_V(6); PG8_BAR;
    } else {
        PG8_STAGE(PG8_SB(0, 0), cB, voffB); PG8_STAGE(PG8_SA(0, 0), cA, voffA); PG8_STAGE(PG8_SB(0, 1), cB + hstep, voffB); PG8_STAGE(PG8_SA(0, 1), cA + hstep, voffA);
        if (wr == 1) PG8_BAR;
        PG8_WAIT_V(4); PG8_BAR;
        PG8_STAGE(PG8_SB(1, 0), cB + kstep, voffB); PG8_STAGE(PG8_SA(1, 0), cA + kstep, voffA); PG8_STAGE(PG8_SB(1, 1), cB + hstep + kstep, voffB);
        PG8_WAIT_V(6); PG8_BAR;
    }
    for (;;) {
        const bool has_next = S.next(ui + 1, nxt);
        const char* nA = has_next ? (const char*)g.A + (size_t)nxt.pm * tstep : cA; const char* nB = has_next ? (const char*)g.Bt + (size_t)nxt.pn * tstep : cB;
        for (int t = 0; t < nt; t += 2) {
            const bool last = (t == nt - 2);
            const char* a1 = cA + (size_t)(t + 1) * kstep;
            const char* a2 = last ? nA : cA + (size_t)(t + 2) * kstep; const char* b2 = last ? nB : cB + (size_t)(t + 2) * kstep;
            const char* a3 = a2 + kstep; const char* b3 = b2 + kstep;
            if (last && has_next) S.a_ready(nxt);
            if constexpr (SP2) {
            PG8_LDB(B0, 0, 0); PG8_LDB(B1, 0, 1); PG8_SCHED; PG8_LDA(At, 0, 0); PG8_STAGE(PG8_SA(1, 1), a1 + hstep, voffA);
            PG8_WAIT_V(8); PG8_WAIT_L(0); PG8_BAR; PG8_MMA(0, 0, At, B0); PG8_MMA(0, 1, At, B1); PG8_BAR; PG8_SCHED;
            PG8_LDA(At, 0, 1); PG8_STAGE(PG8_SB(0, 0), b2, voffB); PG8_STAGE(PG8_SB(0, 1), b2 + hstep, voffB); PG8_STAGE(PG8_SA(0, 0), a2, voffA);
            PG8_WAIT_V(8); PG8_WAIT_L(0); PG8_BAR; PG8_MMA(1, 0, At, B0); PG8_MMA(1, 1, At, B1); PG8_BAR; PG8_SCHED;
            PG8_LDB(B0, 1, 0); PG8_LDB(B1, 1, 1); PG8_SCHED; PG8_LDA(At, 1, 0); PG8_STAGE(PG8_SA(0, 1), a2 + hstep, voffA);
            PG8_WAIT_V(8); PG8_WAIT_L(0); PG8_BAR; PG8_MMA(0, 0, At, B0); PG8_MMA(0, 1, At, B1); PG8_BAR; PG8_SCHED;
            PG8_LDA(At, 1, 1); PG8_STAGE(PG8_SB(1, 0), b3, voffB); PG8_STAGE(PG8_SB(1, 1), b3 + hstep, voffB); PG8_STAGE(PG8_SA(1, 0), a3, voffA);
            PG8_WAIT_V(8); PG8_WAIT_L(0); PG8_BAR; PG8_MMA(1, 0, At, B0); PG8_MMA(1, 1, At, B1); PG8_BAR; PG8_SCHED;
            } else {
            PG8_LDB(B0, 0, 0); PG8_SCHED; PG8_LDA(At, 0, 0); PG8_STAGE(PG8_SA(1, 1), a1 + hstep, voffA);
            PG8_WAIT_L(8); PG8_BAR; PG8_WAIT_L(0); PG8_MMA(0, 0, At, B0); PG8_BAR; PG8_SCHED;
            PG8_LDB(B1, 0, 1); PG8_STAGE(PG8_SB(0, 0), b2, voffB);
            PG8_BAR; PG8_WAIT_L(0); PG8_MMA(0, 1, At, B1); PG8_BAR;
            PG8_LDA(At, 0, 1); PG8_STAGE(PG8_SA(0, 0), a2, voffA);
            PG8_BAR; PG8_WAIT_L(0); PG8_MMA(1, 0, At, B0); PG8_BAR; PG8_SCHED;
            PG8_STAGE(PG8_SB(0, 1), b2 + hstep, voffB);
            PG8_WAIT_V(6); PG8_BAR; PG8_MMA(1, 1, At, B1); PG8_BAR;
            PG8_LDB(B0, 1, 0); PG8_SCHED; PG8_LDA(At, 1, 0); PG8_STAGE(PG8_SA(0, 1), a2 + hstep, voffA);
            PG8_WAIT_L(8); PG8_BAR; PG8_WAIT_L(0); PG8_MMA(0, 0, At, B0); PG8_BAR; PG8_SCHED;
            PG8_LDB(B1, 1, 1); PG8_STAGE(PG8_SB(1, 0), b3, voffB);
            PG8_BAR; PG8_WAIT_L(0); PG8_MMA(0, 1, At, B1); PG8_BAR;
            PG8_LDA(At, 1, 1); PG8_STAGE(PG8_SA(1, 0), a3, voffA);
            PG8_BAR; PG8_WAIT_L(0); PG8_MMA(1, 0, At, B0); PG8_BAR; PG8_SCHED;
            PG8_STAGE(PG8_SB(1, 1), b3 + hstep, voffB);
            PG8_WAIT_V(6); PG8_BAR; PG8_MMA(1, 1, At, B1); PG8_BAR;
            }
        }
        if constexpr (ALIGN_EPI) { if (wr == 0) PG8_BAR; }
        if constexpr (!Epi::AFTER_DRAIN) { E(acc, cur, wr, wc, fr, fq); S.done(cur); }
        if (!has_next) break;
#pragma unroll
        for (int a = 0; a < 2; ++a)
#pragma unroll
            for (int b = 0; b < 2; ++b)
#pragma unroll
                for (int m = 0; m < 4; ++m)
#pragma unroll
                    for (int n = 0; n < 2; ++n) acc[a][b][m][n] = (f32x4){0.f, 0.f, 0.f, 0.f};
        cur = nxt; cA = nA; cB = nB; ++ui;
        if constexpr (ALIGN_EPI) { if (wr == 1) PG8_BAR; }
    }
    PG8_WAIT_V(0);
    if constexpr (!ALIGN_EPI) { if (wr == 0) PG8_BAR; }
    PG8_BAR;
    if constexpr (Epi::AFTER_DRAIN) { E.fused(acc, cur, wr, wc, fr, fq, lds, wid, lane); S.done(cur); }
#undef PG8_SA
#undef PG8_SB
#undef PG8_STAGE
#undef PG8_LDA
#undef PG8_LDB
#undef PG8_MMA
#undef PG8_WAIT_V
#undef PG8_WAIT_L
#undef PG8_BAR
#undef PG8_SCHED
}
}

DI void prep_tile(const Params& p, int layer, int tile, int part, char* smem) {
  const int tid = otid(), lane = tid & 63, wave = tid >> 6, l31 = lane & 31, hi = lane >> 5;
  const int b = tile / 36, tb = tile % 36, p0 = tb * 64;
  const bool isctx = tb < 4;
  const int row0 = isctx ? (MROWS + b * CT + p0) : (b * SEQ + p0 - CT);
  const bf16_t* U = (const bf16_t*)(p.ws + OFF_U);
  const f32x2* ropeH = (const f32x2*)(p.ws + OFF_ROPEH);
  const f32x2* ropeD = (const f32x2*)(p.ws + OFF_ROPED);
  bf16_t* QD = (bf16_t*)(p.ws + OFF_QD); bf16_t* KD = (bf16_t*)(p.ws + OFF_KD); bf16_t* VTD = (bf16_t*)(p.ws + OFF_VTD);
  bf16_t* QG = (bf16_t*)(p.ws + OFF_QG); bf16_t* KG = (bf16_t*)(p.ws + OFF_KG); bf16_t* VTG = (bf16_t*)(p.ws + OFF_VTG);
  bf16_t* QM = (bf16_t*)(p.ws + OFF_QM); bf16_t* KM = (bf16_t*)(p.ws + OFF_KM); bf16_t* VTM = (bf16_t*)(p.ws + OFF_VTM);
  const float qsD = 0.17677669529663687f * LOG2E, qsG = 0.125f * LOG2E, qsM = 0.10206207261596575f * LOG2E;
  bf16_t* sT = (bf16_t*)smem; bf16_t* sCq = (bf16_t*)(smem + 9216); bf16_t* sCkv = (bf16_t*)(smem + 9216 + 25600);

  if (part == 0) {
  for (int tk = wave; tk < 64; tk += 4) {
    const bf16_t* urow = U + (size_t)(row0 + tk) * INP;
    const int pos = p0 + tk, t = pos - CT;
    float xv[15];
#pragma unroll
    for (int g = 0; g < 15; ++g) {
      const int col = g < 4 ? U_DQ + g * 64 + lane : g < 8 ? U_DK + (g - 4) * 64 + lane : g < 12 ? U_GQ + (g - 8) * 64 + lane : g < 14 ? U_GK + (g - 12) * 64 + lane : U_MR + l31;
      xv[g] = bf2f(urow[col]);
    }
    f32x2 csD = {1.f, 0.f}, csH = {1.f, 0.f};
    if (!isctx) { csD = ropeD[t * 16 + (lane & 15)]; csH = ropeH[t * 32 + l31]; }
#pragma unroll
    for (int g = 0; g < 15; ++g) {
      float x = xv[g];
      if (g < 8) {
        const int h = g & 3; const bool isq = g < 4;
        const int d = lane & 31, m = lane >> 5;
        if (!isctx) { const float pr = __shfl_xor(x, 16); x = (d < 16) ? (x * csD.x - pr * csD.y) : (pr * csD.y + x * csD.x); }
        if (isq) x *= qsD;
        (isq ? QD : KD)[(((size_t)b * 8 + h * 2 + m) * TT + pos) * 32 + d] = f2bf(x);
      } else if (g < 14) {
        const bool isq = g < 12; const int h = isq ? g - 8 : g - 12;
        const float ss = wave_sum(x * x);
        x = x * rsqrtf(ss * (1.f / 64.f) + EPS) * (isq ? p.in[I_GQN] : p.in[I_GKN])[layer * 64 + lane];
        if (!isctx) { const float pr = __shfl_xor(x, 32); x = (lane < 32) ? (x * csH.x - pr * csH.y) : (pr * csH.y + x * csH.x); }
        if (isq) { x *= qsG; QG[(((size_t)b * 4 + h) * TT + pos) * 64 + lane] = f2bf(x); }
        else KG[(((size_t)b * 2 + h) * TT + pos) * 64 + lane] = f2bf(x);
      } else {
        const int d = l31;
        if (!isctx) { const float pr = __shfl_xor(x, 16); x = (d < 16) ? (x * csD.x - pr * csD.y) : (pr * csD.y + x * csD.x); }
        const bf16_t v = f2bf(x);
        const int hh = hi * 2;
        KM[(((size_t)b * 4 + hh) * TT + pos) * 96 + 64 + d] = v;
        KM[(((size_t)b * 4 + hh + 1) * TT + pos) * 96 + 64 + d] = v;
      }
    }
  }
  for (int g = 0; g < 6; ++g) {
    const int colbase = g < 4 ? U_DV + g * 64 : U_GV + (g - 4) * 64;
    bf16_t* dst = g < 4 ? VTD + ((size_t)(b * 4 + g) * 64) * TT : VTG + ((size_t)(b * 2 + g - 4) * 64) * TT;
#pragma unroll
    for (int i = 0; i < 2; ++i) {
      const int c = tid + 256 * i, tk = c >> 3, kc = c & 7;
      const u32x4 v = *(const u32x4*)(U + (size_t)(row0 + tk) * INP + colbase + kc * 8);
      sT[(kc * 8 + 0) * 72 + tk] = (bf16_t)(v.x & 0xffff); sT[(kc * 8 + 1) * 72 + tk] = (bf16_t)(v.x >> 16);
      sT[(kc * 8 + 2) * 72 + tk] = (bf16_t)(v.y & 0xffff); sT[(kc * 8 + 3) * 72 + tk] = (bf16_t)(v.y >> 16);
      sT[(kc * 8 + 4) * 72 + tk] = (bf16_t)(v.z & 0xffff); sT[(kc * 8 + 5) * 72 + tk] = (bf16_t)(v.z >> 16);
      sT[(kc * 8 + 6) * 72 + tk] = (bf16_t)(v.w & 0xffff); sT[(kc * 8 + 7) * 72 + tk] = (bf16_t)(v.w >> 16);
    }
    __syncthreads();
    {
      const int dv = tid >> 2, part = tid & 3;
      const u32x4 a = *(const u32x4*)(sT + dv * 72 + part * 16), bq = *(const u32x4*)(sT + dv * 72 + part * 16 + 8);
      bf16_t* d = dst + (size_t)dv * TT + p0 + part * 16;
      *(u32x4*)d = a; *(u32x4*)(d + 8) = bq;
    }
    __syncthreads();
  }
  return;
  }
#pragma unroll 4
  for (int tk = wave; tk < 64; tk += 4) {
    const bf16_t* urow = U + (size_t)(row0 + tk) * INP;
    const float q0 = bf2f(urow[U_MQ + lane]), q1 = bf2f(urow[U_MQ + 64 + lane]), q2 = bf2f(urow[U_MQ + 128 + lane]);
    const float k0 = bf2f(urow[U_MKV + lane]), k1 = bf2f(urow[U_MKV + 64 + lane]);
    const float sq = wave_sum(q0 * q0 + q1 * q1 + q2 * q2), sk = wave_sum(k0 * k0 + k1 * k1);
    const float rq = rsqrtf(sq * (1.f / 192.f) + EPS), rk = rsqrtf(sk * (1.f / 128.f) + EPS);
    const float* gq = p.in[I_MQN] + layer * 192; const float* gk = p.in[I_MKVN] + layer * 128;
    sCq[tk * 200 + lane] = f2bf(q0 * rq * gq[lane]); sCq[tk * 200 + 64 + lane] = f2bf(q1 * rq * gq[64 + lane]); sCq[tk * 200 + 128 + lane] = f2bf(q2 * rq * gq[128 + lane]);
    sCkv[tk * 136 + lane] = f2bf(k0 * rk * gk[lane]); sCkv[tk * 136 + 64 + lane] = f2bf(k1 * rk * gk[64 + lane]);
  }
  __syncthreads();
  const bf16_t* Wkv = (const bf16_t*)(p.ws + OFF_WUKV) + (size_t)layer * 512 * 128;
  const bf16_t* Wq = (const bf16_t*)(p.ws + OFF_WUQ) + (size_t)layer * 384 * 192;
  for (int task = wave; task < 56; task += 4) {
    if (task < 32) {
      const int ct = task >> 1, tt = task & 1, head = ct >> 2, sub = ct & 3, n0 = head * 128 + sub * 32;
      f32x16 acc = zero16();
      const bf16_t* wrow = Wkv + (size_t)(n0 + l31) * 128 + hi * 8;
      const bf16_t* trow = sCkv + (tt * 32 + l31) * 136 + hi * 8;
      if (sub < 2) {
#pragma unroll
        for (int ks = 0; ks < 8; ++ks) acc = MFMA32(*(const bf16x8*)(wrow + ks * 16), *(const bf16x8*)(trow + ks * 16), acc);
        bf16_t* d = KM + (((size_t)b * 4 + head) * TT + p0 + tt * 32 + l31) * 96 + sub * 32 + 4 * hi;
#pragma unroll
        for (int r4 = 0; r4 < 4; ++r4) { u32x2 w; w.x = pk_bf16(acc[4 * r4], acc[4 * r4 + 1]); w.y = pk_bf16(acc[4 * r4 + 2], acc[4 * r4 + 3]); *(u32x2*)(d + 8 * r4) = w; }
      } else {
#pragma unroll
        for (int ks = 0; ks < 8; ++ks) acc = MFMA32(*(const bf16x8*)(trow + ks * 16), *(const bf16x8*)(wrow + ks * 16), acc);
        bf16_t* d = VTM + (((size_t)b * 4 + head) * 64 + (sub - 2) * 32 + l31) * TT + p0 + tt * 32 + 4 * hi;
#pragma unroll
        for (int r4 = 0; r4 < 4; ++r4) { u32x2 w; w.x = pk_bf16(acc[4 * r4], acc[4 * r4 + 1]); w.y = pk_bf16(acc[4 * r4 + 2], acc[4 * r4 + 3]); *(u32x2*)(d + 8 * r4) = w; }
      }
    } else {
      const int t2 = task - 32, ct = t2 >> 1, tt = t2 & 1, head = ct / 3, sub = ct % 3, n0 = head * 96 + sub * 32;
      f32x16 acc = zero16();
      const bf16_t* wrow = Wq + (size_t)(n0 + l31) * 192 + hi * 8;
      const bf16_t* trow = sCq + (tt * 32 + l31) * 200 + hi * 8;
#pragma unroll
      for (int ks = 0; ks < 12; ++ks) acc = MFMA32(*(const bf16x8*)(wrow + ks * 16), *(const bf16x8*)(trow + ks * 16), acc);
      const int pos = p0 + tt * 32 + l31;
      if (sub == 2 && !isctx) {
        const int t = pos - CT;
#pragma unroll
        for (int r = 0; r < 8; ++r) {
          const f32x2 cs = ropeD[t * 16 + crow(r, hi)];
          const float x1 = acc[r], x2 = acc[r + 8];
          acc[r] = x1 * cs.x - x2 * cs.y; acc[r + 8] = x1 * cs.y + x2 * cs.x;
        }
      }
      bf16_t* d = QM + (((size_t)b * 4 + head) * TT + pos) * 96 + sub * 32 + 4 * hi;
#pragma unroll
      for (int r4 = 0; r4 < 4; ++r4) { u32x2 w; w.x = pk_bf16(acc[4 * r4] * qsM, acc[4 * r4 + 1] * qsM); w.y = pk_bf16(acc[4 * r4 + 2] * qsM, acc[4 * r4 + 3] * qsM); *(u32x2*)(d + 8 * r4) = w; }
    }
  }
  __syncthreads();
}

template <int DQK>
DI void attn_core(const bf16_t* __restrict__ Qb, const bf16_t* __restrict__ Kb, const bf16_t* __restrict__ Vt, int q0, int ntiles,
                  f32x16 (&O)[2], float& lsum, char* smem) {
  const int tid = otid_full(), lane = tid & 63, wave = tid >> 6, l31 = lane & 31, hi = lane >> 5;
  constexpr int KS = DQK / 16, KROW = DQK + 8, KCH = DQK / 8;
  constexpr int KBYTES = 64 * KROW * 2, BUFB = KBYTES + 9216;
  constexpr int NK = 64 * KCH, NKC = (NK + NTHREADS - 1) / NTHREADS;
  static_assert(2 * BUFB <= 49152, "attention LDS");
  bf16x8 qf[KS];
#pragma unroll
  for (int ks = 0; ks < KS; ++ks) qf[ks] = *(const bf16x8*)(Qb + (size_t)(q0 + wave * 32 + l31) * DQK + ks * 16 + hi * 8);
  float mrun = -1e30f; lsum = 0.f; O[0] = zero16(); O[1] = zero16();
  const bf16_t* kg[NKC]; int kl[NKC]; bool kok[NKC];
#pragma unroll
  for (int i = 0; i < NKC; ++i) {
    const int c = tid + NTHREADS * i, key = c / KCH, kc = c % KCH;
    kok[i] = c < NK;
    kg[i] = Kb + (size_t)key * DQK + kc * 8;
    kl[i] = (key * KROW + kc * 8) * 2;
  }
  const bf16_t* vg; int vl;
  { const int dv = tid >> 3, kc = tid & 7; vg = Vt + (size_t)dv * TT + kc * 8; vl = KBYTES + (dv * 72 + kc * 8) * 2; }
  u32x4 rk[NKC], rv;
#pragma unroll
  for (int i = 0; i < NKC; ++i) if (kok[i]) rk[i] = *(const u32x4*)(kg[i]);
  rv = *(const u32x4*)(vg);
#pragma unroll
  for (int i = 0; i < NKC; ++i) if (kok[i]) *(u32x4*)(smem + kl[i]) = rk[i];
  *(u32x4*)(smem + vl) = rv;
  __syncthreads();
  for (int kt = 0; kt < ntiles; ++kt) {
    const int cur = kt & 1; const bool more = kt + 1 < ntiles;
    if (more) {
#pragma unroll
      for (int i = 0; i < NKC; ++i) if (kok[i]) rk[i] = *(const u32x4*)(kg[i] + (size_t)(kt + 1) * 64 * DQK);
      rv = *(const u32x4*)(vg + (kt + 1) * 64);
    }
    const char* sb = smem + cur * BUFB;
    f32x16 s[2];
#pragma unroll
    for (int kb = 0; kb < 2; ++kb) {
      s[kb] = zero16();
      const char* kr = sb + ((kb * 32 + l31) * KROW + hi * 8) * 2;
#pragma unroll
      for (int ks = 0; ks < KS; ++ks) s[kb] = MFMA32(*(const bf16x8*)(kr + ks * 32), qf[ks], s[kb]);
    }
    float mx = s[0][0];
#pragma unroll
    for (int r = 0; r < 16; ++r) { mx = fmaxf(mx, s[0][r]); mx = fmaxf(mx, s[1][r]); }
    mx = fmaxf(mx, __shfl_xor(mx, 32));
    const float mnew = fmaxf(mrun, mx);
    const float alpha = __builtin_amdgcn_exp2f(mrun - mnew);
    mrun = mnew;
    float rs = 0.f;
#pragma unroll
    for (int kb = 0; kb < 2; ++kb)
#pragma unroll
      for (int r = 0; r < 16; ++r) { const float e = __builtin_amdgcn_exp2f(s[kb][r] - mnew); s[kb][r] = e; rs += e; }
    lsum = lsum * alpha + rs;
    O[0] *= alpha; O[1] *= alpha;
#pragma unroll
    for (int s4 = 0; s4 < 4; ++s4) {
      const int kb = s4 >> 1, hf = (s4 & 1) * 8;
      const bf16x8 pb = pack8(s[kb][hf + 0], s[kb][hf + 1], s[kb][hf + 2], s[kb][hf + 3], s[kb][hf + 4], s[kb][hf + 5], s[kb][hf + 6], s[kb][hf + 7]);
#pragma unroll
      for (int dvb = 0; dvb < 2; ++dvb) {
        const char* vr = sb + KBYTES + ((dvb * 32 + l31) * 72 + s4 * 16 + hi * 4) * 2;
        const s16x4 lo = *(const s16x4*)vr, h4 = *(const s16x4*)(vr + 16);
        const bf16x8 a = __builtin_shufflevector(lo, h4, 0, 1, 2, 3, 4, 5, 6, 7);
        O[dvb] = MFMA32(a, pb, O[dvb]);
      }
    }
    if (more) {
      char* db = smem + (cur ^ 1) * BUFB;
#pragma unroll
      for (int i = 0; i < NKC; ++i) if (kok[i]) *(u32x4*)(db + kl[i]) = rk[i];
      *(u32x4*)(db + vl) = rv;
    }
    __syncthreads();
  }
  lsum += __shfl_xor(lsum, 32);
}

DI void attn_unit(const Params& p, int layer, int b, int kind, int head, int qb, char* smem) {
  const int tid_ = otid_full(); const int lane = tid_ & 63, wave = tid_ >> 6, l31 = lane & 31, hi = lane >> 5;
  const int q0 = qb * 256;
  const int ntiles = qb == 0 ? 4 : 36;
  bf16_t* Y = (bf16_t*)(p.ws + OFF_Y);
  const int pos = q0 + wave * 32 + l31;
  bf16_t* yrow = Y + (size_t)hrow_of(b, pos) * DM;
  f32x16 O[2]; float ls;
  if (kind == 1) {
    attn_core<32>((const bf16_t*)(p.ws + OFF_QD) + ((size_t)b * 8 + head * 2) * TT * 32, (const bf16_t*)(p.ws + OFF_KD) + ((size_t)b * 8 + head * 2) * TT * 32,
                  (const bf16_t*)(p.ws + OFF_VTD) + ((size_t)b * 4 + head) * 64 * TT, q0, ntiles, O, ls, smem);
    float* st = (float*)(smem + 49152) + tid_;
    {
      const float i0 = 1.f / ls;
#pragma unroll
      for (int dvb = 0; dvb < 2; ++dvb)
#pragma unroll
        for (int r = 0; r < 16; ++r) st[(dvb * 16 + r) * NTHREADS] = O[dvb][r] * i0;
    }
    __syncthreads();
    attn_core<32>((const bf16_t*)(p.ws + OFF_QD) + ((size_t)b * 8 + head * 2 + 1) * TT * 32, (const bf16_t*)(p.ws + OFF_KD) + ((size_t)b * 8 + head * 2 + 1) * TT * 32,
                  (const bf16_t*)(p.ws + OFF_VTD) + ((size_t)b * 4 + head) * 64 * TT, q0, ntiles, O, ls, smem);
    const float* misc = (const float*)(p.ws + OFF_MISC);
    const float lam = misc[128 + layer], li = misc[136 + layer];
    const float i1 = lam / ls;
    float ss = 0.f;
#pragma unroll
    for (int dvb = 0; dvb < 2; ++dvb)
#pragma unroll
      for (int r = 0; r < 16; ++r) { const float o = st[(dvb * 16 + r) * NTHREADS] - O[dvb][r] * i1; O[dvb][r] = o; ss += o * o; }
    ss += __shfl_xor(ss, 32);
    const float rstd = rsqrtf(ss * (1.f / 64.f) + EPS) * (1.f - li);
    const float* g = p.in[I_DNG] + layer * 64;
#pragma unroll
    for (int dvb = 0; dvb < 2; ++dvb)
#pragma unroll
      for (int r4 = 0; r4 < 4; ++r4) {
        const int dv = dvb * 32 + 8 * r4 + 4 * hi;
        const f32x4 gv = *(const f32x4*)(g + dv);
        u32x2 w; w.x = pk_bf16(O[dvb][4 * r4] * rstd * gv[0], O[dvb][4 * r4 + 1] * rstd * gv[1]);
        w.y = pk_bf16(O[dvb][4 * r4 + 2] * rstd * gv[2], O[dvb][4 * r4 + 3] * rstd * gv[3]);
        *(u32x2*)(yrow + 256 + head * 64 + dv) = w;
      }
  } else {
    int ycol;
    if (kind == 2) {
      attn_core<64>((const bf16_t*)(p.ws + OFF_QG) + ((size_t)b * 4 + head) * TT * 64, (const bf16_t*)(p.ws + OFF_KG) + ((size_t)b * 2 + (head >> 1)) * TT * 64,
                    (const bf16_t*)(p.ws + OFF_VTG) + ((size_t)b * 2 + (head >> 1)) * 64 * TT, q0, ntiles, O, ls, smem);
      ycol = 512 + head * 64;
    } else {
      attn_core<96>((const bf16_t*)(p.ws + OFF_QM) + ((size_t)b * 4 + head) * TT * 96, (const bf16_t*)(p.ws + OFF_KM) + ((size_t)b * 4 + head) * TT * 96,
                    (const bf16_t*)(p.ws + OFF_VTM) + ((size_t)b * 4 + head) * 64 * TT, q0, ntiles, O, ls, smem);
      ycol = 768 + head * 64;
    }
    const float inv = 1.f / ls;
#pragma unroll
    for (int dvb = 0; dvb < 2; ++dvb)
#pragma unroll
      for (int r4 = 0; r4 < 4; ++r4) {
        const int dv = dvb * 32 + 8 * r4 + 4 * hi;
        u32x2 w; w.x = pk_bf16(O[dvb][4 * r4] * inv, O[dvb][4 * r4 + 1] * inv); w.y = pk_bf16(O[dvb][4 * r4 + 2] * inv, O[dvb][4 * r4 + 3] * inv);
        *(u32x2*)(yrow + ycol + dv) = w;
      }
  }
}

DI void ssd_chunk(const Params& p, int layer, int item, char* smem) {
  const int tid = otid(), lane = tid & 63, wave = tid >> 6, l31 = lane & 31, hi = lane >> 5;
  const int pi = wave >> 1, li = wave & 1;
  const int ck = item % 36, r_ = item / 36, d = r_ & 1, g = (r_ >> 1) & 1, b = r_ >> 2, h = 2 * g + half_id(), chain = (b * 4 + h) * 2 + d;
  const bf16_t* U = (const bf16_t*)(p.ws + OFF_U);
  bf16_t* Yssd = (bf16_t*)(p.ws + OFF_XN) + (size_t)d * ROWS * 256;
  bf16_t* sXT = (bf16_t*)smem;
  bf16_t* sB = (bf16_t*)(smem + 9216);
  bf16_t* sC = (bf16_t*)(smem + 18432);
  bf16_t* sBT = (bf16_t*)(smem + 27648);
  float* scs = (float*)(smem + 46080);
  float* sdt = (float*)(smem + 46336);
  float* sW = (float*)(smem + 46592);
  const bool isctx = ck < 4;
  const int Len = isctx ? CT : SEQ, base = isctx ? (MROWS + b * CT) : (b * SEQ), kl = isctx ? ck : ck - 4;
  if (tid < 192) {
    const int cc = tid >> 6, e = tid & 63;
    const int ch = cc == 0 ? (h * 64 + e) : (cc == 1 ? 256 + g * 64 + e : 384 + g * 64 + e);
    const float* cw = p.in[I_CONVW] + ((size_t)layer * 512 + ch) * 3;
    sW[tid * 4 + 0] = cw[0]; sW[tid * 4 + 1] = cw[1]; sW[tid * 4 + 2] = cw[2]; sW[tid * 4 + 3] = p.in[I_CONVB][layer * 512 + ch];
  }
  const bool wrC = (half_id() == 0) && (d == 0);
  bf16_t* CB = (bf16_t*)(p.ws + OFF_CB);
  float raw_dt = 0.f;
  if (wave == 1) {
    const int posj = kl * 64 + lane, t = d ? (Len - 1 - posj) : posj;
    raw_dt = bf2f(U[(size_t)(base + t) * INP + U_DT + d * 4 + h]);
  }
  u32x4 vm6[6], v06[6], vp6[6];
#pragma unroll
  for (int i = 0; i < 6; ++i) {
    const int task = tid + 256 * i, j = task / 24, cc = task % 24;
    const int posj = kl * 64 + j, t = d ? (Len - 1 - posj) : posj;
    const int grp = cc >> 3, c8 = (cc & 7) * 8;
    const int ucol = grp == 0 ? (U_X + h * 64 + c8) : (grp == 1 ? U_B + g * 64 + c8 : U_C + g * 64 + c8);
    const bf16_t* up = U + (size_t)(base + t) * INP + ucol;
    const u32x4 z4 = {0u, 0u, 0u, 0u};
    vm6[i] = (t > 0) ? *(const u32x4*)(up - INP) : z4;
    v06[i] = *(const u32x4*)up;
    vp6[i] = (t < Len - 1) ? *(const u32x4*)(up + INP) : z4;
  }
  if (wave == 1) {
    const float dtb = p.in[I_DTB][layer * 8 + d * 4 + h];
    const float aneg = -expf(p.in[I_ALOG][layer * 8 + d * 4 + h]);
    const int posj = kl * 64 + lane, t = d ? (Len - 1 - posj) : posj;
    const float raw = raw_dt + dtb;
    const float e_ = __expf(-fabsf(raw));
    const float dtv = fmaxf(raw, 0.f) + (e_ < 0.03f ? e_ * (1.f - e_ * (0.5f - e_ * 0.33333334f)) : __logf(1.f + e_));
    float c = dtv * aneg;
#pragma unroll
    for (int o = 1; o < 64; o <<= 1) { const float tv = __shfl_up(c, o); if (lane >= o) c += tv; }
    sdt[lane] = dtv; scs[lane] = c;
    ((float*)(p.ws + OFF_ECL))[(size_t)(d * 4 + h) * ROWS + base + t] = __expf(c);
    if (lane == 63) ((float*)(p.ws + OFF_DEC))[chain * 36 + ck] = __expf(c);
  }
  __syncthreads();
  const float c63 = scs[63];
#pragma unroll
  for (int i = 0; i < 6; ++i) {
    const int task = tid + 256 * i, j = task / 24, cc = task % 24;
    const int posj = kl * 64 + j, t = d ? (Len - 1 - posj) : posj;
    const int grp = cc >> 3, c8 = (cc & 7) * 8;
    const u32x4 vm = vm6[i], v0 = v06[i], vp = vp6[i];
    float o[8];
#pragma unroll
    for (int e2 = 0; e2 < 4; ++e2) {
      const unsigned wm_ = e2 == 0 ? vm.x : e2 == 1 ? vm.y : e2 == 2 ? vm.z : vm.w;
      const unsigned w0_ = e2 == 0 ? v0.x : e2 == 1 ? v0.y : e2 == 2 ? v0.z : v0.w;
      const unsigned wp_ = e2 == 0 ? vp.x : e2 == 1 ? vp.y : e2 == 2 ? vp.z : vp.w;
      const f32x4 wa = *(const f32x4*)(sW + (grp * 64 + c8 + 2 * e2) * 4), wb = *(const f32x4*)(sW + (grp * 64 + c8 + 2 * e2 + 1) * 4);
      o[2 * e2] = silu_f(wa[0] * bflo(wm_) + wa[1] * bflo(w0_) + wa[2] * bflo(wp_) + wa[3]);
      o[2 * e2 + 1] = silu_f(wb[0] * bfhi(wm_) + wb[1] * bfhi(w0_) + wb[2] * bfhi(wp_) + wb[3]);
    }
    if (grp == 0) {
      const float dtv = sdt[j];
#pragma unroll
      for (int e = 0; e < 8; ++e) sXT[(c8 + e) * 72 + j] = f2bf(o[e] * dtv);
    } else if (grp == 1) {
      const float sc_ = __expf(c63 - scs[j]);
      u32x4 w; w.x = pk_bf16(o[0], o[1]); w.y = pk_bf16(o[2], o[3]); w.z = pk_bf16(o[4], o[5]); w.w = pk_bf16(o[6], o[7]);
      *(u32x4*)(sB + j * 72 + c8) = w;
#pragma unroll
      for (int e = 0; e < 8; ++e) sBT[(c8 + e) * 72 + j] = f2bf(o[e] * sc_);
    } else {
      u32x4 w; w.x = pk_bf16(o[0], o[1]); w.y = pk_bf16(o[2], o[3]); w.z = pk_bf16(o[4], o[5]); w.w = pk_bf16(o[6], o[7]);
      *(u32x4*)(sC + j * 72 + c8) = w;
      if (wrC) *(u32x4*)(CB + (size_t)(base + t) * 128 + g * 64 + c8) = w;
    }
  }
  __syncthreads();
  const int lcol = 32 * li + l31;
  const float cl = scs[lcol];
  f32x16 y = zero16();
#pragma unroll
  for (int si = 0; si < 2; ++si) {
    if (si <= li) {
      f32x16 gt = zero16();
#pragma unroll
      for (int ks = 0; ks < 4; ++ks) gt = MFMA32(*(const bf16x8*)(sB + (32 * si + l31) * 72 + ks * 16 + hi * 8), *(const bf16x8*)(sC + lcol * 72 + ks * 16 + hi * 8), gt);
#pragma unroll
      for (int r = 0; r < 16; ++r) { const int s_ = 32 * si + crow(r, hi); gt[r] = (s_ <= lcol) ? gt[r] * __expf(cl - scs[s_]) : 0.f; }
#pragma unroll
      for (int kk = 0; kk < 2; ++kk) {
        const bf16x8 pb = pack8(gt[8 * kk], gt[8 * kk + 1], gt[8 * kk + 2], gt[8 * kk + 3], gt[8 * kk + 4], gt[8 * kk + 5], gt[8 * kk + 6], gt[8 * kk + 7]);
        const bf16_t* xr = sXT + (32 * pi + l31) * 72 + 32 * si + 16 * kk + 4 * hi;
        const s16x4 lo = *(const s16x4*)xr, h4 = *(const s16x4*)(xr + 8);
        y = MFMA32(__builtin_shufflevector(lo, h4, 0, 1, 2, 3, 4, 5, 6, 7), pb, y);
      }
    }
  }
  {
    const int posl = kl * 64 + lcol, t = d ? (Len - 1 - posl) : posl;
    bf16_t* yp = Yssd + (size_t)(base + t) * 256 + h * 64 + 32 * pi + 4 * hi;
#pragma unroll
    for (int r4 = 0; r4 < 4; ++r4) { u32x2 o; o.x = pk_bf16(y[4 * r4], y[4 * r4 + 1]); o.y = pk_bf16(y[4 * r4 + 2], y[4 * r4 + 3]); *(u32x2*)(yp + 8 * r4) = o; }
  }
  f32x16 sacc = zero16();
#pragma unroll
  for (int ks = 0; ks < 4; ++ks) sacc = MFMA32(*(const bf16x8*)(sXT + (32 * pi + l31) * 72 + ks * 16 + hi * 8), *(const bf16x8*)(sBT + (32 * li + l31) * 72 + ks * 16 + hi * 8), sacc);
  bf16_t* Sp = (bf16_t*)(p.ws + OFF_SS) + ((size_t)chain * 37 + ck + 1) * 4096;
#pragma unroll
  for (int r = 0; r < 16; ++r) Sp[(32 * pi + crow(r, hi)) * 64 + 32 * li + l31] = f2bf(sacc[r]);
  __syncthreads();
}

DI void ssd_scan(const Params& p, int chain) {
  const int tid = otid();
  char* slot0 = p.ws + OFF_SS + (size_t)chain * 37 * 8192 + tid * 32;
  const float* dec = (const float*)(p.ws + OFF_DEC) + chain * 36;
  float H[16];
#pragma unroll
  for (int i = 0; i < 16; ++i) H[i] = 0.f;
#pragma unroll 4
  for (int c = 0; c < 36; ++c) {
    const u32x4* sp = (const u32x4*)(slot0 + (size_t)(c + 1) * 8192);
    const u32x4 s0 = sp[0], s1 = sp[1];
    const float dc = dec[c];
    u32x4 w0, w1;
    w0.x = pk_bf16(H[0], H[1]); w0.y = pk_bf16(H[2], H[3]); w0.z = pk_bf16(H[4], H[5]); w0.w = pk_bf16(H[6], H[7]);
    w1.x = pk_bf16(H[8], H[9]); w1.y = pk_bf16(H[10], H[11]); w1.z = pk_bf16(H[12], H[13]); w1.w = pk_bf16(H[14], H[15]);
    u32x4* hp = (u32x4*)(slot0 + (size_t)c * 8192);
    hp[0] = w0; hp[1] = w1;
    H[0] = H[0] * dc + bflo(s0.x); H[1] = H[1] * dc + bfhi(s0.x); H[2] = H[2] * dc + bflo(s0.y); H[3] = H[3] * dc + bfhi(s0.y);
    H[4] = H[4] * dc + bflo(s0.z); H[5] = H[5] * dc + bfhi(s0.z); H[6] = H[6] * dc + bflo(s0.w); H[7] = H[7] * dc + bfhi(s0.w);
    H[8] = H[8] * dc + bflo(s1.x); H[9] = H[9] * dc + bfhi(s1.x); H[10] = H[10] * dc + bflo(s1.y); H[11] = H[11] * dc + bfhi(s1.y);
    H[12] = H[12] * dc + bflo(s1.z); H[13] = H[13] * dc + bfhi(s1.z); H[14] = H[14] * dc + bflo(s1.w); H[15] = H[15] * dc + bfhi(s1.w);
  }
}

DI void ssd_finish_tile(const Params& p, int layer, int tile, char* smem) {
  const int tid = otid(), lane = tid & 63, wave = tid >> 6, l31 = lane & 31, hi = lane >> 5;
  const int b = tile / 72, tb = tile % 72, p0 = tb * 32;
  const bool isctx = tb < 8;
  const int row0 = isctx ? (MROWS + b * CT + p0) : (b * SEQ + p0 - CT);
  const int T64 = tb >> 1, nch = isctx ? 4 : 32, Tl = isctx ? T64 : T64 - 4;
  const bf16_t* U = (const bf16_t*)(p.ws + OFF_U);
  const bf16_t* Y0 = (const bf16_t*)(p.ws + OFF_XN); const bf16_t* Y1 = Y0 + (size_t)ROWS * 256;
  const float* ECL = (const float*)(p.ws + OFF_ECL);
  bf16_t* Y = (bf16_t*)(p.ws + OFF_Y);
  bf16_t* sCc = (bf16_t*)smem;
  float* sY = (float*)(smem + 8704);
  {
    const bf16_t* CB = (const bf16_t*)(p.ws + OFF_CB) + (size_t)row0 * 128;
#pragma unroll
    for (int i = 0; i < 2; ++i) { const int c = tid + 256 * i, r = c >> 4, kc = c & 15; *(u32x4*)(sCc + r * 136 + kc * 8) = *(const u32x4*)(CB + r * 128 + kc * 8); }
  }
  __syncthreads();
  {
    const int pi = wave & 1, g = wave >> 1;
    const int row = row0 + l31;
#pragma unroll
    for (int hh = 0; hh < 2; ++hh) {
      const int h = g * 2 + hh;
      f32x16 ys = zero16();
#pragma unroll
      for (int d = 0; d < 2; ++d) {
        const int kl = d ? (nch - 1 - Tl) : Tl, ck = isctx ? kl : 4 + kl, chain = (b * 4 + h) * 2 + d;
        const char* Hs = p.ws + OFF_SS + ((size_t)chain * 37 + ck) * 8192 + (32 * pi + l31) * 128 + hi * 16;
        f32x16 acc = zero16();
#pragma unroll
        for (int ks = 0; ks < 4; ++ks) acc = MFMA32(*(const bf16x8*)(Hs + ks * 32), *(const bf16x8*)(sCc + l31 * 136 + g * 64 + ks * 16 + hi * 8), acc);
        const float e = ECL[(size_t)(d * 4 + h) * ROWS + row];
        ys += acc * e;
      }
      const bf16_t* y0p = Y0 + (size_t)row * 256 + h * 64 + 32 * pi + 4 * hi; const bf16_t* y1p = Y1 + (size_t)row * 256 + h * 64 + 32 * pi + 4 * hi;
#pragma unroll
      for (int r4 = 0; r4 < 4; ++r4) {
        const u32x2 a_ = *(const u32x2*)(y0p + 8 * r4), c_ = *(const u32x2*)(y1p + 8 * r4);
        const f32x4 a = {bflo(a_.x), bfhi(a_.x), bflo(a_.y), bfhi(a_.y)}, c2 = {bflo(c_.x), bfhi(c_.x), bflo(c_.y), bfhi(c_.y)};
        f32x4 o; o[0] = ys[4 * r4] + a[0] + c2[0]; o[1] = ys[4 * r4 + 1] + a[1] + c2[1]; o[2] = ys[4 * r4 + 2] + a[2] + c2[2]; o[3] = ys[4 * r4 + 3] + a[3] + c2[3];
        *(f32x4*)(sY + l31 * 260 + h * 64 + 32 * pi + 8 * r4 + 4 * hi) = o;
      }
    }
  }
  __syncthreads();
  {
    const int ch = lane * 4, hd = lane >> 4;
    const float dsk = p.in[I_SSDD][layer * 8 + hd] + p.in[I_SSDD][layer * 8 + 4 + hd];
    f32x4 cw[3];
    {
      const float* w = p.in[I_CONVW] + ((size_t)layer * 512 + ch) * 3;
      const f32x4 a = *(const f32x4*)w, b2 = *(const f32x4*)(w + 4), c2 = *(const f32x4*)(w + 8);
      cw[0] = (f32x4){a[0], a[3], b2[2], c2[1]}; cw[1] = (f32x4){a[1], b2[0], b2[3], c2[2]}; cw[2] = (f32x4){a[2], b2[1], c2[0], c2[3]};
    }
    const f32x4 cb = *(const f32x4*)(p.in[I_CONVB] + layer * 512 + ch);
    const f32x4 ng = *(const f32x4*)(p.in[I_SSDNG] + layer * 256 + ch);
    const int Len = isctx ? CT : SEQ;
#pragma unroll 2
    for (int rr = wave; rr < 32; rr += 4) {
      const int row = row0 + rr;
      const int t = isctx ? (p0 + rr) : (p0 - CT + rr);
      const bf16_t* up = U + (size_t)row * INP;
      const u32x2 z2 = *(const u32x2*)(up + U_Z + ch);
      const u32x2 zz = {0u, 0u};
      const u32x2 xm = (t > 0) ? *(const u32x2*)(up - INP + U_X + ch) : zz;
      const u32x2 x0 = *(const u32x2*)(up + U_X + ch);
      const u32x2 xp = (t < Len - 1) ? *(const u32x2*)(up + INP + U_X + ch) : zz;
      const f32x4 xmf = {bflo(xm.x), bfhi(xm.x), bflo(xm.y), bfhi(xm.y)}, x0f = {bflo(x0.x), bfhi(x0.x), bflo(x0.y), bfhi(x0.y)}, xpf = {bflo(xp.x), bfhi(xp.x), bflo(xp.y), bfhi(xp.y)};
      const f32x4 zf = {bflo(z2.x), bfhi(z2.x), bflo(z2.y), bfhi(z2.y)};
      const f32x4 cv = cw[0] * xmf + cw[1] * x0f + cw[2] * xpf + cb;
      const f32x4 ya = *(const f32x4*)(sY + rr * 260 + ch);
      f32x4 gz; float ss = 0.f;
#pragma unroll
      for (int e = 0; e < 4; ++e) { const float xs = silu_f(cv[e]); const float yv = ya[e] + dsk * xs; gz[e] = yv * silu_f(zf[e]); ss += gz[e] * gz[e]; }
      ss = wave_sum(ss);
      const float rstd = rsqrtf(ss * (1.f / 256.f) + EPS);
      u32x2 w; w.x = pk_bf16(gz[0] * rstd * ng[0], gz[1] * rstd * ng[1]); w.y = pk_bf16(gz[2] * rstd * ng[2], gz[3] * rstd * ng[3]);
      *(u32x2*)(Y + (size_t)row * DM + ch) = w;
    }
  }
  __syncthreads();
}

DI void mixer_phase(const Params& p, int layer_c, char* smem, int* s_item) {
  const int layer = layer_c % DEPTH;
  const bool with_ctx = layer < DEPTH - 1;
  const int nqb = with_ctx ? 9 : 8;
  const int natt = 12 * nqb, nfin = with_ctx ? 36 : 32;
  const int nitems = 4 + natt + nfin;
  unsigned* cnt = (unsigned*)(p.ws + OFF_MISC) + layer_c * 8;
  unsigned* sdone = (unsigned*)(p.ws + OFF_MISC) + 72 + layer * 8;
  for (int qq = 0; qq < 8; ++qq) {
    const int q = (blockIdx.x + qq) & 7;
    for (;;) {
      if (threadIdx.x == 0) *s_item = (int)atomicAdd(&cnt[q], 1u);
      __syncthreads();
      const int it = *s_item;
      __syncthreads();
      if (it >= nitems) break;
      if (it < 4) {
        ssd_scan(p, q * 8 + it * 2 + half_id());
        asm volatile("s_waitcnt vmcnt(0)" ::: "memory");
        __syncthreads();
        if (threadIdx.x == 0) {
          __builtin_amdgcn_fence(__ATOMIC_RELEASE, "agent");
          asm volatile("s_waitcnt vmcnt(0)" ::: "memory");
          __hip_atomic_fetch_add(&sdone[q], 1u, __ATOMIC_RELAXED, __HIP_MEMORY_SCOPE_AGENT);
        }
      } else if (it < 4 + natt) {
        const int idx = it - 4;
        int kind, head, qb;
        if (idx < 96) { const int hidx = idx >> 3; qb = (idx & 7) + 1; const int ko = hidx >> 2; kind = ko == 0 ? 1 : (ko == 1 ? 0 : 2); head = hidx & 3; }
        else { const int hidx = idx - 96; qb = 0; const int ko = hidx >> 2; kind = ko == 0 ? 1 : (ko == 1 ? 0 : 2); head = hidx & 3; }
        attn_unit(p, layer, q, kind, head, qb, smem);
      } else {
        if (threadIdx.x == 0) {
          while (__hip_atomic_load(&sdone[q], __ATOMIC_RELAXED, __HIP_MEMORY_SCOPE_AGENT) < 4u) __builtin_amdgcn_s_sleep(2);
          __builtin_amdgcn_fence(__ATOMIC_ACQUIRE, "agent");
          asm volatile("s_waitcnt vmcnt(0)" ::: "memory");
        }
        __syncthreads();
        const int fi = it - 4 - natt;
        const int tile = q * 72 + (with_ctx ? 0 : 8) + fi * 2 + half_id();
        ssd_finish_tile(p, layer, tile, smem + half_id() * SMEM_BYTES);
      }
      __syncthreads();
    }
  }
}

#define XB_TMO      128
#define XB_XCNT(j)  (256  + 64 * (j))
#define XB_XSUB(j)  (1280 + 64 * (j))
#define XB_XGEN(j)  (2304 + 64 * (j))
#define XB_TOP      3328
#define XB_TOPGEN   3392
#define XCD_BAR_WORDS 3456
#define XB_SPIN_CAP (1u << 18)
#define LAS __attribute__((address_space(3)))

__device__ __forceinline__ unsigned xb_ld(unsigned* p)              { return __hip_atomic_load(p, __ATOMIC_RELAXED, __HIP_MEMORY_SCOPE_AGENT); }
__device__ __forceinline__ unsigned xb_add(unsigned* p, unsigned v) { return __hip_atomic_fetch_add(p, v, __ATOMIC_RELAXED, __HIP_MEMORY_SCOPE_AGENT); }
__device__ __forceinline__ unsigned xb_xcc_id() { return (unsigned)__builtin_amdgcn_s_getreg((3 << 11) | 20) & 0xFu; }
#define XB_SPIN(cond, bar) do { unsigned _sp = 0; while (cond) { __builtin_amdgcn_s_sleep(1); \
    if ((++_sp & 255u) == 0u) { if (xb_ld(&(bar)[XB_TMO])) break; if (_sp > XB_SPIN_CAP) { atomicAdd(&(bar)[XB_TMO], 1u); break; } } } } while (0)

struct XcdBarrier {
    unsigned* bar; unsigned x;
    volatile LAS unsigned* st;
};

__device__ __forceinline__ XcdBarrier xcd_barrier_post(unsigned* bar, volatile LAS unsigned* st) {
    XcdBarrier b; b.bar = bar; b.x = xb_xcc_id(); b.st = st;
    if (threadIdx.x == 0) (void)xb_add(&bar[XB_XCNT(b.x)], 1u);
    return b;
}
__device__ __forceinline__ void xcd_barrier_complete(unsigned* bar, unsigned x, unsigned& nloc, unsigned& nx) {
    const unsigned G = gridDim.x * gridDim.y * gridDim.z;
    unsigned sum, cnt, mine, sp = 0u;
    for (;;) {
        sum = 0u; cnt = 0u; mine = 0u;
#pragma unroll
        for (unsigned j = 0; j < 16; ++j) { const unsigned c = xb_ld(&bar[XB_XCNT(j)]); sum += c; cnt += (c > 0u) ? 1u : 0u; mine = (j == x) ? c : mine; }
        if (sum == G) break;
        __builtin_amdgcn_s_sleep(1);
        if ((++sp & 255u) == 0u) { if (xb_ld(&bar[XB_TMO])) break; if (sp > XB_SPIN_CAP) { atomicAdd(&bar[XB_TMO], 1u); break; } }
    }
    nloc = mine > 0u ? mine : 1u; nx = cnt > 0u ? cnt : 1u;
}

__device__ __forceinline__ void xcd_barrier(const XcdBarrier& b) {
    asm volatile("s_waitcnt vmcnt(0)" ::: "memory");
    __syncthreads();
    if (threadIdx.x == 0) {
        unsigned* bar = b.bar;
        __builtin_amdgcn_s_waitcnt(0);
        unsigned nloc = b.st[0], nx = b.st[1];
        if (nloc == 0u) { xcd_barrier_complete(bar, b.x, nloc, nx); b.st[0] = nloc; b.st[1] = nx; }
        const unsigned old = xb_add(&bar[XB_XSUB(b.x)], 1u);
        const unsigned gen = old / nloc;
        if (old + 1u == (gen + 1u) * nloc) {
            __builtin_amdgcn_fence(__ATOMIC_RELEASE, "agent");
            asm volatile("s_waitcnt vmcnt(0)" ::: "memory");
            const unsigned og = xb_add(&bar[XB_TOP], 1u);
            const unsigned tg = og / nx;
            if (og + 1u == (tg + 1u) * nx) xb_add(&bar[XB_TOPGEN], 1u);
            else XB_SPIN(xb_ld(&bar[XB_TOPGEN]) == tg, bar);
            __builtin_amdgcn_fence(__ATOMIC_ACQUIRE, "agent");
            xb_add(&bar[XB_XGEN(b.x)], 1u);
            asm volatile("s_waitcnt vmcnt(0)" ::: "memory");
        } else {
            XB_SPIN(xb_ld(&bar[XB_XGEN(b.x)]) == gen, bar);
            __builtin_amdgcn_fence(__ATOMIC_ACQUIRE, "agent");
            asm volatile("s_waitcnt vmcnt(0)" ::: "memory");
        }
    }
    __syncthreads();
}

DI void gbar(unsigned* bw, unsigned k) {
  asm volatile("s_waitcnt vmcnt(0)" ::: "memory");
  __syncthreads();
  if (threadIdx.x == 0) {
    __builtin_amdgcn_fence(__ATOMIC_RELEASE, "agent");
    asm volatile("s_waitcnt vmcnt(0)" ::: "memory");
    unsigned bx_ = blockIdx.x, gd_ = gridDim.x; asm volatile("" : "+s"(bx_), "+s"(gd_));
    const unsigned x = bx_ & 7u, nloc = (gd_ - x + 7u) >> 3;
    unsigned* sub = bw + 64 * (1 + x); unsigned* gen = bw + 64 * (9 + x); unsigned* top = bw + 64 * 17;
    const unsigned old = __hip_atomic_fetch_add(sub, 1u, __ATOMIC_RELAXED, __HIP_MEMORY_SCOPE_AGENT);
    if (old + 1u == k * nloc) {
      __hip_atomic_fetch_add(top, 1u, __ATOMIC_RELAXED, __HIP_MEMORY_SCOPE_AGENT);
      while (__hip_atomic_load(top, __ATOMIC_RELAXED, __HIP_MEMORY_SCOPE_AGENT) < 8u * k) __builtin_amdgcn_s_sleep(1);
      __hip_atomic_fetch_add(gen, 1u, __ATOMIC_RELAXED, __HIP_MEMORY_SCOPE_AGENT);
    } else {
      while (__hip_atomic_load(gen, __ATOMIC_RELAXED, __HIP_MEMORY_SCOPE_AGENT) < k) __builtin_amdgcn_s_sleep(1);
    }
    __builtin_amdgcn_fence(__ATOMIC_ACQUIRE, "agent");
    asm volatile("s_waitcnt vmcnt(0)" ::: "memory");
  }
  __syncthreads();
}

__global__ void __launch_bounds__(NTHREADS, 2) fwd_megakernel(Params p) {
  cg::grid_group grid = cg::this_grid();
  extern __shared__ __attribute__((aligned(16))) unsigned char lds_dyn[];
  __shared__ uint4 s_misc[2];
  int& s_item = *(int*)&s_misc[1];
  if (threadIdx.x == 0) s_misc[0] = make_uint4(0u, 0u, 0u, 0u);
  __syncthreads();
  (void)xcd_barrier_post((unsigned*)(p.ws + OFF_MISC + 16384), (volatile LAS unsigned*)&s_misc[0]);
#define GBAR() do { XcdBarrier xb_; xb_.bar = (unsigned*)(p.ws + OFF_MISC + 16384); xb_.x = xb_xcc_id(); xb_.st = (volatile LAS unsigned*)&s_misc[0]; xcd_barrier(xb_); } while (0)
  char* smem = (char*)lds_dyn;
  const int half = half_id();
  unsigned* bw = (unsigned*)(p.ws + OFF_MISC) + 256; unsigned bk = 0;
  phase0(p, smem);
  if (p.ws == nullptr) grid.sync();
  GBAR();
  mod_reduce(p);
  GBAR();
  const float* MOD = (const float*)(p.ws + OFF_MOD);
  bf16_t* XN = (bf16_t*)(p.ws + OFF_XN);
  bf16_t* U = (bf16_t*)(p.ws + OFF_U);
  bf16_t* Y = (bf16_t*)(p.ws + OFF_Y);
  bf16_t* HM = (bf16_t*)(p.ws + OFF_HM);
  float* HC = (float*)(p.ws + OFF_HC);
  PG8_LAS unsigned char* glds = (PG8_LAS unsigned char*)lds_dyn;
#pragma unroll 1
  for (int layer = 0; layer < DEPTH; ++layer) {
    const bool with_ctx = layer < DEPTH - 1;
    const int mrows = with_ctx ? ROWS : MROWS;
    int bx = (int)blockIdx.x; asm volatile("" : "+s"(bx));
    for (int rep = 0; rep < PROBE_N1; ++rep) { norm_phase(p, layer, 0, ROWS, layer > 0 ? MOD + (size_t)((layer - 1) * 9 + 8) * 6144 + 5120 : nullptr, HC);
    GBAR(); }
    for (int rep = 0; rep < PROBE_INPROJ; ++rep) { pg8::Gemm g{XN, (const bf16_t*)(p.ws + OFF_WIN) + (size_t)layer * INPW * DM, ROWS, INPW, DM, DM}; pg8::StaticOrder S; S.init(ROWS, INPW, (int)gridDim.x, bx);
      pg8::EpiStore<0> E{U, INP, INP};
      pg8::gemm_phase<pg8::EpiStore<0>, pg8::StaticOrder, true, true>(glds, g, S, E);
    GBAR(); }
    for (int rep = 0; rep < PROBE_PREP; ++rep) {
      unsigned* qc = (unsigned*)(p.ws + OFF_MISC) + 64 + layer + rep * DEPTH;
      for (;;) {
        if (threadIdx.x == 0) s_item = (int)atomicAdd(qc, 1u);
        __syncthreads();
        const int it = s_item;
        __syncthreads();
        if (it >= 1152 + 288) break;
        if (it < 144) prep_tile(p, layer, it * 2 + half, 0, smem + half * SMEM_BYTES);
        else if (it < 288) prep_tile(p, layer, (it - 144) * 2 + half, 1, smem + half * SMEM_BYTES);
        else ssd_chunk(p, layer, it - 288, smem + half * SMEM_BYTES);
      }
      GBAR();
    }
    for (int rep = 0; rep < PROBE_MIX; ++rep) { mixer_phase(p, layer + rep * DEPTH, smem, &s_item);
    GBAR(); }
    { const bf16_t* Wt = (const bf16_t*)(p.ws + OFF_WOUT) + (size_t)layer * DM * DM;
      { pg8::Gemm g{Y, Wt, MROWS, DM, DM, DM}; pg8::StaticOrder S; S.init(MROWS, DM, (int)gridDim.x, bx);
        pg8::EpiResid E{layer == 0 ? p.in[I_X] : p.out, nullptr, p.out, nullptr, MOD + (size_t)layer * 9 * 6144 + 2048, 1.f};
        pg8::gemm_phase<pg8::EpiResid, pg8::StaticOrder, true, true>(glds, g, S, E);
        for (int rep = 0; rep < PROBE_OUT; ++rep) { GBAR(); pg8::EpiResid E2{p.out, nullptr, p.out, nullptr, MOD + (size_t)layer * 9 * 6144 + 2048, 0.f}; pg8::gemm_phase<pg8::EpiResid, pg8::StaticOrder, true, true>(glds, g, S, E2); } }
      if (with_ctx) {
        const int ks = (bx >> 5) & 3;
        pg8::Gemm g{Y + (size_t)MROWS * DM + ks * (DM / 4), Wt + ks * (DM / 4), CROWS, DM, DM, DM / 4}; pg8::SplitOrder S{bx};
        pg8::EpiPartial E{(float*)(p.ws + OFF_SS) + (size_t)ks * CROWS * DM};
        pg8::gemm_phase<pg8::EpiPartial, pg8::SplitOrder, true, true>(glds, g, S, E); } }
    GBAR();
    norm_phase(p, layer, 1, mrows, with_ctx ? MOD + (size_t)(layer * 9 + 8) * 6144 + 2048 : nullptr, layer == 0 ? p.in[I_CTX] : HC);
    GBAR();
    for (int rep = 0; rep < PROBE_UP; ++rep) { pg8::Gemm g{XN, (const bf16_t*)(p.ws + OFF_W1) + (size_t)layer * DFF * DM, mrows, DFF, DM, DM}; pg8::StaticOrder S; S.init(mrows, DFF, (int)gridDim.x, bx);
      pg8::EpiStore<1> E{HM, DFF, DFF};
      pg8::gemm_phase<pg8::EpiStore<1>, pg8::StaticOrder, true, true>(glds, g, S, E);
    GBAR(); }
    { const bf16_t* Wt = (const bf16_t*)(p.ws + OFF_W2) + (size_t)layer * DM * DFF;
      { pg8::Gemm g{HM, Wt, MROWS, DM, DFF, DFF}; pg8::StaticOrder S; S.init(MROWS, DM, (int)gridDim.x, bx);
        pg8::EpiResid E{p.out, nullptr, p.out, nullptr, MOD + (size_t)layer * 9 * 6144 + 5120, 1.f};
        pg8::gemm_phase<pg8::EpiResid, pg8::StaticOrder, true, true>(glds, g, S, E);
        for (int rep = 0; rep < PROBE_DOWN; ++rep) { GBAR(); pg8::EpiResid E2{p.out, nullptr, p.out, nullptr, MOD + (size_t)layer * 9 * 6144 + 5120, 0.f}; pg8::gemm_phase<pg8::EpiResid, pg8::StaticOrder, true, true>(glds, g, S, E2); } }
      if (with_ctx) {
        const int ks = (bx >> 5) & 3;
        pg8::Gemm g{HM + (size_t)MROWS * DFF + ks * (DFF / 4), Wt + ks * (DFF / 4), CROWS, DM, DFF, DFF / 4}; pg8::SplitOrder S{bx};
        pg8::EpiPartial E{(float*)(p.ws + OFF_SS) + (size_t)ks * CROWS * DM};
        pg8::gemm_phase<pg8::EpiPartial, pg8::SplitOrder, true, true>(glds, g, S, E); } }
    GBAR();
  }
  norm_phase(p, 0, 2, MROWS);
}

extern "C" void kernel_launch(void* const* d_in, const int* in_sizes, int n_in, void* d_out, int out_size, void* d_ws, size_t ws_size, hipStream_t stream) {
  static int grid_blocks = 0;
  if (!grid_blocks) {
    int dev = 0, cus = 0, per_cu = 0;
    (void)hipGetDevice(&dev);
    (void)hipDeviceGetAttribute(&cus, hipDeviceAttributeMultiprocessorCount, dev);
    if (hipFuncSetAttribute((const void*)fwd_megakernel, hipFuncAttributeMaxDynamicSharedMemorySize, LDS_BYTES) != hipSuccess) fprintf(stderr, "hipFuncSetAttribute(max dynamic LDS) failed\n");
    (void)hipOccupancyMaxActiveBlocksPerMultiprocessor(&per_cu, (const void*)fwd_megakernel, NTHREADS, LDS_BYTES);
    if (per_cu < 1) { fprintf(stderr, "occupancy query says %d blocks/CU\n", per_cu); per_cu = 1; }
    grid_blocks = cus;
  }
  if (ws_size < OFF_END) { fprintf(stderr, "workspace too small: %zu < %zu\n", ws_size, (size_t)OFF_END); return; }
  Params p{};
  for (int i = 0; i < 27; ++i) p.in[i] = (const float*)d_in[i];
  p.out = (float*)d_out;
  p.ws = (char*)d_ws;
  (void)hipMemsetAsync((char*)d_ws + OFF_MISC, 0, SZ_MISC, stream);
  void* args[] = {&p};
  hipError_t e = hipLaunchCooperativeKernel((void*)fwd_megakernel, dim3(grid_blocks), dim3(NTHREADS), args, LDS_BYTES, stream);
  if (e != hipSuccess) fprintf(stderr, "cooperative launch failed: %s (grid %d)\n", hipGetErrorString(e), grid_blocks);
}
```

```cpp
#include <hip/hip_runtime.h>
#include <hip/hip_cooperative_groups.h>
#include <stdint.h>
#include <cstdio>
namespace cg = cooperative_groups;

typedef unsigned short bf16_t;
typedef short bf16x8 __attribute__((ext_vector_type(8)));
typedef short s16x4 __attribute__((ext_vector_type(4)));
typedef float f32x16 __attribute__((ext_vector_type(16)));
typedef float f32x4 __attribute__((ext_vector_type(4)));
typedef float f32x2 __attribute__((ext_vector_type(2)));
typedef unsigned u32x4 __attribute__((ext_vector_type(4)));
typedef unsigned u32x2 __attribute__((ext_vector_type(2)));
typedef __bf16 bf2_t __attribute__((ext_vector_type(2)));

#define DI __device__ __forceinline__
#define MFMA32(a, b, c) __builtin_amdgcn_mfma_f32_32x32x16_bf16((a), (b), (c), 0, 0, 0)

constexpr int DM = 1024, NB = 8, SEQ = 2048, DEPTH = 4, CT = 256, TT = 2304;
constexpr int MROWS = NB * SEQ, CROWS = NB * CT, ROWS = MROWS + CROWS;
constexpr int INC = 2408, INP = 2432, INPW = 2560, DFF = 4096;
constexpr float EPS = 1e-6f;
constexpr float LOG2E = 1.4426950408889634f;
constexpr int U_Z = 0, U_X = 256, U_B = 512, U_C = 640, U_DT = 768;
constexpr int U_DQ = 776, U_DK = 1032, U_DV = 1288;
constexpr int U_GQ = 1544, U_GK = 1800, U_GV = 1928;
constexpr int U_MQ = 2056, U_MKV = 2248, U_MR = 2376;

constexpr size_t al256(size_t x) { return (x + 255) & ~(size_t)255; }
constexpr size_t SZ_WIN = (size_t)DEPTH * INPW * DM * 2;
constexpr size_t SZ_WOUT = (size_t)DEPTH * DM * DM * 2;
constexpr size_t SZ_W1 = (size_t)DEPTH * DFF * DM * 2;
constexpr size_t SZ_W2 = (size_t)DEPTH * DM * DFF * 2;
constexpr size_t SZ_WUQ = (size_t)DEPTH * 384 * 192 * 2;
constexpr size_t SZ_WUKV = (size_t)DEPTH * 512 * 128 * 2;
constexpr size_t SZ_MOD = (size_t)DEPTH * 9 * 6144 * 4;
constexpr size_t SZ_MISC = 32768;
constexpr size_t SZ_ROPEH = (size_t)SEQ * 32 * 8;
constexpr size_t SZ_ROPED = (size_t)SEQ * 16 * 8;
constexpr size_t SZ_HC = (size_t)CROWS * DM * 4;
constexpr size_t SZ_XN = (size_t)ROWS * DM * 2;
constexpr size_t SZ_U = (size_t)ROWS * INP * 2;
constexpr size_t SZ_QD = (size_t)NB * 8 * TT * 32 * 2;
constexpr size_t SZ_VT4 = (size_t)NB * 4 * 64 * TT * 2;
constexpr size_t SZ_QG = (size_t)NB * 4 * TT * 64 * 2;
constexpr size_t SZ_KG = (size_t)NB * 2 * TT * 64 * 2;
constexpr size_t SZ_QM = (size_t)NB * 4 * TT * 96 * 2;
constexpr size_t SZ_Y = (size_t)ROWS * DM * 2;

constexpr size_t OFF_MOD = 0;
constexpr size_t OFF_MISC = OFF_MOD + al256(SZ_MOD);
constexpr size_t OFF_WIN = OFF_MISC + SZ_MISC;
constexpr size_t OFF_WOUT = OFF_WIN + al256(SZ_WIN);
constexpr size_t OFF_W1 = OFF_WOUT + al256(SZ_WOUT);
constexpr size_t OFF_W2 = OFF_W1 + al256(SZ_W1);
constexpr size_t OFF_WUQ = OFF_W2 + al256(SZ_W2);
constexpr size_t OFF_WUKV = OFF_WUQ + al256(SZ_WUQ);
constexpr size_t OFF_ROPEH = OFF_WUKV + al256(SZ_WUKV);
constexpr size_t OFF_ROPED = OFF_ROPEH + al256(SZ_ROPEH);
constexpr size_t OFF_HC = OFF_ROPED + al256(SZ_ROPED);
constexpr size_t OFF_XN = OFF_HC + al256(SZ_HC);
constexpr size_t OFF_BIG = OFF_XN + al256(SZ_XN);
constexpr size_t OFF_U = OFF_BIG;
constexpr size_t OFF_QD = OFF_U + al256(SZ_U);
constexpr size_t OFF_KD = OFF_QD + al256(SZ_QD);
constexpr size_t OFF_VTD = OFF_KD + al256(SZ_QD);
constexpr size_t OFF_QG = OFF_VTD + al256(SZ_VT4);
constexpr size_t OFF_KG = OFF_QG + al256(SZ_QG);
constexpr size_t OFF_VTG = OFF_KG + al256(SZ_KG);
constexpr size_t OFF_QM = OFF_VTG + al256(SZ_KG);
constexpr size_t OFF_KM = OFF_QM + al256(SZ_QM);
constexpr size_t OFF_VTM = OFF_KM + al256(SZ_QM);
constexpr size_t OFF_Y = OFF_VTM + al256(SZ_VT4);
constexpr size_t SZ_SS = (size_t)64 * 37 * 16384;
constexpr size_t SZ_DEC = (size_t)64 * 36 * 4;
constexpr size_t SZ_ECL = (size_t)8 * ROWS * 4;
constexpr size_t SZ_CB = (size_t)ROWS * 128 * 2;
constexpr size_t OFF_SS = OFF_Y + al256(SZ_Y);
constexpr size_t OFF_DEC = OFF_SS + al256(SZ_SS);
constexpr size_t OFF_ECL = OFF_DEC + al256(SZ_DEC);
constexpr size_t OFF_CB = OFF_ECL + al256(SZ_ECL);
constexpr size_t OFF_END = OFF_CB + al256(SZ_CB);
static_assert(OFF_END <= (size_t)402653184, "workspace budget (4 x mod_w)");
constexpr size_t OFF_HM = OFF_BIG;
static_assert((size_t)ROWS * DFF * 2 <= OFF_Y - OFF_BIG, "HM overlay must not reach Y");
static_assert((size_t)2 * ROWS * 256 * 4 <= SZ_XN, "Yssd overlay");

struct Params {
  const float* in[27];
  float* out;
  char* ws;
};
enum { I_X = 0, I_C, I_CTX, I_CCTX, I_MODW, I_MODB, I_N1G, I_N2G, I_WIN, I_CONVW, I_CONVB, I_DTB, I_ALOG, I_SSDD, I_SSDNG,
       I_DLAM, I_DNG, I_GQN, I_GKN, I_MQN, I_MKVN, I_WUQ, I_WUKV, I_WOUT, I_W1, I_W2, I_FNG };

constexpr int SMEM_BYTES = 65536;
constexpr int LDS_BYTES = 131072, NTHREADS = 512;
#ifndef PROBE_DOWN
#define PROBE_DOWN 0
#endif
#ifndef PROBE_OUT
#define PROBE_OUT 0
#endif
#ifndef PROBE_P0
#define PROBE_P0 1
#endif
#ifndef PROBE_N1
#define PROBE_N1 1
#endif
#ifndef PROBE_FIN
#define PROBE_FIN 1
#endif
#ifndef PROBE_UP
#define PROBE_UP 1
#endif
#ifndef PROBE_PREP
#define PROBE_PREP 1
#endif
#ifndef PROBE_MIX
#define PROBE_MIX 1
#endif
#ifndef PROBE_INPROJ
#define PROBE_INPROJ 1
#endif

DI unsigned pk_bf16(float a, float b) { f32x2 v = {a, b}; bf2_t r = __builtin_convertvector(v, bf2_t); return __builtin_bit_cast(unsigned, r); }
DI bf16_t f2bf(float a) { return (bf16_t)(pk_bf16(a, 0.f) & 0xffffu); }
DI float bf2f(bf16_t v) { return __uint_as_float((unsigned)v << 16); }
DI float bflo(unsigned w) { return __uint_as_float(w << 16); }
DI float bfhi(unsigned w) { return __uint_as_float(w & 0xffff0000u); }
DI float silu_f(float x) { return x / (1.f + __expf(-x)); }
DI float wave_sum(float v) {
#pragma unroll
  for (int o = 32; o >= 1; o >>= 1) v += __shfl_xor(v, o);
  return v;
}
DI int crow(int r, int hi) { return (r & 3) + 8 * (r >> 2) + 4 * hi; }
DI bf16x8 pack8(float a0, float a1, float a2, float a3, float a4, float a5, float a6, float a7) {
  u32x4 p; p.x = pk_bf16(a0, a1); p.y = pk_bf16(a2, a3); p.z = pk_bf16(a4, a5); p.w = pk_bf16(a6, a7);
  return __builtin_bit_cast(bf16x8, p);
}
DI f32x16 zero16() { f32x16 z;
#pragma unroll
  for (int i = 0; i < 16; ++i) z[i] = 0.f;
  return z; }
DI int otid() { int t = threadIdx.x & 255; asm volatile("" : "+v"(t)); return t; }
DI int otid_full() { int t = threadIdx.x; asm volatile("" : "+v"(t)); return t; }
DI int half_id() { return __builtin_amdgcn_readfirstlane((int)threadIdx.x >> 8); }
DI int hrow_of(int b, int pos) { return pos < CT ? (MROWS + b * CT + pos) : (b * SEQ + pos - CT); }

DI void tconv_tile(const float* __restrict__ src, int K, int N, bf16_t* __restrict__ dst, int kt, int nt, unsigned* sT) {
  const int tid = otid();
#pragma unroll
  for (int p = 0; p < 2; ++p) {
    const int idx = tid + 256 * p, kp = idx >> 4, nc = idx & 15;
    const int k = kt * 64 + 2 * kp, n = nt * 64 + nc * 4;
    f32x4 v0 = {0.f, 0.f, 0.f, 0.f}, v1 = {0.f, 0.f, 0.f, 0.f};
    if (n < N) { v0 = *(const f32x4*)(src + (size_t)k * N + n); v1 = *(const f32x4*)(src + (size_t)(k + 1) * N + n); }
#pragma unroll
    for (int e = 0; e < 4; ++e) sT[(nc * 4 + e) * 33 + kp] = pk_bf16(v0[e], v1[e]);
  }
  __syncthreads();
  {
    const int n = tid >> 2, part = tid & 3;
    u32x4 a, b;
    const unsigned* s = sT + n * 33 + part * 8;
    a.x = s[0]; a.y = s[1]; a.z = s[2]; a.w = s[3]; b.x = s[4]; b.y = s[5]; b.z = s[6]; b.w = s[7];
    bf16_t* d = dst + (size_t)(nt * 64 + n) * K + kt * 64 + part * 16;
    *(u32x4*)d = a; *(u32x4*)(d + 8) = b;
  }
  __syncthreads();
}

DI void mod_task(const Params& p, int task, float* sCond) {
  const int tid = otid();
  const int ks = task & 7, cb = (task >> 3) % 24, l = task / 192;
  for (int i = tid; i < 9 * 128; i += 256) {
    const int r = i >> 7, kk = i & 127;
    const float v = (r < 8) ? p.in[I_C][r * DM + ks * 128 + kk] : p.in[I_CCTX][ks * 128 + kk];
    sCond[i] = silu_f(v);
  }
  __syncthreads();
  const int col = cb * 256 + tid;
  const float* w = p.in[I_MODW] + ((size_t)l * DM + ks * 128) * 6144 + col;
  float acc[9];
#pragma unroll
  for (int r = 0; r < 9; ++r) acc[r] = 0.f;
#pragma unroll 8
  for (int kk = 0; kk < 128; ++kk) {
    const float wv = w[(size_t)kk * 6144];
#pragma unroll
    for (int r = 0; r < 9; ++r) acc[r] += sCond[r * 128 + kk] * wv;
  }
  const float bias = (ks == 0) ? p.in[I_MODB][l * 6144 + col] : 0.f;
  float* MODP = (float*)(p.ws + OFF_Y) + (size_t)ks * (DEPTH * 9 * 6144);
#pragma unroll
  for (int r = 0; r < 9; ++r) MODP[(size_t)(l * 9 + r) * 6144 + col] = acc[r] + bias;
  __syncthreads();
}

DI void phase0(const Params& p, char* smem) {
  constexpr int T_WIN = DEPTH * 16 * 38, T_WOUT = DEPTH * 16 * 16, T_W1 = DEPTH * 16 * 64, T_W2 = DEPTH * 64 * 16;
  constexpr int T_UQ = DEPTH * 3 * 6, T_UKV = DEPTH * 2 * 8, T_MOD = 768, T_ROPE = (SEQ * 48) / 256, T_MISC = 1;
  constexpr int E0 = T_WIN, E1 = E0 + T_WOUT, E2 = E1 + T_W1, E3 = E2 + T_W2, E4 = E3 + T_UQ, E5 = E4 + T_UKV, E6 = E5 + T_MOD, E7 = E6 + T_ROPE, E8 = E7 + T_MISC;
  const int tid = otid();
  const int half = half_id(); smem += half * SMEM_BYTES;
  static_assert(E0 % 2 == 0 && E1 % 2 == 0 && E2 % 2 == 0 && E3 % 2 == 0 && E4 % 2 == 0 && E5 % 2 == 0 && E6 % 2 == 0 && E7 % 2 == 0, "half-block pairs must not straddle task types");
  for (int t0 = blockIdx.x * 2; t0 < E8; t0 += gridDim.x * 2) {
    const int t = t0 + half;
    if (t >= E8) break;
    if (t < E0) { const int l = t / (16 * 38), r = t % (16 * 38); tconv_tile(p.in[I_WIN] + (size_t)l * DM * INC, DM, INC, (bf16_t*)(p.ws + OFF_WIN) + (size_t)l * INPW * DM, r / 38, r % 38, (unsigned*)smem); }
    else if (t < E1) { const int u = t - E0, l = u / 256, r = u % 256; tconv_tile(p.in[I_WOUT] + (size_t)l * DM * DM, DM, DM, (bf16_t*)(p.ws + OFF_WOUT) + (size_t)l * DM * DM, r / 16, r % 16, (unsigned*)smem); }
    else if (t < E2) { const int u = t - E1, l = u / 1024, r = u % 1024; tconv_tile(p.in[I_W1] + (size_t)l * DM * DFF, DM, DFF, (bf16_t*)(p.ws + OFF_W1) + (size_t)l * DFF * DM, r / 64, r % 64, (unsigned*)smem); }
    else if (t < E3) { const int u = t - E2, l = u / 1024, r = u % 1024; tconv_tile(p.in[I_W2] + (size_t)l * DFF * DM, DFF, DM, (bf16_t*)(p.ws + OFF_W2) + (size_t)l * DM * DFF, r / 16, r % 16, (unsigned*)smem); }
    else if (t < E4) { const int u = t - E3, l = u / 18, r = u % 18; tconv_tile(p.in[I_WUQ] + (size_t)l * 192 * 384, 192, 384, (bf16_t*)(p.ws + OFF_WUQ) + (size_t)l * 384 * 192, r / 6, r % 6, (unsigned*)smem); }
    else if (t < E5) { const int u = t - E4, l = u / 16, r = u % 16; tconv_tile(p.in[I_WUKV] + (size_t)l * 128 * 512, 128, 512, (bf16_t*)(p.ws + OFF_WUKV) + (size_t)l * 512 * 128, r / 8, r % 8, (unsigned*)smem); }
    else if (t < E6) { mod_task(p, t - E5, (float*)smem); }
    else if (t < E7) {
      const int idx = (t - E6) * 256 + tid;
      int tt, i, nf; f32x2* dst;
      if (idx < SEQ * 32) { tt = idx >> 5; i = idx & 31; nf = 16; dst = (f32x2*)(p.ws + OFF_ROPEH) + idx; }
      else { const int j = idx - SEQ * 32; tt = j >> 4; i = j & 15; nf = 8; dst = (f32x2*)(p.ws + OFF_ROPED) + j; }
      const int f = i & (nf - 1);
      const float pos = (float)((i < nf) ? (tt >> 6) : (tt & 63));
      const float inv = exp2f(-(float)f * (13.287712379549449f / (float)nf));
      float rv = pos * inv * 0.15915494309189535f; rv -= rintf(rv);
      f32x2 cs; cs.x = __builtin_amdgcn_cosf(rv); cs.y = __builtin_amdgcn_sinf(rv);
      *dst = cs;
    } else {
      if (tid < DEPTH) {
        const float* lp = p.in[I_DLAM] + tid * 128;
        float s1 = 0.f, s2 = 0.f;
        for (int i = 0; i < 32; ++i) { s1 += lp[i] * lp[32 + i]; s2 += lp[64 + i] * lp[96 + i]; }
        const float li = 0.8f - 0.6f * expf(-0.3f * (float)tid);
        float* misc = (float*)(p.ws + OFF_MISC);
        misc[128 + tid] = expf(s1) - expf(s2) + li;
        misc[136 + tid] = li;
      }
    }
  }
}

DI void mod_reduce(const Params& p) {
  const float* MODP = (const float*)(p.ws + OFF_Y);
  float* MOD = (float*)(p.ws + OFF_MOD);
  constexpr int NTOT = DEPTH * 9 * 6144;
  for (int i = blockIdx.x * NTHREADS + otid_full(); i < NTOT; i += gridDim.x * NTHREADS) {
    float a = 0.f;
#pragma unroll
    for (int ks = 0; ks < 8; ++ks) a += MODP[(size_t)ks * NTOT + i];
    MOD[i] = a;
  }
}

DI void norm_phase(const Params& p, int layer, int which, int nrows, const float* pend_gate = nullptr, const float* pend_hin = nullptr) {
  constexpr int NR = 3;
  const int tid_ = otid_full(); const int lane = tid_ & 63, wave = tid_ >> 6;
  const int gw = blockIdx.x * 8 + wave, nw = gridDim.x * 8;
  const float* MOD = (const float*)(p.ws + OFF_MOD);
  bf16_t* XN = (bf16_t*)(p.ws + OFF_XN);
  const float* g = (which == 0 ? p.in[I_N1G] : which == 1 ? p.in[I_N2G] : p.in[I_FNG]) + (which == 2 ? 0 : layer * DM);
  f32x4 gv[4];
#pragma unroll
  for (int i = 0; i < 4; ++i) gv[i] = *(const f32x4*)(g + i * 256 + lane * 4);
  for (int row0 = gw; row0 < nrows; row0 += nw * NR) {
    f32x4 v[NR][4];
    float ss[NR];
#pragma unroll
    for (int j = 0; j < NR; ++j) {
      const int row = row0 + j * nw;
      ss[j] = 0.f;
      if (row < nrows) {
        if (pend_gate != nullptr && row >= MROWS) {
          const size_t ro = (size_t)(row - MROWS) * DM;
          const float* P = (const float*)(p.ws + OFF_SS) + ro;
#pragma unroll
          for (int i = 0; i < 4; ++i) {
            const int c = i * 256 + lane * 4;
            const f32x4 a = *(const f32x4*)(P + c), b2 = *(const f32x4*)(P + (size_t)CROWS * DM + c), c2 = *(const f32x4*)(P + (size_t)2 * CROWS * DM + c), d2 = *(const f32x4*)(P + (size_t)3 * CROWS * DM + c);
            v[j][i] = *(const f32x4*)(pend_hin + ro + c) + *(const f32x4*)(pend_gate + c) * (((a + b2) + c2) + d2);
          }
        } else {
          const float* h;
          if (row < MROWS) h = ((which == 0 && layer == 0) ? p.in[I_X] : p.out) + (size_t)row * DM;
          else h = ((which == 0 && layer == 0) ? p.in[I_CTX] : (const float*)(p.ws + OFF_HC)) + (size_t)(row - MROWS) * DM;
#pragma unroll
          for (int i = 0; i < 4; ++i) v[j][i] = *(const f32x4*)(h + i * 256 + lane * 4);
        }
      } else {
#pragma unroll
        for (int i = 0; i < 4; ++i) v[j][i] = (f32x4){0.f, 0.f, 0.f, 0.f};
      }
    }
#pragma unroll
    for (int j = 0; j < NR; ++j) {
      const int row = row0 + j * nw;
      if (row >= nrows) continue;
      if (pend_gate != nullptr && row >= MROWS) {
        float* hc = (float*)(p.ws + OFF_HC) + (size_t)(row - MROWS) * DM;
#pragma unroll
        for (int i = 0; i < 4; ++i) *(f32x4*)(hc + i * 256 + lane * 4) = v[j][i];
      }
#pragma unroll
      for (int i = 0; i < 4; ++i) ss[j] += v[j][i][0] * v[j][i][0] + v[j][i][1] * v[j][i][1] + v[j][i][2] * v[j][i][2] + v[j][i][3] * v[j][i][3];
      const float rstd = rsqrtf(wave_sum(ss[j]) * (1.f / DM) + EPS);
      if (which == 2) {
#pragma unroll
        for (int i = 0; i < 4; ++i) { f32x4 o = v[j][i] * rstd * gv[i]; *(f32x4*)(p.out + (size_t)row * DM + i * 256 + lane * 4) = o; }
      } else {
        const int bidx = row < MROWS ? (row >> 11) : 8;
        const float* sh = MOD + (size_t)(layer * 9 + bidx) * 6144 + which * 3072;
        const float* sc = sh + 1024;
#pragma unroll
        for (int i = 0; i < 4; ++i) {
          const int c = i * 256 + lane * 4;
          const f32x4 shv = *(const f32x4*)(sh + c), scv = *(const f32x4*)(sc + c);
          f32x4 o = v[j][i] * rstd * gv[i] * (1.f + scv) + shv;
          u32x2 w; w.x = pk_bf16(o[0], o[1]); w.y = pk_bf16(o[2], o[3]);
          *(u32x2*)(XN + (size_t)row * DM + c) = w;
        }
      }
    }
  }
}

namespace pg8 {
#define PG8_LAS __attribute__((address_space(3)))
typedef unsigned short bf16_t;
typedef short bf16x8 __attribute__((ext_vector_type(8)));
typedef float f32x4 __attribute__((ext_vector_type(4)));
typedef unsigned u32x4 __attribute__((ext_vector_type(4)));
constexpr int BM = 256, BK = 64, HALF = 128, HTB = HALF * BK * 2  , STAGE_BYTES = 8 * HTB, NXCD = 8, WGM = 8;

__host__ __device__ __forceinline__ int lds_byte(int r, int c) { const int st = (r >> 4) * 2 + (c >> 5), rr = r & 15, cc = c & 31, ob = rr * 64 + cc * 2; return st * 1024 + (ob ^ (((ob >> 9) & 1) << 5)); }
__host__ __device__ __forceinline__ void stage_rc(int b, int& R, int& C) { const int st = b / 1024, sb = b % 1024, swz = sb ^ (((sb >> 9) & 1) << 5); R = (st >> 1) * 16 + swz / 64; C = (st & 1) * 32 + (swz % 64) / 2; }
__host__ __device__ __forceinline__ int perm32(int rho) { const int n = rho >> 4, i = rho & 15; return 8 * (i >> 2) + 4 * n + (i & 3); }

struct Unit { int pm, pn; };
struct Gemm { const bf16_t* A; const bf16_t* Bt; int M, N, K, Kloop; };

struct StaticOrder {
    int nM, nN, nwg, G, c;
    __host__ __device__ void init(int M, int N, int G_, int c_) { nM = M / BM; nN = N / BM; nwg = nM * nN; G = G_; c = c_; }
    __host__ __device__ bool next(int i, Unit& u) const {
        const long L = (long)i * G + c; if (L >= nwg) return false;
        int wgid = (int)L; { const int q = nwg / NXCD, r = nwg % NXCD, xcd = wgid % NXCD, off = wgid / NXCD; wgid = (xcd < r ? xcd * (q + 1) : r * (q + 1) + (xcd - r) * q) + off; }
        const int nig = WGM * nN, gid = wgid / nig, fm = gid * WGM, gsz = (nM - fm) < WGM ? (nM - fm) : WGM;
        u.pm = fm + ((wgid % nig) % gsz); u.pn = (wgid % nig) / gsz; return true;
    }
    __device__ __forceinline__ void a_ready(const Unit&) const {}
    __device__ __forceinline__ void done(const Unit&) const {}
};


struct SplitOrder {
    int c;
    __host__ __device__ bool next(int i, Unit& u) const { if (i != 0 || c >= 128) return false; const int q = c & 31; u.pm = q & 7; u.pn = q >> 3; return true; }
    __device__ __forceinline__ void a_ready(const Unit&) const {}
    __device__ __forceinline__ void done(const Unit&) const {}
};
struct EpiPartial {
    static constexpr bool PERM = false, AFTER_DRAIN = false;
    float* P;
    __device__ __forceinline__ void operator()(const f32x4 (&acc)[2][2][4][2], const Unit& u, int wr, int wc, int fr, int fq) const {
        float* base = P + (size_t)u.pm * BM * 1024;
        const int col0 = u.pn * BM + wc * 32 + 4 * fq;
#pragma unroll
        for (int bj = 0; bj < 2; ++bj)
#pragma unroll
            for (int n = 0; n < 2; ++n)
#pragma unroll
                for (int ai = 0; ai < 2; ++ai)
#pragma unroll
                    for (int m = 0; m < 4; ++m) *(f32x4*)(base + (size_t)(ai * HALF + wr * 64 + m * 16 + fr) * 1024 + col0 + bj * HALF + n * 16) = acc[ai][bj][m][n];
    }
};
template <int ACT> struct EpiStore {
    static constexpr bool PERM = true, AFTER_DRAIN = false;
    bf16_t* O; int ldc; int ncols;
    __device__ __forceinline__ void operator()(const f32x4 (&acc)[2][2][4][2], const Unit& u, int wr, int wc, int fr, int fq) const {
        const int row0 = u.pm * BM + wr * 64 + fr, col0 = u.pn * BM + wc * 32 + 8 * fq;
#pragma unroll
        for (int ai = 0; ai < 2; ++ai)
#pragma unroll
            for (int m = 0; m < 4; ++m) { bf16_t* rowp = O + (size_t)(row0 + ai * HALF + m * 16) * ldc + col0;
#pragma unroll
                for (int bj = 0; bj < 2; ++bj) { if (col0 + bj * HALF < ncols) { f32x4 v0 = acc[ai][bj][m][0], v1 = acc[ai][bj][m][1];
                    if (ACT == 1) { v0 = __builtin_elementwise_max(v0, (f32x4){0.f, 0.f, 0.f, 0.f}); v1 = __builtin_elementwise_max(v1, (f32x4){0.f, 0.f, 0.f, 0.f}); v0 = v0 * v0; v1 = v1 * v1; }
                    u32x4 w; w.x = ::pk_bf16(v0[0], v0[1]); w.y = ::pk_bf16(v0[2], v0[3]); w.z = ::pk_bf16(v1[0], v1[1]); w.w = ::pk_bf16(v1[2], v1[3]);
                    *(u32x4*)(rowp + bj * HALF) = w; } } }
    }
};
struct EpiResid {
    static constexpr bool PERM = false, AFTER_DRAIN = false;
    const float* hin_m; const float* hin_c; float* hout_m; float* hout_c; const float* gate; float gscale;
    __device__ __forceinline__ void operator()(const f32x4 (&acc)[2][2][4][2], const Unit& u, int wr, int wc, int fr, int fq) const {
        const bool ismain = u.pm < 64;
        const float* hin = ismain ? hin_m + (size_t)u.pm * BM * 1024 : hin_c + (size_t)(u.pm - 64) * BM * 1024;
        float* hout = ismain ? hout_m + (size_t)u.pm * BM * 1024 : hout_c + (size_t)(u.pm - 64) * BM * 1024;
        const float* g = gate + (size_t)(ismain ? (u.pm >> 3) : 8) * 6144;
        const int col0 = u.pn * BM + wc * 32 + 4 * fq;
#pragma unroll
        for (int bj = 0; bj < 2; ++bj)
#pragma unroll
            for (int n = 0; n < 2; ++n) { const f32x4 gv = *(const f32x4*)(g + col0 + bj * HALF + n * 16) * gscale;
#pragma unroll
                for (int ai = 0; ai < 2; ++ai)
#pragma unroll
                    for (int m = 0; m < 4; ++m) { const size_t off = (size_t)(ai * HALF + wr * 64 + m * 16 + fr) * 1024 + col0 + bj * HALF + n * 16;
                        *(f32x4*)(hout + off) = *(const f32x4*)(hin + off) + gv * acc[ai][bj][m][n]; } }
    }
};
template <class Epi, class Sched, bool ALIGN_EPI = false, bool SP2 = false>
__device__ __forceinline__ void gemm_phase(PG8_LAS unsigned char* lds, const Gemm g, const Sched& S, const Epi& E) {
    const int tid = ::otid_full(), wid = __builtin_amdgcn_readfirstlane(tid >> 6), lane = tid & 63, wr = wid >> 2, wc = wid & 3, fr = lane & 15, fq = lane >> 4;
    const int K = g.K, nt = g.Kloop / BK;
    unsigned voffA[2], voffB[2];
#pragma unroll
    for (int i = 0; i < 2; ++i) { int R, C; stage_rc(tid * 16 + i * 8192, R, C); const int Rb = Epi::PERM ? ((R & ~31) + perm32(R & 31)) : R;
        voffA[i] = (unsigned)(R * K + C) * 2u; voffB[i] = (unsigned)(Rb * K + C) * 2u; }
    const size_t kstep = (size_t)(BK * 2);
    const size_t hstep = (size_t)HALF * K * 2;
    const size_t tstep = 2 * hstep;
    const unsigned ldsw = (unsigned)wid * 1024u;
    const int aoff = lds_byte(wr * 64 + fr, fq * 8), boff = lds_byte(wc * 32 + fr, fq * 8);
#define PG8_SA(b, h) (((b) * 2 + (h)) * HTB)
#define PG8_SB(b, h) ((4 + (b) * 2 + (h)) * HTB)
#define PG8_STAGE(bufoff, gbase, voff) do { _Pragma("unroll") for (int _i = 0; _i < 2; ++_i) \
        __builtin_amdgcn_global_load_lds((const unsigned*)((const char*)(gbase) + (voff)[_i]), (PG8_LAS unsigned*)(lds + (bufoff) + ldsw + _i * 8192), 16, 0, 0); } while (0)
#define PG8_LDA(dst, b, h) do { _Pragma("unroll") for (int m = 0; m < 4; ++m) _Pragma("unroll") for (int k = 0; k < 2; ++k) dst[m][k] = *(const PG8_LAS bf16x8*)(lds + PG8_SA(b, h) + aoff + m * 2048 + k * 1024); } while (0)
#define PG8_LDB(dst, b, h) do { _Pragma("unroll") for (int n = 0; n < 2; ++n) _Pragma("unroll") for (int k = 0; k < 2; ++k) dst[n][k] = *(const PG8_LAS bf16x8*)(lds + PG8_SB(b, h) + boff + n * 2048 + k * 1024); } while (0)
#define PG8_MMA(ai, bj, At, Bt) do { __builtin_amdgcn_s_setprio(1); _Pragma("unroll") for (int m = 0; m < 4; ++m) _Pragma("unroll") for (int n = 0; n < 2; ++n) _Pragma("unroll") for (int k = 0; k < 2; ++k) \
        acc[ai][bj][m][n] = __builtin_amdgcn_mfma_f32_16x16x32_bf16(Bt[n][k], At[m][k], acc[ai][bj][m][n], 0, 0, 0); __builtin_amdgcn_s_setprio(0); } while (0)
#define PG8_WAIT_V(n) asm volatile("s_waitcnt vmcnt(" #n ")" ::: "memory")
#define PG8_WAIT_L(n) asm volatile("s_waitcnt lgkmcnt(" #n ")" ::: "memory")
#define PG8_BAR __builtin_amdgcn_s_barrier()
#define PG8_SCHED __builtin_amdgcn_sched_barrier(0)
    Unit cur, nxt; int ui = 0;
    if (!S.next(0, cur)) return;
    f32x4 acc[2][2][4][2];
#pragma unroll
    for (int a = 0; a < 2; ++a)
#pragma unroll
        for (int b = 0; b < 2; ++b)
#pragma unroll
            for (int m = 0; m < 4; ++m)
#pragma unroll
                for (int n = 0; n < 2; ++n) acc[a][b][m][n] = (f32x4){0.f, 0.f, 0.f, 0.f};
    bf16x8 At[4][2], B0[2][2], B1[2][2];
    const char* cA = (const char*)g.A + (size_t)cur.pm * tstep; const char* cB = (const char*)g.Bt + (size_t)cur.pn * tstep;
    S.a_ready(cur);
    if constexpr (SP2) {
        PG8_STAGE(PG8_SB(0, 0), cB, voffB); PG8_STAGE(PG8_SB(0, 1), cB + hstep, voffB); PG8_STAGE(PG8_SA(0, 0), cA, voffA); PG8_STAGE(PG8_SA(0, 1), cA + hstep, voffA);
        if (wr == 1) PG8_BAR;
        PG8_WAIT_V(2); PG8_BAR;
        PG8_STAGE(PG8_SB(1, 0), cB + kstep, voffB); PG8_STAGE(PG8_SA(1, 0), cA + kstep, voffA); PG8_STAGE(PG8_SB(1, 1), cB + hstep + kstep, voffB);
        PG8_WAIT_V(6); PG8_BAR;
    } else {
        PG8_STAGE(PG8_SB(0, 0), cB, voffB); PG8_STAGE(PG8_SA(0, 0), cA, voffA); PG8_STAGE(PG8_SB(0, 1), cB + hstep, voffB); PG8_STAGE(PG8_SA(0, 1), cA + hstep, voffA);
        if (wr == 1) PG8_BAR;
        PG8_WAIT_V(4); PG8_BAR;
        PG8_STAGE(PG8_SB(1, 0), cB + kstep, voffB); PG8_STAGE(PG8_SA(1, 0), cA + kstep, voffA); PG8_STAGE(PG8_SB(1, 1), cB + hstep + kstep, voffB);
        PG8_WAIT_V(6); PG8_BAR;
    }
    for (;;) {
        const bool has_next = S.next(ui + 1, nxt);
        const char* nA = has_next ? (const char*)g.A + (size_t)nxt.pm * tstep : cA; const char* nB = has_next ? (const char*)g.Bt + (size_t)nxt.pn * tstep : cB;
        for (int t = 0; t < nt; t += 2) {
            const bool last = (t == nt - 2);
            const char* a1 = cA + (size_t)(t + 1) * kstep;
            const char* a2 = last ? nA : cA + (size_t)(t + 2) * kstep; const char* b2 = last ? nB : cB + (size_t)(t + 2) * kstep;
            const char* a3 = a2 + kstep; const char* b3 = b2 + kstep;
            if (last && has_next) S.a_ready(nxt);
            if constexpr (SP2) {
            PG8_LDB(B0, 0, 0); PG8_LDB(B1, 0, 1); PG8_SCHED; PG8_LDA(At, 0, 0); PG8_STAGE(PG8_SA(1, 1), a1 + hstep, voffA);
            PG8_WAIT_V(8); PG8_WAIT_L(0); PG8_BAR; PG8_MMA(0, 0, At, B0); PG8_MMA(0, 1, At, B1); PG8_BAR; PG8_SCHED;
            PG8_LDA(At, 0, 1); PG8_STAGE(PG8_SB(0, 0), b2, voffB); PG8_STAGE(PG8_SB(0, 1), b2 + hstep, voffB); PG8_STAGE(PG8_SA(0, 0), a2, voffA);
            PG8_WAIT_V(8); PG8_WAIT_L(0); PG8_BAR; PG8_MMA(1, 0, At, B0); PG8_MMA(1, 1, At, B1); PG8_BAR; PG8_SCHED;
            PG8_LDB(B0, 1, 0); PG8_LDB(B1, 1, 1); PG8_SCHED; PG8_LDA(At, 1, 0); PG8_STAGE(PG8_SA(0, 1), a2 + hstep, voffA);
            PG8_WAIT_V(8); PG8_WAIT_L(0); PG8_BAR; PG8_MMA(0, 0, At, B0); PG8_MMA(0, 1, At, B1); PG8_BAR; PG8_SCHED;
            PG8_LDA(At, 1, 1); PG8_STAGE(PG8_SB(1, 0), b3, voffB); PG8_STAGE(PG8_SB(1, 1), b3 + hstep, voffB); PG8_STAGE(PG8_SA(1, 0), a3, voffA);
            PG8_WAIT_V(8); PG8_WAIT_L(0); PG8_BAR; PG8_MMA(1, 0, At, B0); PG8_MMA(1, 1, At, B1); PG8_BAR; PG8_SCHED;
            } else {
            PG8_LDB(B0, 0, 0); PG8_SCHED; PG8_LDA(At, 0, 0); PG8_STAGE(PG8_SA(1, 1), a1 + hstep, voffA);
            PG8_WAIT_L(8); PG8_BAR; PG8_WAIT_L(0); PG8_MMA(0, 0, At, B0); PG8_BAR; PG8_SCHED;
            PG8_LDB(B1, 0, 1); PG8_STAGE(PG8_SB(0, 0), b2, voffB);
            PG8_BAR; PG8_WAIT_L(0); PG8_MMA(0, 1, At, B1); PG8_BAR;
            PG8_LDA(At, 0, 1); PG8_STAGE(PG8_SA(0, 0), a2, voffA);
            PG8_BAR; PG8_WAIT_L(0); PG8_MMA(1, 0, At, B0); PG8_BAR; PG8_SCHED;
            PG8_STAGE(PG8_SB(0, 1), b2 + hstep, voffB);
            PG8_WAIT_V(6); PG8_BAR; PG8_MMA(1, 1, At, B1); PG8_BAR;
            PG8_LDB(B0, 1, 0); PG8_SCHED; PG8_LDA(At, 1, 0); PG8_STAGE(PG8_SA(0, 1), a2 + hstep, voffA);
            PG8_WAIT_L(8); PG8_BAR; PG8_WAIT_L(0); PG8_MMA(0, 0, At, B0); PG8_BAR; PG8_SCHED;
            PG8_LDB(B1, 1, 1); PG8_STAGE(PG8_SB(1, 0), b3, voffB);
            PG8_BAR; PG8_WAIT_L(0); PG8_MMA(0, 1, At, B1); PG8_BAR;
            PG8_LDA(At, 1, 1); PG8_STAGE(PG8_SA(1, 0), a3, voffA);
            PG8_BAR; PG8_WAIT_L(0); PG8_MMA(1, 0, At, B0); PG8_BAR; PG8_SCHED;
            PG8_STAGE(PG8_SB(1, 1), b3 + hstep, voffB);
            PG8_WAIT_V(6); PG8_BAR; PG8_MMA(1, 1, At, B1); PG8_BAR;
            }
        }
        if constexpr (ALIGN_EPI) { if (wr == 0) PG8_BAR; }
        if constexpr (!Epi::AFTER_DRAIN) { E(acc, cur, wr, wc, fr, fq); S.done(cur); }
        if (!has_next) break;
#pragma unroll
        for (int a = 0; a < 2; ++a)
#pragma unroll
            for (int b = 0; b < 2; ++b)
#pragma unroll
                for (int m = 0; m < 4; ++m)
#pragma unroll
                    for (int n = 0; n < 2; ++n) acc[a][b][m][n] = (f32x4){0.f, 0.f, 0.f, 0.f};
        cur = nxt; cA = nA; cB = nB; ++ui;
        if constexpr (ALIGN_EPI) { if (wr == 1) PG8_BAR; }
    }
    PG8_WAIT_V(0);
    if constexpr (!ALIGN_EPI) { if (wr == 0) PG8_BAR; }
    PG8_BAR;
    if constexpr (Epi::AFTER_DRAIN) { E.fused(acc, cur, wr, wc, fr, fq, lds, wid, lane); S.done(cur); }
#undef PG8_SA
#undef PG8_SB
#undef PG8_STAGE
#undef PG8_LDA
#undef PG8_LDB
#undef PG8_MMA
#undef PG8_WAIT_V
#undef PG8_WAIT_L
#undef PG8_BAR
#undef PG8_SCHED
}
}

DI void prep_tile(const Params& p, int layer, int tile, int part, char* smem) {
  const int tid = otid(), lane = tid & 63, wave = tid >> 6, l31 = lane & 31, hi = lane >> 5;
  const int b = tile / 36, tb = tile % 36, p0 = tb * 64;
  const bool isctx = tb < 4;
  const int row0 = isctx ? (MROWS + b * CT + p0) : (b * SEQ + p0 - CT);
  const bf16_t* U = (const bf16_t*)(p.ws + OFF_U);
  const f32x2* ropeH = (const f32x2*)(p.ws + OFF_ROPEH);
  const f32x2* ropeD = (const f32x2*)(p.ws + OFF_ROPED);
  bf16_t* QD = (bf16_t*)(p.ws + OFF_QD); bf16_t* KD = (bf16_t*)(p.ws + OFF_KD); bf16_t* VTD = (bf16_t*)(p.ws + OFF_VTD);
  bf16_t* QG = (bf16_t*)(p.ws + OFF_QG); bf16_t* KG = (bf16_t*)(p.ws + OFF_KG); bf16_t* VTG = (bf16_t*)(p.ws + OFF_VTG);
  bf16_t* QM = (bf16_t*)(p.ws + OFF_QM); bf16_t* KM = (bf16_t*)(p.ws + OFF_KM); bf16_t* VTM = (bf16_t*)(p.ws + OFF_VTM);
  const float qsD = 0.17677669529663687f * LOG2E, qsG = 0.125f * LOG2E, qsM = 0.10206207261596575f * LOG2E;
  bf16_t* sT = (bf16_t*)smem; bf16_t* sCq = (bf16_t*)(smem + 9216); bf16_t* sCkv = (bf16_t*)(smem + 9216 + 25600);

  if (part == 0) {
  for (int tk = wave; tk < 64; tk += 4) {
    const bf16_t* urow = U + (size_t)(row0 + tk) * INP;
    const int pos = p0 + tk, t = pos - CT;
    float xv[15];
#pragma unroll
    for (int g = 0; g < 15; ++g) {
      const int col = g < 4 ? U_DQ + g * 64 + lane : g < 8 ? U_DK + (g - 4) * 64 + lane : g < 12 ? U_GQ + (g - 8) * 64 + lane : g < 14 ? U_GK + (g - 12) * 64 + lane : U_MR + l31;
      xv[g] = bf2f(urow[col]);
    }
    f32x2 csD = {1.f, 0.f}, csH = {1.f, 0.f};
    if (!isctx) { csD = ropeD[t * 16 + (lane & 15)]; csH = ropeH[t * 32 + l31]; }
#pragma unroll
    for (int g = 0; g < 15; ++g) {
      float x = xv[g];
      if (g < 8) {
        const int h = g & 3; const bool isq = g < 4;
        const int d = lane & 31, m = lane >> 5;
        if (!isctx) { const float pr = __shfl_xor(x, 16); x = (d < 16) ? (x * csD.x - pr * csD.y) : (pr * csD.y + x * csD.x); }
        if (isq) x *= qsD;
        (isq ? QD : KD)[(((size_t)b * 8 + h * 2 + m) * TT + pos) * 32 + d] = f2bf(x);
      } else if (g < 14) {
        const bool isq = g < 12; const int h = isq ? g - 8 : g - 12;
        const float ss = wave_sum(x * x);
        x = x * rsqrtf(ss * (1.f / 64.f) + EPS) * (isq ? p.in[I_GQN] : p.in[I_GKN])[layer * 64 + lane];
        if (!isctx) { const float pr = __shfl_xor(x, 32); x = (lane < 32) ? (x * csH.x - pr * csH.y) : (pr * csH.y + x * csH.x); }
        if (isq) { x *= qsG; QG[(((size_t)b * 4 + h) * TT + pos) * 64 + lane] = f2bf(x); }
        else KG[(((size_t)b * 2 + h) * TT + pos) * 64 + lane] = f2bf(x);
      } else {
        const int d = l31;
        if (!isctx) { const float pr = __shfl_xor(x, 16); x = (d < 16) ? (x * csD.x - pr * csD.y) : (pr * csD.y + x * csD.x); }
        const bf16_t v = f2bf(x);
        const int hh = hi * 2;
        KM[(((size_t)b * 4 + hh) * TT + pos) * 96 + 64 + d] = v;
        KM[(((size_t)b * 4 + hh + 1) * TT + pos) * 96 + 64 + d] = v;
      }
    }
  }
  for (int g = 0; g < 6; ++g) {
    const int colbase = g < 4 ? U_DV + g * 64 : U_GV + (g - 4) * 64;
    bf16_t* dst = g < 4 ? VTD + ((size_t)(b * 4 + g) * 64) * TT : VTG + ((size_t)(b * 2 + g - 4) * 64) * TT;
#pragma unroll
    for (int i = 0; i < 2; ++i) {
      const int c = tid + 256 * i, tk0 = c >> 3, kc = c & 7;
      const u32x4 v = *(const u32x4*)(U + (size_t)(row0 + tk0) * INP + colbase + kc * 8);
      const int tk = (tk0 & ~12) | ((tk0 & 4) << 1) | ((tk0 & 8) >> 1);
      sT[(kc * 8 + 0) * 72 + tk] = (bf16_t)(v.x & 0xffff); sT[(kc * 8 + 1) * 72 + tk] = (bf16_t)(v.x >> 16);
      sT[(kc * 8 + 2) * 72 + tk] = (bf16_t)(v.y & 0xffff); sT[(kc * 8 + 3) * 72 + tk] = (bf16_t)(v.y >> 16);
      sT[(kc * 8 + 4) * 72 + tk] = (bf16_t)(v.z & 0xffff); sT[(kc * 8 + 5) * 72 + tk] = (bf16_t)(v.z >> 16);
      sT[(kc * 8 + 6) * 72 + tk] = (bf16_t)(v.w & 0xffff); sT[(kc * 8 + 7) * 72 + tk] = (bf16_t)(v.w >> 16);
    }
    __syncthreads();
    {
      const int dv = tid >> 2, part = tid & 3;
      const u32x4 a = *(const u32x4*)(sT + dv * 72 + part * 16), bq = *(const u32x4*)(sT + dv * 72 + part * 16 + 8);
      bf16_t* d = dst + (size_t)dv * TT + p0 + part * 16;
      *(u32x4*)d = a; *(u32x4*)(d + 8) = bq;
    }
    __syncthreads();
  }
  return;
  }
#pragma unroll 4
  for (int tk = wave; tk < 64; tk += 4) {
    const bf16_t* urow = U + (size_t)(row0 + tk) * INP;
    const float q0 = bf2f(urow[U_MQ + lane]), q1 = bf2f(urow[U_MQ + 64 + lane]), q2 = bf2f(urow[U_MQ + 128 + lane]);
    const float k0 = bf2f(urow[U_MKV + lane]), k1 = bf2f(urow[U_MKV + 64 + lane]);
    const float sq = wave_sum(q0 * q0 + q1 * q1 + q2 * q2), sk = wave_sum(k0 * k0 + k1 * k1);
    const float rq = rsqrtf(sq * (1.f / 192.f) + EPS), rk = rsqrtf(sk * (1.f / 128.f) + EPS);
    const float* gq = p.in[I_MQN] + layer * 192; const float* gk = p.in[I_MKVN] + layer * 128;
    sCq[tk * 200 + lane] = f2bf(q0 * rq * gq[lane]); sCq[tk * 200 + 64 + lane] = f2bf(q1 * rq * gq[64 + lane]); sCq[tk * 200 + 128 + lane] = f2bf(q2 * rq * gq[128 + lane]);
    sCkv[tk * 136 + lane] = f2bf(k0 * rk * gk[lane]); sCkv[tk * 136 + 64 + lane] = f2bf(k1 * rk * gk[64 + lane]);
  }
  __syncthreads();
  const bf16_t* Wkv = (const bf16_t*)(p.ws + OFF_WUKV) + (size_t)layer * 512 * 128;
  const bf16_t* Wq = (const bf16_t*)(p.ws + OFF_WUQ) + (size_t)layer * 384 * 192;
  for (int task = wave; task < 56; task += 4) {
    if (task < 32) {
      const int ct = task >> 1, tt = task & 1, head = ct >> 2, sub = ct & 3, n0 = head * 128 + sub * 32;
      f32x16 acc = zero16();
      const bf16_t* wrow = Wkv + (size_t)(n0 + l31) * 128 + hi * 8;
      const bf16_t* trow = sCkv + (tt * 32 + l31) * 136 + hi * 8;
      if (sub < 2) {
#pragma unroll
        for (int ks = 0; ks < 8; ++ks) acc = MFMA32(*(const bf16x8*)(wrow + ks * 16), *(const bf16x8*)(trow + ks * 16), acc);
        bf16_t* d = KM + (((size_t)b * 4 + head) * TT + p0 + tt * 32 + l31) * 96 + sub * 32 + 4 * hi;
#pragma unroll
        for (int r4 = 0; r4 < 4; ++r4) { u32x2 w; w.x = pk_bf16(acc[4 * r4], acc[4 * r4 + 1]); w.y = pk_bf16(acc[4 * r4 + 2], acc[4 * r4 + 3]); *(u32x2*)(d + 8 * r4) = w; }
      } else {
#pragma unroll
        for (int ks = 0; ks < 8; ++ks) acc = MFMA32(*(const bf16x8*)(trow + ks * 16), *(const bf16x8*)(wrow + ks * 16), acc);
        bf16_t* d = VTM + (((size_t)b * 4 + head) * 64 + (sub - 2) * 32 + l31) * TT + p0 + tt * 32;
#pragma unroll
        for (int r4 = 0; r4 < 4; ++r4) { u32x2 w; w.x = pk_bf16(acc[4 * r4], acc[4 * r4 + 1]); w.y = pk_bf16(acc[4 * r4 + 2], acc[4 * r4 + 3]);
          *(u32x2*)(d + 16 * (r4 >> 1) + 4 * (2 * hi + (r4 & 1))) = w; }
      }
    } else {
      const int t2 = task - 32, ct = t2 >> 1, tt = t2 & 1, head = ct / 3, sub = ct % 3, n0 = head * 96 + sub * 32;
      f32x16 acc = zero16();
      const bf16_t* wrow = Wq + (size_t)(n0 + l31) * 192 + hi * 8;
      const bf16_t* trow = sCq + (tt * 32 + l31) * 200 + hi * 8;
#pragma unroll
      for (int ks = 0; ks < 12; ++ks) acc = MFMA32(*(const bf16x8*)(wrow + ks * 16), *(const bf16x8*)(trow + ks * 16), acc);
      const int pos = p0 + tt * 32 + l31;
      if (sub == 2 && !isctx) {
        const int t = pos - CT;
#pragma unroll
        for (int r = 0; r < 8; ++r) {
          const f32x2 cs = ropeD[t * 16 + crow(r, hi)];
          const float x1 = acc[r], x2 = acc[r + 8];
          acc[r] = x1 * cs.x - x2 * cs.y; acc[r + 8] = x1 * cs.y + x2 * cs.x;
        }
      }
      bf16_t* d = QM + (((size_t)b * 4 + head) * TT + pos) * 96 + sub * 32 + 4 * hi;
#pragma unroll
      for (int r4 = 0; r4 < 4; ++r4) { u32x2 w; w.x = pk_bf16(acc[4 * r4] * qsM, acc[4 * r4 + 1] * qsM); w.y = pk_bf16(acc[4 * r4 + 2] * qsM, acc[4 * r4 + 3] * qsM); *(u32x2*)(d + 8 * r4) = w; }
    }
  }
  __syncthreads();
}

template <int DQK>
DI void attn_core(const bf16_t* __restrict__ Qb, const bf16_t* __restrict__ Kb, const bf16_t* __restrict__ Vt, int q0, int ntiles,
                  f32x16 (&O)[2], float& lsum, char* smem) {
  const int tid = otid_full(), lane = tid & 63, wave = tid >> 6, l31 = lane & 31, hi = lane >> 5;
  constexpr int KS = DQK / 16, KROW = DQK + 8, KCH = DQK / 8;
  constexpr int KBYTES = 64 * KROW * 2, BUFB = KBYTES + 9216;
  constexpr int NK = 64 * KCH, NKC = (NK + NTHREADS - 1) / NTHREADS;
  static_assert(2 * BUFB <= 49152, "attention LDS");
  bf16x8 qf[KS];
#pragma unroll
  for (int ks = 0; ks < KS; ++ks) qf[ks] = *(const bf16x8*)(Qb + (size_t)(q0 + wave * 32 + l31) * DQK + ks * 16 + hi * 8);
  float mrun = -1e30f; lsum = 0.f; O[0] = zero16(); O[1] = zero16();
  const bf16_t* kg[NKC]; int kl[NKC]; bool kok[NKC];
#pragma unroll
  for (int i = 0; i < NKC; ++i) {
    const int c = tid + NTHREADS * i, key = c / KCH, kc = c % KCH;
    kok[i] = c < NK;
    kg[i] = Kb + (size_t)key * DQK + kc * 8;
    kl[i] = (key * KROW + kc * 8) * 2;
  }
  const bf16_t* vg; int vl;
  { const int dv = tid >> 3, kc = tid & 7; vg = Vt + (size_t)dv * TT + kc * 8; vl = KBYTES + (dv * 72 + kc * 8) * 2; }
  u32x4 rk[NKC], rv;
#pragma unroll
  for (int i = 0; i < NKC; ++i) if (kok[i]) rk[i] = *(const u32x4*)(kg[i]);
  rv = *(const u32x4*)(vg);
#pragma unroll
  for (int i = 0; i < NKC; ++i) if (kok[i]) *(u32x4*)(smem + kl[i]) = rk[i];
  *(u32x4*)(smem + vl) = rv;
  __syncthreads();
  for (int kt = 0; kt < ntiles; ++kt) {
    const int cur = kt & 1; const bool more = kt + 1 < ntiles;
    if (more) {
#pragma unroll
      for (int i = 0; i < NKC; ++i) if (kok[i]) rk[i] = *(const u32x4*)(kg[i] + (size_t)(kt + 1) * 64 * DQK);
      rv = *(const u32x4*)(vg + (kt + 1) * 64);
    }
    const char* sb = smem + cur * BUFB;
    f32x16 s[2];
#pragma unroll
    for (int kb = 0; kb < 2; ++kb) {
      s[kb] = zero16();
      const char* kr = sb + ((kb * 32 + l31) * KROW + hi * 8) * 2;
#pragma unroll
      for (int ks = 0; ks < KS; ++ks) s[kb] = MFMA32(*(const bf16x8*)(kr + ks * 32), qf[ks], s[kb]);
    }
    float mx = s[0][0];
#pragma unroll
    for (int r = 0; r < 16; ++r) { mx = fmaxf(mx, s[0][r]); mx = fmaxf(mx, s[1][r]); }
    mx = fmaxf(mx, __shfl_xor(mx, 32));
    const float mnew = fmaxf(mrun, mx);
    const float alpha = __builtin_amdgcn_exp2f(mrun - mnew);
    mrun = mnew;
    float rs = 0.f;
#pragma unroll
    for (int kb = 0; kb < 2; ++kb)
#pragma unroll
      for (int r = 0; r < 16; ++r) { const float e = __builtin_amdgcn_exp2f(s[kb][r] - mnew); s[kb][r] = e; rs += e; }
    lsum = lsum * alpha + rs;
    O[0] *= alpha; O[1] *= alpha;
#pragma unroll
    for (int s4 = 0; s4 < 4; ++s4) {
      const int kb = s4 >> 1, hf = (s4 & 1) * 8;
      const bf16x8 pb = pack8(s[kb][hf + 0], s[kb][hf + 1], s[kb][hf + 2], s[kb][hf + 3], s[kb][hf + 4], s[kb][hf + 5], s[kb][hf + 6], s[kb][hf + 7]);
#pragma unroll
      for (int dvb = 0; dvb < 2; ++dvb) {
        const bf16x8 a = *(const bf16x8*)(sb + KBYTES + ((dvb * 32 + l31) * 72 + s4 * 16 + hi * 8) * 2);
        O[dvb] = MFMA32(a, pb, O[dvb]);
      }
    }
    if (more) {
      char* db = smem + (cur ^ 1) * BUFB;
#pragma unroll
      for (int i = 0; i < NKC; ++i) if (kok[i]) *(u32x4*)(db + kl[i]) = rk[i];
      *(u32x4*)(db + vl) = rv;
    }
    __syncthreads();
  }
  lsum += __shfl_xor(lsum, 32);
}

DI void attn_unit(const Params& p, int layer, int b, int kind, int head, int qb, char* smem) {
  const int tid_ = otid_full(); const int lane = tid_ & 63, wave = tid_ >> 6, l31 = lane & 31, hi = lane >> 5;
  const int q0 = qb * 256;
  const int ntiles = qb == 0 ? 4 : 36;
  bf16_t* Y = (bf16_t*)(p.ws + OFF_Y);
  const int pos = q0 + wave * 32 + l31;
  bf16_t* yrow = Y + (size_t)hrow_of(b, pos) * DM;
  f32x16 O[2]; float ls;
  if (kind == 1) {
    attn_core<32>((const bf16_t*)(p.ws + OFF_QD) + ((size_t)b * 8 + head * 2) * TT * 32, (const bf16_t*)(p.ws + OFF_KD) + ((size_t)b * 8 + head * 2) * TT * 32,
                  (const bf16_t*)(p.ws + OFF_VTD) + ((size_t)b * 4 + head) * 64 * TT, q0, ntiles, O, ls, smem);
    float* st = (float*)(smem + 49152) + tid_;
    {
      const float i0 = 1.f / ls;
#pragma unroll
      for (int dvb = 0; dvb < 2; ++dvb)
#pragma unroll
        for (int r = 0; r < 16; ++r) st[(dvb * 16 + r) * NTHREADS] = O[dvb][r] * i0;
    }
    __syncthreads();
    attn_core<32>((const bf16_t*)(p.ws + OFF_QD) + ((size_t)b * 8 + head * 2 + 1) * TT * 32, (const bf16_t*)(p.ws + OFF_KD) + ((size_t)b * 8 + head * 2 + 1) * TT * 32,
                  (const bf16_t*)(p.ws + OFF_VTD) + ((size_t)b * 4 + head) * 64 * TT, q0, ntiles, O, ls, smem);
    const float* misc = (const float*)(p.ws + OFF_MISC);
    const float lam = misc[128 + layer], li = misc[136 + layer];
    const float i1 = lam / ls;
    float ss = 0.f;
#pragma unroll
    for (int dvb = 0; dvb < 2; ++dvb)
#pragma unroll
      for (int r = 0; r < 16; ++r) { const float o = st[(dvb * 16 + r) * NTHREADS] - O[dvb][r] * i1; O[dvb][r] = o; ss += o * o; }
    ss += __shfl_xor(ss, 32);
    const float rstd = rsqrtf(ss * (1.f / 64.f) + EPS) * (1.f - li);
    const float* g = p.in[I_DNG] + layer * 64;
#pragma unroll
    for (int dvb = 0; dvb < 2; ++dvb)
#pragma unroll
      for (int r4 = 0; r4 < 4; ++r4) {
        const int dv = dvb * 32 + 8 * r4 + 4 * hi;
        const f32x4 gv = *(const f32x4*)(g + dv);
        u32x2 w; w.x = pk_bf16(O[dvb][4 * r4] * rstd * gv[0], O[dvb][4 * r4 + 1] * rstd * gv[1]);
        w.y = pk_bf16(O[dvb][4 * r4 + 2] * rstd * gv[2], O[dvb][4 * r4 + 3] * rstd * gv[3]);
        *(u32x2*)(yrow + 256 + head * 64 + dv) = w;
      }
  } else {
    int ycol;
    if (kind == 2) {
      attn_core<64>((const bf16_t*)(p.ws + OFF_QG) + ((size_t)b * 4 + head) * TT * 64, (const bf16_t*)(p.ws + OFF_KG) + ((size_t)b * 2 + (head >> 1)) * TT * 64,
                    (const bf16_t*)(p.ws + OFF_VTG) + ((size_t)b * 2 + (head >> 1)) * 64 * TT, q0, ntiles, O, ls, smem);
      ycol = 512 + head * 64;
    } else {
      attn_core<96>((const bf16_t*)(p.ws + OFF_QM) + ((size_t)b * 4 + head) * TT * 96, (const bf16_t*)(p.ws + OFF_KM) + ((size_t)b * 4 + head) * TT * 96,
                    (const bf16_t*)(p.ws + OFF_VTM) + ((size_t)b * 4 + head) * 64 * TT, q0, ntiles, O, ls, smem);
      ycol = 768 + head * 64;
    }
    const float inv = 1.f / ls;
#pragma unroll
    for (int dvb = 0; dvb < 2; ++dvb)
#pragma unroll
      for (int r4 = 0; r4 < 4; ++r4) {
        const int dv = dvb * 32 + 8 * r4 + 4 * hi;
        u32x2 w; w.x = pk_bf16(O[dvb][4 * r4] * inv, O[dvb][4 * r4 + 1] * inv); w.y = pk_bf16(O[dvb][4 * r4 + 2] * inv, O[dvb][4 * r4 + 3] * inv);
        *(u32x2*)(yrow + ycol + dv) = w;
      }
  }
}

DI void ssd_chunk(const Params& p, int layer, int item, char* smem) {
  const int tid = otid(), lane = tid & 63, wave = tid >> 6, l31 = lane & 31, hi = lane >> 5;
  const int pi = wave >> 1, li = wave & 1;
  const int ck = item % 36, r_ = item / 36, d = r_ & 1, g = (r_ >> 1) & 1, b = r_ >> 2, h = 2 * g + half_id(), chain = (b * 4 + h) * 2 + d;
  const bf16_t* U = (const bf16_t*)(p.ws + OFF_U);
  bf16_t* Yssd = (bf16_t*)(p.ws + OFF_XN) + (size_t)d * ROWS * 256;
  bf16_t* sXT = (bf16_t*)smem;
  bf16_t* sB = (bf16_t*)(smem + 9216);
  bf16_t* sC = (bf16_t*)(smem + 18432);
  bf16_t* sBT = (bf16_t*)(smem + 27648);
  float* scs = (float*)(smem + 46080);
  float* sdt = (float*)(smem + 46336);
  float* sW = (float*)(smem + 46592);
  const bool isctx = ck < 4;
  const int Len = isctx ? CT : SEQ, base = isctx ? (MROWS + b * CT) : (b * SEQ), kl = isctx ? ck : ck - 4;
  if (tid < 192) {
    const int cc = tid >> 6, e = tid & 63;
    const int ch = cc == 0 ? (h * 64 + e) : (cc == 1 ? 256 + g * 64 + e : 384 + g * 64 + e);
    const float* cw = p.in[I_CONVW] + ((size_t)layer * 512 + ch) * 3;
    sW[tid * 4 + 0] = cw[0]; sW[tid * 4 + 1] = cw[1]; sW[tid * 4 + 2] = cw[2]; sW[tid * 4 + 3] = p.in[I_CONVB][layer * 512 + ch];
  }
  const bool wrC = (half_id() == 0) && (d == 0);
  bf16_t* CB = (bf16_t*)(p.ws + OFF_CB);
  float raw_dt = 0.f;
  if (wave == 1) {
    const int posj = kl * 64 + lane, t = d ? (Len - 1 - posj) : posj;
    raw_dt = bf2f(U[(size_t)(base + t) * INP + U_DT + d * 4 + h]);
  }
  u32x4 vm6[6], v06[6], vp6[6];
#pragma unroll
  for (int i = 0; i < 6; ++i) {
    const int task = tid + 256 * i, j = task / 24, cc = task % 24;
    const int posj = kl * 64 + j, t = d ? (Len - 1 - posj) : posj;
    const int grp = cc >> 3, c8 = (cc & 7) * 8;
    const int ucol = grp == 0 ? (U_X + h * 64 + c8) : (grp == 1 ? U_B + g * 64 + c8 : U_C + g * 64 + c8);
    const bf16_t* up = U + (size_t)(base + t) * INP + ucol;
    const u32x4 z4 = {0u, 0u, 0u, 0u};
    vm6[i] = (t > 0) ? *(const u32x4*)(up - INP) : z4;
    v06[i] = *(const u32x4*)up;
    vp6[i] = (t < Len - 1) ? *(const u32x4*)(up + INP) : z4;
  }
  if (wave == 1) {
    const float dtb = p.in[I_DTB][layer * 8 + d * 4 + h];
    const float aneg = -expf(p.in[I_ALOG][layer * 8 + d * 4 + h]);
    const int posj = kl * 64 + lane, t = d ? (Len - 1 - posj) : posj;
    const float raw = raw_dt + dtb;
    const float e_ = __expf(-fabsf(raw));
    const float dtv = fmaxf(raw, 0.f) + (e_ < 0.03f ? e_ * (1.f - e_ * (0.5f - e_ * 0.33333334f)) : __logf(1.f + e_));
    float c = dtv * aneg;
#pragma unroll
    for (int o = 1; o < 64; o <<= 1) { const float tv = __shfl_up(c, o); if (lane >= o) c += tv; }
    sdt[lane] = dtv; scs[lane] = c;
    ((float*)(p.ws + OFF_ECL))[(size_t)(d * 4 + h) * ROWS + base + t] = __expf(c);
    if (lane == 63) ((float*)(p.ws + OFF_DEC))[chain * 36 + ck] = __expf(c);
  }
  __syncthreads();
  const float c63 = scs[63];
#pragma unroll
  for (int i = 0; i < 6; ++i) {
    const int task = tid + 256 * i, j = task / 24, cc = task % 24;
    const int posj = kl * 64 + j, t = d ? (Len - 1 - posj) : posj;
    const int grp = cc >> 3, c8 = (cc & 7) * 8;
    const u32x4 vm = vm6[i], v0 = v06[i], vp = vp6[i];
    float o[8];
#pragma unroll
    for (int e2 = 0; e2 < 4; ++e2) {
      const unsigned wm_ = e2 == 0 ? vm.x : e2 == 1 ? vm.y : e2 == 2 ? vm.z : vm.w;
      const unsigned w0_ = e2 == 0 ? v0.x : e2 == 1 ? v0.y : e2 == 2 ? v0.z : v0.w;
      const unsigned wp_ = e2 == 0 ? vp.x : e2 == 1 ? vp.y : e2 == 2 ? vp.z : vp.w;
      const f32x4 wa = *(const f32x4*)(sW + (grp * 64 + c8 + 2 * e2) * 4), wb = *(const f32x4*)(sW + (grp * 64 + c8 + 2 * e2 + 1) * 4);
      o[2 * e2] = silu_f(wa[0] * bflo(wm_) + wa[1] * bflo(w0_) + wa[2] * bflo(wp_) + wa[3]);
      o[2 * e2 + 1] = silu_f(wb[0] * bfhi(wm_) + wb[1] * bfhi(w0_) + wb[2] * bfhi(wp_) + wb[3]);
    }
    if (grp == 0) {
      const float dtv = sdt[j];
#pragma unroll
      for (int e = 0; e < 8; ++e) sXT[(c8 + e) * 72 + j] = f2bf(o[e] * dtv);
    } else if (grp == 1) {
      const float sc_ = __expf(c63 - scs[j]);
      u32x4 w; w.x = pk_bf16(o[0], o[1]); w.y = pk_bf16(o[2], o[3]); w.z = pk_bf16(o[4], o[5]); w.w = pk_bf16(o[6], o[7]);
      *(u32x4*)(sB + j * 72 + c8) = w;
#pragma unroll
      for (int e = 0; e < 8; ++e) sBT[(c8 + e) * 72 + j] = f2bf(o[e] * sc_);
    } else {
      u32x4 w; w.x = pk_bf16(o[0], o[1]); w.y = pk_bf16(o[2], o[3]); w.z = pk_bf16(o[4], o[5]); w.w = pk_bf16(o[6], o[7]);
      *(u32x4*)(sC + j * 72 + c8) = w;
      if (wrC) *(u32x4*)(CB + (size_t)(base + t) * 128 + g * 64 + c8) = w;
    }
  }
  __syncthreads();
  const int lcol = 32 * li + l31;
  const float cl = scs[lcol];
  f32x16 y = zero16();
#pragma unroll
  for (int si = 0; si < 2; ++si) {
    if (si <= li) {
      f32x16 gt = zero16();
#pragma unroll
      for (int ks = 0; ks < 4; ++ks) gt = MFMA32(*(const bf16x8*)(sB + (32 * si + l31) * 72 + ks * 16 + hi * 8), *(const bf16x8*)(sC + lcol * 72 + ks * 16 + hi * 8), gt);
#pragma unroll
      for (int r = 0; r < 16; ++r) { const int s_ = 32 * si + crow(r, hi); gt[r] = (s_ <= lcol) ? gt[r] * __expf(cl - scs[s_]) : 0.f; }
#pragma unroll
      for (int kk = 0; kk < 2; ++kk) {
        const bf16x8 pb = pack8(gt[8 * kk], gt[8 * kk + 1], gt[8 * kk + 2], gt[8 * kk + 3], gt[8 * kk + 4], gt[8 * kk + 5], gt[8 * kk + 6], gt[8 * kk + 7]);
        const bf16_t* xr = sXT + (32 * pi + l31) * 72 + 32 * si + 16 * kk + 4 * hi;
        const s16x4 lo = *(const s16x4*)xr, h4 = *(const s16x4*)(xr + 8);
        y = MFMA32(__builtin_shufflevector(lo, h4, 0, 1, 2, 3, 4, 5, 6, 7), pb, y);
      }
    }
  }
  {
    const int posl = kl * 64 + lcol, t = d ? (Len - 1 - posl) : posl;
    bf16_t* yp = Yssd + (size_t)(base + t) * 256 + h * 64 + 32 * pi + 4 * hi;
#pragma unroll
    for (int r4 = 0; r4 < 4; ++r4) { u32x2 o; o.x = pk_bf16(y[4 * r4], y[4 * r4 + 1]); o.y = pk_bf16(y[4 * r4 + 2], y[4 * r4 + 3]); *(u32x2*)(yp + 8 * r4) = o; }
  }
  f32x16 sacc = zero16();
#pragma unroll
  for (int ks = 0; ks < 4; ++ks) sacc = MFMA32(*(const bf16x8*)(sXT + (32 * pi + l31) * 72 + ks * 16 + hi * 8), *(const bf16x8*)(sBT + (32 * li + l31) * 72 + ks * 16 + hi * 8), sacc);
  bf16_t* Sp = (bf16_t*)(p.ws + OFF_SS) + ((size_t)chain * 37 + ck + 1) * 4096;
#pragma unroll
  for (int r = 0; r < 16; ++r) Sp[(32 * pi + crow(r, hi)) * 64 + 32 * li + l31] = f2bf(sacc[r]);
  __syncthreads();
}

DI void ssd_scan(const Params& p, int chain) {
  const int tid = otid();
  char* slot0 = p.ws + OFF_SS + (size_t)chain * 37 * 8192 + tid * 32;
  const float* dec = (const float*)(p.ws + OFF_DEC) + chain * 36;
  float H[16];
#pragma unroll
  for (int i = 0; i < 16; ++i) H[i] = 0.f;
#pragma unroll 4
  for (int c = 0; c < 36; ++c) {
    const u32x4* sp = (const u32x4*)(slot0 + (size_t)(c + 1) * 8192);
    const u32x4 s0 = sp[0], s1 = sp[1];
    const float dc = dec[c];
    u32x4 w0, w1;
    w0.x = pk_bf16(H[0], H[1]); w0.y = pk_bf16(H[2], H[3]); w0.z = pk_bf16(H[4], H[5]); w0.w = pk_bf16(H[6], H[7]);
    w1.x = pk_bf16(H[8], H[9]); w1.y = pk_bf16(H[10], H[11]); w1.z = pk_bf16(H[12], H[13]); w1.w = pk_bf16(H[14], H[15]);
    u32x4* hp = (u32x4*)(slot0 + (size_t)c * 8192);
    hp[0] = w0; hp[1] = w1;
    H[0] = H[0] * dc + bflo(s0.x); H[1] = H[1] * dc + bfhi(s0.x); H[2] = H[2] * dc + bflo(s0.y); H[3] = H[3] * dc + bfhi(s0.y);
    H[4] = H[4] * dc + bflo(s0.z); H[5] = H[5] * dc + bfhi(s0.z); H[6] = H[6] * dc + bflo(s0.w); H[7] = H[7] * dc + bfhi(s0.w);
    H[8] = H[8] * dc + bflo(s1.x); H[9] = H[9] * dc + bfhi(s1.x); H[10] = H[10] * dc + bflo(s1.y); H[11] = H[11] * dc + bfhi(s1.y);
    H[12] = H[12] * dc + bflo(s1.z); H[13] = H[13] * dc + bfhi(s1.z); H[14] = H[14] * dc + bflo(s1.w); H[15] = H[15] * dc + bfhi(s1.w);
  }
}

DI void ssd_finish_tile(const Params& p, int layer, int tile, char* smem) {
  const int tid = otid(), lane = tid & 63, wave = tid >> 6, l31 = lane & 31, hi = lane >> 5;
  const int b = tile / 72, tb = tile % 72, p0 = tb * 32;
  const bool isctx = tb < 8;
  const int row0 = isctx ? (MROWS + b * CT + p0) : (b * SEQ + p0 - CT);
  const int T64 = tb >> 1, nch = isctx ? 4 : 32, Tl = isctx ? T64 : T64 - 4;
  const bf16_t* U = (const bf16_t*)(p.ws + OFF_U);
  const bf16_t* Y0 = (const bf16_t*)(p.ws + OFF_XN); const bf16_t* Y1 = Y0 + (size_t)ROWS * 256;
  const float* ECL = (const float*)(p.ws + OFF_ECL);
  bf16_t* Y = (bf16_t*)(p.ws + OFF_Y);
  bf16_t* sCc = (bf16_t*)smem;
  float* sY = (float*)(smem + 8704);
  {
    const bf16_t* CB = (const bf16_t*)(p.ws + OFF_CB) + (size_t)row0 * 128;
#pragma unroll
    for (int i = 0; i < 2; ++i) { const int c = tid + 256 * i, r = c >> 4, kc = c & 15; *(u32x4*)(sCc + r * 136 + kc * 8) = *(const u32x4*)(CB + r * 128 + kc * 8); }
  }
  __syncthreads();
  {
    const int pi = wave & 1, g = wave >> 1;
    const int row = row0 + l31;
#pragma unroll
    for (int hh = 0; hh < 2; ++hh) {
      const int h = g * 2 + hh;
      f32x16 ys = zero16();
#pragma unroll
      for (int d = 0; d < 2; ++d) {
        const int kl = d ? (nch - 1 - Tl) : Tl, ck = isctx ? kl : 4 + kl, chain = (b * 4 + h) * 2 + d;
        const char* Hs = p.ws + OFF_SS + ((size_t)chain * 37 + ck) * 8192 + (32 * pi + l31) * 128 + hi * 16;
        f32x16 acc = zero16();
#pragma unroll
        for (int ks = 0; ks < 4; ++ks) acc = MFMA32(*(const bf16x8*)(Hs + ks * 32), *(const bf16x8*)(sCc + l31 * 136 + g * 64 + ks * 16 + hi * 8), acc);
        const float e = ECL[(size_t)(d * 4 + h) * ROWS + row];
        ys += acc * e;
      }
      const bf16_t* y0p = Y0 + (size_t)row * 256 + h * 64 + 32 * pi + 4 * hi; const bf16_t* y1p = Y1 + (size_t)row * 256 + h * 64 + 32 * pi + 4 * hi;
#pragma unroll
      for (int r4 = 0; r4 < 4; ++r4) {
        const u32x2 a_ = *(const u32x2*)(y0p + 8 * r4), c_ = *(const u32x2*)(y1p + 8 * r4);
        const f32x4 a = {bflo(a_.x), bfhi(a_.x), bflo(a_.y), bfhi(a_.y)}, c2 = {bflo(c_.x), bfhi(c_.x), bflo(c_.y), bfhi(c_.y)};
        f32x4 o; o[0] = ys[4 * r4] + a[0] + c2[0]; o[1] = ys[4 * r4 + 1] + a[1] + c2[1]; o[2] = ys[4 * r4 + 2] + a[2] + c2[2]; o[3] = ys[4 * r4 + 3] + a[3] + c2[3];
        *(f32x4*)(sY + l31 * 260 + h * 64 + 32 * pi + 8 * r4 + 4 * hi) = o;
      }
    }
  }
  __syncthreads();
  {
    const int ch = lane * 4, hd = lane >> 4;
    const float dsk = p.in[I_SSDD][layer * 8 + hd] + p.in[I_SSDD][layer * 8 + 4 + hd];
    f32x4 cw[3];
    {
      const float* w = p.in[I_CONVW] + ((size_t)layer * 512 + ch) * 3;
      const f32x4 a = *(const f32x4*)w, b2 = *(const f32x4*)(w + 4), c2 = *(const f32x4*)(w + 8);
      cw[0] = (f32x4){a[0], a[3], b2[2], c2[1]}; cw[1] = (f32x4){a[1], b2[0], b2[3], c2[2]}; cw[2] = (f32x4){a[2], b2[1], c2[0], c2[3]};
    }
    const f32x4 cb = *(const f32x4*)(p.in[I_CONVB] + layer * 512 + ch);
    const f32x4 ng = *(const f32x4*)(p.in[I_SSDNG] + layer * 256 + ch);
    const int Len = isctx ? CT : SEQ;
#pragma unroll 2
    for (int rr = wave; rr < 32; rr += 4) {
      const int row = row0 + rr;
      const int t = isctx ? (p0 + rr) : (p0 - CT + rr);
      const bf16_t* up = U + (size_t)row * INP;
      const u32x2 z2 = *(const u32x2*)(up + U_Z + ch);
      const u32x2 zz = {0u, 0u};
      const u32x2 xm = (t > 0) ? *(const u32x2*)(up - INP + U_X + ch) : zz;
      const u32x2 x0 = *(const u32x2*)(up + U_X + ch);
      const u32x2 xp = (t < Len - 1) ? *(const u32x2*)(up + INP + U_X + ch) : zz;
      const f32x4 xmf = {bflo(xm.x), bfhi(xm.x), bflo(xm.y), bfhi(xm.y)}, x0f = {bflo(x0.x), bfhi(x0.x), bflo(x0.y), bfhi(x0.y)}, xpf = {bflo(xp.x), bfhi(xp.x), bflo(xp.y), bfhi(xp.y)};
      const f32x4 zf = {bflo(z2.x), bfhi(z2.x), bflo(z2.y), bfhi(z2.y)};
      const f32x4 cv = cw[0] * xmf + cw[1] * x0f + cw[2] * xpf + cb;
      const f32x4 ya = *(const f32x4*)(sY + rr * 260 + ch);
      f32x4 gz; float ss = 0.f;
#pragma unroll
      for (int e = 0; e < 4; ++e) { const float xs = silu_f(cv[e]); const float yv = ya[e] + dsk * xs; gz[e] = yv * silu_f(zf[e]); ss += gz[e] * gz[e]; }
      ss = wave_sum(ss);
      const float rstd = rsqrtf(ss * (1.f / 256.f) + EPS);
      u32x2 w; w.x = pk_bf16(gz[0] * rstd * ng[0], gz[1] * rstd * ng[1]); w.y = pk_bf16(gz[2] * rstd * ng[2], gz[3] * rstd * ng[3]);
      *(u32x2*)(Y + (size_t)row * DM + ch) = w;
    }
  }
  __syncthreads();
}

DI void mixer_phase(const Params& p, int layer_c, char* smem, int* s_item) {
  const int layer = layer_c % DEPTH;
  const bool with_ctx = layer < DEPTH - 1;
  const int nqb = with_ctx ? 9 : 8;
  const int natt = 12 * nqb, nfin = with_ctx ? 36 : 32;
  const int nitems = 4 + natt + nfin;
  unsigned* cnt = (unsigned*)(p.ws + OFF_MISC) + layer_c * 8;
  unsigned* sdone = (unsigned*)(p.ws + OFF_MISC) + 72 + layer * 8;
  for (int qq = 0; qq < 8; ++qq) {
    const int q = (blockIdx.x + qq) & 7;
    for (;;) {
      if (threadIdx.x == 0) *s_item = (int)atomicAdd(&cnt[q], 1u);
      __syncthreads();
      const int it = *s_item;
      __syncthreads();
      if (it >= nitems) break;
      if (it < 4) {
        ssd_scan(p, q * 8 + it * 2 + half_id());
        asm volatile("s_waitcnt vmcnt(0)" ::: "memory");
        __syncthreads();
        if (threadIdx.x == 0) {
          __builtin_amdgcn_fence(__ATOMIC_RELEASE, "agent");
          asm volatile("s_waitcnt vmcnt(0)" ::: "memory");
          __hip_atomic_fetch_add(&sdone[q], 1u, __ATOMIC_RELAXED, __HIP_MEMORY_SCOPE_AGENT);
        }
      } else if (it < 4 + natt) {
        const int idx = it - 4;
        int kind, head, qb;
        if (idx < 96) { const int hidx = idx >> 3; qb = (idx & 7) + 1; const int ko = hidx >> 2; kind = ko == 0 ? 1 : (ko == 1 ? 0 : 2); head = hidx & 3; }
        else { const int hidx = idx - 96; qb = 0; const int ko = hidx >> 2; kind = ko == 0 ? 1 : (ko == 1 ? 0 : 2); head = hidx & 3; }
        attn_unit(p, layer, q, kind, head, qb, smem);
      } else {
        if (threadIdx.x == 0) {
          while (__hip_atomic_load(&sdone[q], __ATOMIC_RELAXED, __HIP_MEMORY_SCOPE_AGENT) < 4u) __builtin_amdgcn_s_sleep(2);
          __builtin_amdgcn_fence(__ATOMIC_ACQUIRE, "agent");
          asm volatile("s_waitcnt vmcnt(0)" ::: "memory");
        }
        __syncthreads();
        const int fi = it - 4 - natt;
        const int tile = q * 72 + (with_ctx ? 0 : 8) + fi * 2 + half_id();
        ssd_finish_tile(p, layer, tile, smem + half_id() * SMEM_BYTES);
      }
      __syncthreads();
    }
  }
}

#define XB_TMO      128
#define XB_XCNT(j)  (256  + 64 * (j))
#define XB_XSUB(j)  (1280 + 64 * (j))
#define XB_XGEN(j)  (2304 + 64 * (j))
#define XB_TOP      3328
#define XB_TOPGEN   3392
#define XCD_BAR_WORDS 3456
#define XB_SPIN_CAP (1u << 18)
#define LAS __attribute__((address_space(3)))

__device__ __forceinline__ unsigned xb_ld(unsigned* p)              { return __hip_atomic_load(p, __ATOMIC_RELAXED, __HIP_MEMORY_SCOPE_AGENT); }
__device__ __forceinline__ unsigned xb_add(unsigned* p, unsigned v) { return __hip_atomic_fetch_add(p, v, __ATOMIC_RELAXED, __HIP_MEMORY_SCOPE_AGENT); }
__device__ __forceinline__ unsigned xb_xcc_id() { return (unsigned)__builtin_amdgcn_s_getreg((3 << 11) | 20) & 0xFu; }
#define XB_SPIN(cond, bar) do { unsigned _sp = 0; while (cond) { __builtin_amdgcn_s_sleep(1); \
    if ((++_sp & 255u) == 0u) { if (xb_ld(&(bar)[XB_TMO])) break; if (_sp > XB_SPIN_CAP) { atomicAdd(&(bar)[XB_TMO], 1u); break; } } } } while (0)

struct XcdBarrier {
    unsigned* bar; unsigned x;
    volatile LAS unsigned* st;
};

__device__ __forceinline__ XcdBarrier xcd_barrier_post(unsigned* bar, volatile LAS unsigned* st) {
    XcdBarrier b; b.bar = bar; b.x = xb_xcc_id(); b.st = st;
    if (threadIdx.x == 0) (void)xb_add(&bar[XB_XCNT(b.x)], 1u);
    return b;
}
__device__ __forceinline__ void xcd_barrier_complete(unsigned* bar, unsigned x, unsigned& nloc, unsigned& nx) {
    const unsigned G = gridDim.x * gridDim.y * gridDim.z;
    unsigned sum, cnt, mine, sp = 0u;
    for (;;) {
        sum = 0u; cnt = 0u; mine = 0u;
#pragma unroll
        for (unsigned j = 0; j < 16; ++j) { const unsigned c = xb_ld(&bar[XB_XCNT(j)]); sum += c; cnt += (c > 0u) ? 1u : 0u; mine = (j == x) ? c : mine; }
        if (sum == G) break;
        __builtin_amdgcn_s_sleep(1);
        if ((++sp & 255u) == 0u) { if (xb_ld(&bar[XB_TMO])) break; if (sp > XB_SPIN_CAP) { atomicAdd(&bar[XB_TMO], 1u); break; } }
    }
    nloc = mine > 0u ? mine : 1u; nx = cnt > 0u ? cnt : 1u;
}

__device__ __forceinline__ void xcd_barrier(const XcdBarrier& b) {
    asm volatile("s_waitcnt vmcnt(0)" ::: "memory");
    __syncthreads();
    if (threadIdx.x == 0) {
        unsigned* bar = b.bar;
        __builtin_amdgcn_s_waitcnt(0);
        unsigned nloc = b.st[0], nx = b.st[1];
        if (nloc == 0u) { xcd_barrier_complete(bar, b.x, nloc, nx); b.st[0] = nloc; b.st[1] = nx; }
        const unsigned old = xb_add(&bar[XB_XSUB(b.x)], 1u);
        const unsigned gen = old / nloc;
        if (old + 1u == (gen + 1u) * nloc) {
            __builtin_amdgcn_fence(__ATOMIC_RELEASE, "agent");
            asm volatile("s_waitcnt vmcnt(0)" ::: "memory");
            const unsigned og = xb_add(&bar[XB_TOP], 1u);
            const unsigned tg = og / nx;
            if (og + 1u == (tg + 1u) * nx) xb_add(&bar[XB_TOPGEN], 1u);
            else XB_SPIN(xb_ld(&bar[XB_TOPGEN]) == tg, bar);
            __builtin_amdgcn_fence(__ATOMIC_ACQUIRE, "agent");
            xb_add(&bar[XB_XGEN(b.x)], 1u);
            asm volatile("s_waitcnt vmcnt(0)" ::: "memory");
        } else {
            XB_SPIN(xb_ld(&bar[XB_XGEN(b.x)]) == gen, bar);
            __builtin_amdgcn_fence(__ATOMIC_ACQUIRE, "agent");
            asm volatile("s_waitcnt vmcnt(0)" ::: "memory");
        }
    }
    __syncthreads();
}

DI void gbar(unsigned* bw, unsigned k) {
  asm volatile("s_waitcnt vmcnt(0)" ::: "memory");
  __syncthreads();
  if (threadIdx.x == 0) {
    __builtin_amdgcn_fence(__ATOMIC_RELEASE, "agent");
    asm volatile("s_waitcnt vmcnt(0)" ::: "memory");
    unsigned bx_ = blockIdx.x, gd_ = gridDim.x; asm volatile("" : "+s"(bx_), "+s"(gd_));
    const unsigned x = bx_ & 7u, nloc = (gd_ - x + 7u) >> 3;
    unsigned* sub = bw + 64 * (1 + x); unsigned* gen = bw + 64 * (9 + x); unsigned* top = bw + 64 * 17;
    const unsigned old = __hip_atomic_fetch_add(sub, 1u, __ATOMIC_RELAXED, __HIP_MEMORY_SCOPE_AGENT);
    if (old + 1u == k * nloc) {
      __hip_atomic_fetch_add(top, 1u, __ATOMIC_RELAXED, __HIP_MEMORY_SCOPE_AGENT);
      while (__hip_atomic_load(top, __ATOMIC_RELAXED, __HIP_MEMORY_SCOPE_AGENT) < 8u * k) __builtin_amdgcn_s_sleep(1);
      __hip_atomic_fetch_add(gen, 1u, __ATOMIC_RELAXED, __HIP_MEMORY_SCOPE_AGENT);
    } else {
      while (__hip_atomic_load(gen, __ATOMIC_RELAXED, __HIP_MEMORY_SCOPE_AGENT) < k) __builtin_amdgcn_s_sleep(1);
    }
    __builtin_amdgcn_fence(__ATOMIC_ACQUIRE, "agent");
    asm volatile("s_waitcnt vmcnt(0)" ::: "memory");
  }
  __syncthreads();
}

__global__ void __launch_bounds__(NTHREADS, 2) fwd_megakernel(Params p) {
  cg::grid_group grid = cg::this_grid();
  extern __shared__ __attribute__((aligned(16))) unsigned char lds_dyn[];
  __shared__ uint4 s_misc[2];
  int& s_item = *(int*)&s_misc[1];
  if (threadIdx.x == 0) s_misc[0] = make_uint4(0u, 0u, 0u, 0u);
  __syncthreads();
  (void)xcd_barrier_post((unsigned*)(p.ws + OFF_MISC + 16384), (volatile LAS unsigned*)&s_misc[0]);
#define GBAR() do { XcdBarrier xb_; xb_.bar = (unsigned*)(p.ws + OFF_MISC + 16384); xb_.x = xb_xcc_id(); xb_.st = (volatile LAS unsigned*)&s_misc[0]; xcd_barrier(xb_); } while (0)
  char* smem = (char*)lds_dyn;
  const int half = half_id();
  unsigned* bw = (unsigned*)(p.ws + OFF_MISC) + 256; unsigned bk = 0;
  phase0(p, smem);
  if (p.ws == nullptr) grid.sync();
  GBAR();
  mod_reduce(p);
  GBAR();
  const float* MOD = (const float*)(p.ws + OFF_MOD);
  bf16_t* XN = (bf16_t*)(p.ws + OFF_XN);
  bf16_t* U = (bf16_t*)(p.ws + OFF_U);
  bf16_t* Y = (bf16_t*)(p.ws + OFF_Y);
  bf16_t* HM = (bf16_t*)(p.ws + OFF_HM);
  float* HC = (float*)(p.ws + OFF_HC);
  PG8_LAS unsigned char* glds = (PG8_LAS unsigned char*)lds_dyn;
#pragma unroll 1
  for (int layer = 0; layer < DEPTH; ++layer) {
    const bool with_ctx = layer < DEPTH - 1;
    const int mrows = with_ctx ? ROWS : MROWS;
    int bx = (int)blockIdx.x; asm volatile("" : "+s"(bx));
    for (int rep = 0; rep < PROBE_N1; ++rep) { norm_phase(p, layer, 0, ROWS, layer > 0 ? MOD + (size_t)((layer - 1) * 9 + 8) * 6144 + 5120 : nullptr, HC);
    GBAR(); }
    for (int rep = 0; rep < PROBE_INPROJ; ++rep) { pg8::Gemm g{XN, (const bf16_t*)(p.ws + OFF_WIN) + (size_t)layer * INPW * DM, ROWS, INPW, DM, DM}; pg8::StaticOrder S; S.init(ROWS, INPW, (int)gridDim.x, bx);
      pg8::EpiStore<0> E{U, INP, INP};
      pg8::gemm_phase<pg8::EpiStore<0>, pg8::StaticOrder, true, true>(glds, g, S, E);
    GBAR(); }
    for (int rep = 0; rep < PROBE_PREP; ++rep) {
      unsigned* qc = (unsigned*)(p.ws + OFF_MISC) + 64 + layer + rep * DEPTH;
      for (;;) {
        if (threadIdx.x == 0) s_item = (int)atomicAdd(qc, 1u);
        __syncthreads();
        const int it = s_item;
        __syncthreads();
        if (it >= 1152 + 288) break;
        if (it < 144) prep_tile(p, layer, it * 2 + half, 0, smem + half * SMEM_BYTES);
        else if (it < 288) prep_tile(p, layer, (it - 144) * 2 + half, 1, smem + half * SMEM_BYTES);
        else ssd_chunk(p, layer, it - 288, smem + half * SMEM_BYTES);
      }
      GBAR();
    }
    for (int rep = 0; rep < PROBE_MIX; ++rep) { mixer_phase(p, layer + rep * DEPTH, smem, &s_item);
    GBAR(); }
    { const bf16_t* Wt = (const bf16_t*)(p.ws + OFF_WOUT) + (size_t)layer * DM * DM;
      { pg8::Gemm g{Y, Wt, MROWS, DM, DM, DM}; pg8::StaticOrder S; S.init(MROWS, DM, (int)gridDim.x, bx);
        pg8::EpiResid E{layer == 0 ? p.in[I_X] : p.out, nullptr, p.out, nullptr, MOD + (size_t)layer * 9 * 6144 + 2048, 1.f};
        pg8::gemm_phase<pg8::EpiResid, pg8::StaticOrder, true, true>(glds, g, S, E);
        for (int rep = 0; rep < PROBE_OUT; ++rep) { GBAR(); pg8::EpiResid E2{p.out, nullptr, p.out, nullptr, MOD + (size_t)layer * 9 * 6144 + 2048, 0.f}; pg8::gemm_phase<pg8::EpiResid, pg8::StaticOrder, true, true>(glds, g, S, E2); } }
      if (with_ctx) {
        const int ks = (bx >> 5) & 3;
        pg8::Gemm g{Y + (size_t)MROWS * DM + ks * (DM / 4), Wt + ks * (DM / 4), CROWS, DM, DM, DM / 4}; pg8::SplitOrder S{bx};
        pg8::EpiPartial E{(float*)(p.ws + OFF_SS) + (size_t)ks * CROWS * DM};
        pg8::gemm_phase<pg8::EpiPartial, pg8::SplitOrder, true, true>(glds, g, S, E); } }
    GBAR();
    norm_phase(p, layer, 1, mrows, with_ctx ? MOD + (size_t)(layer * 9 + 8) * 6144 + 2048 : nullptr, layer == 0 ? p.in[I_CTX] : HC);
    GBAR();
    for (int rep = 0; rep < PROBE_UP; ++rep) { pg8::Gemm g{XN, (const bf16_t*)(p.ws + OFF_W1) + (size_t)layer * DFF * DM, mrows, DFF, DM, DM}; pg8::StaticOrder S; S.init(mrows, DFF, (int)gridDim.x, bx);
      pg8::EpiStore<1> E{HM, DFF, DFF};
      pg8::gemm_phase<pg8::EpiStore<1>, pg8::StaticOrder, true, true>(glds, g, S, E);
    GBAR(); }
    { const bf16_t* Wt = (const bf16_t*)(p.ws + OFF_W2) + (size_t)layer * DM * DFF;
      { pg8::Gemm g{HM, Wt, MROWS, DM, DFF, DFF}; pg8::StaticOrder S; S.init(MROWS, DM, (int)gridDim.x, bx);
        pg8::EpiResid E{p.out, nullptr, p.out, nullptr, MOD + (size_t)layer * 9 * 6144 + 5120, 1.f};
        pg8::gemm_phase<pg8::EpiResid, pg8::StaticOrder, true, true>(glds, g, S, E);
        for (int rep = 0; rep < PROBE_DOWN; ++rep) { GBAR(); pg8::EpiResid E2{p.out, nullptr, p.out, nullptr, MOD + (size_t)layer * 9 * 6144 + 5120, 0.f}; pg8::gemm_phase<pg8::EpiResid, pg8::StaticOrder, true, true>(glds, g, S, E2); } }
      if (with_ctx) {
        const int ks = (bx >> 5) & 3;
        pg8::Gemm g{HM + (size_t)MROWS * DFF + ks * (DFF / 4), Wt + ks * (DFF / 4), CROWS, DM, DFF, DFF / 4}; pg8::SplitOrder S{bx};
        pg8::EpiPartial E{(float*)(p.ws + OFF_SS) + (size_t)ks * CROWS * DM};
        pg8::gemm_phase<pg8::EpiPartial, pg8::SplitOrder, true, true>(glds, g, S, E); } }
    GBAR();
  }
  norm_phase(p, 0, 2, MROWS);
}

extern "C" void kernel_launch(void* const* d_in, const int* in_sizes, int n_in, void* d_out, int out_size, void* d_ws, size_t ws_size, hipStream_t stream) {
  static int grid_blocks = 0;
  if (!grid_blocks) {
    int dev = 0, cus = 0, per_cu = 0;
    (void)hipGetDevice(&dev);
    (void)hipDeviceGetAttribute(&cus, hipDeviceAttributeMultiprocessorCount, dev);
    if (hipFuncSetAttribute((const void*)fwd_megakernel, hipFuncAttributeMaxDynamicSharedMemorySize, LDS_BYTES) != hipSuccess) fprintf(stderr, "hipFuncSetAttribute(max dynamic LDS) failed\n");
    (void)hipOccupancyMaxActiveBlocksPerMultiprocessor(&per_cu, (const void*)fwd_megakernel, NTHREADS, LDS_BYTES);
    if (per_cu < 1) { fprintf(stderr, "occupancy query says %d blocks/CU\n", per_cu); per_cu = 1; }
    grid_blocks = cus;
  }
  if (ws_size < OFF_END) { fprintf(stderr, "workspace too small: %zu < %zu\n", ws_size, (size_t)OFF_END); return; }
  Params p{};
  for (int i = 0; i < 27; ++i) p.in[i] = (const float*)d_in[i];
  p.out = (float*)d_out;
  p.ws = (char*)d_ws;
  (void)hipMemsetAsync((char*)d_ws + OFF_MISC, 0, SZ_MISC, stream);
  void* args[] = {&p};
  hipError_t e = hipLaunchCooperativeKernel((void*)fwd_megakernel, dim3(grid_blocks), dim3(NTHREADS), args, LDS_BYTES, stream);
  if (e != hipSuccess) fprintf(stderr, "cooperative launch failed: %s (grid %d)\n", hipGetErrorString(e), grid_blocks);
}
```

```cpp
#include <hip/hip_runtime.h>
#include <hip/hip_cooperative_groups.h>
#include <stdint.h>
#include <cstdio>
namespace cg = cooperative_groups;

typedef unsigned short bf16_t;
typedef short bf16x8 __attribute__((ext_vector_type(8)));
typedef short s16x4 __attribute__((ext_vector_type(4)));
typedef float f32x16 __attribute__((ext_vector_type(16)));
typedef float f32x4 __attribute__((ext_vector_type(4)));
typedef float f32x2 __attribute__((ext_vector_type(2)));
typedef unsigned u32x4 __attribute__((ext_vector_type(4)));
typedef unsigned u32x2 __attribute__((ext_vector_type(2)));
typedef __bf16 bf2_t __attribute__((ext_vector_type(2)));

#define DI __device__ __forceinline__
#define MFMA32(a, b, c) __builtin_amdgcn_mfma_f32_32x32x16_bf16((a), (b), (c), 0, 0, 0)

constexpr int DM = 1024, NB = 8, SEQ = 2048, DEPTH = 4, CT = 256, TT = 2304;
constexpr int MROWS = NB * SEQ, CROWS = NB * CT, ROWS = MROWS + CROWS;
constexpr int INC = 2408, INP = 2432, INPW = 2560, DFF = 4096;
constexpr float EPS = 1e-6f;
constexpr float LOG2E = 1.4426950408889634f;
constexpr int U_Z = 0, U_X = 256, U_B = 512, U_C = 640, U_DT = 768;
constexpr int U_DQ = 776, U_DK = 1032, U_DV = 1288;
constexpr int U_GQ = 1544, U_GK = 1800, U_GV = 1928;
constexpr int U_MQ = 2056, U_MKV = 2248, U_MR = 2376;

constexpr size_t al256(size_t x) { return (x + 255) & ~(size_t)255; }
constexpr size_t SZ_WIN = (size_t)DEPTH * INPW * DM * 2;
constexpr size_t SZ_WOUT = (size_t)DEPTH * DM * DM * 2;
constexpr size_t SZ_W1 = (size_t)DEPTH * DFF * DM * 2;
constexpr size_t SZ_W2 = (size_t)DEPTH * DM * DFF * 2;
constexpr size_t SZ_WUQ = (size_t)DEPTH * 384 * 192 * 2;
constexpr size_t SZ_WUKV = (size_t)DEPTH * 512 * 128 * 2;
constexpr size_t SZ_MOD = (size_t)DEPTH * 9 * 6144 * 4;
constexpr size_t SZ_MISC = 32768;
constexpr size_t SZ_ROPEH = (size_t)SEQ * 32 * 8;
constexpr size_t SZ_ROPED = (size_t)SEQ * 16 * 8;
constexpr size_t SZ_HC = (size_t)CROWS * DM * 4;
constexpr size_t SZ_XN = (size_t)ROWS * DM * 2;
constexpr size_t SZ_U = (size_t)ROWS * INP * 2;
constexpr size_t SZ_QD = (size_t)NB * 8 * TT * 32 * 2;
constexpr size_t SZ_VT4 = (size_t)NB * 4 * 64 * TT * 2;
constexpr size_t SZ_QG = (size_t)NB * 4 * TT * 64 * 2;
constexpr size_t SZ_KG = (size_t)NB * 2 * TT * 64 * 2;
constexpr size_t SZ_QM = (size_t)NB * 4 * TT * 96 * 2;
constexpr size_t SZ_Y = (size_t)ROWS * DM * 2;

constexpr size_t OFF_MOD = 0;
constexpr size_t OFF_MISC = OFF_MOD + al256(SZ_MOD);
constexpr size_t OFF_WIN = OFF_MISC + SZ_MISC;
constexpr size_t OFF_WOUT = OFF_WIN + al256(SZ_WIN);
constexpr size_t OFF_W1 = OFF_WOUT + al256(SZ_WOUT);
constexpr size_t OFF_W2 = OFF_W1 + al256(SZ_W1);
constexpr size_t OFF_WUQ = OFF_W2 + al256(SZ_W2);
constexpr size_t OFF_WUKV = OFF_WUQ + al256(SZ_WUQ);
constexpr size_t OFF_ROPEH = OFF_WUKV + al256(SZ_WUKV);
constexpr size_t OFF_ROPED = OFF_ROPEH + al256(SZ_ROPEH);
constexpr size_t OFF_HC = OFF_ROPED + al256(SZ_ROPED);
constexpr size_t OFF_XN = OFF_HC + al256(SZ_HC);
constexpr size_t OFF_BIG = OFF_XN + al256(SZ_XN);
constexpr size_t OFF_U = OFF_BIG;
constexpr size_t OFF_QD = OFF_U + al256(SZ_U);
constexpr size_t OFF_KD = OFF_QD + al256(SZ_QD);
constexpr size_t OFF_VTD = OFF_KD + al256(SZ_QD);
constexpr size_t OFF_QG = OFF_VTD + al256(SZ_VT4);
constexpr size_t OFF_KG = OFF_QG + al256(SZ_QG);
constexpr size_t OFF_VTG = OFF_KG + al256(SZ_KG);
constexpr size_t OFF_QM = OFF_VTG + al256(SZ_KG);
constexpr size_t OFF_KM = OFF_QM + al256(SZ_QM);
constexpr size_t OFF_VTM = OFF_KM + al256(SZ_QM);
constexpr size_t OFF_Y = OFF_VTM + al256(SZ_VT4);
constexpr size_t SZ_SS = (size_t)64 * 37 * 16384;
constexpr size_t SZ_DEC = (size_t)64 * 36 * 4;
constexpr size_t SZ_ECL = (size_t)8 * ROWS * 4;
constexpr size_t SZ_CB = (size_t)ROWS * 128 * 2;
constexpr size_t OFF_SS = OFF_Y + al256(SZ_Y);
constexpr size_t OFF_DEC = OFF_SS + al256(SZ_SS);
constexpr size_t OFF_ECL = OFF_DEC + al256(SZ_DEC);
constexpr size_t OFF_CB = OFF_ECL + al256(SZ_ECL);
constexpr size_t OFF_END = OFF_CB + al256(SZ_CB);
static_assert(OFF_END <= (size_t)402653184, "workspace budget (4 x mod_w)");
constexpr size_t OFF_HM = OFF_BIG;
static_assert((size_t)ROWS * DFF * 2 <= OFF_Y - OFF_BIG, "HM overlay must not reach Y");
static_assert((size_t)2 * ROWS * 256 * 4 <= SZ_XN, "Yssd overlay");

struct Params {
  const float* in[27];
  float* out;
  char* ws;
};
enum { I_X = 0, I_C, I_CTX, I_CCTX, I_MODW, I_MODB, I_N1G, I_N2G, I_WIN, I_CONVW, I_CONVB, I_DTB, I_ALOG, I_SSDD, I_SSDNG,
       I_DLAM, I_DNG, I_GQN, I_GKN, I_MQN, I_MKVN, I_WUQ, I_WUKV, I_WOUT, I_W1, I_W2, I_FNG };

constexpr int SMEM_BYTES = 65536;
constexpr int LDS_BYTES = 131072, NTHREADS = 512;
#ifndef PROBE_DOWN
#define PROBE_DOWN 0
#endif
#ifndef PROBE_OUT
#define PROBE_OUT 0
#endif
#ifndef PROBE_P0
#define PROBE_P0 1
#endif
#ifndef PROBE_N1
#define PROBE_N1 1
#endif
#ifndef PROBE_FIN
#define PROBE_FIN 1
#endif
#ifndef PROBE_UP
#define PROBE_UP 1
#endif
#ifndef PROBE_PREP
#define PROBE_PREP 1
#endif
#ifndef PROBE_MIX
#define PROBE_MIX 1
#endif
#ifndef PROBE_INPROJ
#define PROBE_INPROJ 1
#endif

DI unsigned pk_bf16(float a, float b) { f32x2 v = {a, b}; bf2_t r = __builtin_convertvector(v, bf2_t); return __builtin_bit_cast(unsigned, r); }
DI bf16_t f2bf(float a) { return (bf16_t)(pk_bf16(a, 0.f) & 0xffffu); }
DI float bf2f(bf16_t v) { return __uint_as_float((unsigned)v << 16); }
DI float bflo(unsigned w) { return __uint_as_float(w << 16); }
DI float bfhi(unsigned w) { return __uint_as_float(w & 0xffff0000u); }
DI float silu_f(float x) { return x / (1.f + __expf(-x)); }
DI float wave_sum(float v) {
#pragma unroll
  for (int o = 32; o >= 1; o >>= 1) v += __shfl_xor(v, o);
  return v;
}
DI int crow(int r, int hi) { return (r & 3) + 8 * (r >> 2) + 4 * hi; }
DI bf16x8 pack8(float a0, float a1, float a2, float a3, float a4, float a5, float a6, float a7) {
  u32x4 p; p.x = pk_bf16(a0, a1); p.y = pk_bf16(a2, a3); p.z = pk_bf16(a4, a5); p.w = pk_bf16(a6, a7);
  return __builtin_bit_cast(bf16x8, p);
}
DI f32x16 zero16() { f32x16 z;
#pragma unroll
  for (int i = 0; i < 16; ++i) z[i] = 0.f;
  return z; }
DI int otid() { int t = threadIdx.x & 255; asm volatile("" : "+v"(t)); return t; }
DI int otid_full() { int t = threadIdx.x; asm volatile("" : "+v"(t)); return t; }
DI int half_id() { return __builtin_amdgcn_readfirstlane((int)threadIdx.x >> 8); }
DI int hrow_of(int b, int pos) { return pos < CT ? (MROWS + b * CT + pos) : (b * SEQ + pos - CT); }

DI void tconv_tile(const float* __restrict__ src, int K, int N, bf16_t* __restrict__ dst, int kt, int nt, unsigned* sT) {
  const int tid = otid();
#pragma unroll
  for (int p = 0; p < 2; ++p) {
    const int idx = tid + 256 * p, kp = idx >> 4, nc = idx & 15;
    const int k = kt * 64 + 2 * kp, n = nt * 64 + nc * 4;
    f32x4 v0 = {0.f, 0.f, 0.f, 0.f}, v1 = {0.f, 0.f, 0.f, 0.f};
    if (n < N) { v0 = *(const f32x4*)(src + (size_t)k * N + n); v1 = *(const f32x4*)(src + (size_t)(k + 1) * N + n); }
#pragma unroll
    for (int e = 0; e < 4; ++e) sT[(nc * 4 + e) * 33 + kp] = pk_bf16(v0[e], v1[e]);
  }
  __syncthreads();
  {
    const int n = tid >> 2, part = tid & 3;
    u32x4 a, b;
    const unsigned* s = sT + n * 33 + part * 8;
    a.x = s[0]; a.y = s[1]; a.z = s[2]; a.w = s[3]; b.x = s[4]; b.y = s[5]; b.z = s[6]; b.w = s[7];
    bf16_t* d = dst + (size_t)(nt * 64 + n) * K + kt * 64 + part * 16;
    *(u32x4*)d = a; *(u32x4*)(d + 8) = b;
  }
  __syncthreads();
}

DI void mod_task(const Params& p, int task, float* sCond) {
  const int tid = otid();
  const int ks = task & 7, cb = (task >> 3) % 24, l = task / 192;
  for (int i = tid; i < 9 * 128; i += 256) {
    const int r = i >> 7, kk = i & 127;
    const float v = (r < 8) ? p.in[I_C][r * DM + ks * 128 + kk] : p.in[I_CCTX][ks * 128 + kk];
    sCond[i] = silu_f(v);
  }
  __syncthreads();
  const int col = cb * 256 + tid;
  const float* w = p.in[I_MODW] + ((size_t)l * DM + ks * 128) * 6144 + col;
  float acc[9];
#pragma unroll
  for (int r = 0; r < 9; ++r) acc[r] = 0.f;
#pragma unroll 8
  for (int kk = 0; kk < 128; ++kk) {
    const float wv = w[(size_t)kk * 6144];
#pragma unroll
    for (int r = 0; r < 9; ++r) acc[r] += sCond[r * 128 + kk] * wv;
  }
  const float bias = (ks == 0) ? p.in[I_MODB][l * 6144 + col] : 0.f;
  float* MODP = (float*)(p.ws + OFF_Y) + (size_t)ks * (DEPTH * 9 * 6144);
#pragma unroll
  for (int r = 0; r < 9; ++r) MODP[(size_t)(l * 9 + r) * 6144 + col] = acc[r] + bias;
  __syncthreads();
}

DI void phase0(const Params& p, char* smem) {
  constexpr int T_WIN = DEPTH * 16 * 38, T_WOUT = DEPTH * 16 * 16, T_W1 = DEPTH * 16 * 64, T_W2 = DEPTH * 64 * 16;
  constexpr int T_UQ = DEPTH * 3 * 6, T_UKV = DEPTH * 2 * 8, T_MOD = 768, T_ROPE = (SEQ * 48) / 256, T_MISC = 1;
  constexpr int E0 = T_WIN, E1 = E0 + T_WOUT, E2 = E1 + T_W1, E3 = E2 + T_W2, E4 = E3 + T_UQ, E5 = E4 + T_UKV, E6 = E5 + T_MOD, E7 = E6 + T_ROPE, E8 = E7 + T_MISC;
  const int tid = otid();
  const int half = half_id(); smem += half * SMEM_BYTES;
  static_assert(E0 % 2 == 0 && E1 % 2 == 0 && E2 % 2 == 0 && E3 % 2 == 0 && E4 % 2 == 0 && E5 % 2 == 0 && E6 % 2 == 0 && E7 % 2 == 0, "half-block pairs must not straddle task types");
  for (int t0 = blockIdx.x * 2; t0 < E8; t0 += gridDim.x * 2) {
    const int t = t0 + half;
    if (t >= E8) break;
    if (t < E0) { const int l = t / (16 * 38), r = t % (16 * 38); tconv_tile(p.in[I_WIN] + (size_t)l * DM * INC, DM, INC, (bf16_t*)(p.ws + OFF_WIN) + (size_t)l * INPW * DM, r / 38, r % 38, (unsigned*)smem); }
    else if (t < E1) { const int u = t - E0, l = u / 256, r = u % 256; tconv_tile(p.in[I_WOUT] + (size_t)l * DM * DM, DM, DM, (bf16_t*)(p.ws + OFF_WOUT) + (size_t)l * DM * DM, r / 16, r % 16, (unsigned*)smem); }
    else if (t < E2) { const int u = t - E1, l = u / 1024, r = u % 1024; tconv_tile(p.in[I_W1] + (size_t)l * DM * DFF, DM, DFF, (bf16_t*)(p.ws + OFF_W1) + (size_t)l * DFF * DM, r / 64, r % 64, (unsigned*)smem); }
    else if (t < E3) { const int u = t - E2, l = u / 1024, r = u % 1024; tconv_tile(p.in[I_W2] + (size_t)l * DFF * DM, DFF, DM, (bf16_t*)(p.ws + OFF_W2) + (size_t)l * DM * DFF, r / 16, r % 16, (unsigned*)smem); }
    else if (t < E4) { const int u = t - E3, l = u / 18, r = u % 18; tconv_tile(p.in[I_WUQ] + (size_t)l * 192 * 384, 192, 384, (bf16_t*)(p.ws + OFF_WUQ) + (size_t)l * 384 * 192, r / 6, r % 6, (unsigned*)smem); }
    else if (t < E5) { const int u = t - E4, l = u / 16, r = u % 16; tconv_tile(p.in[I_WUKV] + (size_t)l * 128 * 512, 128, 512, (bf16_t*)(p.ws + OFF_WUKV) + (size_t)l * 512 * 128, r / 8, r % 8, (unsigned*)smem); }
    else if (t < E6) { mod_task(p, t - E5, (float*)smem); }
    else if (t < E7) {
      const int idx = (t - E6) * 256 + tid;
      int tt, i, nf; f32x2* dst;
      if (idx < SEQ * 32) { tt = idx >> 5; i = idx & 31; nf = 16; dst = (f32x2*)(p.ws + OFF_ROPEH) + idx; }
      else { const int j = idx - SEQ * 32; tt = j >> 4; i = j & 15; nf = 8; dst = (f32x2*)(p.ws + OFF_ROPED) + j; }
      const int f = i & (nf - 1);
      const float pos = (float)((i < nf) ? (tt >> 6) : (tt & 63));
      const float inv = exp2f(-(float)f * (13.287712379549449f / (float)nf));
      float rv = pos * inv * 0.15915494309189535f; rv -= rintf(rv);
      f32x2 cs; cs.x = __builtin_amdgcn_cosf(rv); cs.y = __builtin_amdgcn_sinf(rv);
      *dst = cs;
    } else {
      if (tid < DEPTH) {
        const float* lp = p.in[I_DLAM] + tid * 128;
        float s1 = 0.f, s2 = 0.f;
        for (int i = 0; i < 32; ++i) { s1 += lp[i] * lp[32 + i]; s2 += lp[64 + i] * lp[96 + i]; }
        const float li = 0.8f - 0.6f * expf(-0.3f * (float)tid);
        float* misc = (float*)(p.ws + OFF_MISC);
        misc[128 + tid] = expf(s1) - expf(s2) + li;
        misc[136 + tid] = li;
      }
    }
  }
}

DI void mod_reduce(const Params& p) {
  const float* MODP = (const float*)(p.ws + OFF_Y);
  float* MOD = (float*)(p.ws + OFF_MOD);
  constexpr int NTOT = DEPTH * 9 * 6144;
  for (int i = blockIdx.x * NTHREADS + otid_full(); i < NTOT; i += gridDim.x * NTHREADS) {
    float a = 0.f;
#pragma unroll
    for (int ks = 0; ks < 8; ++ks) a += MODP[(size_t)ks * NTOT + i];
    MOD[i] = a;
  }
}

DI void norm_phase(const Params& p, int layer, int which, int nrows, const float* pend_gate = nullptr, const float* pend_hin = nullptr) {
  constexpr int NR = 3;
  const int tid_ = otid_full(); const int lane = tid_ & 63, wave = tid_ >> 6;
  const int gw = blockIdx.x * 8 + wave, nw = gridDim.x * 8;
  const float* MOD = (const float*)(p.ws + OFF_MOD);
  bf16_t* XN = (bf16_t*)(p.ws + OFF_XN);
  const float* g = (which == 0 ? p.in[I_N1G] : which == 1 ? p.in[I_N2G] : p.in[I_FNG]) + (which == 2 ? 0 : layer * DM);
  f32x4 gv[4];
#pragma unroll
  for (int i = 0; i < 4; ++i) gv[i] = *(const f32x4*)(g + i * 256 + lane * 4);
  for (int row0 = gw; row0 < nrows; row0 += nw * NR) {
    f32x4 v[NR][4];
    float ss[NR];
#pragma unroll
    for (int j = 0; j < NR; ++j) {
      const int row = row0 + j * nw;
      ss[j] = 0.f;
      if (row < nrows) {
        if (pend_gate != nullptr && row >= MROWS) {
          const size_t ro = (size_t)(row - MROWS) * DM;
          const float* P = (const float*)(p.ws + OFF_SS) + ro;
#pragma unroll
          for (int i = 0; i < 4; ++i) {
            const int c = i * 256 + lane * 4;
            const f32x4 a = *(const f32x4*)(P + c), b2 = *(const f32x4*)(P + (size_t)CROWS * DM + c), c2 = *(const f32x4*)(P + (size_t)2 * CROWS * DM + c), d2 = *(const f32x4*)(P + (size_t)3 * CROWS * DM + c);
            v[j][i] = *(const f32x4*)(pend_hin + ro + c) + *(const f32x4*)(pend_gate + c) * (((a + b2) + c2) + d2);
          }
        } else {
          const float* h;
          if (row < MROWS) h = ((which == 0 && layer == 0) ? p.in[I_X] : p.out) + (size_t)row * DM;
          else h = ((which == 0 && layer == 0) ? p.in[I_CTX] : (const float*)(p.ws + OFF_HC)) + (size_t)(row - MROWS) * DM;
#pragma unroll
          for (int i = 0; i < 4; ++i) v[j][i] = *(const f32x4*)(h + i * 256 + lane * 4);
        }
      } else {
#pragma unroll
        for (int i = 0; i < 4; ++i) v[j][i] = (f32x4){0.f, 0.f, 0.f, 0.f};
      }
    }
#pragma unroll
    for (int j = 0; j < NR; ++j) {
      const int row = row0 + j * nw;
      if (row >= nrows) continue;
      if (pend_gate != nullptr && row >= MROWS) {
        float* hc = (float*)(p.ws + OFF_HC) + (size_t)(row - MROWS) * DM;
#pragma unroll
        for (int i = 0; i < 4; ++i) *(f32x4*)(hc + i * 256 + lane * 4) = v[j][i];
      }
#pragma unroll
      for (int i = 0; i < 4; ++i) ss[j] += v[j][i][0] * v[j][i][0] + v[j][i][1] * v[j][i][1] + v[j][i][2] * v[j][i][2] + v[j][i][3] * v[j][i][3];
      const float rstd = rsqrtf(wave_sum(ss[j]) * (1.f / DM) + EPS);
      if (which == 2) {
#pragma unroll
        for (int i = 0; i < 4; ++i) { f32x4 o = v[j][i] * rstd * gv[i]; *(f32x4*)(p.out + (size_t)row * DM + i * 256 + lane * 4) = o; }
      } else {
        const int bidx = row < MROWS ? (row >> 11) : 8;
        const float* sh = MOD + (size_t)(layer * 9 + bidx) * 6144 + which * 3072;
        const float* sc = sh + 1024;
#pragma unroll
        for (int i = 0; i < 4; ++i) {
          const int c = i * 256 + lane * 4;
          const f32x4 shv = *(const f32x4*)(sh + c), scv = *(const f32x4*)(sc + c);
          f32x4 o = v[j][i] * rstd * gv[i] * (1.f + scv) + shv;
          u32x2 w; w.x = pk_bf16(o[0], o[1]); w.y = pk_bf16(o[2], o[3]);
          *(u32x2*)(XN + (size_t)row * DM + c) = w;
        }
      }
    }
  }
}

namespace pg8 {
#define PG8_LAS __attribute__((address_space(3)))
typedef unsigned short bf16_t;
typedef short bf16x8 __attribute__((ext_vector_type(8)));
typedef float f32x4 __attribute__((ext_vector_type(4)));
typedef unsigned u32x4 __attribute__((ext_vector_type(4)));
constexpr int BM = 256, BK = 64, HALF = 128, HTB = HALF * BK * 2  , STAGE_BYTES = 8 * HTB, NXCD = 8, WGM = 8;

__host__ __device__ __forceinline__ int lds_byte(int r, int c) { const int st = (r >> 4) * 2 + (c >> 5), rr = r & 15, cc = c & 31, ob = rr * 64 + cc * 2; return st * 1024 + (ob ^ (((ob >> 9) & 1) << 5)); }
__host__ __device__ __forceinline__ void stage_rc(int b, int& R, int& C) { const int st = b / 1024, sb = b % 1024, swz = sb ^ (((sb >> 9) & 1) << 5); R = (st >> 1) * 16 + swz / 64; C = (st & 1) * 32 + (swz % 64) / 2; }
__host__ __device__ __forceinline__ int perm32(int rho) { const int n = rho >> 4, i = rho & 15; return 8 * (i >> 2) + 4 * n + (i & 3); }

struct Unit { int pm, pn; };
struct Gemm { const bf16_t* A; const bf16_t* Bt; int M, N, K, Kloop; };

struct StaticOrder {
    int nM, nN, nwg, G, c;
    __host__ __device__ void init(int M, int N, int G_, int c_) { nM = M / BM; nN = N / BM; nwg = nM * nN; G = G_; c = c_; }
    __host__ __device__ bool next(int i, Unit& u) const {
        const long L = (long)i * G + c; if (L >= nwg) return false;
        int wgid = (int)L; { const int q = nwg / NXCD, r = nwg % NXCD, xcd = wgid % NXCD, off = wgid / NXCD; wgid = (xcd < r ? xcd * (q + 1) : r * (q + 1) + (xcd - r) * q) + off; }
        const int nig = WGM * nN, gid = wgid / nig, fm = gid * WGM, gsz = (nM - fm) < WGM ? (nM - fm) : WGM;
        u.pm = fm + ((wgid % nig) % gsz); u.pn = (wgid % nig) / gsz; return true;
    }
    __device__ __forceinline__ void a_ready(const Unit&) const {}
    __device__ __forceinline__ void done(const Unit&) const {}
};


struct SplitOrder {
    int c;
    __host__ __device__ bool next(int i, Unit& u) const { if (i != 0 || c >= 128) return false; const int q = c & 31; u.pm = q & 7; u.pn = q >> 3; return true; }
    __device__ __forceinline__ void a_ready(const Unit&) const {}
    __device__ __forceinline__ void done(const Unit&) const {}
};
struct EpiPartial {
    static constexpr bool PERM = false, AFTER_DRAIN = false;
    float* P;
    __device__ __forceinline__ void operator()(const f32x4 (&acc)[2][2][4][2], const Unit& u, int wr, int wc, int fr, int fq) const {
        float* base = P + (size_t)u.pm * BM * 1024;
        const int col0 = u.pn * BM + wc * 32 + 4 * fq;
#pragma unroll
        for (int bj = 0; bj < 2; ++bj)
#pragma unroll
            for (int n = 0; n < 2; ++n)
#pragma unroll
                for (int ai = 0; ai < 2; ++ai)
#pragma unroll
                    for (int m = 0; m < 4; ++m) *(f32x4*)(base + (size_t)(ai * HALF + wr * 64 + m * 16 + fr) * 1024 + col0 + bj * HALF + n * 16) = acc[ai][bj][m][n];
    }
};
template <int ACT> struct EpiStore {
    static constexpr bool PERM = true, AFTER_DRAIN = false;
    bf16_t* O; int ldc; int ncols;
    __device__ __forceinline__ void operator()(const f32x4 (&acc)[2][2][4][2], const Unit& u, int wr, int wc, int fr, int fq) const {
        const int row0 = u.pm * BM + wr * 64 + fr, col0 = u.pn * BM + wc * 32 + 8 * fq;
#pragma unroll
        for (int ai = 0; ai < 2; ++ai)
#pragma unroll
            for (int m = 0; m < 4; ++m) { bf16_t* rowp = O + (size_t)(row0 + ai * HALF + m * 16) * ldc + col0;
#pragma unroll
                for (int bj = 0; bj < 2; ++bj) { if (col0 + bj * HALF < ncols) { f32x4 v0 = acc[ai][bj][m][0], v1 = acc[ai][bj][m][1];
                    if (ACT == 1) { v0 = __builtin_elementwise_max(v0, (f32x4){0.f, 0.f, 0.f, 0.f}); v1 = __builtin_elementwise_max(v1, (f32x4){0.f, 0.f, 0.f, 0.f}); v0 = v0 * v0; v1 = v1 * v1; }
                    u32x4 w; w.x = ::pk_bf16(v0[0], v0[1]); w.y = ::pk_bf16(v0[2], v0[3]); w.z = ::pk_bf16(v1[0], v1[1]); w.w = ::pk_bf16(v1[2], v1[3]);
                    *(u32x4*)(rowp + bj * HALF) = w; } } }
    }
};
struct EpiResid {
    static constexpr bool PERM = false, AFTER_DRAIN = false;
    const float* hin_m; const float* hin_c; float* hout_m; float* hout_c; const float* gate; float gscale;
    __device__ __forceinline__ void operator()(const f32x4 (&acc)[2][2][4][2], const Unit& u, int wr, int wc, int fr, int fq) const {
        const bool ismain = u.pm < 64;
        const float* hin = ismain ? hin_m + (size_t)u.pm * BM * 1024 : hin_c + (size_t)(u.pm - 64) * BM * 1024;
        float* hout = ismain ? hout_m + (size_t)u.pm * BM * 1024 : hout_c + (size_t)(u.pm - 64) * BM * 1024;
        const float* g = gate + (size_t)(ismain ? (u.pm >> 3) : 8) * 6144;
        const int col0 = u.pn * BM + wc * 32 + 4 * fq;
#pragma unroll
        for (int bj = 0; bj < 2; ++bj)
#pragma unroll
            for (int n = 0; n < 2; ++n) { const f32x4 gv = *(const f32x4*)(g + col0 + bj * HALF + n * 16) * gscale;
#pragma unroll
                for (int ai = 0; ai < 2; ++ai)
#pragma unroll
                    for (int m = 0; m < 4; ++m) { const size_t off = (size_t)(ai * HALF + wr * 64 + m * 16 + fr) * 1024 + col0 + bj * HALF + n * 16;
                        *(f32x4*)(hout + off) = *(const f32x4*)(hin + off) + gv * acc[ai][bj][m][n]; } }
    }
};
template <class Epi, class Sched, bool ALIGN_EPI = false, bool SP2 = false>
__device__ __forceinline__ void gemm_phase(PG8_LAS unsigned char* lds, const Gemm g, const Sched& S, const Epi& E) {
    const int tid = ::otid_full(), wid = __builtin_amdgcn_readfirstlane(tid >> 6), lane = tid & 63, wr = wid >> 2, wc = wid & 3, fr = lane & 15, fq = lane >> 4;
    const int K = g.K, nt = g.Kloop / BK;
    unsigned voffA[2], voffB[2];
#pragma unroll
    for (int i = 0; i < 2; ++i) { int R, C; stage_rc(tid * 16 + i * 8192, R, C); const int Rb = Epi::PERM ? ((R & ~31) + perm32(R & 31)) : R;
        voffA[i] = (unsigned)(R * K + C) * 2u; voffB[i] = (unsigned)(Rb * K + C) * 2u; }
    const size_t kstep = (size_t)(BK * 2);
    const size_t hstep = (size_t)HALF * K * 2;
    const size_t tstep = 2 * hstep;
    const unsigned ldsw = (unsigned)wid * 1024u;
    const int aoff = lds_byte(wr * 64 + fr, fq * 8), boff = lds_byte(wc * 32 + fr, fq * 8);
#define PG8_SA(b, h) (((b) * 2 + (h)) * HTB)
#define PG8_SB(b, h) ((4 + (b) * 2 + (h)) * HTB)
#define PG8_STAGE(bufoff, gbase, voff) do { _Pragma("unroll") for (int _i = 0; _i < 2; ++_i) \
        __builtin_amdgcn_global_load_lds((const unsigned*)((const char*)(gbase) + (voff)[_i]), (PG8_LAS unsigned*)(lds + (bufoff) + ldsw + _i * 8192), 16, 0, 0); } while (0)
#define PG8_LDA(dst, b, h) do { _Pragma("unroll") for (int m = 0; m < 4; ++m) _Pragma("unroll") for (int k = 0; k < 2; ++k) dst[m][k] = *(const PG8_LAS bf16x8*)(lds + PG8_SA(b, h) + aoff + m * 2048 + k * 1024); } while (0)
#define PG8_LDB(dst, b, h) do { _Pragma("unroll") for (int n = 0; n < 2; ++n) _Pragma("unroll") for (int k = 0; k < 2; ++k) dst[n][k] = *(const PG8_LAS bf16x8*)(lds + PG8_SB(b, h) + boff + n * 2048 + k * 1024); } while (0)
#define PG8_MMA(ai, bj, At, Bt) do { __builtin_amdgcn_s_setprio(1); _Pragma("unroll") for (int m = 0; m < 4; ++m) _Pragma("unroll") for (int n = 0; n < 2; ++n) _Pragma("unroll") for (int k = 0; k < 2; ++k) \
        acc[ai][bj][m][n] = __builtin_amdgcn_mfma_f32_16x16x32_bf16(Bt[n][k], At[m][k], acc[ai][bj][m][n], 0, 0, 0); __builtin_amdgcn_s_setprio(0); } while (0)
#define PG8_WAIT_V(n) asm volatile("s_waitcnt vmcnt(" #n ")" ::: "memory")
#define PG8_WAIT_L(n) asm volatile("s_waitcnt lgkmcnt(" #n ")" ::: "memory")
#define PG8_BAR __builtin_amdgcn_s_barrier()
#define PG8_SCHED __builtin_amdgcn_sched_barrier(0)
    Unit cur, nxt; int ui = 0;
    if (!S.next(0, cur)) return;
    f32x4 acc[2][2][4][2];
#pragma unroll
    for (int a = 0; a < 2; ++a)
#pragma unroll
        for (int b = 0; b < 2; ++b)
#pragma unroll
            for (int m = 0; m < 4; ++m)
#pragma unroll
                for (int n = 0; n < 2; ++n) acc[a][b][m][n] = (f32x4){0.f, 0.f, 0.f, 0.f};
    bf16x8 At[4][2], B0[2][2], B1[2][2];
    const char* cA = (const char*)g.A + (size_t)cur.pm * tstep; const char* cB = (const char*)g.Bt + (size_t)cur.pn * tstep;
    S.a_ready(cur);
    if constexpr (SP2) {
        PG8_STAGE(PG8_SB(0, 0), cB, voffB); PG8_STAGE(PG8_SB(0, 1), cB + hstep, voffB); PG8_STAGE(PG8_SA(0, 0), cA, voffA); PG8_STAGE(PG8_SA(0, 1), cA + hstep, voffA);
        if (wr == 1) PG8_BAR;
        PG8_WAIT_V(2); PG8_BAR;
        PG8_STAGE(PG8_SB(1, 0), cB + kstep, voffB); PG8_STAGE(PG8_SA(1, 0), cA + kstep, voffA); PG8_STAGE(PG8_SB(1, 1), cB + hstep + kstep, voffB);
        PG8_WAIT_V(6); PG8_BAR;
    } else {
        PG8_STAGE(PG8_SB(0, 0), cB, voffB); PG8_STAGE(PG8_SA(0, 0), cA, voffA); PG8_STAGE(PG8_SB(0, 1), cB + hstep, voffB); PG8_STAGE(PG8_SA(0, 1), cA + hstep, voffA);
        if (wr == 1) PG8_BAR;
        PG8_WAIT_V(4); PG8_BAR;
        PG8_STAGE(PG8_SB(1, 0), cB + kstep, voffB); PG8_STAGE(PG8_SA(1, 0), cA + kstep, voffA); PG8_STAGE(PG8_SB(1, 1), cB + hstep + kstep, voffB);
        PG8_WAIT_V(6); PG8_BAR;
    }
    for (;;) {
        const bool has_next = S.next(ui + 1, nxt);
        const char* nA = has_next ? (const char*)g.A + (size_t)nxt.pm * tstep : cA; const char* nB = has_next ? (const char*)g.Bt + (size_t)nxt.pn * tstep : cB;
        for (int t = 0; t < nt; t += 2) {
            const bool last = (t == nt - 2);
            const char* a1 = cA + (size_t)(t + 1) * kstep;
            const char* a2 = last ? nA : cA + (size_t)(t + 2) * kstep; const char* b2 = last ? nB : cB + (size_t)(t + 2) * kstep;
            const char* a3 = a2 + kstep; const char* b3 = b2 + kstep;
            if (last && has_next) S.a_ready(nxt);
            if constexpr (SP2) {
            PG8_LDB(B0, 0, 0); PG8_LDB(B1, 0, 1); PG8_SCHED; PG8_LDA(At, 0, 0); PG8_STAGE(PG8_SA(1, 1), a1 + hstep, voffA);
            PG8_WAIT_V(8); PG8_WAIT_L(0); PG8_BAR; PG8_MMA(0, 0, At, B0); PG8_MMA(0, 1, At, B1); PG8_BAR; PG8_SCHED;
            PG8_LDA(At, 0, 1); PG8_STAGE(PG8_SB(0, 0), b2, voffB); PG8_STAGE(PG8_SB(0, 1), b2 + hstep, voffB); PG8_STAGE(PG8_SA(0, 0), a2, voffA);
            PG8_WAIT_V(8); PG8_WAIT_L(0); PG8_BAR; PG8_MMA(1, 0, At, B0); PG8_MMA(1, 1, At, B1); PG8_BAR; PG8_SCHED;
            PG8_LDB(B0, 1, 0); PG8_LDB(B1, 1, 1); PG8_SCHED; PG8_LDA(At, 1, 0); PG8_STAGE(PG8_SA(0, 1), a2 + hstep, voffA);
            PG8_WAIT_V(8); PG8_WAIT_L(0); PG8_BAR; PG8_MMA(0, 0, At, B0); PG8_MMA(0, 1, At, B1); PG8_BAR; PG8_SCHED;
            PG8_LDA(At, 1, 1); PG8_STAGE(PG8_SB(1, 0), b3, voffB); PG8_STAGE(PG8_SB(1, 1), b3 + hstep, voffB); PG8_STAGE(PG8_SA(1, 0), a3, voffA);
            PG8_WAIT_V(8); PG8_WAIT_L(0); PG8_BAR; PG8_MMA(1, 0, At, B0); PG8_MMA(1, 1, At, B1); PG8_BAR; PG8_SCHED;
            } else {
            PG8_LDB(B0, 0, 0); PG8_SCHED; PG8_LDA(At, 0, 0); PG8_STAGE(PG8_SA(1, 1), a1 + hstep, voffA);
            PG8_WAIT_L(8); PG8_BAR; PG8_WAIT_L(0); PG8_MMA(0, 0, At, B0); PG8_BAR; PG8_SCHED;
            PG8_LDB(B1, 0, 1); PG8_STAGE(PG8_SB(0, 0), b2, voffB);
            PG8_BAR; PG8_WAIT_L(0); PG8_MMA(0, 1, At, B1); PG8_BAR;
            PG8_LDA(At, 0, 1); PG8_STAGE(PG8_SA(0, 0), a2, voffA);
            PG8_BAR; PG8_WAIT_L(0); PG8_MMA(1, 0, At, B0); PG8_BAR; PG8_SCHED;
            PG8_STAGE(PG8_SB(0, 1), b2 + hstep, voffB);
            PG8_WAIT_V(6); PG8_BAR; PG8_MMA(1, 1, At, B1); PG8_BAR;
            PG8_LDB(B0, 1, 0); PG8_SCHED; PG8_LDA(At, 1, 0); PG8_STAGE(PG8_SA(0, 1), a2 + hstep, voffA);
            PG8_WAIT_L(8); PG8_BAR; PG8_WAIT_L(0); PG8_MMA(0, 0, At, B0); PG8_BAR; PG8_SCHED;
            PG8_LDB(B1, 1, 1); PG8_STAGE(PG8_SB(1, 0), b3, voffB);
            PG8_BAR; PG8_WAIT_L(0); PG8_MMA(0, 1, At, B1); PG8_BAR;
            PG8_LDA(At, 1, 1); PG8_STAGE(PG8_SA(1, 0), a3, voffA);
            PG8_BAR; PG8_WAIT_L(0); PG8_MMA(1, 0, At, B0); PG8_BAR; PG8_SCHED;
            PG8_STAGE(PG8_SB(1, 1), b3 + hstep, voffB);
            PG8_WAIT_V(6); PG8_BAR; PG8_MMA(1, 1, At, B1); PG8_BAR;
            }
        }
        if constexpr (ALIGN_EPI) { if (wr == 0) PG8_BAR; }
        if constexpr (!Epi::AFTER_DRAIN) { E(acc, cur, wr, wc, fr, fq); S.done(cur); }
        if (!has_next) break;
#pragma unroll
        for (int a = 0; a < 2; ++a)
#pragma unroll
            for (int b = 0; b < 2; ++b)
#pragma unroll
                for (int m = 0; m < 4; ++m)
#pragma unroll
                    for (int n = 0; n < 2; ++n) acc[a][b][m][n] = (f32x4){0.f, 0.f, 0.f, 0.f};
        cur = nxt; cA = nA; cB = nB; ++ui;
        if constexpr (ALIGN_EPI) { if (wr == 1) PG8_BAR; }
    }
    PG8_WAIT_V(0);
    if constexpr (!ALIGN_EPI) { if (wr == 0) PG8_BAR; }
    PG8_BAR;
    if constexpr (Epi::AFTER_DRAIN) { E.fused(acc, cur, wr, wc, fr, fq, lds, wid, lane); S.done(cur); }
#undef PG8_SA
#undef PG8_SB
#undef PG8_STAGE
#undef PG8_LDA
#undef PG8_LDB
#undef PG8_MMA
#undef PG8_WAIT_V
#undef PG8_WAIT_L
#undef PG8_BAR
#undef PG8_SCHED
}
}

DI void prep_tile(const Params& p, int layer, int tile, int part, char* smem) {
  const int tid = otid(), lane = tid & 63, wave = tid >> 6, l31 = lane & 31, hi = lane >> 5;
  const int b = tile / 36, tb = tile % 36, p0 = tb * 64;
  const bool isctx = tb < 4;
  const int row0 = isctx ? (MROWS + b * CT + p0) : (b * SEQ + p0 - CT);
  const bf16_t* U = (const bf16_t*)(p.ws + OFF_U);
  const f32x2* ropeH = (const f32x2*)(p.ws + OFF_ROPEH);
  const f32x2* ropeD = (const f32x2*)(p.ws + OFF_ROPED);
  bf16_t* QD = (bf16_t*)(p.ws + OFF_QD); bf16_t* KD = (bf16_t*)(p.ws + OFF_KD); bf16_t* VTD = (bf16_t*)(p.ws + OFF_VTD);
  bf16_t* QG = (bf16_t*)(p.ws + OFF_QG); bf16_t* KG = (bf16_t*)(p.ws + OFF_KG); bf16_t* VTG = (bf16_t*)(p.ws + OFF_VTG);
  bf16_t* QM = (bf16_t*)(p.ws + OFF_QM); bf16_t* KM = (bf16_t*)(p.ws + OFF_KM); bf16_t* VTM = (bf16_t*)(p.ws + OFF_VTM);
  const float qsD = 0.17677669529663687f * LOG2E, qsG = 0.125f * LOG2E, qsM = 0.10206207261596575f * LOG2E;
  bf16_t* sT = (bf16_t*)smem; bf16_t* sCq = (bf16_t*)(smem + 9216); bf16_t* sCkv = (bf16_t*)(smem + 9216 + 25600);

  if (part == 0) {
#pragma unroll 1
  for (int i = 0; i < 4; ++i) {
    const int task = tid + 256 * i;
    if (task >= 15 * 64) break;
    const int g = task >> 6, tk = task & 63;
    const bf16_t* urow = U + (size_t)(row0 + tk) * INP;
    const int pos = p0 + tk, t = pos - CT;
    if (g < 14) {
      const bool isdiff = g < 8;
      const bool isq = isdiff ? (g < 4) : (g < 12);
      const int h = isdiff ? (g & 3) : (isq ? g - 8 : g - 12);
      const int col = isdiff ? ((isq ? U_DQ : U_DK) + h * 64) : ((isq ? U_GQ : U_GK) + h * 64);
      float x[64];
#pragma unroll
      for (int c = 0; c < 8; ++c) {
        const u32x4 v = *(const u32x4*)(urow + col + c * 8);
        x[c * 8 + 0] = bflo(v.x); x[c * 8 + 1] = bfhi(v.x); x[c * 8 + 2] = bflo(v.y); x[c * 8 + 3] = bfhi(v.y);
        x[c * 8 + 4] = bflo(v.z); x[c * 8 + 5] = bfhi(v.z); x[c * 8 + 6] = bflo(v.w); x[c * 8 + 7] = bfhi(v.w);
      }
      if (isdiff) {
        if (!isctx) {
#pragma unroll
          for (int m = 0; m < 2; ++m)
#pragma unroll
            for (int d = 0; d < 16; ++d) {
              const f32x2 cs = ropeD[t * 16 + d];
              const float x1 = x[m * 32 + d], x2 = x[m * 32 + 16 + d];
              x[m * 32 + d] = x1 * cs.x - x2 * cs.y; x[m * 32 + 16 + d] = x1 * cs.y + x2 * cs.x;
            }
        }
        const float sc_ = isq ? qsD : 1.f;
        bf16_t* dst = (isq ? QD : KD) + (((size_t)b * 8 + h * 2) * TT + pos) * 32;
#pragma unroll
        for (int m = 0; m < 2; ++m)
#pragma unroll
          for (int c = 0; c < 4; ++c) {
            u32x4 w; const int o = m * 32 + c * 8;
            w.x = pk_bf16(x[o] * sc_, x[o + 1] * sc_); w.y = pk_bf16(x[o + 2] * sc_, x[o + 3] * sc_); w.z = pk_bf16(x[o + 4] * sc_, x[o + 5] * sc_); w.w = pk_bf16(x[o + 6] * sc_, x[o + 7] * sc_);
            *(u32x4*)(dst + (size_t)m * TT * 32 + c * 8) = w;
          }
      } else {
        float ss = 0.f;
#pragma unroll
        for (int d = 0; d < 64; ++d) ss += x[d] * x[d];
        const float rstd = rsqrtf(ss * (1.f / 64.f) + EPS);
        const float* gn = (isq ? p.in[I_GQN] : p.in[I_GKN]) + layer * 64;
#pragma unroll
        for (int c = 0; c < 16; ++c) { const f32x4 gv = *(const f32x4*)(gn + c * 4); x[c * 4] *= rstd * gv[0]; x[c * 4 + 1] *= rstd * gv[1]; x[c * 4 + 2] *= rstd * gv[2]; x[c * 4 + 3] *= rstd * gv[3]; }
        if (!isctx) {
#pragma unroll
          for (int d = 0; d < 32; ++d) {
            const f32x2 cs = ropeH[t * 32 + d];
            const float x1 = x[d], x2 = x[32 + d];
            x[d] = x1 * cs.x - x2 * cs.y; x[32 + d] = x1 * cs.y + x2 * cs.x;
          }
        }
        const float sc_ = isq ? qsG : 1.f;
        bf16_t* dst = isq ? QG + (((size_t)b * 4 + h) * TT + pos) * 64 : KG + (((size_t)b * 2 + h) * TT + pos) * 64;
#pragma unroll
        for (int c = 0; c < 8; ++c) {
          u32x4 w; const int o = c * 8;
          w.x = pk_bf16(x[o] * sc_, x[o + 1] * sc_); w.y = pk_bf16(x[o + 2] * sc_, x[o + 3] * sc_); w.z = pk_bf16(x[o + 4] * sc_, x[o + 5] * sc_); w.w = pk_bf16(x[o + 6] * sc_, x[o + 7] * sc_);
          *(u32x4*)(dst + c * 8) = w;
        }
      }
    } else {
      float x[32];
#pragma unroll
      for (int c = 0; c < 4; ++c) {
        const u32x4 v = *(const u32x4*)(urow + U_MR + c * 8);
        x[c * 8 + 0] = bflo(v.x); x[c * 8 + 1] = bfhi(v.x); x[c * 8 + 2] = bflo(v.y); x[c * 8 + 3] = bfhi(v.y);
        x[c * 8 + 4] = bflo(v.z); x[c * 8 + 5] = bfhi(v.z); x[c * 8 + 6] = bflo(v.w); x[c * 8 + 7] = bfhi(v.w);
      }
      if (!isctx) {
#pragma unroll
        for (int d = 0; d < 16; ++d) {
          const f32x2 cs = ropeD[t * 16 + d];
          const float x1 = x[d], x2 = x[16 + d];
          x[d] = x1 * cs.x - x2 * cs.y; x[16 + d] = x1 * cs.y + x2 * cs.x;
        }
      }
      u32x4 w[4];
#pragma unroll
      for (int c = 0; c < 4; ++c) { const int o = c * 8; w[c].x = pk_bf16(x[o], x[o + 1]); w[c].y = pk_bf16(x[o + 2], x[o + 3]); w[c].z = pk_bf16(x[o + 4], x[o + 5]); w[c].w = pk_bf16(x[o + 6], x[o + 7]); }
#pragma unroll
      for (int hh = 0; hh < 4; ++hh)
#pragma unroll
        for (int c = 0; c < 4; ++c) *(u32x4*)(KM + (((size_t)b * 4 + hh) * TT + pos) * 96 + 64 + c * 8) = w[c];
    }
  }
  for (int g = 0; g < 6; ++g) {
    const int colbase = g < 4 ? U_DV + g * 64 : U_GV + (g - 4) * 64;
    bf16_t* dst = g < 4 ? VTD + ((size_t)(b * 4 + g) * 64) * TT : VTG + ((size_t)(b * 2 + g - 4) * 64) * TT;
#pragma unroll
    for (int i = 0; i < 2; ++i) {
      const int c = tid + 256 * i, tk0 = c >> 3, kc = c & 7;
      const u32x4 v = *(const u32x4*)(U + (size_t)(row0 + tk0) * INP + colbase + kc * 8);
      const int tk = (tk0 & ~12) | ((tk0 & 4) << 1) | ((tk0 & 8) >> 1);
      sT[(kc * 8 + 0) * 72 + tk] = (bf16_t)(v.x & 0xffff); sT[(kc * 8 + 1) * 72 + tk] = (bf16_t)(v.x >> 16);
      sT[(kc * 8 + 2) * 72 + tk] = (bf16_t)(v.y & 0xffff); sT[(kc * 8 + 3) * 72 + tk] = (bf16_t)(v.y >> 16);
      sT[(kc * 8 + 4) * 72 + tk] = (bf16_t)(v.z & 0xffff); sT[(kc * 8 + 5) * 72 + tk] = (bf16_t)(v.z >> 16);
      sT[(kc * 8 + 6) * 72 + tk] = (bf16_t)(v.w & 0xffff); sT[(kc * 8 + 7) * 72 + tk] = (bf16_t)(v.w >> 16);
    }
    __syncthreads();
    {
      const int dv = tid >> 2, part = tid & 3;
      const u32x4 a = *(const u32x4*)(sT + dv * 72 + part * 16), bq = *(const u32x4*)(sT + dv * 72 + part * 16 + 8);
      bf16_t* d = dst + (size_t)dv * TT + p0 + part * 16;
      *(u32x4*)d = a; *(u32x4*)(d + 8) = bq;
    }
    __syncthreads();
  }
  return;
  }
#pragma unroll 4
  for (int tk = wave; tk < 64; tk += 4) {
    const bf16_t* urow = U + (size_t)(row0 + tk) * INP;
    const float q0 = bf2f(urow[U_MQ + lane]), q1 = bf2f(urow[U_MQ + 64 + lane]), q2 = bf2f(urow[U_MQ + 128 + lane]);
    const float k0 = bf2f(urow[U_MKV + lane]), k1 = bf2f(urow[U_MKV + 64 + lane]);
    const float sq = wave_sum(q0 * q0 + q1 * q1 + q2 * q2), sk = wave_sum(k0 * k0 + k1 * k1);
    const float rq = rsqrtf(sq * (1.f / 192.f) + EPS), rk = rsqrtf(sk * (1.f / 128.f) + EPS);
    const float* gq = p.in[I_MQN] + layer * 192; const float* gk = p.in[I_MKVN] + layer * 128;
    sCq[tk * 200 + lane] = f2bf(q0 * rq * gq[lane]); sCq[tk * 200 + 64 + lane] = f2bf(q1 * rq * gq[64 + lane]); sCq[tk * 200 + 128 + lane] = f2bf(q2 * rq * gq[128 + lane]);
    sCkv[tk * 136 + lane] = f2bf(k0 * rk * gk[lane]); sCkv[tk * 136 + 64 + lane] = f2bf(k1 * rk * gk[64 + lane]);
  }
  __syncthreads();
  const bf16_t* Wkv = (const bf16_t*)(p.ws + OFF_WUKV) + (size_t)layer * 512 * 128;
  const bf16_t* Wq = (const bf16_t*)(p.ws + OFF_WUQ) + (size_t)layer * 384 * 192;
  for (int task = wave; task < 56; task += 4) {
    if (task < 32) {
      const int ct = task >> 1, tt = task & 1, head = ct >> 2, sub = ct & 3, n0 = head * 128 + sub * 32;
      f32x16 acc = zero16();
      const bf16_t* wrow = Wkv + (size_t)(n0 + l31) * 128 + hi * 8;
      const bf16_t* trow = sCkv + (tt * 32 + l31) * 136 + hi * 8;
      if (sub < 2) {
#pragma unroll
        for (int ks = 0; ks < 8; ++ks) acc = MFMA32(*(const bf16x8*)(wrow + ks * 16), *(const bf16x8*)(trow + ks * 16), acc);
        bf16_t* d = KM + (((size_t)b * 4 + head) * TT + p0 + tt * 32 + l31) * 96 + sub * 32 + 4 * hi;
#pragma unroll
        for (int r4 = 0; r4 < 4; ++r4) { u32x2 w; w.x = pk_bf16(acc[4 * r4], acc[4 * r4 + 1]); w.y = pk_bf16(acc[4 * r4 + 2], acc[4 * r4 + 3]); *(u32x2*)(d + 8 * r4) = w; }
      } else {
#pragma unroll
        for (int ks = 0; ks < 8; ++ks) acc = MFMA32(*(const bf16x8*)(trow + ks * 16), *(const bf16x8*)(wrow + ks * 16), acc);
        bf16_t* d = VTM + (((size_t)b * 4 + head) * 64 + (sub - 2) * 32 + l31) * TT + p0 + tt * 32;
#pragma unroll
        for (int r4 = 0; r4 < 4; ++r4) { u32x2 w; w.x = pk_bf16(acc[4 * r4], acc[4 * r4 + 1]); w.y = pk_bf16(acc[4 * r4 + 2], acc[4 * r4 + 3]);
          *(u32x2*)(d + 16 * (r4 >> 1) + 4 * (2 * hi + (r4 & 1))) = w; }
      }
    } else {
      const int t2 = task - 32, ct = t2 >> 1, tt = t2 & 1, head = ct / 3, sub = ct % 3, n0 = head * 96 + sub * 32;
      f32x16 acc = zero16();
      const bf16_t* wrow = Wq + (size_t)(n0 + l31) * 192 + hi * 8;
      const bf16_t* trow = sCq + (tt * 32 + l31) * 200 + hi * 8;
#pragma unroll
      for (int ks = 0; ks < 12; ++ks) acc = MFMA32(*(const bf16x8*)(wrow + ks * 16), *(const bf16x8*)(trow + ks * 16), acc);
      const int pos = p0 + tt * 32 + l31;
      if (sub == 2 && !isctx) {
        const int t = pos - CT;
#pragma unroll
        for (int r = 0; r < 8; ++r) {
          const f32x2 cs = ropeD[t * 16 + crow(r, hi)];
          const float x1 = acc[r], x2 = acc[r + 8];
          acc[r] = x1 * cs.x - x2 * cs.y; acc[r + 8] = x1 * cs.y + x2 * cs.x;
        }
      }
      bf16_t* d = QM + (((size_t)b * 4 + head) * TT + pos) * 96 + sub * 32 + 4 * hi;
#pragma unroll
      for (int r4 = 0; r4 < 4; ++r4) { u32x2 w; w.x = pk_bf16(acc[4 * r4] * qsM, acc[4 * r4 + 1] * qsM); w.y = pk_bf16(acc[4 * r4 + 2] * qsM, acc[4 * r4 + 3] * qsM); *(u32x2*)(d + 8 * r4) = w; }
    }
  }
  __syncthreads();
}

template <int DQK>
DI void attn_core(const bf16_t* __restrict__ Qb, const bf16_t* __restrict__ Kb, const bf16_t* __restrict__ Vt, int q0, int ntiles,
                  f32x16 (&O)[2], float& lsum, char* smem) {
  const int tid = otid_full(), lane = tid & 63, wave = tid >> 6, l31 = lane & 31, hi = lane >> 5;
  constexpr int KS = DQK / 16, KROW = DQK + 8, KCH = DQK / 8;
  constexpr int KBYTES = 64 * KROW * 2, BUFB = KBYTES + 9216;
  constexpr int NK = 64 * KCH, NKC = (NK + NTHREADS - 1) / NTHREADS;
  static_assert(2 * BUFB <= 49152, "attention LDS");
  bf16x8 qf[KS];
#pragma unroll
  for (int ks = 0; ks < KS; ++ks) qf[ks] = *(const bf16x8*)(Qb + (size_t)(q0 + wave * 32 + l31) * DQK + ks * 16 + hi * 8);
  float mrun = -1e30f; lsum = 0.f; O[0] = zero16(); O[1] = zero16();
  const bf16_t* kg[NKC]; int kl[NKC]; bool kok[NKC];
#pragma unroll
  for (int i = 0; i < NKC; ++i) {
    const int c = tid + NTHREADS * i, key = c / KCH, kc = c % KCH;
    kok[i] = c < NK;
    kg[i] = Kb + (size_t)key * DQK + kc * 8;
    kl[i] = (key * KROW + kc * 8) * 2;
  }
  const bf16_t* vg; int vl;
  { const int dv = tid >> 3, kc = tid & 7; vg = Vt + (size_t)dv * TT + kc * 8; vl = KBYTES + (dv * 72 + kc * 8) * 2; }
  u32x4 rk[NKC], rv;
#pragma unroll
  for (int i = 0; i < NKC; ++i) if (kok[i]) rk[i] = *(const u32x4*)(kg[i]);
  rv = *(const u32x4*)(vg);
#pragma unroll
  for (int i = 0; i < NKC; ++i) if (kok[i]) *(u32x4*)(smem + kl[i]) = rk[i];
  *(u32x4*)(smem + vl) = rv;
  __syncthreads();
  for (int kt = 0; kt < ntiles; ++kt) {
    const int cur = kt & 1; const bool more = kt + 1 < ntiles;
    if (more) {
#pragma unroll
      for (int i = 0; i < NKC; ++i) if (kok[i]) rk[i] = *(const u32x4*)(kg[i] + (size_t)(kt + 1) * 64 * DQK);
      rv = *(const u32x4*)(vg + (kt + 1) * 64);
    }
    const char* sb = smem + cur * BUFB;
    f32x16 s[2];
#pragma unroll
    for (int kb = 0; kb < 2; ++kb) {
      s[kb] = zero16();
      const char* kr = sb + ((kb * 32 + l31) * KROW + hi * 8) * 2;
#pragma unroll
      for (int ks = 0; ks < KS; ++ks) s[kb] = MFMA32(*(const bf16x8*)(kr + ks * 32), qf[ks], s[kb]);
    }
    float mx = s[0][0];
#pragma unroll
    for (int r = 0; r < 16; ++r) { mx = fmaxf(mx, s[0][r]); mx = fmaxf(mx, s[1][r]); }
    mx = fmaxf(mx, __shfl_xor(mx, 32));
    const float mnew = fmaxf(mrun, mx);
    const float alpha = __builtin_amdgcn_exp2f(mrun - mnew);
    mrun = mnew;
    float rs = 0.f;
#pragma unroll
    for (int kb = 0; kb < 2; ++kb)
#pragma unroll
      for (int r = 0; r < 16; ++r) { const float e = __builtin_amdgcn_exp2f(s[kb][r] - mnew); s[kb][r] = e; rs += e; }
    lsum = lsum * alpha + rs;
    O[0] *= alpha; O[1] *= alpha;
#pragma unroll
    for (int s4 = 0; s4 < 4; ++s4) {
      const int kb = s4 >> 1, hf = (s4 & 1) * 8;
      const bf16x8 pb = pack8(s[kb][hf + 0], s[kb][hf + 1], s[kb][hf + 2], s[kb][hf + 3], s[kb][hf + 4], s[kb][hf + 5], s[kb][hf + 6], s[kb][hf + 7]);
#pragma unroll
      for (int dvb = 0; dvb < 2; ++dvb) {
        const bf16x8 a = *(const bf16x8*)(sb + KBYTES + ((dvb * 32 + l31) * 72 + s4 * 16 + hi * 8) * 2);
        O[dvb] = MFMA32(a, pb, O[dvb]);
      }
    }
    if (more) {
      char* db = smem + (cur ^ 1) * BUFB;
#pragma unroll
      for (int i = 0; i < NKC; ++i) if (kok[i]) *(u32x4*)(db + kl[i]) = rk[i];
      *(u32x4*)(db + vl) = rv;
    }
    __syncthreads();
  }
  lsum += __shfl_xor(lsum, 32);
}

DI void attn_unit(const Params& p, int layer, int b, int kind, int head, int qb, char* smem) {
  const int tid_ = otid_full(); const int lane = tid_ & 63, wave = tid_ >> 6, l31 = lane & 31, hi = lane >> 5;
  const int q0 = qb * 256;
  const int ntiles = qb == 0 ? 4 : 36;
  bf16_t* Y = (bf16_t*)(p.ws + OFF_Y);
  const int pos = q0 + wave * 32 + l31;
  bf16_t* yrow = Y + (size_t)hrow_of(b, pos) * DM;
  f32x16 O[2]; float ls;
  if (kind == 1) {
    attn_core<32>((const bf16_t*)(p.ws + OFF_QD) + ((size_t)b * 8 + head * 2) * TT * 32, (const bf16_t*)(p.ws + OFF_KD) + ((size_t)b * 8 + head * 2) * TT * 32,
                  (const bf16_t*)(p.ws + OFF_VTD) + ((size_t)b * 4 + head) * 64 * TT, q0, ntiles, O, ls, smem);
    float* st = (float*)(smem + 49152) + tid_;
    {
      const float i0 = 1.f / ls;
#pragma unroll
      for (int dvb = 0; dvb < 2; ++dvb)
#pragma unroll
        for (int r = 0; r < 16; ++r) st[(dvb * 16 + r) * NTHREADS] = O[dvb][r] * i0;
    }
    __syncthreads();
    attn_core<32>((const bf16_t*)(p.ws + OFF_QD) + ((size_t)b * 8 + head * 2 + 1) * TT * 32, (const bf16_t*)(p.ws + OFF_KD) + ((size_t)b * 8 + head * 2 + 1) * TT * 32,
                  (const bf16_t*)(p.ws + OFF_VTD) + ((size_t)b * 4 + head) * 64 * TT, q0, ntiles, O, ls, smem);
    const float* misc = (const float*)(p.ws + OFF_MISC);
    const float lam = misc[128 + layer], li = misc[136 + layer];
    const float i1 = lam / ls;
    float ss = 0.f;
#pragma unroll
    for (int dvb = 0; dvb < 2; ++dvb)
#pragma unroll
      for (int r = 0; r < 16; ++r) { const float o = st[(dvb * 16 + r) * NTHREADS] - O[dvb][r] * i1; O[dvb][r] = o; ss += o * o; }
    ss += __shfl_xor(ss, 32);
    const float rstd = rsqrtf(ss * (1.f / 64.f) + EPS) * (1.f - li);
    const float* g = p.in[I_DNG] + layer * 64;
#pragma unroll
    for (int dvb = 0; dvb < 2; ++dvb)
#pragma unroll
      for (int r4 = 0; r4 < 4; ++r4) {
        const int dv = dvb * 32 + 8 * r4 + 4 * hi;
        const f32x4 gv = *(const f32x4*)(g + dv);
        u32x2 w; w.x = pk_bf16(O[dvb][4 * r4] * rstd * gv[0], O[dvb][4 * r4 + 1] * rstd * gv[1]);
        w.y = pk_bf16(O[dvb][4 * r4 + 2] * rstd * gv[2], O[dvb][4 * r4 + 3] * rstd * gv[3]);
        *(u32x2*)(yrow + 256 + head * 64 + dv) = w;
      }
  } else {
    int ycol;
    if (kind == 2) {
      attn_core<64>((const bf16_t*)(p.ws + OFF_QG) + ((size_t)b * 4 + head) * TT * 64, (const bf16_t*)(p.ws + OFF_KG) + ((size_t)b * 2 + (head >> 1)) * TT * 64,
                    (const bf16_t*)(p.ws + OFF_VTG) + ((size_t)b * 2 + (head >> 1)) * 64 * TT, q0, ntiles, O, ls, smem);
      ycol = 512 + head * 64;
    } else {
      attn_core<96>((const bf16_t*)(p.ws + OFF_QM) + ((size_t)b * 4 + head) * TT * 96, (const bf16_t*)(p.ws + OFF_KM) + ((size_t)b * 4 + head) * TT * 96,
                    (const bf16_t*)(p.ws + OFF_VTM) + ((size_t)b * 4 + head) * 64 * TT, q0, ntiles, O, ls, smem);
      ycol = 768 + head * 64;
    }
    const float inv = 1.f / ls;
#pragma unroll
    for (int dvb = 0; dvb < 2; ++dvb)
#pragma unroll
      for (int r4 = 0; r4 < 4; ++r4) {
        const int dv = dvb * 32 + 8 * r4 + 4 * hi;
        u32x2 w; w.x = pk_bf16(O[dvb][4 * r4] * inv, O[dvb][4 * r4 + 1] * inv); w.y = pk_bf16(O[dvb][4 * r4 + 2] * inv, O[dvb][4 * r4 + 3] * inv);
        *(u32x2*)(yrow + ycol + dv) = w;
      }
  }
}

DI void ssd_chunk(const Params& p, int layer, int item, char* smem) {
  const int tid = otid(), lane = tid & 63, wave = tid >> 6, l31 = lane & 31, hi = lane >> 5;
  const int pi = wave >> 1, li = wave & 1;
  const int ck = item % 36, r_ = item / 36, d = r_ & 1, g = (r_ >> 1) & 1, b = r_ >> 2, h = 2 * g + half_id(), chain = (b * 4 + h) * 2 + d;
  const bf16_t* U = (const bf16_t*)(p.ws + OFF_U);
  bf16_t* Yssd = (bf16_t*)(p.ws + OFF_XN) + (size_t)d * ROWS * 256;
  bf16_t* sXT = (bf16_t*)smem;
  bf16_t* sB = (bf16_t*)(smem + 9216);
  bf16_t* sC = (bf16_t*)(smem + 18432);
  bf16_t* sBT = (bf16_t*)(smem + 27648);
  float* scs = (float*)(smem + 46080);
  float* sdt = (float*)(smem + 46336);
  float* sW = (float*)(smem + 46592);
  const bool isctx = ck < 4;
  const int Len = isctx ? CT : SEQ, base = isctx ? (MROWS + b * CT) : (b * SEQ), kl = isctx ? ck : ck - 4;
  if (tid < 192) {
    const int cc = tid >> 6, e = tid & 63;
    const int ch = cc == 0 ? (h * 64 + e) : (cc == 1 ? 256 + g * 64 + e : 384 + g * 64 + e);
    const float* cw = p.in[I_CONVW] + ((size_t)layer * 512 + ch) * 3;
    sW[tid * 4 + 0] = cw[0]; sW[tid * 4 + 1] = cw[1]; sW[tid * 4 + 2] = cw[2]; sW[tid * 4 + 3] = p.in[I_CONVB][layer * 512 + ch];
  }
  const bool wrC = (half_id() == 0) && (d == 0);
  bf16_t* CB = (bf16_t*)(p.ws + OFF_CB);
  float raw_dt = 0.f;
  if (wave == 1) {
    const int posj = kl * 64 + lane, t = d ? (Len - 1 - posj) : posj;
    raw_dt = bf2f(U[(size_t)(base + t) * INP + U_DT + d * 4 + h]);
  }
  u32x4 vm6[6], v06[6], vp6[6];
#pragma unroll
  for (int i = 0; i < 6; ++i) {
    const int task = tid + 256 * i, j = task / 24, cc = task % 24;
    const int posj = kl * 64 + j, t = d ? (Len - 1 - posj) : posj;
    const int grp = cc >> 3, c8 = (cc & 7) * 8;
    const int ucol = grp == 0 ? (U_X + h * 64 + c8) : (grp == 1 ? U_B + g * 64 + c8 : U_C + g * 64 + c8);
    const bf16_t* up = U + (size_t)(base + t) * INP + ucol;
    const u32x4 z4 = {0u, 0u, 0u, 0u};
    vm6[i] = (t > 0) ? *(const u32x4*)(up - INP) : z4;
    v06[i] = *(const u32x4*)up;
    vp6[i] = (t < Len - 1) ? *(const u32x4*)(up + INP) : z4;
  }
  if (wave == 1) {
    const float dtb = p.in[I_DTB][layer * 8 + d * 4 + h];
    const float aneg = -expf(p.in[I_ALOG][layer * 8 + d * 4 + h]);
    const int posj = kl * 64 + lane, t = d ? (Len - 1 - posj) : posj;
    const float raw = raw_dt + dtb;
    const float e_ = __expf(-fabsf(raw));
    const float dtv = fmaxf(raw, 0.f) + (e_ < 0.03f ? e_ * (1.f - e_ * (0.5f - e_ * 0.33333334f)) : __logf(1.f + e_));
    float c = dtv * aneg;
#pragma unroll
    for (int o = 1; o < 64; o <<= 1) { const float tv = __shfl_up(c, o); if (lane >= o) c += tv; }
    sdt[lane] = dtv; scs[lane] = c;
    ((float*)(p.ws + OFF_ECL))[(size_t)(d * 4 + h) * ROWS + base + t] = __expf(c);
    if (lane == 63) ((float*)(p.ws + OFF_DEC))[chain * 36 + ck] = __expf(c);
  }
  __syncthreads();
  const float c63 = scs[63];
#pragma unroll
  for (int i = 0; i < 6; ++i) {
    const int task = tid + 256 * i, j = task / 24, cc = task % 24;
    const int posj = kl * 64 + j, t = d ? (Len - 1 - posj) : posj;
    const int grp = cc >> 3, c8 = (cc & 7) * 8;
    const u32x4 vm = vm6[i], v0 = v06[i], vp = vp6[i];
    float o[8];
#pragma unroll
    for (int e2 = 0; e2 < 4; ++e2) {
      const unsigned wm_ = e2 == 0 ? vm.x : e2 == 1 ? vm.y : e2 == 2 ? vm.z : vm.w;
      const unsigned w0_ = e2 == 0 ? v0.x : e2 == 1 ? v0.y : e2 == 2 ? v0.z : v0.w;
      const unsigned wp_ = e2 == 0 ? vp.x : e2 == 1 ? vp.y : e2 == 2 ? vp.z : vp.w;
      const f32x4 wa = *(const f32x4*)(sW + (grp * 64 + c8 + 2 * e2) * 4), wb = *(const f32x4*)(sW + (grp * 64 + c8 + 2 * e2 + 1) * 4);
      o[2 * e2] = silu_f(wa[0] * bflo(wm_) + wa[1] * bflo(w0_) + wa[2] * bflo(wp_) + wa[3]);
      o[2 * e2 + 1] = silu_f(wb[0] * bfhi(wm_) + wb[1] * bfhi(w0_) + wb[2] * bfhi(wp_) + wb[3]);
    }
    if (grp == 0) {
      const float dtv = sdt[j];
#pragma unroll
      for (int e = 0; e < 8; ++e) sXT[(c8 + e) * 72 + j] = f2bf(o[e] * dtv);
    } else if (grp == 1) {
      const float sc_ = __expf(c63 - scs[j]);
      u32x4 w; w.x = pk_bf16(o[0], o[1]); w.y = pk_bf16(o[2], o[3]); w.z = pk_bf16(o[4], o[5]); w.w = pk_bf16(o[6], o[7]);
      *(u32x4*)(sB + j * 72 + c8) = w;
#pragma unroll
      for (int e = 0; e < 8; ++e) sBT[(c8 + e) * 72 + j] = f2bf(o[e] * sc_);
    } else {
      u32x4 w; w.x = pk_bf16(o[0], o[1]); w.y = pk_bf16(o[2], o[3]); w.z = pk_bf16(o[4], o[5]); w.w = pk_bf16(o[6], o[7]);
      *(u32x4*)(sC + j * 72 + c8) = w;
      if (wrC) *(u32x4*)(CB + (size_t)(base + t) * 128 + g * 64 + c8) = w;
    }
  }
  __syncthreads();
  const int lcol = 32 * li + l31;
  const float cl = scs[lcol];
  f32x16 y = zero16();
#pragma unroll
  for (int si = 0; si < 2; ++si) {
    if (si <= li) {
      f32x16 gt = zero16();
#pragma unroll
      for (int ks = 0; ks < 4; ++ks) gt = MFMA32(*(const bf16x8*)(sB + (32 * si + l31) * 72 + ks * 16 + hi * 8), *(const bf16x8*)(sC + lcol * 72 + ks * 16 + hi * 8), gt);
#pragma unroll
      for (int r = 0; r < 16; ++r) { const int s_ = 32 * si + crow(r, hi); gt[r] = (s_ <= lcol) ? gt[r] * __expf(cl - scs[s_]) : 0.f; }
#pragma unroll
      for (int kk = 0; kk < 2; ++kk) {
        const bf16x8 pb = pack8(gt[8 * kk], gt[8 * kk + 1], gt[8 * kk + 2], gt[8 * kk + 3], gt[8 * kk + 4], gt[8 * kk + 5], gt[8 * kk + 6], gt[8 * kk + 7]);
        const bf16_t* xr = sXT + (32 * pi + l31) * 72 + 32 * si + 16 * kk + 4 * hi;
        const s16x4 lo = *(const s16x4*)xr, h4 = *(const s16x4*)(xr + 8);
        y = MFMA32(__builtin_shufflevector(lo, h4, 0, 1, 2, 3, 4, 5, 6, 7), pb, y);
      }
    }
  }
  {
    const int posl = kl * 64 + lcol, t = d ? (Len - 1 - posl) : posl;
    bf16_t* yp = Yssd + (size_t)(base + t) * 256 + h * 64 + 32 * pi + 4 * hi;
#pragma unroll
    for (int r4 = 0; r4 < 4; ++r4) { u32x2 o; o.x = pk_bf16(y[4 * r4], y[4 * r4 + 1]); o.y = pk_bf16(y[4 * r4 + 2], y[4 * r4 + 3]); *(u32x2*)(yp + 8 * r4) = o; }
  }
  f32x16 sacc = zero16();
#pragma unroll
  for (int ks = 0; ks < 4; ++ks) sacc = MFMA32(*(const bf16x8*)(sXT + (32 * pi + l31) * 72 + ks * 16 + hi * 8), *(const bf16x8*)(sBT + (32 * li + l31) * 72 + ks * 16 + hi * 8), sacc);
  bf16_t* Sp = (bf16_t*)(p.ws + OFF_SS) + ((size_t)chain * 37 + ck + 1) * 4096;
#pragma unroll
  for (int r = 0; r < 16; ++r) Sp[(32 * pi + crow(r, hi)) * 64 + 32 * li + l31] = f2bf(sacc[r]);
  __syncthreads();
}

DI void ssd_scan(const Params& p, int chain) {
  const int tid = otid();
  char* slot0 = p.ws + OFF_SS + (size_t)chain * 37 * 8192 + tid * 32;
  const float* dec = (const float*)(p.ws + OFF_DEC) + chain * 36;
  float H[16];
#pragma unroll
  for (int i = 0; i < 16; ++i) H[i] = 0.f;
#pragma unroll 4
  for (int c = 0; c < 36; ++c) {
    const u32x4* sp = (const u32x4*)(slot0 + (size_t)(c + 1) * 8192);
    const u32x4 s0 = sp[0], s1 = sp[1];
    const float dc = dec[c];
    u32x4 w0, w1;
    w0.x = pk_bf16(H[0], H[1]); w0.y = pk_bf16(H[2], H[3]); w0.z = pk_bf16(H[4], H[5]); w0.w = pk_bf16(H[6], H[7]);
    w1.x = pk_bf16(H[8], H[9]); w1.y = pk_bf16(H[10], H[11]); w1.z = pk_bf16(H[12], H[13]); w1.w = pk_bf16(H[14], H[15]);
    u32x4* hp = (u32x4*)(slot0 + (size_t)c * 8192);
    hp[0] = w0; hp[1] = w1;
    H[0] = H[0] * dc + bflo(s0.x); H[1] = H[1] * dc + bfhi(s0.x); H[2] = H[2] * dc + bflo(s0.y); H[3] = H[3] * dc + bfhi(s0.y);
    H[4] = H[4] * dc + bflo(s0.z); H[5] = H[5] * dc + bfhi(s0.z); H[6] = H[6] * dc + bflo(s0.w); H[7] = H[7] * dc + bfhi(s0.w);
    H[8] = H[8] * dc + bflo(s1.x); H[9] = H[9] * dc + bfhi(s1.x); H[10] = H[10] * dc + bflo(s1.y); H[11] = H[11] * dc + bfhi(s1.y);
    H[12] = H[12] * dc + bflo(s1.z); H[13] = H[13] * dc + bfhi(s1.z); H[14] = H[14] * dc + bflo(s1.w); H[15] = H[15] * dc + bfhi(s1.w);
  }
}

DI void ssd_finish_tile(const Params& p, int layer, int tile, char* smem) {
  const int tid = otid(), lane = tid & 63, wave = tid >> 6, l31 = lane & 31, hi = lane >> 5;
  const int b = tile / 72, tb = tile % 72, p0 = tb * 32;
  const bool isctx = tb < 8;
  const int row0 = isctx ? (MROWS + b * CT + p0) : (b * SEQ + p0 - CT);
  const int T64 = tb >> 1, nch = isctx ? 4 : 32, Tl = isctx ? T64 : T64 - 4;
  const bf16_t* U = (const bf16_t*)(p.ws + OFF_U);
  const bf16_t* Y0 = (const bf16_t*)(p.ws + OFF_XN); const bf16_t* Y1 = Y0 + (size_t)ROWS * 256;
  const float* ECL = (const float*)(p.ws + OFF_ECL);
  bf16_t* Y = (bf16_t*)(p.ws + OFF_Y);
  bf16_t* sCc = (bf16_t*)smem;
  float* sY = (float*)(smem + 8704);
  {
    const bf16_t* CB = (const bf16_t*)(p.ws + OFF_CB) + (size_t)row0 * 128;
#pragma unroll
    for (int i = 0; i < 2; ++i) { const int c = tid + 256 * i, r = c >> 4, kc = c & 15; *(u32x4*)(sCc + r * 136 + kc * 8) = *(const u32x4*)(CB + r * 128 + kc * 8); }
  }
  __syncthreads();
  {
    const int pi = wave & 1, g = wave >> 1;
    const int row = row0 + l31;
#pragma unroll
    for (int hh = 0; hh < 2; ++hh) {
      const int h = g * 2 + hh;
      f32x16 ys = zero16();
#pragma unroll
      for (int d = 0; d < 2; ++d) {
        const int kl = d ? (nch - 1 - Tl) : Tl, ck = isctx ? kl : 4 + kl, chain = (b * 4 + h) * 2 + d;
        const char* Hs = p.ws + OFF_SS + ((size_t)chain * 37 + ck) * 8192 + (32 * pi + l31) * 128 + hi * 16;
        f32x16 acc = zero16();
#pragma unroll
        for (int ks = 0; ks < 4; ++ks) acc = MFMA32(*(const bf16x8*)(Hs + ks * 32), *(const bf16x8*)(sCc + l31 * 136 + g * 64 + ks * 16 + hi * 8), acc);
        const float e = ECL[(size_t)(d * 4 + h) * ROWS + row];
        ys += acc * e;
      }
      const bf16_t* y0p = Y0 + (size_t)row * 256 + h * 64 + 32 * pi + 4 * hi; const bf16_t* y1p = Y1 + (size_t)row * 256 + h * 64 + 32 * pi + 4 * hi;
#pragma unroll
      for (int r4 = 0; r4 < 4; ++r4) {
        const u32x2 a_ = *(const u32x2*)(y0p + 8 * r4), c_ = *(const u32x2*)(y1p + 8 * r4);
        const f32x4 a = {bflo(a_.x), bfhi(a_.x), bflo(a_.y), bfhi(a_.y)}, c2 = {bflo(c_.x), bfhi(c_.x), bflo(c_.y), bfhi(c_.y)};
        f32x4 o; o[0] = ys[4 * r4] + a[0] + c2[0]; o[1] = ys[4 * r4 + 1] + a[1] + c2[1]; o[2] = ys[4 * r4 + 2] + a[2] + c2[2]; o[3] = ys[4 * r4 + 3] + a[3] + c2[3];
        *(f32x4*)(sY + l31 * 260 + h * 64 + 32 * pi + 8 * r4 + 4 * hi) = o;
      }
    }
  }
  __syncthreads();
  {
    const int ch = lane * 4, hd = lane >> 4;
    const float dsk = p.in[I_SSDD][layer * 8 + hd] + p.in[I_SSDD][layer * 8 + 4 + hd];
    f32x4 cw[3];
    {
      const float* w = p.in[I_CONVW] + ((size_t)layer * 512 + ch) * 3;
      const f32x4 a = *(const f32x4*)w, b2 = *(const f32x4*)(w + 4), c2 = *(const f32x4*)(w + 8);
      cw[0] = (f32x4){a[0], a[3], b2[2], c2[1]}; cw[1] = (f32x4){a[1], b2[0], b2[3], c2[2]}; cw[2] = (f32x4){a[2], b2[1], c2[0], c2[3]};
    }
    const f32x4 cb = *(const f32x4*)(p.in[I_CONVB] + layer * 512 + ch);
    const f32x4 ng = *(const f32x4*)(p.in[I_SSDNG] + layer * 256 + ch);
    const int Len = isctx ? CT : SEQ;
#pragma unroll 2
    for (int rr = wave; rr < 32; rr += 4) {
      const int row = row0 + rr;
      const int t = isctx ? (p0 + rr) : (p0 - CT + rr);
      const bf16_t* up = U + (size_t)row * INP;
      const u32x2 z2 = *(const u32x2*)(up + U_Z + ch);
      const u32x2 zz = {0u, 0u};
      const u32x2 xm = (t > 0) ? *(const u32x2*)(up - INP + U_X + ch) : zz;
      const u32x2 x0 = *(const u32x2*)(up + U_X + ch);
      const u32x2 xp = (t < Len - 1) ? *(const u32x2*)(up + INP + U_X + ch) : zz;
      const f32x4 xmf = {bflo(xm.x), bfhi(xm.x), bflo(xm.y), bfhi(xm.y)}, x0f = {bflo(x0.x), bfhi(x0.x), bflo(x0.y), bfhi(x0.y)}, xpf = {bflo(xp.x), bfhi(xp.x), bflo(xp.y), bfhi(xp.y)};
      const f32x4 zf = {bflo(z2.x), bfhi(z2.x), bflo(z2.y), bfhi(z2.y)};
      const f32x4 cv = cw[0] * xmf + cw[1] * x0f + cw[2] * xpf + cb;
      const f32x4 ya = *(const f32x4*)(sY + rr * 260 + ch);
      f32x4 gz; float ss = 0.f;
#pragma unroll
      for (int e = 0; e < 4; ++e) { const float xs = silu_f(cv[e]); const float yv = ya[e] + dsk * xs; gz[e] = yv * silu_f(zf[e]); ss += gz[e] * gz[e]; }
      ss = wave_sum(ss);
      const float rstd = rsqrtf(ss * (1.f / 256.f) + EPS);
      u32x2 w; w.x = pk_bf16(gz[0] * rstd * ng[0], gz[1] * rstd * ng[1]); w.y = pk_bf16(gz[2] * rstd * ng[2], gz[3] * rstd * ng[3]);
      *(u32x2*)(Y + (size_t)row * DM + ch) = w;
    }
  }
  __syncthreads();
}

DI void mixer_phase(const Params& p, int layer_c, char* smem, int* s_item) {
  const int layer = layer_c % DEPTH;
  const bool with_ctx = layer < DEPTH - 1;
  const int nqb = with_ctx ? 9 : 8;
  const int natt = 12 * nqb, nfin = with_ctx ? 36 : 32;
  const int nitems = 4 + natt + nfin;
  unsigned* cnt = (unsigned*)(p.ws + OFF_MISC) + layer_c * 8;
  unsigned* sdone = (unsigned*)(p.ws + OFF_MISC) + 72 + layer * 8;
  for (int qq = 0; qq < 8; ++qq) {
    const int q = (blockIdx.x + qq) & 7;
    for (;;) {
      if (threadIdx.x == 0) *s_item = (int)atomicAdd(&cnt[q], 1u);
      __syncthreads();
      const int it = *s_item;
      __syncthreads();
      if (it >= nitems) break;
      if (it < 4) {
        ssd_scan(p, q * 8 + it * 2 + half_id());
        asm volatile("s_waitcnt vmcnt(0)" ::: "memory");
        __syncthreads();
        if (threadIdx.x == 0) {
          __builtin_amdgcn_fence(__ATOMIC_RELEASE, "agent");
          asm volatile("s_waitcnt vmcnt(0)" ::: "memory");
          __hip_atomic_fetch_add(&sdone[q], 1u, __ATOMIC_RELAXED, __HIP_MEMORY_SCOPE_AGENT);
        }
      } else if (it < 4 + natt) {
        const int idx = it - 4;
        int kind, head, qb;
        if (idx < 96) { const int hidx = idx >> 3; qb = (idx & 7) + 1; const int ko = hidx >> 2; kind = ko == 0 ? 1 : (ko == 1 ? 0 : 2); head = hidx & 3; }
        else { const int hidx = idx - 96; qb = 0; const int ko = hidx >> 2; kind = ko == 0 ? 1 : (ko == 1 ? 0 : 2); head = hidx & 3; }
        attn_unit(p, layer, q, kind, head, qb, smem);
      } else {
        if (threadIdx.x == 0) {
          while (__hip_atomic_load(&sdone[q], __ATOMIC_RELAXED, __HIP_MEMORY_SCOPE_AGENT) < 4u) __builtin_amdgcn_s_sleep(2);
          __builtin_amdgcn_fence(__ATOMIC_ACQUIRE, "agent");
          asm volatile("s_waitcnt vmcnt(0)" ::: "memory");
        }
        __syncthreads();
        const int fi = it - 4 - natt;
        const int tile = q * 72 + (with_ctx ? 0 : 8) + fi * 2 + half_id();
        ssd_finish_tile(p, layer, tile, smem + half_id() * SMEM_BYTES);
      }
      __syncthreads();
    }
  }
}

#define XB_TMO      128
#define XB_XCNT(j)  (256  + 64 * (j))
#define XB_XSUB(j)  (1280 + 64 * (j))
#define XB_XGEN(j)  (2304 + 64 * (j))
#define XB_TOP      3328
#define XB_TOPGEN   3392
#define XCD_BAR_WORDS 3456
#define XB_SPIN_CAP (1u << 18)
#define LAS __attribute__((address_space(3)))

__device__ __forceinline__ unsigned xb_ld(unsigned* p)              { return __hip_atomic_load(p, __ATOMIC_RELAXED, __HIP_MEMORY_SCOPE_AGENT); }
__device__ __forceinline__ unsigned xb_add(unsigned* p, unsigned v) { return __hip_atomic_fetch_add(p, v, __ATOMIC_RELAXED, __HIP_MEMORY_SCOPE_AGENT); }
__device__ __forceinline__ unsigned xb_xcc_id() { return (unsigned)__builtin_amdgcn_s_getreg((3 << 11) | 20) & 0xFu; }
#define XB_SPIN(cond, bar) do { unsigned _sp = 0; while (cond) { __builtin_amdgcn_s_sleep(1); \
    if ((++_sp & 255u) == 0u) { if (xb_ld(&(bar)[XB_TMO])) break; if (_sp > XB_SPIN_CAP) { atomicAdd(&(bar)[XB_TMO], 1u); break; } } } } while (0)

struct XcdBarrier {
    unsigned* bar; unsigned x;
    volatile LAS unsigned* st;
};

__device__ __forceinline__ XcdBarrier xcd_barrier_post(unsigned* bar, volatile LAS unsigned* st) {
    XcdBarrier b; b.bar = bar; b.x = xb_xcc_id(); b.st = st;
    if (threadIdx.x == 0) (void)xb_add(&bar[XB_XCNT(b.x)], 1u);
    return b;
}
__device__ __forceinline__ void xcd_barrier_complete(unsigned* bar, unsigned x, unsigned& nloc, unsigned& nx) {
    const unsigned G = gridDim.x * gridDim.y * gridDim.z;
    unsigned sum, cnt, mine, sp = 0u;
    for (;;) {
        sum = 0u; cnt = 0u; mine = 0u;
#pragma unroll
        for (unsigned j = 0; j < 16; ++j) { const unsigned c = xb_ld(&bar[XB_XCNT(j)]); sum += c; cnt += (c > 0u) ? 1u : 0u; mine = (j == x) ? c : mine; }
        if (sum == G) break;
        __builtin_amdgcn_s_sleep(1);
        if ((++sp & 255u) == 0u) { if (xb_ld(&bar[XB_TMO])) break; if (sp > XB_SPIN_CAP) { atomicAdd(&bar[XB_TMO], 1u); break; } }
    }
    nloc = mine > 0u ? mine : 1u; nx = cnt > 0u ? cnt : 1u;
}

__device__ __forceinline__ void xcd_barrier(const XcdBarrier& b) {
    asm volatile("s_waitcnt vmcnt(0)" ::: "memory");
    __syncthreads();
    if (threadIdx.x == 0) {
        unsigned* bar = b.bar;
        __builtin_amdgcn_s_waitcnt(0);
        unsigned nloc = b.st[0], nx = b.st[1];
        if (nloc == 0u) { xcd_barrier_complete(bar, b.x, nloc, nx); b.st[0] = nloc; b.st[1] = nx; }
        const unsigned old = xb_add(&bar[XB_XSUB(b.x)], 1u);
        const unsigned gen = old / nloc;
        if (old + 1u == (gen + 1u) * nloc) {
            __builtin_amdgcn_fence(__ATOMIC_RELEASE, "agent");
            asm volatile("s_waitcnt vmcnt(0)" ::: "memory");
            const unsigned og = xb_add(&bar[XB_TOP], 1u);
            const unsigned tg = og / nx;
            if (og + 1u == (tg + 1u) * nx) xb_add(&bar[XB_TOPGEN], 1u);
            else XB_SPIN(xb_ld(&bar[XB_TOPGEN]) == tg, bar);
            __builtin_amdgcn_fence(__ATOMIC_ACQUIRE, "agent");
            xb_add(&bar[XB_XGEN(b.x)], 1u);
            asm volatile("s_waitcnt vmcnt(0)" ::: "memory");
        } else {
            XB_SPIN(xb_ld(&bar[XB_XGEN(b.x)]) == gen, bar);
            __builtin_amdgcn_fence(__ATOMIC_ACQUIRE, "agent");
            asm volatile("s_waitcnt vmcnt(0)" ::: "memory");
        }
    }
    __syncthreads();
}

DI void gbar(unsigned* bw, unsigned k) {
  asm volatile("s_waitcnt vmcnt(0)" ::: "memory");
  __syncthreads();
  if (threadIdx.x == 0) {
    __builtin_amdgcn_fence(__ATOMIC_RELEASE, "agent");
    asm volatile("s_waitcnt vmcnt(0)" ::: "memory");
    unsigned bx_ = blockIdx.x, gd_ = gridDim.x; asm volatile("" : "+s"(bx_), "+s"(gd_));
    const unsigned x = bx_ & 7u, nloc = (gd_ - x + 7u) >> 3;
    unsigned* sub = bw + 64 * (1 + x); unsigned* gen = bw + 64 * (9 + x); unsigned* top = bw + 64 * 17;
    const unsigned old = __hip_atomic_fetch_add(sub, 1u, __ATOMIC_RELAXED, __HIP_MEMORY_SCOPE_AGENT);
    if (old + 1u == k * nloc) {
      __hip_atomic_fetch_add(top, 1u, __ATOMIC_RELAXED, __HIP_MEMORY_SCOPE_AGENT);
      while (__hip_atomic_load(top, __ATOMIC_RELAXED, __HIP_MEMORY_SCOPE_AGENT) < 8u * k) __builtin_amdgcn_s_sleep(1);
      __hip_atomic_fetch_add(gen, 1u, __ATOMIC_RELAXED, __HIP_MEMORY_SCOPE_AGENT);
    } else {
      while (__hip_atomic_load(gen, __ATOMIC_RELAXED, __HIP_MEMORY_SCOPE_AGENT) < k) __builtin_amdgcn_s_sleep(1);
    }
    __builtin_amdgcn_fence(__ATOMIC_ACQUIRE, "agent");
    asm volatile("s_waitcnt vmcnt(0)" ::: "memory");
  }
  __syncthreads();
}

__global__ void __launch_bounds__(NTHREADS, 2) fwd_megakernel(Params p) {
  cg::grid_group grid = cg::this_grid();
  extern __shared__ __attribute__((aligned(16))) unsigned char lds_dyn[];
  __shared__ uint4 s_misc[2];
  int& s_item = *(int*)&s_misc[1];
  if (threadIdx.x == 0) s_misc[0] = make_uint4(0u, 0u, 0u, 0u);
  __syncthreads();
  (void)xcd_barrier_post((unsigned*)(p.ws + OFF_MISC + 16384), (volatile LAS unsigned*)&s_misc[0]);
#define GBAR() do { XcdBarrier xb_; xb_.bar = (unsigned*)(p.ws + OFF_MISC + 16384); xb_.x = xb_xcc_id(); xb_.st = (volatile LAS unsigned*)&s_misc[0]; xcd_barrier(xb_); } while (0)
  char* smem = (char*)lds_dyn;
  const int half = half_id();
  unsigned* bw = (unsigned*)(p.ws + OFF_MISC) + 256; unsigned bk = 0;
  phase0(p, smem);
  if (p.ws == nullptr) grid.sync();
  GBAR();
  mod_reduce(p);
  GBAR();
  const float* MOD = (const float*)(p.ws + OFF_MOD);
  bf16_t* XN = (bf16_t*)(p.ws + OFF_XN);
  bf16_t* U = (bf16_t*)(p.ws + OFF_U);
  bf16_t* Y = (bf16_t*)(p.ws + OFF_Y);
  bf16_t* HM = (bf16_t*)(p.ws + OFF_HM);
  float* HC = (float*)(p.ws + OFF_HC);
  PG8_LAS unsigned char* glds = (PG8_LAS unsigned char*)lds_dyn;
#pragma unroll 1
  for (int layer = 0; layer < DEPTH; ++layer) {
    const bool with_ctx = layer < DEPTH - 1;
    const int mrows = with_ctx ? ROWS : MROWS;
    int bx = (int)blockIdx.x; asm volatile("" : "+s"(bx));
    for (int rep = 0; rep < PROBE_N1; ++rep) { norm_phase(p, layer, 0, ROWS, layer > 0 ? MOD + (size_t)((layer - 1) * 9 + 8) * 6144 + 5120 : nullptr, HC);
    GBAR(); }
    for (int rep = 0; rep < PROBE_INPROJ; ++rep) { pg8::Gemm g{XN, (const bf16_t*)(p.ws + OFF_WIN) + (size_t)layer * INPW * DM, ROWS, INPW, DM, DM}; pg8::StaticOrder S; S.init(ROWS, INPW, (int)gridDim.x, bx);
      pg8::EpiStore<0> E{U, INP, INP};
      pg8::gemm_phase<pg8::EpiStore<0>, pg8::StaticOrder, true, true>(glds, g, S, E);
    GBAR(); }
    for (int rep = 0; rep < PROBE_PREP; ++rep) {
      unsigned* qc = (unsigned*)(p.ws + OFF_MISC) + 64 + layer + rep * DEPTH;
      for (;;) {
        if (threadIdx.x == 0) s_item = (int)atomicAdd(qc, 1u);
        __syncthreads();
        const int it = s_item;
        __syncthreads();
        if (it >= 1152 + 288) break;
        if (it < 144) prep_tile(p, layer, it * 2 + half, 0, smem + half * SMEM_BYTES);
        else if (it < 288) prep_tile(p, layer, (it - 144) * 2 + half, 1, smem + half * SMEM_BYTES);
        else ssd_chunk(p, layer, it - 288, smem + half * SMEM_BYTES);
      }
      GBAR();
    }
    for (int rep = 0; rep < PROBE_MIX; ++rep) { mixer_phase(p, layer + rep * DEPTH, smem, &s_item);
    GBAR(); }
    { const bf16_t* Wt = (const bf16_t*)(p.ws + OFF_WOUT) + (size_t)layer * DM * DM;
      { pg8::Gemm g{Y, Wt, MROWS, DM, DM, DM}; pg8::StaticOrder S; S.init(MROWS, DM, (int)gridDim.x, bx);
        pg8::EpiResid E{layer == 0 ? p.in[I_X] : p.out, nullptr, p.out, nullptr, MOD + (size_t)layer * 9 * 6144 + 2048, 1.f};
        pg8::gemm_phase<pg8::EpiResid, pg8::StaticOrder, true, true>(glds, g, S, E);
        for (int rep = 0; rep < PROBE_OUT; ++rep) { GBAR(); pg8::EpiResid E2{p.out, nullptr, p.out, nullptr, MOD + (size_t)layer * 9 * 6144 + 2048, 0.f}; pg8::gemm_phase<pg8::EpiResid, pg8::StaticOrder, true, true>(glds, g, S, E2); } }
      if (with_ctx) {
        const int ks = (bx >> 5) & 3;
        pg8::Gemm g{Y + (size_t)MROWS * DM + ks * (DM / 4), Wt + ks * (DM / 4), CROWS, DM, DM, DM / 4}; pg8::SplitOrder S{bx};
        pg8::EpiPartial E{(float*)(p.ws + OFF_SS) + (size_t)ks * CROWS * DM};
        pg8::gemm_phase<pg8::EpiPartial, pg8::SplitOrder, true, true>(glds, g, S, E); } }
    GBAR();
    norm_phase(p, layer, 1, mrows, with_ctx ? MOD + (size_t)(layer * 9 + 8) * 6144 + 2048 : nullptr, layer == 0 ? p.in[I_CTX] : HC);
    GBAR();
    for (int rep = 0; rep < PROBE_UP; ++rep) { pg8::Gemm g{XN, (const bf16_t*)(p.ws + OFF_W1) + (size_t)layer * DFF * DM, mrows, DFF, DM, DM}; pg8::StaticOrder S; S.init(mrows, DFF, (int)gridDim.x, bx);
      pg8::EpiStore<1> E{HM, DFF, DFF};
      pg8::gemm_phase<pg8::EpiStore<1>, pg8::StaticOrder, true, true>(glds, g, S, E);
    GBAR(); }
    { const bf16_t* Wt = (const bf16_t*)(p.ws + OFF_W2) + (size_t)layer * DM * DFF;
      { pg8::Gemm g{HM, Wt, MROWS, DM, DFF, DFF}; pg8::StaticOrder S; S.init(MROWS, DM, (int)gridDim.x, bx);
        pg8::EpiResid E{p.out, nullptr, p.out, nullptr, MOD + (size_t)layer * 9 * 6144 + 5120, 1.f};
        pg8::gemm_phase<pg8::EpiResid, pg8::StaticOrder, true, true>(glds, g, S, E);
        for (int rep = 0; rep < PROBE_DOWN; ++rep) { GBAR(); pg8::EpiResid E2{p.out, nullptr, p.out, nullptr, MOD + (size_t)layer * 9 * 6144 + 5120, 0.f}; pg8::gemm_phase<pg8::EpiResid, pg8::StaticOrder, true, true>(glds, g, S, E2); } }
      if (with_ctx) {
        const int ks = (bx >> 5) & 3;
        pg8::Gemm g{HM + (size_t)MROWS * DFF + ks * (DFF / 4), Wt + ks * (DFF / 4), CROWS, DM, DFF, DFF / 4}; pg8::SplitOrder S{bx};
        pg8::EpiPartial E{(float*)(p.ws + OFF_SS) + (size_t)ks * CROWS * DM};
        pg8::gemm_phase<pg8::EpiPartial, pg8::SplitOrder, true, true>(glds, g, S, E); } }
    GBAR();
  }
  norm_phase(p, 0, 2, MROWS);
}

extern "C" void kernel_launch(void* const* d_in, const int* in_sizes, int n_in, void* d_out, int out_size, void* d_ws, size_t ws_size, hipStream_t stream) {
  static int grid_blocks = 0;
  if (!grid_blocks) {
    int dev = 0, cus = 0, per_cu = 0;
    (void)hipGetDevice(&dev);
    (void)hipDeviceGetAttribute(&cus, hipDeviceAttributeMultiprocessorCount, dev);
    if (hipFuncSetAttribute((const void*)fwd_megakernel, hipFuncAttributeMaxDynamicSharedMemorySize, LDS_BYTES) != hipSuccess) fprintf(stderr, "hipFuncSetAttribute(max dynamic LDS) failed\n");
    (void)hipOccupancyMaxActiveBlocksPerMultiprocessor(&per_cu, (const void*)fwd_megakernel, NTHREADS, LDS_BYTES);
    if (per_cu < 1) { fprintf(stderr, "occupancy query says %d blocks/CU\n", per_cu); per_cu = 1; }
    grid_blocks = cus;
  }
  if (ws_size < OFF_END) { fprintf(stderr, "workspace too small: %zu < %zu\n", ws_size, (size_t)OFF_END); return; }
  Params p{};
  for (int i = 0; i < 27; ++i) p.in[i] = (const float*)d_in[i];
  p.out = (float*)d_out;
  p.ws = (char*)d_ws;
  (void)hipMemsetAsync((char*)d_ws + OFF_MISC, 0, SZ_MISC, stream);
  void* args[] = {&p};
  hipError_t e = hipLaunchCooperativeKernel((void*)fwd_megakernel, dim3(grid_blocks), dim3(NTHREADS), args, LDS_BYTES, stream);
  if (e != hipSuccess) fprintf(stderr, "cooperative launch failed: %s (grid %d)\n", hipGetErrorString(e), grid_blocks);
}
```

```cpp
#include <hip/hip_runtime.h>
#include <hip/hip_cooperative_groups.h>
#include <stdint.h>
#include <cstdio>
namespace cg = cooperative_groups;

typedef unsigned short bf16_t;
typedef short bf16x8 __attribute__((ext_vector_type(8)));
typedef short s16x4 __attribute__((ext_vector_type(4)));
typedef float f32x16 __attribute__((ext_vector_type(16)));
typedef float f32x4 __attribute__((ext_vector_type(4)));
typedef float f32x2 __attribute__((ext_vector_type(2)));
typedef unsigned u32x4 __attribute__((ext_vector_type(4)));
typedef unsigned u32x2 __attribute__((ext_vector_type(2)));
typedef __bf16 bf2_t __attribute__((ext_vector_type(2)));

#define DI __device__ __forceinline__
#define MFMA32(a, b, c) __builtin_amdgcn_mfma_f32_32x32x16_bf16((a), (b), (c), 0, 0, 0)

constexpr int DM = 1024, NB = 8, SEQ = 2048, DEPTH = 4, CT = 256, TT = 2304;
constexpr int MROWS = NB * SEQ, CROWS = NB * CT, ROWS = MROWS + CROWS;
constexpr int INC = 2408, INP = 2432, INPW = 2560, DFF = 4096;
constexpr float EPS = 1e-6f;
constexpr float LOG2E = 1.4426950408889634f;
constexpr int U_Z = 0, U_X = 256, U_B = 512, U_C = 640, U_DT = 768;
constexpr int U_DQ = 776, U_DK = 1032, U_DV = 1288;
constexpr int U_GQ = 1544, U_GK = 1800, U_GV = 1928;
constexpr int U_MQ = 2056, U_MKV = 2248, U_MR = 2376;

constexpr size_t al256(size_t x) { return (x + 255) & ~(size_t)255; }
constexpr size_t SZ_WIN = (size_t)DEPTH * INPW * DM * 2;
constexpr size_t SZ_WOUT = (size_t)DEPTH * DM * DM * 2;
constexpr size_t SZ_W1 = (size_t)DEPTH * DFF * DM * 2;
constexpr size_t SZ_W2 = (size_t)DEPTH * DM * DFF * 2;
constexpr size_t SZ_WUQ = (size_t)DEPTH * 384 * 192 * 2;
constexpr size_t SZ_WUKV = (size_t)DEPTH * 512 * 128 * 2;
constexpr size_t SZ_MOD = (size_t)DEPTH * 9 * 6144 * 4;
constexpr size_t SZ_MISC = 32768;
constexpr size_t SZ_ROPEH = (size_t)SEQ * 32 * 8;
constexpr size_t SZ_ROPED = (size_t)SEQ * 16 * 8;
constexpr size_t SZ_HC = (size_t)CROWS * DM * 4;
constexpr size_t SZ_XN = (size_t)ROWS * DM * 2;
constexpr size_t SZ_U = (size_t)ROWS * INP * 2;
constexpr size_t SZ_QD = (size_t)NB * 8 * TT * 32 * 2;
constexpr size_t SZ_VT4 = (size_t)NB * 4 * 64 * TT * 2;
constexpr size_t SZ_QG = (size_t)NB * 4 * TT * 64 * 2;
constexpr size_t SZ_KG = (size_t)NB * 2 * TT * 64 * 2;
constexpr size_t SZ_QM = (size_t)NB * 4 * TT * 96 * 2;
constexpr size_t SZ_Y = (size_t)ROWS * DM * 2;

constexpr size_t OFF_MOD = 0;
constexpr size_t OFF_MISC = OFF_MOD + al256(SZ_MOD);
constexpr size_t OFF_WIN = OFF_MISC + SZ_MISC;
constexpr size_t OFF_WOUT = OFF_WIN + al256(SZ_WIN);
constexpr size_t OFF_W1 = OFF_WOUT + al256(SZ_WOUT);
constexpr size_t OFF_W2 = OFF_W1 + al256(SZ_W1);
constexpr size_t OFF_WUQ = OFF_W2 + al256(SZ_W2);
constexpr size_t OFF_WUKV = OFF_WUQ + al256(SZ_WUQ);
constexpr size_t OFF_ROPEH = OFF_WUKV + al256(SZ_WUKV);
constexpr size_t OFF_ROPED = OFF_ROPEH + al256(SZ_ROPEH);
constexpr size_t OFF_HC = OFF_ROPED + al256(SZ_ROPED);
constexpr size_t OFF_XN = OFF_HC + al256(SZ_HC);
constexpr size_t OFF_BIG = OFF_XN + al256(SZ_XN);
constexpr size_t OFF_U = OFF_BIG;
constexpr size_t OFF_QD = OFF_U + al256(SZ_U);
constexpr size_t OFF_KD = OFF_QD + al256(SZ_QD);
constexpr size_t OFF_VTD = OFF_KD + al256(SZ_QD);
constexpr size_t OFF_QG = OFF_VTD + al256(SZ_VT4);
constexpr size_t OFF_KG = OFF_QG + al256(SZ_QG);
constexpr size_t OFF_VTG = OFF_KG + al256(SZ_KG);
constexpr size_t OFF_QM = OFF_VTG + al256(SZ_KG);
constexpr size_t OFF_KM = OFF_QM + al256(SZ_QM);
constexpr size_t OFF_VTM = OFF_KM + al256(SZ_QM);
constexpr size_t OFF_Y = OFF_VTM + al256(SZ_VT4);
constexpr size_t SZ_SS = (size_t)64 * 37 * 16384;
constexpr size_t SZ_DEC = (size_t)64 * 36 * 4;
constexpr size_t SZ_ECL = (size_t)8 * ROWS * 4;
constexpr size_t SZ_CB = (size_t)ROWS * 128 * 2;
constexpr size_t OFF_SS = OFF_Y + al256(SZ_Y);
constexpr size_t OFF_DEC = OFF_SS + al256(SZ_SS);
constexpr size_t OFF_ECL = OFF_DEC + al256(SZ_DEC);
constexpr size_t OFF_CB = OFF_ECL + al256(SZ_ECL);
constexpr size_t OFF_END = OFF_CB + al256(SZ_CB);
static_assert(OFF_END <= (size_t)402653184, "workspace budget (4 x mod_w)");
constexpr size_t OFF_HM = OFF_BIG;
static_assert((size_t)ROWS * DFF * 2 <= OFF_Y - OFF_BIG, "HM overlay must not reach Y");
static_assert((size_t)2 * ROWS * 256 * 4 <= SZ_XN, "Yssd overlay");

struct Params {
  const float* in[27];
  float* out;
  char* ws;
};
enum { I_X = 0, I_C, I_CTX, I_CCTX, I_MODW, I_MODB, I_N1G, I_N2G, I_WIN, I_CONVW, I_CONVB, I_DTB, I_ALOG, I_SSDD, I_SSDNG,
       I_DLAM, I_DNG, I_GQN, I_GKN, I_MQN, I_MKVN, I_WUQ, I_WUKV, I_WOUT, I_W1, I_W2, I_FNG };

constexpr int SMEM_BYTES = 65536;
constexpr int LDS_BYTES = 131072, NTHREADS = 512;
#ifndef PROBE_DOWN
#define PROBE_DOWN 0
#endif
#ifndef PROBE_OUT
#define PROBE_OUT 0
#endif
#ifndef PROBE_P0
#define PROBE_P0 1
#endif
#ifndef PROBE_N1
#define PROBE_N1 1
#endif
#ifndef PROBE_FIN
#define PROBE_FIN 1
#endif
#ifndef PROBE_UP
#define PROBE_UP 1
#endif
#ifndef PROBE_PREP
#define PROBE_PREP 1
#endif
#ifndef PROBE_MIX
#define PROBE_MIX 1
#endif
#ifndef PROBE_INPROJ
#define PROBE_INPROJ 1
#endif

DI unsigned pk_bf16(float a, float b) { f32x2 v = {a, b}; bf2_t r = __builtin_convertvector(v, bf2_t); return __builtin_bit_cast(unsigned, r); }
DI bf16_t f2bf(float a) { return (bf16_t)(pk_bf16(a, 0.f) & 0xffffu); }
DI float bf2f(bf16_t v) { return __uint_as_float((unsigned)v << 16); }
DI float bflo(unsigned w) { return __uint_as_float(w << 16); }
DI float bfhi(unsigned w) { return __uint_as_float(w & 0xffff0000u); }
DI float silu_f(float x) { return x / (1.f + __expf(-x)); }
DI float wave_sum(float v) {
#pragma unroll
  for (int o = 32; o >= 1; o >>= 1) v += __shfl_xor(v, o);
  return v;
}
DI int crow(int r, int hi) { return (r & 3) + 8 * (r >> 2) + 4 * hi; }
DI bf16x8 pack8(float a0, float a1, float a2, float a3, float a4, float a5, float a6, float a7) {
  u32x4 p; p.x = pk_bf16(a0, a1); p.y = pk_bf16(a2, a3); p.z = pk_bf16(a4, a5); p.w = pk_bf16(a6, a7);
  return __builtin_bit_cast(bf16x8, p);
}
DI f32x16 zero16() { f32x16 z;
#pragma unroll
  for (int i = 0; i < 16; ++i) z[i] = 0.f;
  return z; }
DI int otid() { int t = threadIdx.x & 255; asm volatile("" : "+v"(t)); return t; }
DI int otid_full() { int t = threadIdx.x; asm volatile("" : "+v"(t)); return t; }
DI int half_id() { return __builtin_amdgcn_readfirstlane((int)threadIdx.x >> 8); }
DI int hrow_of(int b, int pos) { return pos < CT ? (MROWS + b * CT + pos) : (b * SEQ + pos - CT); }

DI void tconv_tile(const float* __restrict__ src, int K, int N, bf16_t* __restrict__ dst, int kt, int nt, unsigned* sT) {
  const int tid = otid();
#pragma unroll
  for (int p = 0; p < 2; ++p) {
    const int idx = tid + 256 * p, kp = idx >> 4, nc = idx & 15;
    const int k = kt * 64 + 2 * kp, n = nt * 64 + nc * 4;
    f32x4 v0 = {0.f, 0.f, 0.f, 0.f}, v1 = {0.f, 0.f, 0.f, 0.f};
    if (n < N) { v0 = *(const f32x4*)(src + (size_t)k * N + n); v1 = *(const f32x4*)(src + (size_t)(k + 1) * N + n); }
#pragma unroll
    for (int e = 0; e < 4; ++e) sT[(nc * 4 + e) * 33 + kp] = pk_bf16(v0[e], v1[e]);
  }
  __syncthreads();
  {
    const int n = tid >> 2, part = tid & 3;
    u32x4 a, b;
    const unsigned* s = sT + n * 33 + part * 8;
    a.x = s[0]; a.y = s[1]; a.z = s[2]; a.w = s[3]; b.x = s[4]; b.y = s[5]; b.z = s[6]; b.w = s[7];
    bf16_t* d = dst + (size_t)(nt * 64 + n) * K + kt * 64 + part * 16;
    *(u32x4*)d = a; *(u32x4*)(d + 8) = b;
  }
  __syncthreads();
}

DI void mod_task(const Params& p, int task, float* sCond) {
  const int tid = otid();
  const int ks = task & 7, cb = (task >> 3) % 24, l = task / 192;
  for (int i = tid; i < 9 * 128; i += 256) {
    const int r = i >> 7, kk = i & 127;
    const float v = (r < 8) ? p.in[I_C][r * DM + ks * 128 + kk] : p.in[I_CCTX][ks * 128 + kk];
    sCond[i] = silu_f(v);
  }
  __syncthreads();
  const int col = cb * 256 + tid;
  const float* w = p.in[I_MODW] + ((size_t)l * DM + ks * 128) * 6144 + col;
  float acc[9];
#pragma unroll
  for (int r = 0; r < 9; ++r) acc[r] = 0.f;
#pragma unroll 8
  for (int kk = 0; kk < 128; ++kk) {
    const float wv = w[(size_t)kk * 6144];
#pragma unroll
    for (int r = 0; r < 9; ++r) acc[r] += sCond[r * 128 + kk] * wv;
  }
  const float bias = (ks == 0) ? p.in[I_MODB][l * 6144 + col] : 0.f;
  float* MODP = (float*)(p.ws + OFF_Y) + (size_t)ks * (DEPTH * 9 * 6144);
#pragma unroll
  for (int r = 0; r < 9; ++r) MODP[(size_t)(l * 9 + r) * 6144 + col] = acc[r] + bias;
  __syncthreads();
}

DI void phase0(const Params& p, char* smem) {
  constexpr int T_WIN = DEPTH * 16 * 38, T_WOUT = DEPTH * 16 * 16, T_W1 = DEPTH * 16 * 64, T_W2 = DEPTH * 64 * 16;
  constexpr int T_UQ = DEPTH * 3 * 6, T_UKV = DEPTH * 2 * 8, T_MOD = 768, T_ROPE = (SEQ * 48) / 256, T_MISC = 1;
  constexpr int E0 = T_WIN, E1 = E0 + T_WOUT, E2 = E1 + T_W1, E3 = E2 + T_W2, E4 = E3 + T_UQ, E5 = E4 + T_UKV, E6 = E5 + T_MOD, E7 = E6 + T_ROPE, E8 = E7 + T_MISC;
  const int tid = otid();
  const int half = half_id(); smem += half * SMEM_BYTES;
  static_assert(E0 % 2 == 0 && E1 % 2 == 0 && E2 % 2 == 0 && E3 % 2 == 0 && E4 % 2 == 0 && E5 % 2 == 0 && E6 % 2 == 0 && E7 % 2 == 0, "half-block pairs must not straddle task types");
  for (int t0 = blockIdx.x * 2; t0 < E8; t0 += gridDim.x * 2) {
    const int t = t0 + half;
    if (t >= E8) break;
    if (t < E0) { const int l = t / (16 * 38), r = t % (16 * 38); tconv_tile(p.in[I_WIN] + (size_t)l * DM * INC, DM, INC, (bf16_t*)(p.ws + OFF_WIN) + (size_t)l * INPW * DM, r / 38, r % 38, (unsigned*)smem); }
    else if (t < E1) { const int u = t - E0, l = u / 256, r = u % 256; tconv_tile(p.in[I_WOUT] + (size_t)l * DM * DM, DM, DM, (bf16_t*)(p.ws + OFF_WOUT) + (size_t)l * DM * DM, r / 16, r % 16, (unsigned*)smem); }
    else if (t < E2) { const int u = t - E1, l = u / 1024, r = u % 1024; tconv_tile(p.in[I_W1] + (size_t)l * DM * DFF, DM, DFF, (bf16_t*)(p.ws + OFF_W1) + (size_t)l * DFF * DM, r / 64, r % 64, (unsigned*)smem); }
    else if (t < E3) { const int u = t - E2, l = u / 1024, r = u % 1024; tconv_tile(p.in[I_W2] + (size_t)l * DFF * DM, DFF, DM, (bf16_t*)(p.ws + OFF_W2) + (size_t)l * DM * DFF, r / 16, r % 16, (unsigned*)smem); }
    else if (t < E4) { const int u = t - E3, l = u / 18, r = u % 18; tconv_tile(p.in[I_WUQ] + (size_t)l * 192 * 384, 192, 384, (bf16_t*)(p.ws + OFF_WUQ) + (size_t)l * 384 * 192, r / 6, r % 6, (unsigned*)smem); }
    else if (t < E5) { const int u = t - E4, l = u / 16, r = u % 16; tconv_tile(p.in[I_WUKV] + (size_t)l * 128 * 512, 128, 512, (bf16_t*)(p.ws + OFF_WUKV) + (size_t)l * 512 * 128, r / 8, r % 8, (unsigned*)smem); }
    else if (t < E6) { mod_task(p, t - E5, (float*)smem); }
    else if (t < E7) {
      const int idx = (t - E6) * 256 + tid;
      int tt, i, nf; f32x2* dst;
      if (idx < SEQ * 32) { tt = idx >> 5; i = idx & 31; nf = 16; dst = (f32x2*)(p.ws + OFF_ROPEH) + idx; }
      else { const int j = idx - SEQ * 32; tt = j >> 4; i = j & 15; nf = 8; dst = (f32x2*)(p.ws + OFF_ROPED) + j; }
      const int f = i & (nf - 1);
      const float pos = (float)((i < nf) ? (tt >> 6) : (tt & 63));
      const float inv = exp2f(-(float)f * (13.287712379549449f / (float)nf));
      float rv = pos * inv * 0.15915494309189535f; rv -= rintf(rv);
      f32x2 cs; cs.x = __builtin_amdgcn_cosf(rv); cs.y = __builtin_amdgcn_sinf(rv);
      *dst = cs;
    } else {
      if (tid < DEPTH) {
        const float* lp = p.in[I_DLAM] + tid * 128;
        float s1 = 0.f, s2 = 0.f;
        for (int i = 0; i < 32; ++i) { s1 += lp[i] * lp[32 + i]; s2 += lp[64 + i] * lp[96 + i]; }
        const float li = 0.8f - 0.6f * expf(-0.3f * (float)tid);
        float* misc = (float*)(p.ws + OFF_MISC);
        misc[128 + tid] = expf(s1) - expf(s2) + li;
        misc[136 + tid] = li;
      }
    }
  }
}

DI void mod_reduce(const Params& p) {
  const float* MODP = (const float*)(p.ws + OFF_Y);
  float* MOD = (float*)(p.ws + OFF_MOD);
  constexpr int NTOT = DEPTH * 9 * 6144;
  for (int i = blockIdx.x * NTHREADS + otid_full(); i < NTOT; i += gridDim.x * NTHREADS) {
    float a = 0.f;
#pragma unroll
    for (int ks = 0; ks < 8; ++ks) a += MODP[(size_t)ks * NTOT + i];
    MOD[i] = a;
  }
}

DI void norm_phase(const Params& p, int layer, int which, int nrows, const float* pend_gate = nullptr, const float* pend_hin = nullptr) {
  constexpr int NR = 3;
  const int tid_ = otid_full(); const int lane = tid_ & 63, wave = tid_ >> 6;
  const int gw = blockIdx.x * 8 + wave, nw = gridDim.x * 8;
  const float* MOD = (const float*)(p.ws + OFF_MOD);
  bf16_t* XN = (bf16_t*)(p.ws + OFF_XN);
  const float* g = (which == 0 ? p.in[I_N1G] : which == 1 ? p.in[I_N2G] : p.in[I_FNG]) + (which == 2 ? 0 : layer * DM);
  f32x4 gv[4];
#pragma unroll
  for (int i = 0; i < 4; ++i) gv[i] = *(const f32x4*)(g + i * 256 + lane * 4);
  for (int row0 = gw; row0 < nrows; row0 += nw * NR) {
    f32x4 v[NR][4];
    float ss[NR];
#pragma unroll
    for (int j = 0; j < NR; ++j) {
      const int row = row0 + j * nw;
      ss[j] = 0.f;
      if (row < nrows) {
        if (pend_gate != nullptr && row >= MROWS) {
          const size_t ro = (size_t)(row - MROWS) * DM;
          const float* P = (const float*)(p.ws + OFF_SS) + ro;
#pragma unroll
          for (int i = 0; i < 4; ++i) {
            const int c = i * 256 + lane * 4;
            const f32x4 a = *(const f32x4*)(P + c), b2 = *(const f32x4*)(P + (size_t)CROWS * DM + c), c2 = *(const f32x4*)(P + (size_t)2 * CROWS * DM + c), d2 = *(const f32x4*)(P + (size_t)3 * CROWS * DM + c);
            v[j][i] = *(const f32x4*)(pend_hin + ro + c) + *(const f32x4*)(pend_gate + c) * (((a + b2) + c2) + d2);
          }
        } else {
          const float* h;
          if (row < MROWS) h = ((which == 0 && layer == 0) ? p.in[I_X] : p.out) + (size_t)row * DM;
          else h = ((which == 0 && layer == 0) ? p.in[I_CTX] : (const float*)(p.ws + OFF_HC)) + (size_t)(row - MROWS) * DM;
#pragma unroll
          for (int i = 0; i < 4; ++i) v[j][i] = *(const f32x4*)(h + i * 256 + lane * 4);
        }
      } else {
#pragma unroll
        for (int i = 0; i < 4; ++i) v[j][i] = (f32x4){0.f, 0.f, 0.f, 0.f};
      }
    }
#pragma unroll
    for (int j = 0; j < NR; ++j) {
      const int row = row0 + j * nw;
      if (row >= nrows) continue;
      if (pend_gate != nullptr && row >= MROWS) {
        float* hc = (float*)(p.ws + OFF_HC) + (size_t)(row - MROWS) * DM;
#pragma unroll
        for (int i = 0; i < 4; ++i) *(f32x4*)(hc + i * 256 + lane * 4) = v[j][i];
      }
#pragma unroll
      for (int i = 0; i < 4; ++i) ss[j] += v[j][i][0] * v[j][i][0] + v[j][i][1] * v[j][i][1] + v[j][i][2] * v[j][i][2] + v[j][i][3] * v[j][i][3];
      const float rstd = rsqrtf(wave_sum(ss[j]) * (1.f / DM) + EPS);
      if (which == 2) {
#pragma unroll
        for (int i = 0; i < 4; ++i) { f32x4 o = v[j][i] * rstd * gv[i]; *(f32x4*)(p.out + (size_t)row * DM + i * 256 + lane * 4) = o; }
      } else {
        const int bidx = row < MROWS ? (row >> 11) : 8;
        const float* sh = MOD + (size_t)(layer * 9 + bidx) * 6144 + which * 3072;
        const float* sc = sh + 1024;
#pragma unroll
        for (int i = 0; i < 4; ++i) {
          const int c = i * 256 + lane * 4;
          const f32x4 shv = *(const f32x4*)(sh + c), scv = *(const f32x4*)(sc + c);
          f32x4 o = v[j][i] * rstd * gv[i] * (1.f + scv) + shv;
          u32x2 w; w.x = pk_bf16(o[0], o[1]); w.y = pk_bf16(o[2], o[3]);
          *(u32x2*)(XN + (size_t)row * DM + c) = w;
        }
      }
    }
  }
}

namespace pg8 {
#define PG8_LAS __attribute__((address_space(3)))
typedef unsigned short bf16_t;
typedef short bf16x8 __attribute__((ext_vector_type(8)));
typedef float f32x4 __attribute__((ext_vector_type(4)));
typedef unsigned u32x4 __attribute__((ext_vector_type(4)));
constexpr int BM = 256, BK = 64, HALF = 128, HTB = HALF * BK * 2  , STAGE_BYTES = 8 * HTB, NXCD = 8, WGM = 8;

__host__ __device__ __forceinline__ int lds_byte(int r, int c) { const int st = (r >> 4) * 2 + (c >> 5), rr = r & 15, cc = c & 31, ob = rr * 64 + cc * 2; return st * 1024 + (ob ^ (((ob >> 9) & 1) << 5)); }
__host__ __device__ __forceinline__ void stage_rc(int b, int& R, int& C) { const int st = b / 1024, sb = b % 1024, swz = sb ^ (((sb >> 9) & 1) << 5); R = (st >> 1) * 16 + swz / 64; C = (st & 1) * 32 + (swz % 64) / 2; }
__host__ __device__ __forceinline__ int perm32(int rho) { const int n = rho >> 4, i = rho & 15; return 8 * (i >> 2) + 4 * n + (i & 3); }

struct Unit { int pm, pn; };
struct Gemm { const bf16_t* A; const bf16_t* Bt; int M, N, K, Kloop; };

struct StaticOrder {
    int nM, nN, nwg, G, c;
    __host__ __device__ void init(int M, int N, int G_, int c_) { nM = M / BM; nN = N / BM; nwg = nM * nN; G = G_; c = c_; }
    __host__ __device__ bool next(int i, Unit& u) const {
        const long L = (long)i * G + c; if (L >= nwg) return false;
        int wgid = (int)L; { const int q = nwg / NXCD, r = nwg % NXCD, xcd = wgid % NXCD, off = wgid / NXCD; wgid = (xcd < r ? xcd * (q + 1) : r * (q + 1) + (xcd - r) * q) + off; }
        const int nig = WGM * nN, gid = wgid / nig, fm = gid * WGM, gsz = (nM - fm) < WGM ? (nM - fm) : WGM;
        u.pm = fm + ((wgid % nig) % gsz); u.pn = (wgid % nig) / gsz; return true;
    }
    __device__ __forceinline__ void a_ready(const Unit&) const {}
    __device__ __forceinline__ void done(const Unit&) const {}
};


struct SplitOrder {
    int c;
    __host__ __device__ bool next(int i, Unit& u) const { if (i != 0 || c >= 128) return false; const int q = c & 31; u.pm = q & 7; u.pn = q >> 3; return true; }
    __device__ __forceinline__ void a_ready(const Unit&) const {}
    __device__ __forceinline__ void done(const Unit&) const {}
};
struct EpiPartial {
    static constexpr bool PERM = false, AFTER_DRAIN = false;
    float* P;
    __device__ __forceinline__ void operator()(const f32x4 (&acc)[2][2][4][2], const Unit& u, int wr, int wc, int fr, int fq) const {
        float* base = P + (size_t)u.pm * BM * 1024;
        const int col0 = u.pn * BM + wc * 32 + 4 * fq;
#pragma unroll
        for (int bj = 0; bj < 2; ++bj)
#pragma unroll
            for (int n = 0; n < 2; ++n)
#pragma unroll
                for (int ai = 0; ai < 2; ++ai)
#pragma unroll
                    for (int m = 0; m < 4; ++m) *(f32x4*)(base + (size_t)(ai * HALF + wr * 64 + m * 16 + fr) * 1024 + col0 + bj * HALF + n * 16) = acc[ai][bj][m][n];
    }
};
template <int ACT> struct EpiStore {
    static constexpr bool PERM = true, AFTER_DRAIN = false;
    bf16_t* O; int ldc; int ncols;
    __device__ __forceinline__ void operator()(const f32x4 (&acc)[2][2][4][2], const Unit& u, int wr, int wc, int fr, int fq) const {
        const int row0 = u.pm * BM + wr * 64 + fr, col0 = u.pn * BM + wc * 32 + 8 * fq;
#pragma unroll
        for (int ai = 0; ai < 2; ++ai)
#pragma unroll
            for (int m = 0; m < 4; ++m) { bf16_t* rowp = O + (size_t)(row0 + ai * HALF + m * 16) * ldc + col0;
#pragma unroll
                for (int bj = 0; bj < 2; ++bj) { if (col0 + bj * HALF < ncols) { f32x4 v0 = acc[ai][bj][m][0], v1 = acc[ai][bj][m][1];
                    if (ACT == 1) { v0 = __builtin_elementwise_max(v0, (f32x4){0.f, 0.f, 0.f, 0.f}); v1 = __builtin_elementwise_max(v1, (f32x4){0.f, 0.f, 0.f, 0.f}); v0 = v0 * v0; v1 = v1 * v1; }
                    u32x4 w; w.x = ::pk_bf16(v0[0], v0[1]); w.y = ::pk_bf16(v0[2], v0[3]); w.z = ::pk_bf16(v1[0], v1[1]); w.w = ::pk_bf16(v1[2], v1[3]);
                    *(u32x4*)(rowp + bj * HALF) = w; } } }
    }
};
struct EpiResid {
    static constexpr bool PERM = false, AFTER_DRAIN = false;
    const float* hin_m; const float* hin_c; float* hout_m; float* hout_c; const float* gate; float gscale;
    __device__ __forceinline__ void operator()(const f32x4 (&acc)[2][2][4][2], const Unit& u, int wr, int wc, int fr, int fq) const {
        const bool ismain = u.pm < 64;
        const float* hin = ismain ? hin_m + (size_t)u.pm * BM * 1024 : hin_c + (size_t)(u.pm - 64) * BM * 1024;
        float* hout = ismain ? hout_m + (size_t)u.pm * BM * 1024 : hout_c + (size_t)(u.pm - 64) * BM * 1024;
        const float* g = gate + (size_t)(ismain ? (u.pm >> 3) : 8) * 6144;
        const int col0 = u.pn * BM + wc * 32 + 4 * fq;
        f32x4 gv[2][2];
#pragma unroll
        for (int bj = 0; bj < 2; ++bj)
#pragma unroll
            for (int n = 0; n < 2; ++n) gv[bj][n] = *(const f32x4*)(g + col0 + bj * HALF + n * 16) * gscale;
#pragma unroll
        for (int ai = 0; ai < 2; ++ai) {
            f32x4 hv[4][2][2];
#pragma unroll
            for (int m = 0; m < 4; ++m)
#pragma unroll
                for (int bj = 0; bj < 2; ++bj)
#pragma unroll
                    for (int n = 0; n < 2; ++n) hv[m][bj][n] = *(const f32x4*)(hin + (size_t)(ai * HALF + wr * 64 + m * 16 + fr) * 1024 + col0 + bj * HALF + n * 16);
            __builtin_amdgcn_sched_barrier(0);
#pragma unroll
            for (int m = 0; m < 4; ++m)
#pragma unroll
                for (int bj = 0; bj < 2; ++bj)
#pragma unroll
                    for (int n = 0; n < 2; ++n) *(f32x4*)(hout + (size_t)(ai * HALF + wr * 64 + m * 16 + fr) * 1024 + col0 + bj * HALF + n * 16) = hv[m][bj][n] + gv[bj][n] * acc[ai][bj][m][n];
            __builtin_amdgcn_sched_barrier(0);
        }
    }
};
template <class Epi, class Sched, bool ALIGN_EPI = false, bool SP2 = false>
__device__ __forceinline__ void gemm_phase(PG8_LAS unsigned char* lds, const Gemm g, const Sched& S, const Epi& E) {
    const int tid = ::otid_full(), wid = __builtin_amdgcn_readfirstlane(tid >> 6), lane = tid & 63, wr = wid >> 2, wc = wid & 3, fr = lane & 15, fq = lane >> 4;
    const int K = g.K, nt = g.Kloop / BK;
    unsigned voffA[2], voffB[2];
#pragma unroll
    for (int i = 0; i < 2; ++i) { int R, C; stage_rc(tid * 16 + i * 8192, R, C); const int Rb = Epi::PERM ? ((R & ~31) + perm32(R & 31)) : R;
        voffA[i] = (unsigned)(R * K + C) * 2u; voffB[i] = (unsigned)(Rb * K + C) * 2u; }
    const size_t kstep = (size_t)(BK * 2);
    const size_t hstep = (size_t)HALF * K * 2;
    const size_t tstep = 2 * hstep;
    const unsigned ldsw = (unsigned)wid * 1024u;
    const int aoff = lds_byte(wr * 64 + fr, fq * 8), boff = lds_byte(wc * 32 + fr, fq * 8);
#define PG8_SA(b, h) (((b) * 2 + (h)) * HTB)
#define PG8_SB(b, h) ((4 + (b) * 2 + (h)) * HTB)
#define PG8_STAGE(bufoff, gbase, voff) do { _Pragma("unroll") for (int _i = 0; _i < 2; ++_i) \
        __builtin_amdgcn_global_load_lds((const unsigned*)((const char*)(gbase) + (voff)[_i]), (PG8_LAS unsigned*)(lds + (bufoff) + ldsw + _i * 8192), 16, 0, 0); } while (0)
#define PG8_LDA(dst, b, h) do { _Pragma("unroll") for (int m = 0; m < 4; ++m) _Pragma("unroll") for (int k = 0; k < 2; ++k) dst[m][k] = *(const PG8_LAS bf16x8*)(lds + PG8_SA(b, h) + aoff + m * 2048 + k * 1024); } while (0)
#define PG8_LDB(dst, b, h) do { _Pragma("unroll") for (int n = 0; n < 2; ++n) _Pragma("unroll") for (int k = 0; k < 2; ++k) dst[n][k] = *(const PG8_LAS bf16x8*)(lds + PG8_SB(b, h) + boff + n * 2048 + k * 1024); } while (0)
#define PG8_MMA(ai, bj, At, Bt) do { __builtin_amdgcn_s_setprio(1); _Pragma("unroll") for (int m = 0; m < 4; ++m) _Pragma("unroll") for (int n = 0; n < 2; ++n) _Pragma("unroll") for (int k = 0; k < 2; ++k) \
        acc[ai][bj][m][n] = __builtin_amdgcn_mfma_f32_16x16x32_bf16(Bt[n][k], At[m][k], acc[ai][bj][m][n], 0, 0, 0); __builtin_amdgcn_s_setprio(0); } while (0)
#define PG8_WAIT_V(n) asm volatile("s_waitcnt vmcnt(" #n ")" ::: "memory")
#define PG8_WAIT_L(n) asm volatile("s_waitcnt lgkmcnt(" #n ")" ::: "memory")
#define PG8_BAR __builtin_amdgcn_s_barrier()
#define PG8_SCHED __builtin_amdgcn_sched_barrier(0)
    Unit cur, nxt; int ui = 0;
    if (!S.next(0, cur)) return;
    f32x4 acc[2][2][4][2];
#pragma unroll
    for (int a = 0; a < 2; ++a)
#pragma unroll
        for (int b = 0; b < 2; ++b)
#pragma unroll
            for (int m = 0; m < 4; ++m)
#pragma unroll
                for (int n = 0; n < 2; ++n) acc[a][b][m][n] = (f32x4){0.f, 0.f, 0.f, 0.f};
    bf16x8 At[4][2], B0[2][2], B1[2][2];
    const char* cA = (const char*)g.A + (size_t)cur.pm * tstep; const char* cB = (const char*)g.Bt + (size_t)cur.pn * tstep;
    S.a_ready(cur);
    if constexpr (SP2) {
        PG8_STAGE(PG8_SB(0, 0), cB, voffB); PG8_STAGE(PG8_SB(0, 1), cB + hstep, voffB); PG8_STAGE(PG8_SA(0, 0), cA, voffA); PG8_STAGE(PG8_SA(0, 1), cA + hstep, voffA);
        if (wr == 1) PG8_BAR;
        PG8_WAIT_V(2); PG8_BAR;
        PG8_STAGE(PG8_SB(1, 0), cB + kstep, voffB); PG8_STAGE(PG8_SA(1, 0), cA + kstep, voffA); PG8_STAGE(PG8_SB(1, 1), cB + hstep + kstep, voffB);
        PG8_WAIT_V(6); PG8_BAR;
    } else {
        PG8_STAGE(PG8_SB(0, 0), cB, voffB); PG8_STAGE(PG8_SA(0, 0), cA, voffA); PG8_STAGE(PG8_SB(0, 1), cB + hstep, voffB); PG8_STAGE(PG8_SA(0, 1), cA + hstep, voffA);
        if (wr == 1) PG8_BAR;
        PG8_WAIT_V(4); PG8_BAR;
        PG8_STAGE(PG8_SB(1, 0), cB + kstep, voffB); PG8_STAGE(PG8_SA(1, 0), cA + kstep, voffA); PG8_STAGE(PG8_SB(1, 1), cB + hstep + kstep, voffB);
        PG8_WAIT_V(6); PG8_BAR;
    }
    for (;;) {
        const bool has_next = S.next(ui + 1, nxt);
        const char* nA = has_next ? (const char*)g.A + (size_t)nxt.pm * tstep : cA; const char* nB = has_next ? (const char*)g.Bt + (size_t)nxt.pn * tstep : cB;
        for (int t = 0; t < nt; t += 2) {
            const bool last = (t == nt - 2);
            const char* a1 = cA + (size_t)(t + 1) * kstep;
            const char* a2 = last ? nA : cA + (size_t)(t + 2) * kstep; const char* b2 = last ? nB : cB + (size_t)(t + 2) * kstep;
            const char* a3 = a2 + kstep; const char* b3 = b2 + kstep;
            if (last && has_next) S.a_ready(nxt);
            if constexpr (SP2) {
            PG8_LDB(B0, 0, 0); PG8_LDB(B1, 0, 1); PG8_SCHED; PG8_LDA(At, 0, 0); PG8_STAGE(PG8_SA(1, 1), a1 + hstep, voffA);
            PG8_WAIT_V(8); PG8_WAIT_L(0); PG8_BAR; PG8_MMA(0, 0, At, B0); PG8_MMA(0, 1, At, B1); PG8_BAR; PG8_SCHED;
            PG8_LDA(At, 0, 1); PG8_STAGE(PG8_SB(0, 0), b2, voffB); PG8_STAGE(PG8_SB(0, 1), b2 + hstep, voffB); PG8_STAGE(PG8_SA(0, 0), a2, voffA);
            PG8_WAIT_V(8); PG8_WAIT_L(0); PG8_BAR; PG8_MMA(1, 0, At, B0); PG8_MMA(1, 1, At, B1); PG8_BAR; PG8_SCHED;
            PG8_LDB(B0, 1, 0); PG8_LDB(B1, 1, 1); PG8_SCHED; PG8_LDA(At, 1, 0); PG8_STAGE(PG8_SA(0, 1), a2 + hstep, voffA);
            PG8_WAIT_V(8); PG8_WAIT_L(0); PG8_BAR; PG8_MMA(0, 0, At, B0); PG8_MMA(0, 1, At, B1); PG8_BAR; PG8_SCHED;
            PG8_LDA(At, 1, 1); PG8_STAGE(PG8_SB(1, 0), b3, voffB); PG8_STAGE(PG8_SB(1, 1), b3 + hstep, voffB); PG8_STAGE(PG8_SA(1, 0), a3, voffA);
            PG8_WAIT_V(8); PG8_WAIT_L(0); PG8_BAR; PG8_MMA(1, 0, At, B0); PG8_MMA(1, 1, At, B1); PG8_BAR; PG8_SCHED;
            } else {
            PG8_LDB(B0, 0, 0); PG8_SCHED; PG8_LDA(At, 0, 0); PG8_STAGE(PG8_SA(1, 1), a1 + hstep, voffA);
            PG8_WAIT_L(8); PG8_BAR; PG8_WAIT_L(0); PG8_MMA(0, 0, At, B0); PG8_BAR; PG8_SCHED;
            PG8_LDB(B1, 0, 1); PG8_STAGE(PG8_SB(0, 0), b2, voffB);
            PG8_BAR; PG8_WAIT_L(0); PG8_MMA(0, 1, At, B1); PG8_BAR;
            PG8_LDA(At, 0, 1); PG8_STAGE(PG8_SA(0, 0), a2, voffA);
            PG8_BAR; PG8_WAIT_L(0); PG8_MMA(1, 0, At, B0); PG8_BAR; PG8_SCHED;
            PG8_STAGE(PG8_SB(0, 1), b2 + hstep, voffB);
            PG8_WAIT_V(6); PG8_BAR; PG8_MMA(1, 1, At, B1); PG8_BAR;
            PG8_LDB(B0, 1, 0); PG8_SCHED; PG8_LDA(At, 1, 0); PG8_STAGE(PG8_SA(0, 1), a2 + hstep, voffA);
            PG8_WAIT_L(8); PG8_BAR; PG8_WAIT_L(0); PG8_MMA(0, 0, At, B0); PG8_BAR; PG8_SCHED;
            PG8_LDB(B1, 1, 1); PG8_STAGE(PG8_SB(1, 0), b3, voffB);
            PG8_BAR; PG8_WAIT_L(0); PG8_MMA(0, 1, At, B1); PG8_BAR;
            PG8_LDA(At, 1, 1); PG8_STAGE(PG8_SA(1, 0), a3, voffA);
            PG8_BAR; PG8_WAIT_L(0); PG8_MMA(1, 0, At, B0); PG8_BAR; PG8_SCHED;
            PG8_STAGE(PG8_SB(1, 1), b3 + hstep, voffB);
            PG8_WAIT_V(6); PG8_BAR; PG8_MMA(1, 1, At, B1); PG8_BAR;
            }
        }
        if constexpr (ALIGN_EPI) { if (wr == 0) PG8_BAR; }
        if constexpr (!Epi::AFTER_DRAIN) { E(acc, cur, wr, wc, fr, fq); S.done(cur); }
        if (!has_next) break;
#pragma unroll
        for (int a = 0; a < 2; ++a)
#pragma unroll
            for (int b = 0; b < 2; ++b)
#pragma unroll
                for (int m = 0; m < 4; ++m)
#pragma unroll
                    for (int n = 0; n < 2; ++n) acc[a][b][m][n] = (f32x4){0.f, 0.f, 0.f, 0.f};
        cur = nxt; cA = nA; cB = nB; ++ui;
        if constexpr (ALIGN_EPI) { if (wr == 1) PG8_BAR; }
    }
    PG8_WAIT_V(0);
    if constexpr (!ALIGN_EPI) { if (wr == 0) PG8_BAR; }
    PG8_BAR;
    if constexpr (Epi::AFTER_DRAIN) { E.fused(acc, cur, wr, wc, fr, fq, lds, wid, lane); S.done(cur); }
#undef PG8_SA
#undef PG8_SB
#undef PG8_STAGE
#undef PG8_LDA
#undef PG8_LDB
#undef PG8_MMA
#undef PG8_WAIT_V
#undef PG8_WAIT_L
#undef PG8_BAR
#undef PG8_SCHED
}
}

DI void prep_tile(const Params& p, int layer, int tile, int part, char* smem) {
  const int tid = otid(), lane = tid & 63, wave = tid >> 6, l31 = lane & 31, hi = lane >> 5;
  const int b = tile / 36, tb = tile % 36, p0 = tb * 64;
  const bool isctx = tb < 4;
  const int row0 = isctx ? (MROWS + b * CT + p0) : (b * SEQ + p0 - CT);
  const bf16_t* U = (const bf16_t*)(p.ws + OFF_U);
  const f32x2* ropeH = (const f32x2*)(p.ws + OFF_ROPEH);
  const f32x2* ropeD = (const f32x2*)(p.ws + OFF_ROPED);
  bf16_t* QD = (bf16_t*)(p.ws + OFF_QD); bf16_t* KD = (bf16_t*)(p.ws + OFF_KD); bf16_t* VTD = (bf16_t*)(p.ws + OFF_VTD);
  bf16_t* QG = (bf16_t*)(p.ws + OFF_QG); bf16_t* KG = (bf16_t*)(p.ws + OFF_KG); bf16_t* VTG = (bf16_t*)(p.ws + OFF_VTG);
  bf16_t* QM = (bf16_t*)(p.ws + OFF_QM); bf16_t* KM = (bf16_t*)(p.ws + OFF_KM); bf16_t* VTM = (bf16_t*)(p.ws + OFF_VTM);
  const float qsD = 0.17677669529663687f * LOG2E, qsG = 0.125f * LOG2E, qsM = 0.10206207261596575f * LOG2E;
  bf16_t* sT = (bf16_t*)smem; bf16_t* sCq = (bf16_t*)(smem + 9216); bf16_t* sCkv = (bf16_t*)(smem + 9216 + 25600);

  if (part == 0) {
#pragma unroll 1
  for (int i = 0; i < 4; ++i) {
    const int task = tid + 256 * i;
    if (task >= 15 * 64) break;
    const int g = task >> 6, tk = task & 63;
    const bf16_t* urow = U + (size_t)(row0 + tk) * INP;
    const int pos = p0 + tk, t = pos - CT;
    if (g < 14) {
      const bool isdiff = g < 8;
      const bool isq = isdiff ? (g < 4) : (g < 12);
      const int h = isdiff ? (g & 3) : (isq ? g - 8 : g - 12);
      const int col = isdiff ? ((isq ? U_DQ : U_DK) + h * 64) : ((isq ? U_GQ : U_GK) + h * 64);
      float x[64];
#pragma unroll
      for (int c = 0; c < 8; ++c) {
        const u32x4 v = *(const u32x4*)(urow + col + c * 8);
        x[c * 8 + 0] = bflo(v.x); x[c * 8 + 1] = bfhi(v.x); x[c * 8 + 2] = bflo(v.y); x[c * 8 + 3] = bfhi(v.y);
        x[c * 8 + 4] = bflo(v.z); x[c * 8 + 5] = bfhi(v.z); x[c * 8 + 6] = bflo(v.w); x[c * 8 + 7] = bfhi(v.w);
      }
      if (isdiff) {
        if (!isctx) {
#pragma unroll
          for (int m = 0; m < 2; ++m)
#pragma unroll
            for (int d = 0; d < 16; ++d) {
              const f32x2 cs = ropeD[t * 16 + d];
              const float x1 = x[m * 32 + d], x2 = x[m * 32 + 16 + d];
              x[m * 32 + d] = x1 * cs.x - x2 * cs.y; x[m * 32 + 16 + d] = x1 * cs.y + x2 * cs.x;
            }
        }
        const float sc_ = isq ? qsD : 1.f;
        bf16_t* dst = (isq ? QD : KD) + (((size_t)b * 8 + h * 2) * TT + pos) * 32;
#pragma unroll
        for (int m = 0; m < 2; ++m)
#pragma unroll
          for (int c = 0; c < 4; ++c) {
            u32x4 w; const int o = m * 32 + c * 8;
            w.x = pk_bf16(x[o] * sc_, x[o + 1] * sc_); w.y = pk_bf16(x[o + 2] * sc_, x[o + 3] * sc_); w.z = pk_bf16(x[o + 4] * sc_, x[o + 5] * sc_); w.w = pk_bf16(x[o + 6] * sc_, x[o + 7] * sc_);
            *(u32x4*)(dst + (size_t)m * TT * 32 + c * 8) = w;
          }
      } else {
        float ss = 0.f;
#pragma unroll
        for (int d = 0; d < 64; ++d) ss += x[d] * x[d];
        const float rstd = rsqrtf(ss * (1.f / 64.f) + EPS);
        const float* gn = (isq ? p.in[I_GQN] : p.in[I_GKN]) + layer * 64;
#pragma unroll
        for (int c = 0; c < 16; ++c) { const f32x4 gv = *(const f32x4*)(gn + c * 4); x[c * 4] *= rstd * gv[0]; x[c * 4 + 1] *= rstd * gv[1]; x[c * 4 + 2] *= rstd * gv[2]; x[c * 4 + 3] *= rstd * gv[3]; }
        if (!isctx) {
#pragma unroll
          for (int d = 0; d < 32; ++d) {
            const f32x2 cs = ropeH[t * 32 + d];
            const float x1 = x[d], x2 = x[32 + d];
            x[d] = x1 * cs.x - x2 * cs.y; x[32 + d] = x1 * cs.y + x2 * cs.x;
          }
        }
        const float sc_ = isq ? qsG : 1.f;
        bf16_t* dst = isq ? QG + (((size_t)b * 4 + h) * TT + pos) * 64 : KG + (((size_t)b * 2 + h) * TT + pos) * 64;
#pragma unroll
        for (int c = 0; c < 8; ++c) {
          u32x4 w; const int o = c * 8;
          w.x = pk_bf16(x[o] * sc_, x[o + 1] * sc_); w.y = pk_bf16(x[o + 2] * sc_, x[o + 3] * sc_); w.z = pk_bf16(x[o + 4] * sc_, x[o + 5] * sc_); w.w = pk_bf16(x[o + 6] * sc_, x[o + 7] * sc_);
          *(u32x4*)(dst + c * 8) = w;
        }
      }
    } else {
      float x[32];
#pragma unroll
      for (int c = 0; c < 4; ++c) {
        const u32x4 v = *(const u32x4*)(urow + U_MR + c * 8);
        x[c * 8 + 0] = bflo(v.x); x[c * 8 + 1] = bfhi(v.x); x[c * 8 + 2] = bflo(v.y); x[c * 8 + 3] = bfhi(v.y);
        x[c * 8 + 4] = bflo(v.z); x[c * 8 + 5] = bfhi(v.z); x[c * 8 + 6] = bflo(v.w); x[c * 8 + 7] = bfhi(v.w);
      }
      if (!isctx) {
#pragma unroll
        for (int d = 0; d < 16; ++d) {
          const f32x2 cs = ropeD[t * 16 + d];
          const float x1 = x[d], x2 = x[16 + d];
          x[d] = x1 * cs.x - x2 * cs.y; x[16 + d] = x1 * cs.y + x2 * cs.x;
        }
      }
      u32x4 w[4];
#pragma unroll
      for (int c = 0; c < 4; ++c) { const int o = c * 8; w[c].x = pk_bf16(x[o], x[o + 1]); w[c].y = pk_bf16(x[o + 2], x[o + 3]); w[c].z = pk_bf16(x[o + 4], x[o + 5]); w[c].w = pk_bf16(x[o + 6], x[o + 7]); }
#pragma unroll
      for (int hh = 0; hh < 4; ++hh)
#pragma unroll
        for (int c = 0; c < 4; ++c) *(u32x4*)(KM + (((size_t)b * 4 + hh) * TT + pos) * 96 + 64 + c * 8) = w[c];
    }
  }
  for (int g = 0; g < 6; ++g) {
    const int colbase = g < 4 ? U_DV + g * 64 : U_GV + (g - 4) * 64;
    bf16_t* dst = g < 4 ? VTD + ((size_t)(b * 4 + g) * 64) * TT : VTG + ((size_t)(b * 2 + g - 4) * 64) * TT;
#pragma unroll
    for (int i = 0; i < 2; ++i) {
      const int c = tid + 256 * i, tk0 = c >> 3, kc = c & 7;
      const u32x4 v = *(const u32x4*)(U + (size_t)(row0 + tk0) * INP + colbase + kc * 8);
      const int tk = (tk0 & ~12) | ((tk0 & 4) << 1) | ((tk0 & 8) >> 1);
      sT[(kc * 8 + 0) * 72 + tk] = (bf16_t)(v.x & 0xffff); sT[(kc * 8 + 1) * 72 + tk] = (bf16_t)(v.x >> 16);
      sT[(kc * 8 + 2) * 72 + tk] = (bf16_t)(v.y & 0xffff); sT[(kc * 8 + 3) * 72 + tk] = (bf16_t)(v.y >> 16);
      sT[(kc * 8 + 4) * 72 + tk] = (bf16_t)(v.z & 0xffff); sT[(kc * 8 + 5) * 72 + tk] = (bf16_t)(v.z >> 16);
      sT[(kc * 8 + 6) * 72 + tk] = (bf16_t)(v.w & 0xffff); sT[(kc * 8 + 7) * 72 + tk] = (bf16_t)(v.w >> 16);
    }
    __syncthreads();
    {
      const int dv = tid >> 2, part = tid & 3;
      const u32x4 a = *(const u32x4*)(sT + dv * 72 + part * 16), bq = *(const u32x4*)(sT + dv * 72 + part * 16 + 8);
      bf16_t* d = dst + (size_t)dv * TT + p0 + part * 16;
      *(u32x4*)d = a; *(u32x4*)(d + 8) = bq;
    }
    __syncthreads();
  }
  return;
  }
#pragma unroll 4
  for (int tk = wave; tk < 64; tk += 4) {
    const bf16_t* urow = U + (size_t)(row0 + tk) * INP;
    const float q0 = bf2f(urow[U_MQ + lane]), q1 = bf2f(urow[U_MQ + 64 + lane]), q2 = bf2f(urow[U_MQ + 128 + lane]);
    const float k0 = bf2f(urow[U_MKV + lane]), k1 = bf2f(urow[U_MKV + 64 + lane]);
    const float sq = wave_sum(q0 * q0 + q1 * q1 + q2 * q2), sk = wave_sum(k0 * k0 + k1 * k1);
    const float rq = rsqrtf(sq * (1.f / 192.f) + EPS), rk = rsqrtf(sk * (1.f / 128.f) + EPS);
    const float* gq = p.in[I_MQN] + layer * 192; const float* gk = p.in[I_MKVN] + layer * 128;
    sCq[tk * 200 + lane] = f2bf(q0 * rq * gq[lane]); sCq[tk * 200 + 64 + lane] = f2bf(q1 * rq * gq[64 + lane]); sCq[tk * 200 + 128 + lane] = f2bf(q2 * rq * gq[128 + lane]);
    sCkv[tk * 136 + lane] = f2bf(k0 * rk * gk[lane]); sCkv[tk * 136 + 64 + lane] = f2bf(k1 * rk * gk[64 + lane]);
  }
  __syncthreads();
  const bf16_t* Wkv = (const bf16_t*)(p.ws + OFF_WUKV) + (size_t)layer * 512 * 128;
  const bf16_t* Wq = (const bf16_t*)(p.ws + OFF_WUQ) + (size_t)layer * 384 * 192;
#pragma unroll 1
  for (int task = wave; task < 28; task += 4) {
    if (task < 16) {
      const int ct = task, head = ct >> 2, sub = ct & 3, n0 = head * 128 + sub * 32;
      const bf16_t* wrow = Wkv + (size_t)(n0 + l31) * 128 + hi * 8;
      bf16x8 wf[8];
#pragma unroll
      for (int ks = 0; ks < 8; ++ks) wf[ks] = *(const bf16x8*)(wrow + ks * 16);
      bf16x8 tf[2][8];
#pragma unroll
      for (int tt = 0; tt < 2; ++tt)
#pragma unroll
        for (int ks = 0; ks < 8; ++ks) tf[tt][ks] = *(const bf16x8*)(sCkv + (tt * 32 + l31) * 136 + hi * 8 + ks * 16);
      __builtin_amdgcn_sched_barrier(0);
      f32x16 acc[2]; acc[0] = zero16(); acc[1] = zero16();
      if (sub < 2) {
#pragma unroll
        for (int ks = 0; ks < 8; ++ks) { acc[0] = MFMA32(wf[ks], tf[0][ks], acc[0]); acc[1] = MFMA32(wf[ks], tf[1][ks], acc[1]); }
#pragma unroll
        for (int tt = 0; tt < 2; ++tt) {
          bf16_t* d = KM + (((size_t)b * 4 + head) * TT + p0 + tt * 32 + l31) * 96 + sub * 32 + 4 * hi;
#pragma unroll
          for (int r4 = 0; r4 < 4; ++r4) { u32x2 w; w.x = pk_bf16(acc[tt][4 * r4], acc[tt][4 * r4 + 1]); w.y = pk_bf16(acc[tt][4 * r4 + 2], acc[tt][4 * r4 + 3]); *(u32x2*)(d + 8 * r4) = w; }
        }
      } else {
#pragma unroll
        for (int ks = 0; ks < 8; ++ks) { acc[0] = MFMA32(tf[0][ks], wf[ks], acc[0]); acc[1] = MFMA32(tf[1][ks], wf[ks], acc[1]); }
#pragma unroll
        for (int tt = 0; tt < 2; ++tt) {
          bf16_t* d = VTM + (((size_t)b * 4 + head) * 64 + (sub - 2) * 32 + l31) * TT + p0 + tt * 32;
#pragma unroll
          for (int r4 = 0; r4 < 4; ++r4) { u32x2 w; w.x = pk_bf16(acc[tt][4 * r4], acc[tt][4 * r4 + 1]); w.y = pk_bf16(acc[tt][4 * r4 + 2], acc[tt][4 * r4 + 3]);
            *(u32x2*)(d + 16 * (r4 >> 1) + 4 * (2 * hi + (r4 & 1))) = w; }
        }
      }
    } else {
      const int ct = task - 16, head = ct / 3, sub = ct % 3, n0 = head * 96 + sub * 32;
      const bf16_t* wrow = Wq + (size_t)(n0 + l31) * 192 + hi * 8;
      bf16x8 wf[12];
#pragma unroll
      for (int ks = 0; ks < 12; ++ks) wf[ks] = *(const bf16x8*)(wrow + ks * 16);
      __builtin_amdgcn_sched_barrier(0);
#pragma unroll
      for (int tt = 0; tt < 2; ++tt) {
        bf16x8 tf[12];
#pragma unroll
        for (int ks = 0; ks < 12; ++ks) tf[ks] = *(const bf16x8*)(sCq + (tt * 32 + l31) * 200 + hi * 8 + ks * 16);
        __builtin_amdgcn_sched_barrier(0);
        f32x16 acc = zero16();
#pragma unroll
        for (int ks = 0; ks < 12; ++ks) acc = MFMA32(wf[ks], tf[ks], acc);
        const int pos = p0 + tt * 32 + l31;
        if (sub == 2 && !isctx) {
          const int t = pos - CT;
#pragma unroll
          for (int r = 0; r < 8; ++r) {
            const f32x2 cs = ropeD[t * 16 + crow(r, hi)];
            const float x1 = acc[r], x2 = acc[r + 8];
            acc[r] = x1 * cs.x - x2 * cs.y; acc[r + 8] = x1 * cs.y + x2 * cs.x;
          }
        }
        bf16_t* d = QM + (((size_t)b * 4 + head) * TT + pos) * 96 + sub * 32 + 4 * hi;
#pragma unroll
        for (int r4 = 0; r4 < 4; ++r4) { u32x2 w; w.x = pk_bf16(acc[4 * r4] * qsM, acc[4 * r4 + 1] * qsM); w.y = pk_bf16(acc[4 * r4 + 2] * qsM, acc[4 * r4 + 3] * qsM); *(u32x2*)(d + 8 * r4) = w; }
      }
    }
  }
  __syncthreads();
}

template <int DQK>
DI void attn_core(const bf16_t* __restrict__ Qb, const bf16_t* __restrict__ Kb, const bf16_t* __restrict__ Vt, int q0, int ntiles,
                  f32x16 (&O)[2], float& lsum, char* smem) {
  const int tid = otid_full(), lane = tid & 63, wave = tid >> 6, l31 = lane & 31, hi = lane >> 5;
  constexpr int KS = DQK / 16, KROW = DQK + 8, KCH = DQK / 8;
  constexpr int KBYTES = 64 * KROW * 2, BUFB = KBYTES + 9216;
  constexpr int NK = 64 * KCH, NKC = (NK + NTHREADS - 1) / NTHREADS;
  static_assert(2 * BUFB <= 49152, "attention LDS");
  bf16x8 qf[KS];
#pragma unroll
  for (int ks = 0; ks < KS; ++ks) qf[ks] = *(const bf16x8*)(Qb + (size_t)(q0 + wave * 32 + l31) * DQK + ks * 16 + hi * 8);
  float mrun = -1e30f; lsum = 0.f; O[0] = zero16(); O[1] = zero16();
  const bf16_t* kg[NKC]; int kl[NKC]; bool kok[NKC];
#pragma unroll
  for (int i = 0; i < NKC; ++i) {
    const int c = tid + NTHREADS * i, key = c / KCH, kc = c % KCH;
    kok[i] = c < NK;
    kg[i] = Kb + (size_t)key * DQK + kc * 8;
    kl[i] = (key * KROW + kc * 8) * 2;
  }
  const bf16_t* vg; int vl;
  { const int dv = tid >> 3, kc = tid & 7; vg = Vt + (size_t)dv * TT + kc * 8; vl = KBYTES + (dv * 72 + kc * 8) * 2; }
  u32x4 rk[NKC], rv;
#pragma unroll
  for (int i = 0; i < NKC; ++i) if (kok[i]) rk[i] = *(const u32x4*)(kg[i]);
  rv = *(const u32x4*)(vg);
#pragma unroll
  for (int i = 0; i < NKC; ++i) if (kok[i]) *(u32x4*)(smem + kl[i]) = rk[i];
  *(u32x4*)(smem + vl) = rv;
  __syncthreads();
  for (int kt = 0; kt < ntiles; ++kt) {
    const int cur = kt & 1; const bool more = kt + 1 < ntiles;
    if (more) {
#pragma unroll
      for (int i = 0; i < NKC; ++i) if (kok[i]) rk[i] = *(const u32x4*)(kg[i] + (size_t)(kt + 1) * 64 * DQK);
      rv = *(const u32x4*)(vg + (kt + 1) * 64);
    }
    const char* sb = smem + cur * BUFB;
    bf16x8 kf[2][KS];
#pragma unroll
    for (int kb = 0; kb < 2; ++kb)
#pragma unroll
      for (int ks = 0; ks < KS; ++ks) kf[kb][ks] = *(const bf16x8*)(sb + ((kb * 32 + l31) * KROW + hi * 8) * 2 + ks * 32);
    __builtin_amdgcn_sched_barrier(0);
    f32x16 s[2];
#pragma unroll
    for (int kb = 0; kb < 2; ++kb) {
      s[kb] = zero16();
#pragma unroll
      for (int ks = 0; ks < KS; ++ks) s[kb] = MFMA32(kf[kb][ks], qf[ks], s[kb]);
    }
    bf16x8 vf[4][2];
#pragma unroll
    for (int s4 = 0; s4 < 4; ++s4)
#pragma unroll
      for (int dvb = 0; dvb < 2; ++dvb) vf[s4][dvb] = *(const bf16x8*)(sb + KBYTES + ((dvb * 32 + l31) * 72 + s4 * 16 + hi * 8) * 2);
    __builtin_amdgcn_sched_barrier(0);
    float mx = s[0][0];
#pragma unroll
    for (int r = 0; r < 16; ++r) { mx = fmaxf(mx, s[0][r]); mx = fmaxf(mx, s[1][r]); }
    mx = fmaxf(mx, __shfl_xor(mx, 32));
    const float mnew = fmaxf(mrun, mx);
    const float alpha = __builtin_amdgcn_exp2f(mrun - mnew);
    mrun = mnew;
    float rs = 0.f;
#pragma unroll
    for (int kb = 0; kb < 2; ++kb)
#pragma unroll
      for (int r = 0; r < 16; ++r) { const float e = __builtin_amdgcn_exp2f(s[kb][r] - mnew); s[kb][r] = e; rs += e; }
    lsum = lsum * alpha + rs;
    O[0] *= alpha; O[1] *= alpha;
#pragma unroll
    for (int s4 = 0; s4 < 4; ++s4) {
      const int kb = s4 >> 1, hf = (s4 & 1) * 8;
      const bf16x8 pb = pack8(s[kb][hf + 0], s[kb][hf + 1], s[kb][hf + 2], s[kb][hf + 3], s[kb][hf + 4], s[kb][hf + 5], s[kb][hf + 6], s[kb][hf + 7]);
#pragma unroll
      for (int dvb = 0; dvb < 2; ++dvb) O[dvb] = MFMA32(vf[s4][dvb], pb, O[dvb]);
    }
    if (more) {
      char* db = smem + (cur ^ 1) * BUFB;
#pragma unroll
      for (int i = 0; i < NKC; ++i) if (kok[i]) *(u32x4*)(db + kl[i]) = rk[i];
      *(u32x4*)(db + vl) = rv;
    }
    __syncthreads();
  }
  lsum += __shfl_xor(lsum, 32);
}

DI void attn_unit(const Params& p, int layer, int b, int kind, int head, int qb, char* smem) {
  const int tid_ = otid_full(); const int lane = tid_ & 63, wave = tid_ >> 6, l31 = lane & 31, hi = lane >> 5;
  const int q0 = qb * 256;
  const int ntiles = qb == 0 ? 4 : 36;
  bf16_t* Y = (bf16_t*)(p.ws + OFF_Y);
  const int pos = q0 + wave * 32 + l31;
  bf16_t* yrow = Y + (size_t)hrow_of(b, pos) * DM;
  f32x16 O[2]; float ls;
  if (kind == 1) {
    attn_core<32>((const bf16_t*)(p.ws + OFF_QD) + ((size_t)b * 8 + head * 2) * TT * 32, (const bf16_t*)(p.ws + OFF_KD) + ((size_t)b * 8 + head * 2) * TT * 32,
                  (const bf16_t*)(p.ws + OFF_VTD) + ((size_t)b * 4 + head) * 64 * TT, q0, ntiles, O, ls, smem);
    float* st = (float*)(smem + 49152) + tid_;
    {
      const float i0 = 1.f / ls;
#pragma unroll
      for (int dvb = 0; dvb < 2; ++dvb)
#pragma unroll
        for (int r = 0; r < 16; ++r) st[(dvb * 16 + r) * NTHREADS] = O[dvb][r] * i0;
    }
    __syncthreads();
    attn_core<32>((const bf16_t*)(p.ws + OFF_QD) + ((size_t)b * 8 + head * 2 + 1) * TT * 32, (const bf16_t*)(p.ws + OFF_KD) + ((size_t)b * 8 + head * 2 + 1) * TT * 32,
                  (const bf16_t*)(p.ws + OFF_VTD) + ((size_t)b * 4 + head) * 64 * TT, q0, ntiles, O, ls, smem);
    const float* misc = (const float*)(p.ws + OFF_MISC);
    const float lam = misc[128 + layer], li = misc[136 + layer];
    const float i1 = lam / ls;
    float ss = 0.f;
#pragma unroll
    for (int dvb = 0; dvb < 2; ++dvb)
#pragma unroll
      for (int r = 0; r < 16; ++r) { const float o = st[(dvb * 16 + r) * NTHREADS] - O[dvb][r] * i1; O[dvb][r] = o; ss += o * o; }
    ss += __shfl_xor(ss, 32);
    const float rstd = rsqrtf(ss * (1.f / 64.f) + EPS) * (1.f - li);
    const float* g = p.in[I_DNG] + layer * 64;
#pragma unroll
    for (int dvb = 0; dvb < 2; ++dvb)
#pragma unroll
      for (int r4 = 0; r4 < 4; ++r4) {
        const int dv = dvb * 32 + 8 * r4 + 4 * hi;
        const f32x4 gv = *(const f32x4*)(g + dv);
        u32x2 w; w.x = pk_bf16(O[dvb][4 * r4] * rstd * gv[0], O[dvb][4 * r4 + 1] * rstd * gv[1]);
        w.y = pk_bf16(O[dvb][4 * r4 + 2] * rstd * gv[2], O[dvb][4 * r4 + 3] * rstd * gv[3]);
        *(u32x2*)(yrow + 256 + head * 64 + dv) = w;
      }
  } else {
    int ycol;
    if (kind == 2) {
      attn_core<64>((const bf16_t*)(p.ws + OFF_QG) + ((size_t)b * 4 + head) * TT * 64, (const bf16_t*)(p.ws + OFF_KG) + ((size_t)b * 2 + (head >> 1)) * TT * 64,
                    (const bf16_t*)(p.ws + OFF_VTG) + ((size_t)b * 2 + (head >> 1)) * 64 * TT, q0, ntiles, O, ls, smem);
      ycol = 512 + head * 64;
    } else {
      attn_core<96>((const bf16_t*)(p.ws + OFF_QM) + ((size_t)b * 4 + head) * TT * 96, (const bf16_t*)(p.ws + OFF_KM) + ((size_t)b * 4 + head) * TT * 96,
                    (const bf16_t*)(p.ws + OFF_VTM) + ((size_t)b * 4 + head) * 64 * TT, q0, ntiles, O, ls, smem);
      ycol = 768 + head * 64;
    }
    const float inv = 1.f / ls;
#pragma unroll
    for (int dvb = 0; dvb < 2; ++dvb)
#pragma unroll
      for (int r4 = 0; r4 < 4; ++r4) {
        const int dv = dvb * 32 + 8 * r4 + 4 * hi;
        u32x2 w; w.x = pk_bf16(O[dvb][4 * r4] * inv, O[dvb][4 * r4 + 1] * inv); w.y = pk_bf16(O[dvb][4 * r4 + 2] * inv, O[dvb][4 * r4 + 3] * inv);
        *(u32x2*)(yrow + ycol + dv) = w;
      }
  }
}

DI void ssd_chunk(const Params& p, int layer, int item, char* smem) {
  const int tid = otid(), lane = tid & 63, wave = tid >> 6, l31 = lane & 31, hi = lane >> 5;
  const int pi = wave >> 1, li = wave & 1;
  const int ck = item % 36, r_ = item / 36, d = r_ & 1, g = (r_ >> 1) & 1, b = r_ >> 2, h = 2 * g + half_id(), chain = (b * 4 + h) * 2 + d;
  const bf16_t* U = (const bf16_t*)(p.ws + OFF_U);
  bf16_t* Yssd = (bf16_t*)(p.ws + OFF_XN) + (size_t)d * ROWS * 256;
  bf16_t* sXT = (bf16_t*)smem;
  bf16_t* sB = (bf16_t*)(smem + 9216);
  bf16_t* sC = (bf16_t*)(smem + 18432);
  bf16_t* sBT = (bf16_t*)(smem + 27648);
  float* scs = (float*)(smem + 46080);
  float* sdt = (float*)(smem + 46336);
  float* sW = (float*)(smem + 46592);
  const bool isctx = ck < 4;
  const int Len = isctx ? CT : SEQ, base = isctx ? (MROWS + b * CT) : (b * SEQ), kl = isctx ? ck : ck - 4;
  if (tid < 192) {
    const int cc = tid >> 6, e = tid & 63;
    const int ch = cc == 0 ? (h * 64 + e) : (cc == 1 ? 256 + g * 64 + e : 384 + g * 64 + e);
    const float* cw = p.in[I_CONVW] + ((size_t)layer * 512 + ch) * 3;
    sW[tid * 4 + 0] = cw[0]; sW[tid * 4 + 1] = cw[1]; sW[tid * 4 + 2] = cw[2]; sW[tid * 4 + 3] = p.in[I_CONVB][layer * 512 + ch];
  }
  const bool wrC = (half_id() == 0) && (d == 0);
  bf16_t* CB = (bf16_t*)(p.ws + OFF_CB);
  float raw_dt = 0.f;
  if (wave == 1) {
    const int posj = kl * 64 + lane, t = d ? (Len - 1 - posj) : posj;
    raw_dt = bf2f(U[(size_t)(base + t) * INP + U_DT + d * 4 + h]);
  }
  u32x4 vm6[6], v06[6], vp6[6];
#pragma unroll
  for (int i = 0; i < 6; ++i) {
    const int task = tid + 256 * i, j = task / 24, cc = task % 24;
    const int posj = kl * 64 + j, t = d ? (Len - 1 - posj) : posj;
    const int grp = cc >> 3, c8 = (cc & 7) * 8;
    const int ucol = grp == 0 ? (U_X + h * 64 + c8) : (grp == 1 ? U_B + g * 64 + c8 : U_C + g * 64 + c8);
    const bf16_t* up = U + (size_t)(base + t) * INP + ucol;
    const u32x4 z4 = {0u, 0u, 0u, 0u};
    vm6[i] = (t > 0) ? *(const u32x4*)(up - INP) : z4;
    v06[i] = *(const u32x4*)up;
    vp6[i] = (t < Len - 1) ? *(const u32x4*)(up + INP) : z4;
  }
  if (wave == 1) {
    const float dtb = p.in[I_DTB][layer * 8 + d * 4 + h];
    const float aneg = -expf(p.in[I_ALOG][layer * 8 + d * 4 + h]);
    const int posj = kl * 64 + lane, t = d ? (Len - 1 - posj) : posj;
    const float raw = raw_dt + dtb;
    const float e_ = __expf(-fabsf(raw));
    const float dtv = fmaxf(raw, 0.f) + (e_ < 0.03f ? e_ * (1.f - e_ * (0.5f - e_ * 0.33333334f)) : __logf(1.f + e_));
    float c = dtv * aneg;
#pragma unroll
    for (int o = 1; o < 64; o <<= 1) { const float tv = __shfl_up(c, o); if (lane >= o) c += tv; }
    sdt[lane] = dtv; scs[lane] = c;
    ((float*)(p.ws + OFF_ECL))[(size_t)(d * 4 + h) * ROWS + base + t] = __expf(c);
    if (lane == 63) ((float*)(p.ws + OFF_DEC))[chain * 36 + ck] = __expf(c);
  }
  __syncthreads();
  const float c63 = scs[63];
#pragma unroll
  for (int i = 0; i < 6; ++i) {
    const int task = tid + 256 * i, j = task / 24, cc = task % 24;
    const int posj = kl * 64 + j, t = d ? (Len - 1 - posj) : posj;
    const int grp = cc >> 3, c8 = (cc & 7) * 8;
    const u32x4 vm = vm6[i], v0 = v06[i], vp = vp6[i];
    float o[8];
#pragma unroll
    for (int e2 = 0; e2 < 4; ++e2) {
      const unsigned wm_ = e2 == 0 ? vm.x : e2 == 1 ? vm.y : e2 == 2 ? vm.z : vm.w;
      const unsigned w0_ = e2 == 0 ? v0.x : e2 == 1 ? v0.y : e2 == 2 ? v0.z : v0.w;
      const unsigned wp_ = e2 == 0 ? vp.x : e2 == 1 ? vp.y : e2 == 2 ? vp.z : vp.w;
      const f32x4 wa = *(const f32x4*)(sW + (grp * 64 + c8 + 2 * e2) * 4), wb = *(const f32x4*)(sW + (grp * 64 + c8 + 2 * e2 + 1) * 4);
      o[2 * e2] = silu_f(wa[0] * bflo(wm_) + wa[1] * bflo(w0_) + wa[2] * bflo(wp_) + wa[3]);
      o[2 * e2 + 1] = silu_f(wb[0] * bfhi(wm_) + wb[1] * bfhi(w0_) + wb[2] * bfhi(wp_) + wb[3]);
    }
    if (grp == 0) {
      const float dtv = sdt[j];
#pragma unroll
      for (int e = 0; e < 8; ++e) sXT[(c8 + e) * 72 + j] = f2bf(o[e] * dtv);
    } else if (grp == 1) {
      const float sc_ = __expf(c63 - scs[j]);
      u32x4 w; w.x = pk_bf16(o[0], o[1]); w.y = pk_bf16(o[2], o[3]); w.z = pk_bf16(o[4], o[5]); w.w = pk_bf16(o[6], o[7]);
      *(u32x4*)(sB + j * 72 + c8) = w;
#pragma unroll
      for (int e = 0; e < 8; ++e) sBT[(c8 + e) * 72 + j] = f2bf(o[e] * sc_);
    } else {
      u32x4 w; w.x = pk_bf16(o[0], o[1]); w.y = pk_bf16(o[2], o[3]); w.z = pk_bf16(o[4], o[5]); w.w = pk_bf16(o[6], o[7]);
      *(u32x4*)(sC + j * 72 + c8) = w;
      if (wrC) *(u32x4*)(CB + (size_t)(base + t) * 128 + g * 64 + c8) = w;
    }
  }
  __syncthreads();
  const int lcol = 32 * li + l31;
  const float cl = scs[lcol];
  f32x16 y = zero16();
#pragma unroll
  for (int si = 0; si < 2; ++si) {
    if (si <= li) {
      f32x16 gt = zero16();
#pragma unroll
      for (int ks = 0; ks < 4; ++ks) gt = MFMA32(*(const bf16x8*)(sB + (32 * si + l31) * 72 + ks * 16 + hi * 8), *(const bf16x8*)(sC + lcol * 72 + ks * 16 + hi * 8), gt);
#pragma unroll
      for (int r = 0; r < 16; ++r) { const int s_ = 32 * si + crow(r, hi); gt[r] = (s_ <= lcol) ? gt[r] * __expf(cl - scs[s_]) : 0.f; }
#pragma unroll
      for (int kk = 0; kk < 2; ++kk) {
        const bf16x8 pb = pack8(gt[8 * kk], gt[8 * kk + 1], gt[8 * kk + 2], gt[8 * kk + 3], gt[8 * kk + 4], gt[8 * kk + 5], gt[8 * kk + 6], gt[8 * kk + 7]);
        const bf16_t* xr = sXT + (32 * pi + l31) * 72 + 32 * si + 16 * kk + 4 * hi;
        const s16x4 lo = *(const s16x4*)xr, h4 = *(const s16x4*)(xr + 8);
        y = MFMA32(__builtin_shufflevector(lo, h4, 0, 1, 2, 3, 4, 5, 6, 7), pb, y);
      }
    }
  }
  {
    const int posl = kl * 64 + lcol, t = d ? (Len - 1 - posl) : posl;
    bf16_t* yp = Yssd + (size_t)(base + t) * 256 + h * 64 + 32 * pi + 4 * hi;
#pragma unroll
    for (int r4 = 0; r4 < 4; ++r4) { u32x2 o; o.x = pk_bf16(y[4 * r4], y[4 * r4 + 1]); o.y = pk_bf16(y[4 * r4 + 2], y[4 * r4 + 3]); *(u32x2*)(yp + 8 * r4) = o; }
  }
  f32x16 sacc = zero16();
#pragma unroll
  for (int ks = 0; ks < 4; ++ks) sacc = MFMA32(*(const bf16x8*)(sXT + (32 * pi + l31) * 72 + ks * 16 + hi * 8), *(const bf16x8*)(sBT + (32 * li + l31) * 72 + ks * 16 + hi * 8), sacc);
  bf16_t* Sp = (bf16_t*)(p.ws + OFF_SS) + ((size_t)chain * 37 + ck + 1) * 4096;
#pragma unroll
  for (int r = 0; r < 16; ++r) Sp[(32 * pi + crow(r, hi)) * 64 + 32 * li + l31] = f2bf(sacc[r]);
  __syncthreads();
}

DI void ssd_scan(const Params& p, int chain) {
  const int tid = otid();
  char* slot0 = p.ws + OFF_SS + (size_t)chain * 37 * 8192 + tid * 32;
  const float* dec = (const float*)(p.ws + OFF_DEC) + chain * 36;
  float H[16];
#pragma unroll
  for (int i = 0; i < 16; ++i) H[i] = 0.f;
#pragma unroll 4
  for (int c = 0; c < 36; ++c) {
    const u32x4* sp = (const u32x4*)(slot0 + (size_t)(c + 1) * 8192);
    const u32x4 s0 = sp[0], s1 = sp[1];
    const float dc = dec[c];
    u32x4 w0, w1;
    w0.x = pk_bf16(H[0], H[1]); w0.y = pk_bf16(H[2], H[3]); w0.z = pk_bf16(H[4], H[5]); w0.w = pk_bf16(H[6], H[7]);
    w1.x = pk_bf16(H[8], H[9]); w1.y = pk_bf16(H[10], H[11]); w1.z = pk_bf16(H[12], H[13]); w1.w = pk_bf16(H[14], H[15]);
    u32x4* hp = (u32x4*)(slot0 + (size_t)c * 8192);
    hp[0] = w0; hp[1] = w1;
    H[0] = H[0] * dc + bflo(s0.x); H[1] = H[1] * dc + bfhi(s0.x); H[2] = H[2] * dc + bflo(s0.y); H[3] = H[3] * dc + bfhi(s0.y);
    H[4] = H[4] * dc + bflo(s0.z); H[5] = H[5] * dc + bfhi(s0.z); H[6] = H[6] * dc + bflo(s0.w); H[7] = H[7] * dc + bfhi(s0.w);
    H[8] = H[8] * dc + bflo(s1.x); H[9] = H[9] * dc + bfhi(s1.x); H[10] = H[10] * dc + bflo(s1.y); H[11] = H[11] * dc + bfhi(s1.y);
    H[12] = H[12] * dc + bflo(s1.z); H[13] = H[13] * dc + bfhi(s1.z); H[14] = H[14] * dc + bflo(s1.w); H[15] = H[15] * dc + bfhi(s1.w);
  }
}

DI void ssd_finish_tile(const Params& p, int layer, int tile, char* smem) {
  const int tid = otid(), lane = tid & 63, wave = tid >> 6, l31 = lane & 31, hi = lane >> 5;
  const int b = tile / 72, tb = tile % 72, p0 = tb * 32;
  const bool isctx = tb < 8;
  const int row0 = isctx ? (MROWS + b * CT + p0) : (b * SEQ + p0 - CT);
  const int T64 = tb >> 1, nch = isctx ? 4 : 32, Tl = isctx ? T64 : T64 - 4;
  const bf16_t* U = (const bf16_t*)(p.ws + OFF_U);
  const bf16_t* Y0 = (const bf16_t*)(p.ws + OFF_XN); const bf16_t* Y1 = Y0 + (size_t)ROWS * 256;
  const float* ECL = (const float*)(p.ws + OFF_ECL);
  bf16_t* Y = (bf16_t*)(p.ws + OFF_Y);
  bf16_t* sCc = (bf16_t*)smem;
  float* sY = (float*)(smem + 8704);
  {
    const bf16_t* CB = (const bf16_t*)(p.ws + OFF_CB) + (size_t)row0 * 128;
#pragma unroll
    for (int i = 0; i < 2; ++i) { const int c = tid + 256 * i, r = c >> 4, kc = c & 15; *(u32x4*)(sCc + r * 136 + kc * 8) = *(const u32x4*)(CB + r * 128 + kc * 8); }
  }
  __syncthreads();
  {
    const int pi = wave & 1, g = wave >> 1;
    const int row = row0 + l31;
    bf16x8 hf[2][2][4];
#pragma unroll
    for (int hh = 0; hh < 2; ++hh)
#pragma unroll
      for (int d = 0; d < 2; ++d) {
        const int h = g * 2 + hh;
        const int kl = d ? (nch - 1 - Tl) : Tl, ck = isctx ? kl : 4 + kl, chain = (b * 4 + h) * 2 + d;
        const char* Hs = p.ws + OFF_SS + ((size_t)chain * 37 + ck) * 8192 + (32 * pi + l31) * 128 + hi * 16;
#pragma unroll
        for (int ks = 0; ks < 4; ++ks) hf[hh][d][ks] = *(const bf16x8*)(Hs + ks * 32);
      }
    bf16x8 cfr[4];
#pragma unroll
    for (int ks = 0; ks < 4; ++ks) cfr[ks] = *(const bf16x8*)(sCc + l31 * 136 + g * 64 + ks * 16 + hi * 8);
    __builtin_amdgcn_sched_barrier(0);
#pragma unroll
    for (int hh = 0; hh < 2; ++hh) {
      const int h = g * 2 + hh;
      f32x16 ys = zero16();
#pragma unroll
      for (int d = 0; d < 2; ++d) {
        f32x16 acc = zero16();
#pragma unroll
        for (int ks = 0; ks < 4; ++ks) acc = MFMA32(hf[hh][d][ks], cfr[ks], acc);
        const float e = ECL[(size_t)(d * 4 + h) * ROWS + row];
        ys += acc * e;
      }
      const bf16_t* y0p = Y0 + (size_t)row * 256 + h * 64 + 32 * pi + 4 * hi; const bf16_t* y1p = Y1 + (size_t)row * 256 + h * 64 + 32 * pi + 4 * hi;
#pragma unroll
      for (int r4 = 0; r4 < 4; ++r4) {
        const u32x2 a_ = *(const u32x2*)(y0p + 8 * r4), c_ = *(const u32x2*)(y1p + 8 * r4);
        const f32x4 a = {bflo(a_.x), bfhi(a_.x), bflo(a_.y), bfhi(a_.y)}, c2 = {bflo(c_.x), bfhi(c_.x), bflo(c_.y), bfhi(c_.y)};
        f32x4 o; o[0] = ys[4 * r4] + a[0] + c2[0]; o[1] = ys[4 * r4 + 1] + a[1] + c2[1]; o[2] = ys[4 * r4 + 2] + a[2] + c2[2]; o[3] = ys[4 * r4 + 3] + a[3] + c2[3];
        *(f32x4*)(sY + l31 * 260 + h * 64 + 32 * pi + 8 * r4 + 4 * hi) = o;
      }
    }
  }
  __syncthreads();
  {
    const int ch = lane * 4, hd = lane >> 4;
    const float dsk = p.in[I_SSDD][layer * 8 + hd] + p.in[I_SSDD][layer * 8 + 4 + hd];
    f32x4 cw[3];
    {
      const float* w = p.in[I_CONVW] + ((size_t)layer * 512 + ch) * 3;
      const f32x4 a = *(const f32x4*)w, b2 = *(const f32x4*)(w + 4), c2 = *(const f32x4*)(w + 8);
      cw[0] = (f32x4){a[0], a[3], b2[2], c2[1]}; cw[1] = (f32x4){a[1], b2[0], b2[3], c2[2]}; cw[2] = (f32x4){a[2], b2[1], c2[0], c2[3]};
    }
    const f32x4 cb = *(const f32x4*)(p.in[I_CONVB] + layer * 512 + ch);
    const f32x4 ng = *(const f32x4*)(p.in[I_SSDNG] + layer * 256 + ch);
    const int Len = isctx ? CT : SEQ;
#pragma unroll 2
    for (int rr = wave; rr < 32; rr += 4) {
      const int row = row0 + rr;
      const int t = isctx ? (p0 + rr) : (p0 - CT + rr);
      const bf16_t* up = U + (size_t)row * INP;
      const u32x2 z2 = *(const u32x2*)(up + U_Z + ch);
      const u32x2 zz = {0u, 0u};
      const u32x2 xm = (t > 0) ? *(const u32x2*)(up - INP + U_X + ch) : zz;
      const u32x2 x0 = *(const u32x2*)(up + U_X + ch);
      const u32x2 xp = (t < Len - 1) ? *(const u32x2*)(up + INP + U_X + ch) : zz;
      const f32x4 xmf = {bflo(xm.x), bfhi(xm.x), bflo(xm.y), bfhi(xm.y)}, x0f = {bflo(x0.x), bfhi(x0.x), bflo(x0.y), bfhi(x0.y)}, xpf = {bflo(xp.x), bfhi(xp.x), bflo(xp.y), bfhi(xp.y)};
      const f32x4 zf = {bflo(z2.x), bfhi(z2.x), bflo(z2.y), bfhi(z2.y)};
      const f32x4 cv = cw[0] * xmf + cw[1] * x0f + cw[2] * xpf + cb;
      const f32x4 ya = *(const f32x4*)(sY + rr * 260 + ch);
      f32x4 gz; float ss = 0.f;
#pragma unroll
      for (int e = 0; e < 4; ++e) { const float xs = silu_f(cv[e]); const float yv = ya[e] + dsk * xs; gz[e] = yv * silu_f(zf[e]); ss += gz[e] * gz[e]; }
      ss = wave_sum(ss);
      const float rstd = rsqrtf(ss * (1.f / 256.f) + EPS);
      u32x2 w; w.x = pk_bf16(gz[0] * rstd * ng[0], gz[1] * rstd * ng[1]); w.y = pk_bf16(gz[2] * rstd * ng[2], gz[3] * rstd * ng[3]);
      *(u32x2*)(Y + (size_t)row * DM + ch) = w;
    }
  }
  __syncthreads();
}

DI void mixer_phase(const Params& p, int layer_c, char* smem, int* s_item) {
  const int layer = layer_c % DEPTH;
  const bool with_ctx = layer < DEPTH - 1;
  const int nqb = with_ctx ? 9 : 8;
  const int natt = 12 * nqb, nfin = with_ctx ? 36 : 32;
  const int nitems = 4 + natt + nfin;
  unsigned* cnt = (unsigned*)(p.ws + OFF_MISC) + layer_c * 8;
  unsigned* sdone = (unsigned*)(p.ws + OFF_MISC) + 72 + layer * 8;
  for (int qq = 0; qq < 8; ++qq) {
    const int q = (blockIdx.x + qq) & 7;
    for (;;) {
      if (threadIdx.x == 0) *s_item = (int)atomicAdd(&cnt[q], 1u);
      __syncthreads();
      const int it = *s_item;
      __syncthreads();
      if (it >= nitems) break;
      if (it < 4) {
        ssd_scan(p, q * 8 + it * 2 + half_id());
        asm volatile("s_waitcnt vmcnt(0)" ::: "memory");
        __syncthreads();
        if (threadIdx.x == 0) {
          __builtin_amdgcn_fence(__ATOMIC_RELEASE, "agent");
          asm volatile("s_waitcnt vmcnt(0)" ::: "memory");
          __hip_atomic_fetch_add(&sdone[q], 1u, __ATOMIC_RELAXED, __HIP_MEMORY_SCOPE_AGENT);
        }
      } else if (it < 4 + natt) {
        const int idx = it - 4;
        int kind, head, qb;
        if (idx < 96) { const int hidx = idx >> 3; qb = (idx & 7) + 1; const int ko = hidx >> 2; kind = ko == 0 ? 1 : (ko == 1 ? 0 : 2); head = hidx & 3; }
        else { const int hidx = idx - 96; qb = 0; const int ko = hidx >> 2; kind = ko == 0 ? 1 : (ko == 1 ? 0 : 2); head = hidx & 3; }
        attn_unit(p, layer, q, kind, head, qb, smem);
      } else {
        if (threadIdx.x == 0) {
          while (__hip_atomic_load(&sdone[q], __ATOMIC_RELAXED, __HIP_MEMORY_SCOPE_AGENT) < 4u) __builtin_amdgcn_s_sleep(2);
          __builtin_amdgcn_fence(__ATOMIC_ACQUIRE, "agent");
          asm volatile("s_waitcnt vmcnt(0)" ::: "memory");
        }
        __syncthreads();
        const int fi = it - 4 - natt;
        const int tile = q * 72 + (with_ctx ? 0 : 8) + fi * 2 + half_id();
        ssd_finish_tile(p, layer, tile, smem + half_id() * SMEM_BYTES);
      }
      __syncthreads();
    }
  }
}

#define XB_TMO      128
#define XB_XCNT(j)  (256  + 64 * (j))
#define XB_XSUB(j)  (1280 + 64 * (j))
#define XB_XGEN(j)  (2304 + 64 * (j))
#define XB_TOP      3328
#define XB_TOPGEN   3392
#define XCD_BAR_WORDS 3456
#define XB_SPIN_CAP (1u << 18)
#define LAS __attribute__((address_space(3)))

__device__ __forceinline__ unsigned xb_ld(unsigned* p)              { return __hip_atomic_load(p, __ATOMIC_RELAXED, __HIP_MEMORY_SCOPE_AGENT); }
__device__ __forceinline__ unsigned xb_add(unsigned* p, unsigned v) { return __hip_atomic_fetch_add(p, v, __ATOMIC_RELAXED, __HIP_MEMORY_SCOPE_AGENT); }
__device__ __forceinline__ unsigned xb_xcc_id() { return (unsigned)__builtin_amdgcn_s_getreg((3 << 11) | 20) & 0xFu; }
#define XB_SPIN(cond, bar) do { unsigned _sp = 0; while (cond) { __builtin_amdgcn_s_sleep(1); \
    if ((++_sp & 255u) == 0u) { if (xb_ld(&(bar)[XB_TMO])) break; if (_sp > XB_SPIN_CAP) { atomicAdd(&(bar)[XB_TMO], 1u); break; } } } } while (0)

struct XcdBarrier {
    unsigned* bar; unsigned x;
    volatile LAS unsigned* st;
};

__device__ __forceinline__ XcdBarrier xcd_barrier_post(unsigned* bar, volatile LAS unsigned* st) {
    XcdBarrier b; b.bar = bar; b.x = xb_xcc_id(); b.st = st;
    if (threadIdx.x == 0) (void)xb_add(&bar[XB_XCNT(b.x)], 1u);
    return b;
}
__device__ __forceinline__ void xcd_barrier_complete(unsigned* bar, unsigned x, unsigned& nloc, unsigned& nx) {
    const unsigned G = gridDim.x * gridDim.y * gridDim.z;
    unsigned sum, cnt, mine, sp = 0u;
    for (;;) {
        sum = 0u; cnt = 0u; mine = 0u;
#pragma unroll
        for (unsigned j = 0; j < 16; ++j) { const unsigned c = xb_ld(&bar[XB_XCNT(j)]); sum += c; cnt += (c > 0u) ? 1u : 0u; mine = (j == x) ? c : mine; }
        if (sum == G) break;
        __builtin_amdgcn_s_sleep(1);
        if ((++sp & 255u) == 0u) { if (xb_ld(&bar[XB_TMO])) break; if (sp > XB_SPIN_CAP) { atomicAdd(&bar[XB_TMO], 1u); break; } }
    }
    nloc = mine > 0u ? mine : 1u; nx = cnt > 0u ? cnt : 1u;
}

__device__ __forceinline__ void xcd_barrier(const XcdBarrier& b) {
    asm volatile("s_waitcnt vmcnt(0)" ::: "memory");
    __syncthreads();
    if (threadIdx.x == 0) {
        unsigned* bar = b.bar;
        __builtin_amdgcn_s_waitcnt(0);
        unsigned nloc = b.st[0], nx = b.st[1];
        if (nloc == 0u) { xcd_barrier_complete(bar, b.x, nloc, nx); b.st[0] = nloc; b.st[1] = nx; }
        const unsigned old = xb_add(&bar[XB_XSUB(b.x)], 1u);
        const unsigned gen = old / nloc;
        if (old + 1u == (gen + 1u) * nloc) {
            __builtin_amdgcn_fence(__ATOMIC_RELEASE, "agent");
            asm volatile("s_waitcnt vmcnt(0)" ::: "memory");
            const unsigned og = xb_add(&bar[XB_TOP], 1u);
            const unsigned tg = og / nx;
            if (og + 1u == (tg + 1u) * nx) xb_add(&bar[XB_TOPGEN], 1u);
            else XB_SPIN(xb_ld(&bar[XB_TOPGEN]) == tg, bar);
            __builtin_amdgcn_fence(__ATOMIC_ACQUIRE, "agent");
            xb_add(&bar[XB_XGEN(b.x)], 1u);
            asm volatile("s_waitcnt vmcnt(0)" ::: "memory");
        } else {
            XB_SPIN(xb_ld(&bar[XB_XGEN(b.x)]) == gen, bar);
            __builtin_amdgcn_fence(__ATOMIC_ACQUIRE, "agent");
            asm volatile("s_waitcnt vmcnt(0)" ::: "memory");
        }
    }
    __syncthreads();
}

DI void gbar(unsigned* bw, unsigned k) {
  asm volatile("s_waitcnt vmcnt(0)" ::: "memory");
  __syncthreads();
  if (threadIdx.x == 0) {
    __builtin_amdgcn_fence(__ATOMIC_RELEASE, "agent");
    asm volatile("s_waitcnt vmcnt(0)" ::: "memory");
    unsigned bx_ = blockIdx.x, gd_ = gridDim.x; asm volatile("" : "+s"(bx_), "+s"(gd_));
    const unsigned x = bx_ & 7u, nloc = (gd_ - x + 7u) >> 3;
    unsigned* sub = bw + 64 * (1 + x); unsigned* gen = bw + 64 * (9 + x); unsigned* top = bw + 64 * 17;
    const unsigned old = __hip_atomic_fetch_add(sub, 1u, __ATOMIC_RELAXED, __HIP_MEMORY_SCOPE_AGENT);
    if (old + 1u == k * nloc) {
      __hip_atomic_fetch_add(top, 1u, __ATOMIC_RELAXED, __HIP_MEMORY_SCOPE_AGENT);
      while (__hip_atomic_load(top, __ATOMIC_RELAXED, __HIP_MEMORY_SCOPE_AGENT) < 8u * k) __builtin_amdgcn_s_sleep(1);
      __hip_atomic_fetch_add(gen, 1u, __ATOMIC_RELAXED, __HIP_MEMORY_SCOPE_AGENT);
    } else {
      while (__hip_atomic_load(gen, __ATOMIC_RELAXED, __HIP_MEMORY_SCOPE_AGENT) < k) __builtin_amdgcn_s_sleep(1);
    }
    __builtin_amdgcn_fence(__ATOMIC_ACQUIRE, "agent");
    asm volatile("s_waitcnt vmcnt(0)" ::: "memory");
  }
  __syncthreads();
}

__global__ void __launch_bounds__(NTHREADS, 2) fwd_megakernel(Params p) {
  cg::grid_group grid = cg::this_grid();
  extern __shared__ __attribute__((aligned(16))) unsigned char lds_dyn[];
  __shared__ uint4 s_misc[2];
  int& s_item = *(int*)&s_misc[1];
  if (threadIdx.x == 0) s_misc[0] = make_uint4(0u, 0u, 0u, 0u);
  __syncthreads();
  (void)xcd_barrier_post((unsigned*)(p.ws + OFF_MISC + 16384), (volatile LAS unsigned*)&s_misc[0]);
#define GBAR() do { XcdBarrier xb_; xb_.bar = (unsigned*)(p.ws + OFF_MISC + 16384); xb_.x = xb_xcc_id(); xb_.st = (volatile LAS unsigned*)&s_misc[0]; xcd_barrier(xb_); } while (0)
  char* smem = (char*)lds_dyn;
  const int half = half_id();
  unsigned* bw = (unsigned*)(p.ws + OFF_MISC) + 256; unsigned bk = 0;
  phase0(p, smem);
  if (p.ws == nullptr) grid.sync();
  GBAR();
  mod_reduce(p);
  GBAR();
  const float* MOD = (const float*)(p.ws + OFF_MOD);
  bf16_t* XN = (bf16_t*)(p.ws + OFF_XN);
  bf16_t* U = (bf16_t*)(p.ws + OFF_U);
  bf16_t* Y = (bf16_t*)(p.ws + OFF_Y);
  bf16_t* HM = (bf16_t*)(p.ws + OFF_HM);
  float* HC = (float*)(p.ws + OFF_HC);
  PG8_LAS unsigned char* glds = (PG8_LAS unsigned char*)lds_dyn;
#pragma unroll 1
  for (int layer = 0; layer < DEPTH; ++layer) {
    const bool with_ctx = layer < DEPTH - 1;
    const int mrows = with_ctx ? ROWS : MROWS;
    int bx = (int)blockIdx.x; asm volatile("" : "+s"(bx));
    for (int rep = 0; rep < PROBE_N1; ++rep) { norm_phase(p, layer, 0, ROWS, layer > 0 ? MOD + (size_t)((layer - 1) * 9 + 8) * 6144 + 5120 : nullptr, HC);
    GBAR(); }
    for (int rep = 0; rep < PROBE_INPROJ; ++rep) { pg8::Gemm g{XN, (const bf16_t*)(p.ws + OFF_WIN) + (size_t)layer * INPW * DM, ROWS, INPW, DM, DM}; pg8::StaticOrder S; S.init(ROWS, INPW, (int)gridDim.x, bx);
      pg8::EpiStore<0> E{U, INP, INP};
      pg8::gemm_phase<pg8::EpiStore<0>, pg8::StaticOrder, true, true>(glds, g, S, E);
    GBAR(); }
    for (int rep = 0; rep < PROBE_PREP; ++rep) {
      unsigned* qc = (unsigned*)(p.ws + OFF_MISC) + 64 + layer + rep * DEPTH;
      for (;;) {
        if (threadIdx.x == 0) s_item = (int)atomicAdd(qc, 1u);
        __syncthreads();
        const int it = s_item;
        __syncthreads();
        if (it >= 1152 + 288) break;
        if (it < 144) prep_tile(p, layer, it * 2 + half, 0, smem + half * SMEM_BYTES);
        else if (it < 288) prep_tile(p, layer, (it - 144) * 2 + half, 1, smem + half * SMEM_BYTES);
        else ssd_chunk(p, layer, it - 288, smem + half * SMEM_BYTES);
      }
      GBAR();
    }
    for (int rep = 0; rep < PROBE_MIX; ++rep) { mixer_phase(p, layer + rep * DEPTH, smem, &s_item);
    GBAR(); }
    { const bf16_t* Wt = (const bf16_t*)(p.ws + OFF_WOUT) + (size_t)layer * DM * DM;
      { pg8::Gemm g{Y, Wt, MROWS, DM, DM, DM}; pg8::StaticOrder S; S.init(MROWS, DM, (int)gridDim.x, bx);
        pg8::EpiResid E{layer == 0 ? p.in[I_X] : p.out, nullptr, p.out, nullptr, MOD + (size_t)layer * 9 * 6144 + 2048, 1.f};
        pg8::gemm_phase<pg8::EpiResid, pg8::StaticOrder, true, true>(glds, g, S, E);
        for (int rep = 0; rep < PROBE_OUT; ++rep) { GBAR(); pg8::EpiResid E2{p.out, nullptr, p.out, nullptr, MOD + (size_t)layer * 9 * 6144 + 2048, 0.f}; pg8::gemm_phase<pg8::EpiResid, pg8::StaticOrder, true, true>(glds, g, S, E2); } }
      if (with_ctx) {
        const int ks = (bx >> 5) & 3;
        pg8::Gemm g{Y + (size_t)MROWS * DM + ks * (DM / 4), Wt + ks * (DM / 4), CROWS, DM, DM, DM / 4}; pg8::SplitOrder S{bx};
        pg8::EpiPartial E{(float*)(p.ws + OFF_SS) + (size_t)ks * CROWS * DM};
        pg8::gemm_phase<pg8::EpiPartial, pg8::SplitOrder, true, true>(glds, g, S, E); } }
    GBAR();
    norm_phase(p, layer, 1, mrows, with_ctx ? MOD + (size_t)(layer * 9 + 8) * 6144 + 2048 : nullptr, layer == 0 ? p.in[I_CTX] : HC);
    GBAR();
    for (int rep = 0; rep < PROBE_UP; ++rep) { pg8::Gemm g{XN, (const bf16_t*)(p.ws + OFF_W1) + (size_t)layer * DFF * DM, mrows, DFF, DM, DM}; pg8::StaticOrder S; S.init(mrows, DFF, (int)gridDim.x, bx);
      pg8::EpiStore<1> E{HM, DFF, DFF};
      pg8::gemm_phase<pg8::EpiStore<1>, pg8::StaticOrder, true, true>(glds, g, S, E);
    GBAR(); }
    { const bf16_t* Wt = (const bf16_t*)(p.ws + OFF_W2) + (size_t)layer * DM * DFF;
      { pg8::Gemm g{HM, Wt, MROWS, DM, DFF, DFF}; pg8::StaticOrder S; S.init(MROWS, DM, (int)gridDim.x, bx);
        pg8::EpiResid E{p.out, nullptr, p.out, nullptr, MOD + (size_t)layer * 9 * 6144 + 5120, 1.f};
        pg8::gemm_phase<pg8::EpiResid, pg8::StaticOrder, true, true>(glds, g, S, E);
        for (int rep = 0; rep < PROBE_DOWN; ++rep) { GBAR(); pg8::EpiResid E2{p.out, nullptr, p.out, nullptr, MOD + (size_t)layer * 9 * 6144 + 5120, 0.f}; pg8::gemm_phase<pg8::EpiResid, pg8::StaticOrder, true, true>(glds, g, S, E2); } }
      if (with_ctx) {
        const int ks = (bx >> 5) & 3;
        pg8::Gemm g{HM + (size_t)MROWS * DFF + ks * (DFF / 4), Wt + ks * (DFF / 4), CROWS, DM, DFF, DFF / 4}; pg8::SplitOrder S{bx};
        pg8::EpiPartial E{(float*)(p.ws + OFF_SS) + (size_t)ks * CROWS * DM};
        pg8::gemm_phase<pg8::EpiPartial, pg8::SplitOrder, true, true>(glds, g, S, E); } }
    GBAR();
  }
  norm_phase(p, 0, 2, MROWS);
}

extern "C" void kernel_launch(void* const* d_in, const int* in_sizes, int n_in, void* d_out, int out_size, void* d_ws, size_t ws_size, hipStream_t stream) {
  static int grid_blocks = 0;
  if (!grid_blocks) {
    int dev = 0, cus = 0, per_cu = 0;
    (void)hipGetDevice(&dev);
    (void)hipDeviceGetAttribute(&cus, hipDeviceAttributeMultiprocessorCount, dev);
    if (hipFuncSetAttribute((const void*)fwd_megakernel, hipFuncAttributeMaxDynamicSharedMemorySize, LDS_BYTES) != hipSuccess) fprintf(stderr, "hipFuncSetAttribute(max dynamic LDS) failed\n");
    (void)hipOccupancyMaxActiveBlocksPerMultiprocessor(&per_cu, (const void*)fwd_megakernel, NTHREADS, LDS_BYTES);
    if (per_cu < 1) { fprintf(stderr, "occupancy query says %d blocks/CU\n", per_cu); per_cu = 1; }
    grid_blocks = cus;
  }
  if (ws_size < OFF_END) { fprintf(stderr, "workspace too small: %zu < %zu\n", ws_size, (size_t)OFF_END); return; }
  Params p{};
  for (int i = 0; i < 27; ++i) p.in[i] = (const float*)d_in[i];
  p.out = (float*)d_out;
  p.ws = (char*)d_ws;
  (void)hipMemsetAsync((char*)d_ws + OFF_MISC, 0, SZ_MISC, stream);
  void* args[] = {&p};
  hipError_t e = hipLaunchCooperativeKernel((void*)fwd_megakernel, dim3(grid_blocks), dim3(NTHREADS), args, LDS_BYTES, stream);
  if (e != hipSuccess) fprintf(stderr, "cooperative launch failed: %s (grid %d)\n", hipGetErrorString(e), grid_blocks);
}
```

```cpp
#include <hip/hip_runtime.h>
#include <hip/hip_cooperative_groups.h>
#include <stdint.h>
#include <cstdio>
namespace cg = cooperative_groups;

typedef unsigned short bf16_t;
typedef short bf16x8 __attribute__((ext_vector_type(8)));
typedef short s16x4 __attribute__((ext_vector_type(4)));
typedef float f32x16 __attribute__((ext_vector_type(16)));
typedef float f32x4 __attribute__((ext_vector_type(4)));
typedef float f32x2 __attribute__((ext_vector_type(2)));
typedef unsigned u32x4 __attribute__((ext_vector_type(4)));
typedef unsigned u32x2 __attribute__((ext_vector_type(2)));
typedef __bf16 bf2_t __attribute__((ext_vector_type(2)));

#define DI __device__ __forceinline__
#define MFMA32(a, b, c) __builtin_amdgcn_mfma_f32_32x32x16_bf16((a), (b), (c), 0, 0, 0)

constexpr int DM = 1024, NB = 8, SEQ = 2048, DEPTH = 4, CT = 256, TT = 2304;
constexpr int MROWS = NB * SEQ, CROWS = NB * CT, ROWS = MROWS + CROWS;
constexpr int INC = 2408, INP = 2432, INPW = 2560, DFF = 4096;
constexpr float EPS = 1e-6f;
constexpr float LOG2E = 1.4426950408889634f;
constexpr int U_Z = 0, U_X = 256, U_B = 512, U_C = 640, U_DT = 768;
constexpr int U_DQ = 776, U_DK = 1032, U_DV = 1288;
constexpr int U_GQ = 1544, U_GK = 1800, U_GV = 1928;
constexpr int U_MQ = 2056, U_MKV = 2248, U_MR = 2376;

constexpr size_t al256(size_t x) { return (x + 255) & ~(size_t)255; }
constexpr size_t SZ_WIN = (size_t)DEPTH * INPW * DM * 2;
constexpr size_t SZ_WOUT = (size_t)DEPTH * DM * DM * 2;
constexpr size_t SZ_W1 = (size_t)DEPTH * DFF * DM * 2;
constexpr size_t SZ_W2 = (size_t)DEPTH * DM * DFF * 2;
constexpr size_t SZ_WUQ = (size_t)DEPTH * 384 * 192 * 2;
constexpr size_t SZ_WUKV = (size_t)DEPTH * 512 * 128 * 2;
constexpr size_t SZ_MOD = (size_t)DEPTH * 9 * 6144 * 4;
constexpr size_t SZ_MISC = 32768;
constexpr size_t SZ_ROPEH = (size_t)SEQ * 32 * 8;
constexpr size_t SZ_ROPED = (size_t)SEQ * 16 * 8;
constexpr size_t SZ_HC = (size_t)CROWS * DM * 4;
constexpr size_t SZ_XN = (size_t)ROWS * DM * 2;
constexpr size_t SZ_U = (size_t)ROWS * INP * 2;
constexpr size_t SZ_QD = (size_t)NB * 8 * TT * 32 * 2;
constexpr size_t SZ_VT4 = (size_t)NB * 4 * 64 * TT * 2;
constexpr size_t SZ_QG = (size_t)NB * 4 * TT * 64 * 2;
constexpr size_t SZ_KG = (size_t)NB * 2 * TT * 64 * 2;
constexpr size_t SZ_QM = (size_t)NB * 4 * TT * 96 * 2;
constexpr size_t SZ_Y = (size_t)ROWS * DM * 2;

constexpr size_t OFF_MOD = 0;
constexpr size_t OFF_MISC = OFF_MOD + al256(SZ_MOD);
constexpr size_t OFF_WIN = OFF_MISC + SZ_MISC;
constexpr size_t OFF_WOUT = OFF_WIN + al256(SZ_WIN);
constexpr size_t OFF_W1 = OFF_WOUT + al256(SZ_WOUT);
constexpr size_t OFF_W2 = OFF_W1 + al256(SZ_W1);
constexpr size_t OFF_WUQ = OFF_W2 + al256(SZ_W2);
constexpr size_t OFF_WUKV = OFF_WUQ + al256(SZ_WUQ);
constexpr size_t OFF_ROPEH = OFF_WUKV + al256(SZ_WUKV);
constexpr size_t OFF_ROPED = OFF_ROPEH + al256(SZ_ROPEH);
constexpr size_t OFF_HC = OFF_ROPED + al256(SZ_ROPED);
constexpr size_t OFF_XN = OFF_HC + al256(SZ_HC);
constexpr size_t OFF_BIG = OFF_XN + al256(SZ_XN);
constexpr size_t OFF_U = OFF_BIG;
constexpr size_t OFF_QD = OFF_U + al256(SZ_U);
constexpr size_t OFF_KD = OFF_QD + al256(SZ_QD);
constexpr size_t OFF_VTD = OFF_KD + al256(SZ_QD);
constexpr size_t OFF_QG = OFF_VTD + al256(SZ_VT4);
constexpr size_t OFF_KG = OFF_QG + al256(SZ_QG);
constexpr size_t OFF_VTG = OFF_KG + al256(SZ_KG);
constexpr size_t OFF_QM = OFF_VTG + al256(SZ_KG);
constexpr size_t OFF_KM = OFF_QM + al256(SZ_QM);
constexpr size_t OFF_VTM = OFF_KM + al256(SZ_QM);
constexpr size_t OFF_Y = OFF_VTM + al256(SZ_VT4);
constexpr size_t SZ_SS = (size_t)64 * 37 * 16384;
constexpr size_t SZ_DEC = (size_t)64 * 36 * 4;
constexpr size_t SZ_ECL = (size_t)8 * ROWS * 4;
constexpr size_t SZ_CB = (size_t)ROWS * 128 * 2;
constexpr size_t OFF_SS = OFF_Y + al256(SZ_Y);
constexpr size_t OFF_DEC = OFF_SS + al256(SZ_SS);
constexpr size_t OFF_ECL = OFF_DEC + al256(SZ_DEC);
constexpr size_t OFF_CB = OFF_ECL + al256(SZ_ECL);
constexpr size_t OFF_END = OFF_CB + al256(SZ_CB);
static_assert(OFF_END <= (size_t)402653184, "workspace budget (4 x mod_w)");
constexpr size_t OFF_HM = OFF_BIG;
static_assert((size_t)ROWS * DFF * 2 <= OFF_Y - OFF_BIG, "HM overlay must not reach Y");
static_assert((size_t)2 * ROWS * 256 * 4 <= SZ_XN, "Yssd overlay");

struct Params {
  const float* in[27];
  float* out;
  char* ws;
};
enum { I_X = 0, I_C, I_CTX, I_CCTX, I_MODW, I_MODB, I_N1G, I_N2G, I_WIN, I_CONVW, I_CONVB, I_DTB, I_ALOG, I_SSDD, I_SSDNG,
       I_DLAM, I_DNG, I_GQN, I_GKN, I_MQN, I_MKVN, I_WUQ, I_WUKV, I_WOUT, I_W1, I_W2, I_FNG };

constexpr int SMEM_BYTES = 65536;
constexpr int LDS_BYTES = 131072, NTHREADS = 512;
#ifndef PROBE_DOWN
#define PROBE_DOWN 0
#endif
#ifndef PROBE_OUT
#define PROBE_OUT 0
#endif
#ifndef PROBE_P0
#define PROBE_P0 1
#endif
#ifndef PROBE_N1
#define PROBE_N1 1
#endif
#ifndef PROBE_FIN
#define PROBE_FIN 1
#endif
#ifndef PROBE_UP
#define PROBE_UP 1
#endif
#ifndef PROBE_PREP
#define PROBE_PREP 1
#endif
#ifndef PROBE_MIX
#define PROBE_MIX 1
#endif
#ifndef PROBE_INPROJ
#define PROBE_INPROJ 1
#endif

DI unsigned pk_bf16(float a, float b) { f32x2 v = {a, b}; bf2_t r = __builtin_convertvector(v, bf2_t); return __builtin_bit_cast(unsigned, r); }
DI bf16_t f2bf(float a) { return (bf16_t)(pk_bf16(a, 0.f) & 0xffffu); }
DI float bf2f(bf16_t v) { return __uint_as_float((unsigned)v << 16); }
DI float bflo(unsigned w) { return __uint_as_float(w << 16); }
DI float bfhi(unsigned w) { return __uint_as_float(w & 0xffff0000u); }
DI float silu_f(float x) { return x / (1.f + __expf(-x)); }
DI float wave_sum(float v) {
#pragma unroll
  for (int o = 32; o >= 1; o >>= 1) v += __shfl_xor(v, o);
  return v;
}
DI int crow(int r, int hi) { return (r & 3) + 8 * (r >> 2) + 4 * hi; }
DI bf16x8 pack8(float a0, float a1, float a2, float a3, float a4, float a5, float a6, float a7) {
  u32x4 p; p.x = pk_bf16(a0, a1); p.y = pk_bf16(a2, a3); p.z = pk_bf16(a4, a5); p.w = pk_bf16(a6, a7);
  return __builtin_bit_cast(bf16x8, p);
}
DI f32x16 zero16() { f32x16 z;
#pragma unroll
  for (int i = 0; i < 16; ++i) z[i] = 0.f;
  return z; }
DI int otid() { int t = threadIdx.x & 255; asm volatile("" : "+v"(t)); return t; }
DI int otid_full() { int t = threadIdx.x; asm volatile("" : "+v"(t)); return t; }
DI int half_id() { return __builtin_amdgcn_readfirstlane((int)threadIdx.x >> 8); }
DI int hrow_of(int b, int pos) { return pos < CT ? (MROWS + b * CT + pos) : (b * SEQ + pos - CT); }

DI void tconv_tile(const float* __restrict__ src, int K, int N, bf16_t* __restrict__ dst, int kt, int nt, unsigned* sT) {
  const int tid = otid();
#pragma unroll
  for (int p = 0; p < 2; ++p) {
    const int idx = tid + 256 * p, kp = idx >> 4, nc = idx & 15;
    const int k = kt * 64 + 2 * kp, n = nt * 64 + nc * 4;
    f32x4 v0 = {0.f, 0.f, 0.f, 0.f}, v1 = {0.f, 0.f, 0.f, 0.f};
    if (n < N) { v0 = *(const f32x4*)(src + (size_t)k * N + n); v1 = *(const f32x4*)(src + (size_t)(k + 1) * N + n); }
#pragma unroll
    for (int e = 0; e < 4; ++e) sT[(nc * 4 + e) * 33 + kp] = pk_bf16(v0[e], v1[e]);
  }
  __syncthreads();
  {
    const int n = tid >> 2, part = tid & 3;
    u32x4 a, b;
    const unsigned* s = sT + n * 33 + part * 8;
    a.x = s[0]; a.y = s[1]; a.z = s[2]; a.w = s[3]; b.x = s[4]; b.y = s[5]; b.z = s[6]; b.w = s[7];
    bf16_t* d = dst + (size_t)(nt * 64 + n) * K + kt * 64 + part * 16;
    *(u32x4*)d = a; *(u32x4*)(d + 8) = b;
  }
  __syncthreads();
}

DI void mod_task(const Params& p, int task, float* sCond) {
  const int tid = otid();
  const int ks = task & 7, cb = (task >> 3) % 24, l = task / 192;
  for (int i = tid; i < 9 * 128; i += 256) {
    const int r = i >> 7, kk = i & 127;
    const float v = (r < 8) ? p.in[I_C][r * DM + ks * 128 + kk] : p.in[I_CCTX][ks * 128 + kk];
    sCond[i] = silu_f(v);
  }
  __syncthreads();
  const int col = cb * 256 + tid;
  const float* w = p.in[I_MODW] + ((size_t)l * DM + ks * 128) * 6144 + col;
  float acc[9];
#pragma unroll
  for (int r = 0; r < 9; ++r) acc[r] = 0.f;
#pragma unroll 8
  for (int kk = 0; kk < 128; ++kk) {
    const float wv = w[(size_t)kk * 6144];
#pragma unroll
    for (int r = 0; r < 9; ++r) acc[r] += sCond[r * 128 + kk] * wv;
  }
  const float bias = (ks == 0) ? p.in[I_MODB][l * 6144 + col] : 0.f;
  float* MODP = (float*)(p.ws + OFF_Y) + (size_t)ks * (DEPTH * 9 * 6144);
#pragma unroll
  for (int r = 0; r < 9; ++r) MODP[(size_t)(l * 9 + r) * 6144 + col] = acc[r] + bias;
  __syncthreads();
}

DI void phase0(const Params& p, char* smem) {
  constexpr int T_WIN = DEPTH * 16 * 38, T_WOUT = DEPTH * 16 * 16, T_W1 = DEPTH * 16 * 64, T_W2 = DEPTH * 64 * 16;
  constexpr int T_UQ = DEPTH * 3 * 6, T_UKV = DEPTH * 2 * 8, T_MOD = 768, T_ROPE = (SEQ * 48) / 256, T_MISC = 1;
  constexpr int E0 = T_WIN, E1 = E0 + T_WOUT, E2 = E1 + T_W1, E3 = E2 + T_W2, E4 = E3 + T_UQ, E5 = E4 + T_UKV, E6 = E5 + T_MOD, E7 = E6 + T_ROPE, E8 = E7 + T_MISC;
  const int tid = otid();
  const int half = half_id(); smem += half * SMEM_BYTES;
  static_assert(E0 % 2 == 0 && E1 % 2 == 0 && E2 % 2 == 0 && E3 % 2 == 0 && E4 % 2 == 0 && E5 % 2 == 0 && E6 % 2 == 0 && E7 % 2 == 0, "half-block pairs must not straddle task types");
  for (int t0 = blockIdx.x * 2; t0 < E8; t0 += gridDim.x * 2) {
    const int t = t0 + half;
    if (t >= E8) break;
    if (t < E0) { const int l = t / (16 * 38), r = t % (16 * 38); tconv_tile(p.in[I_WIN] + (size_t)l * DM * INC, DM, INC, (bf16_t*)(p.ws + OFF_WIN) + (size_t)l * INPW * DM, r / 38, r % 38, (unsigned*)smem); }
    else if (t < E1) { const int u = t - E0, l = u / 256, r = u % 256; tconv_tile(p.in[I_WOUT] + (size_t)l * DM * DM, DM, DM, (bf16_t*)(p.ws + OFF_WOUT) + (size_t)l * DM * DM, r / 16, r % 16, (unsigned*)smem); }
    else if (t < E2) { const int u = t - E1, l = u / 1024, r = u % 1024; tconv_tile(p.in[I_W1] + (size_t)l * DM * DFF, DM, DFF, (bf16_t*)(p.ws + OFF_W1) + (size_t)l * DFF * DM, r / 64, r % 64, (unsigned*)smem); }
    else if (t < E3) { const int u = t - E2, l = u / 1024, r = u % 1024; tconv_tile(p.in[I_W2] + (size_t)l * DFF * DM, DFF, DM, (bf16_t*)(p.ws + OFF_W2) + (size_t)l * DM * DFF, r / 16, r % 16, (unsigned*)smem); }
    else if (t < E4) { const int u = t - E3, l = u / 18, r = u % 18; tconv_tile(p.in[I_WUQ] + (size_t)l * 192 * 384, 192, 384, (bf16_t*)(p.ws + OFF_WUQ) + (size_t)l * 384 * 192, r / 6, r % 6, (unsigned*)smem); }
    else if (t < E5) { const int u = t - E4, l = u / 16, r = u % 16; tconv_tile(p.in[I_WUKV] + (size_t)l * 128 * 512, 128, 512, (bf16_t*)(p.ws + OFF_WUKV) + (size_t)l * 512 * 128, r / 8, r % 8, (unsigned*)smem); }
    else if (t < E6) { mod_task(p, t - E5, (float*)smem); }
    else if (t < E7) {
      const int idx = (t - E6) * 256 + tid;
      int tt, i, nf; f32x2* dst;
      if (idx < SEQ * 32) { tt = idx >> 5; i = idx & 31; nf = 16; dst = (f32x2*)(p.ws + OFF_ROPEH) + idx; }
      else { const int j = idx - SEQ * 32; tt = j >> 4; i = j & 15; nf = 8; dst = (f32x2*)(p.ws + OFF_ROPED) + j; }
      const int f = i & (nf - 1);
      const float pos = (float)((i < nf) ? (tt >> 6) : (tt & 63));
      const float inv = exp2f(-(float)f * (13.287712379549449f / (float)nf));
      float rv = pos * inv * 0.15915494309189535f; rv -= rintf(rv);
      f32x2 cs; cs.x = __builtin_amdgcn_cosf(rv); cs.y = __builtin_amdgcn_sinf(rv);
      *dst = cs;
    } else {
      if (tid < DEPTH) {
        const float* lp = p.in[I_DLAM] + tid * 128;
        float s1 = 0.f, s2 = 0.f;
        for (int i = 0; i < 32; ++i) { s1 += lp[i] * lp[32 + i]; s2 += lp[64 + i] * lp[96 + i]; }
        const float li = 0.8f - 0.6f * expf(-0.3f * (float)tid);
        float* misc = (float*)(p.ws + OFF_MISC);
        misc[128 + tid] = expf(s1) - expf(s2) + li;
        misc[136 + tid] = li;
      }
    }
  }
}

DI void mod_reduce(const Params& p) {
  const float* MODP = (const float*)(p.ws + OFF_Y);
  float* MOD = (float*)(p.ws + OFF_MOD);
  constexpr int NTOT = DEPTH * 9 * 6144;
  for (int i = blockIdx.x * NTHREADS + otid_full(); i < NTOT; i += gridDim.x * NTHREADS) {
    float a = 0.f;
#pragma unroll
    for (int ks = 0; ks < 8; ++ks) a += MODP[(size_t)ks * NTOT + i];
    MOD[i] = a;
  }
}

DI void norm_phase(const Params& p, int layer, int which, int nrows, const float* pend_gate = nullptr, const float* pend_hin = nullptr) {
  constexpr int NR = 3;
  const int tid_ = otid_full(); const int lane = tid_ & 63, wave = tid_ >> 6;
  const int gw = blockIdx.x * 8 + wave, nw = gridDim.x * 8;
  const float* MOD = (const float*)(p.ws + OFF_MOD);
  bf16_t* XN = (bf16_t*)(p.ws + OFF_XN);
  const float* g = (which == 0 ? p.in[I_N1G] : which == 1 ? p.in[I_N2G] : p.in[I_FNG]) + (which == 2 ? 0 : layer * DM);
  f32x4 gv[4];
#pragma unroll
  for (int i = 0; i < 4; ++i) gv[i] = *(const f32x4*)(g + i * 256 + lane * 4);
  for (int row0 = gw; row0 < nrows; row0 += nw * NR) {
    f32x4 v[NR][4], shv[NR][4], scv[NR][4];
    float ss[NR];
#pragma unroll
    for (int j = 0; j < NR; ++j) {
      const int row = row0 + j * nw;
      ss[j] = 0.f;
      if (which != 2 && row < nrows) {
        const int bidx = row < MROWS ? (row >> 11) : 8;
        const float* sh = MOD + (size_t)(layer * 9 + bidx) * 6144 + which * 3072;
#pragma unroll
        for (int i = 0; i < 4; ++i) { shv[j][i] = *(const f32x4*)(sh + i * 256 + lane * 4); scv[j][i] = *(const f32x4*)(sh + 1024 + i * 256 + lane * 4); }
      }
      if (row < nrows) {
        if (pend_gate != nullptr && row >= MROWS) {
          const size_t ro = (size_t)(row - MROWS) * DM;
          const float* P = (const float*)(p.ws + OFF_SS) + ro;
#pragma unroll
          for (int i = 0; i < 4; ++i) {
            const int c = i * 256 + lane * 4;
            const f32x4 a = *(const f32x4*)(P + c), b2 = *(const f32x4*)(P + (size_t)CROWS * DM + c), c2 = *(const f32x4*)(P + (size_t)2 * CROWS * DM + c), d2 = *(const f32x4*)(P + (size_t)3 * CROWS * DM + c);
            v[j][i] = *(const f32x4*)(pend_hin + ro + c) + *(const f32x4*)(pend_gate + c) * (((a + b2) + c2) + d2);
          }
        } else {
          const float* h;
          if (row < MROWS) h = ((which == 0 && layer == 0) ? p.in[I_X] : p.out) + (size_t)row * DM;
          else h = ((which == 0 && layer == 0) ? p.in[I_CTX] : (const float*)(p.ws + OFF_HC)) + (size_t)(row - MROWS) * DM;
#pragma unroll
          for (int i = 0; i < 4; ++i) v[j][i] = *(const f32x4*)(h + i * 256 + lane * 4);
        }
      } else {
#pragma unroll
        for (int i = 0; i < 4; ++i) v[j][i] = (f32x4){0.f, 0.f, 0.f, 0.f};
      }
    }
#pragma unroll
    for (int j = 0; j < NR; ++j) {
      const int row = row0 + j * nw;
      if (row >= nrows) continue;
      if (pend_gate != nullptr && row >= MROWS) {
        float* hc = (float*)(p.ws + OFF_HC) + (size_t)(row - MROWS) * DM;
#pragma unroll
        for (int i = 0; i < 4; ++i) *(f32x4*)(hc + i * 256 + lane * 4) = v[j][i];
      }
#pragma unroll
      for (int i = 0; i < 4; ++i) ss[j] += v[j][i][0] * v[j][i][0] + v[j][i][1] * v[j][i][1] + v[j][i][2] * v[j][i][2] + v[j][i][3] * v[j][i][3];
      const float rstd = rsqrtf(wave_sum(ss[j]) * (1.f / DM) + EPS);
      if (which == 2) {
#pragma unroll
        for (int i = 0; i < 4; ++i) { f32x4 o = v[j][i] * rstd * gv[i]; *(f32x4*)(p.out + (size_t)row * DM + i * 256 + lane * 4) = o; }
      } else {
#pragma unroll
        for (int i = 0; i < 4; ++i) {
          const int c = i * 256 + lane * 4;
          f32x4 o = v[j][i] * rstd * gv[i] * (1.f + scv[j][i]) + shv[j][i];
          u32x2 w; w.x = pk_bf16(o[0], o[1]); w.y = pk_bf16(o[2], o[3]);
          *(u32x2*)(XN + (size_t)row * DM + c) = w;
        }
      }
    }
  }
}

namespace pg8 {
#define PG8_LAS __attribute__((address_space(3)))
typedef unsigned short bf16_t;
typedef short bf16x8 __attribute__((ext_vector_type(8)));
typedef float f32x4 __attribute__((ext_vector_type(4)));
typedef unsigned u32x4 __attribute__((ext_vector_type(4)));
constexpr int BM = 256, BK = 64, HALF = 128, HTB = HALF * BK * 2  , STAGE_BYTES = 8 * HTB, NXCD = 8, WGM = 8;

__host__ __device__ __forceinline__ int lds_byte(int r, int c) { const int st = (r >> 4) * 2 + (c >> 5), rr = r & 15, cc = c & 31, ob = rr * 64 + cc * 2; return st * 1024 + (ob ^ (((ob >> 9) & 1) << 5)); }
__host__ __device__ __forceinline__ void stage_rc(int b, int& R, int& C) { const int st = b / 1024, sb = b % 1024, swz = sb ^ (((sb >> 9) & 1) << 5); R = (st >> 1) * 16 + swz / 64; C = (st & 1) * 32 + (swz % 64) / 2; }
__host__ __device__ __forceinline__ int perm32(int rho) { const int n = rho >> 4, i = rho & 15; return 8 * (i >> 2) + 4 * n + (i & 3); }

struct Unit { int pm, pn; };
struct Gemm { const bf16_t* A; const bf16_t* Bt; int M, N, K, Kloop; };

struct StaticOrder {
    int nM, nN, nwg, G, c;
    __host__ __device__ void init(int M, int N, int G_, int c_) { nM = M / BM; nN = N / BM; nwg = nM * nN; G = G_; c = c_; }
    __host__ __device__ bool next(int i, Unit& u) const {
        const long L = (long)i * G + c; if (L >= nwg) return false;
        int wgid = (int)L; { const int q = nwg / NXCD, r = nwg % NXCD, xcd = wgid % NXCD, off = wgid / NXCD; wgid = (xcd < r ? xcd * (q + 1) : r * (q + 1) + (xcd - r) * q) + off; }
        const int nig = WGM * nN, gid = wgid / nig, fm = gid * WGM, gsz = (nM - fm) < WGM ? (nM - fm) : WGM;
        u.pm = fm + ((wgid % nig) % gsz); u.pn = (wgid % nig) / gsz; return true;
    }
    __device__ __forceinline__ void a_ready(const Unit&) const {}
    __device__ __forceinline__ void done(const Unit&) const {}
};


struct SplitOrder {
    int c;
    __host__ __device__ bool next(int i, Unit& u) const { if (i != 0 || c >= 128) return false; const int q = c & 31; u.pm = q & 7; u.pn = q >> 3; return true; }
    __device__ __forceinline__ void a_ready(const Unit&) const {}
    __device__ __forceinline__ void done(const Unit&) const {}
};
struct EpiPartial {
    static constexpr bool PERM = false, AFTER_DRAIN = false;
    float* P;
    __device__ __forceinline__ void operator()(const f32x4 (&acc)[2][2][4][2], const Unit& u, int wr, int wc, int fr, int fq) const {
        float* base = P + (size_t)u.pm * BM * 1024;
        const int col0 = u.pn * BM + wc * 32 + 4 * fq;
#pragma unroll
        for (int bj = 0; bj < 2; ++bj)
#pragma unroll
            for (int n = 0; n < 2; ++n)
#pragma unroll
                for (int ai = 0; ai < 2; ++ai)
#pragma unroll
                    for (int m = 0; m < 4; ++m) *(f32x4*)(base + (size_t)(ai * HALF + wr * 64 + m * 16 + fr) * 1024 + col0 + bj * HALF + n * 16) = acc[ai][bj][m][n];
    }
};
template <int ACT> struct EpiStore {
    static constexpr bool PERM = true, AFTER_DRAIN = false;
    bf16_t* O; int ldc; int ncols;
    __device__ __forceinline__ void operator()(const f32x4 (&acc)[2][2][4][2], const Unit& u, int wr, int wc, int fr, int fq) const {
        const int row0 = u.pm * BM + wr * 64 + fr, col0 = u.pn * BM + wc * 32 + 8 * fq;
#pragma unroll
        for (int ai = 0; ai < 2; ++ai)
#pragma unroll
            for (int m = 0; m < 4; ++m) { bf16_t* rowp = O + (size_t)(row0 + ai * HALF + m * 16) * ldc + col0;
#pragma unroll
                for (int bj = 0; bj < 2; ++bj) { if (col0 + bj * HALF < ncols) { f32x4 v0 = acc[ai][bj][m][0], v1 = acc[ai][bj][m][1];
                    if (ACT == 1) { v0 = __builtin_elementwise_max(v0, (f32x4){0.f, 0.f, 0.f, 0.f}); v1 = __builtin_elementwise_max(v1, (f32x4){0.f, 0.f, 0.f, 0.f}); v0 = v0 * v0; v1 = v1 * v1; }
                    u32x4 w; w.x = ::pk_bf16(v0[0], v0[1]); w.y = ::pk_bf16(v0[2], v0[3]); w.z = ::pk_bf16(v1[0], v1[1]); w.w = ::pk_bf16(v1[2], v1[3]);
                    *(u32x4*)(rowp + bj * HALF) = w; } } }
    }
};
struct EpiResid {
    static constexpr bool PERM = false, AFTER_DRAIN = false;
    const float* hin_m; const float* hin_c; float* hout_m; float* hout_c; const float* gate; float gscale;
    __device__ __forceinline__ void operator()(const f32x4 (&acc)[2][2][4][2], const Unit& u, int wr, int wc, int fr, int fq) const {
        const bool ismain = u.pm < 64;
        const float* hin = ismain ? hin_m + (size_t)u.pm * BM * 1024 : hin_c + (size_t)(u.pm - 64) * BM * 1024;
        float* hout = ismain ? hout_m + (size_t)u.pm * BM * 1024 : hout_c + (size_t)(u.pm - 64) * BM * 1024;
        const float* g = gate + (size_t)(ismain ? (u.pm >> 3) : 8) * 6144;
        const int col0 = u.pn * BM + wc * 32 + 4 * fq;
        f32x4 gv[2][2];
#pragma unroll
        for (int bj = 0; bj < 2; ++bj)
#pragma unroll
            for (int n = 0; n < 2; ++n) gv[bj][n] = *(const f32x4*)(g + col0 + bj * HALF + n * 16) * gscale;
#pragma unroll
        for (int ai = 0; ai < 2; ++ai) {
            f32x4 hv[4][2][2];
#pragma unroll
            for (int m = 0; m < 4; ++m)
#pragma unroll
                for (int bj = 0; bj < 2; ++bj)
#pragma unroll
                    for (int n = 0; n < 2; ++n) hv[m][bj][n] = *(const f32x4*)(hin + (size_t)(ai * HALF + wr * 64 + m * 16 + fr) * 1024 + col0 + bj * HALF + n * 16);
            __builtin_amdgcn_sched_barrier(0);
#pragma unroll
            for (int m = 0; m < 4; ++m)
#pragma unroll
                for (int bj = 0; bj < 2; ++bj)
#pragma unroll
                    for (int n = 0; n < 2; ++n) *(f32x4*)(hout + (size_t)(ai * HALF + wr * 64 + m * 16 + fr) * 1024 + col0 + bj * HALF + n * 16) = hv[m][bj][n] + gv[bj][n] * acc[ai][bj][m][n];
            __builtin_amdgcn_sched_barrier(0);
        }
    }
};
template <class Epi, class Sched, bool ALIGN_EPI = false, bool SP2 = false>
__device__ __forceinline__ void gemm_phase(PG8_LAS unsigned char* lds, const Gemm g, const Sched& S, const Epi& E) {
    const int tid = ::otid_full(), wid = __builtin_amdgcn_readfirstlane(tid >> 6), lane = tid & 63, wr = wid >> 2, wc = wid & 3, fr = lane & 15, fq = lane >> 4;
    const int K = g.K, nt = g.Kloop / BK;
    unsigned voffA[2], voffB[2];
#pragma unroll
    for (int i = 0; i < 2; ++i) { int R, C; stage_rc(tid * 16 + i * 8192, R, C); const int Rb = Epi::PERM ? ((R & ~31) + perm32(R & 31)) : R;
        voffA[i] = (unsigned)(R * K + C) * 2u; voffB[i] = (unsigned)(Rb * K + C) * 2u; }
    const size_t kstep = (size_t)(BK * 2);
    const size_t hstep = (size_t)HALF * K * 2;
    const size_t tstep = 2 * hstep;
    const unsigned ldsw = (unsigned)wid * 1024u;
    const int aoff = lds_byte(wr * 64 + fr, fq * 8), boff = lds_byte(wc * 32 + fr, fq * 8);
#define PG8_SA(b, h) (((b) * 2 + (h)) * HTB)
#define PG8_SB(b, h) ((4 + (b) * 2 + (h)) * HTB)
#define PG8_STAGE(bufoff, gbase, voff) do { _Pragma("unroll") for (int _i = 0; _i < 2; ++_i) \
        __builtin_amdgcn_global_load_lds((const unsigned*)((const char*)(gbase) + (voff)[_i]), (PG8_LAS unsigned*)(lds + (bufoff) + ldsw + _i * 8192), 16, 0, 0); } while (0)
#define PG8_LDA(dst, b, h) do { _Pragma("unroll") for (int m = 0; m < 4; ++m) _Pragma("unroll") for (int k = 0; k < 2; ++k) dst[m][k] = *(const PG8_LAS bf16x8*)(lds + PG8_SA(b, h) + aoff + m * 2048 + k * 1024); } while (0)
#define PG8_LDB(dst, b, h) do { _Pragma("unroll") for (int n = 0; n < 2; ++n) _Pragma("unroll") for (int k = 0; k < 2; ++k) dst[n][k] = *(const PG8_LAS bf16x8*)(lds + PG8_SB(b, h) + boff + n * 2048 + k * 1024); } while (0)
#define PG8_MMA(ai, bj, At, Bt) do { __builtin_amdgcn_s_setprio(1); _Pragma("unroll") for (int m = 0; m < 4; ++m) _Pragma("unroll") for (int n = 0; n < 2; ++n) _Pragma("unroll") for (int k = 0; k < 2; ++k) \
        acc[ai][bj][m][n] = __builtin_amdgcn_mfma_f32_16x16x32_bf16(Bt[n][k], At[m][k], acc[ai][bj][m][n], 0, 0, 0); __builtin_amdgcn_s_setprio(0); } while (0)
#define PG8_WAIT_V(n) asm volatile("s_waitcnt vmcnt(" #n ")" ::: "memory")
#define PG8_WAIT_L(n) asm volatile("s_waitcnt lgkmcnt(" #n ")" ::: "memory")
#define PG8_BAR __builtin_amdgcn_s_barrier()
#define PG8_SCHED __builtin_amdgcn_sched_barrier(0)
    Unit cur, nxt; int ui = 0;
    if (!S.next(0, cur)) return;
    f32x4 acc[2][2][4][2];
#pragma unroll
    for (int a = 0; a < 2; ++a)
#pragma unroll
        for (int b = 0; b < 2; ++b)
#pragma unroll
            for (int m = 0; m < 4; ++m)
#pragma unroll
                for (int n = 0; n < 2; ++n) acc[a][b][m][n] = (f32x4){0.f, 0.f, 0.f, 0.f};
    bf16x8 At[4][2], B0[2][2], B1[2][2];
    const char* cA = (const char*)g.A + (size_t)cur.pm * tstep; const char* cB = (const char*)g.Bt + (size_t)cur.pn * tstep;
    S.a_ready(cur);
    if constexpr (SP2) {
        PG8_STAGE(PG8_SB(0, 0), cB, voffB); PG8_STAGE(PG8_SB(0, 1), cB + hstep, voffB); PG8_STAGE(PG8_SA(0, 0), cA, voffA); PG8_STAGE(PG8_SA(0, 1), cA + hstep, voffA);
        if (wr == 1) PG8_BAR;
        PG8_WAIT_V(2); PG8_BAR;
        PG8_STAGE(PG8_SB(1, 0), cB + kstep, voffB); PG8_STAGE(PG8_SA(1, 0), cA + kstep, voffA); PG8_STAGE(PG8_SB(1, 1), cB + hstep + kstep, voffB);
        PG8_WAIT_V(6); PG8_BAR;
    } else {
        PG8_STAGE(PG8_SB(0, 0), cB, voffB); PG8_STAGE(PG8_SA(0, 0), cA, voffA); PG8_STAGE(PG8_SB(0, 1), cB + hstep, voffB); PG8_STAGE(PG8_SA(0, 1), cA + hstep, voffA);
        if (wr == 1) PG8_BAR;
        PG8_WAIT_V(4); PG8_BAR;
        PG8_STAGE(PG8_SB(1, 0), cB + kstep, voffB); PG8_STAGE(PG8_SA(1, 0), cA + kstep, voffA); PG8_STAGE(PG8_SB(1, 1), cB + hstep + kstep, voffB);
        PG8_WAIT_V(6); PG8_BAR;
    }
    for (;;) {
        const bool has_next = S.next(ui + 1, nxt);
        const char* nA = has_next ? (const char*)g.A + (size_t)nxt.pm * tstep : cA; const char* nB = has_next ? (const char*)g.Bt + (size_t)nxt.pn * tstep : cB;
        for (int t = 0; t < nt; t += 2) {
            const bool last = (t == nt - 2);
            const char* a1 = cA + (size_t)(t + 1) * kstep;
            const char* a2 = last ? nA : cA + (size_t)(t + 2) * kstep; const char* b2 = last ? nB : cB + (size_t)(t + 2) * kstep;
            const char* a3 = a2 + kstep; const char* b3 = b2 + kstep;
            if (last && has_next) S.a_ready(nxt);
            if constexpr (SP2) {
            PG8_LDB(B0, 0, 0); PG8_LDB(B1, 0, 1); PG8_SCHED; PG8_LDA(At, 0, 0); PG8_STAGE(PG8_SA(1, 1), a1 + hstep, voffA);
            PG8_WAIT_V(8); PG8_WAIT_L(0); PG8_BAR; PG8_MMA(0, 0, At, B0); PG8_MMA(0, 1, At, B1); PG8_BAR; PG8_SCHED;
            PG8_LDA(At, 0, 1); PG8_STAGE(PG8_SB(0, 0), b2, voffB); PG8_STAGE(PG8_SB(0, 1), b2 + hstep, voffB); PG8_STAGE(PG8_SA(0, 0), a2, voffA);
            PG8_WAIT_V(8); PG8_WAIT_L(0); PG8_BAR; PG8_MMA(1, 0, At, B0); PG8_MMA(1, 1, At, B1); PG8_BAR; PG8_SCHED;
            PG8_LDB(B0, 1, 0); PG8_LDB(B1, 1, 1); PG8_SCHED; PG8_LDA(At, 1, 0); PG8_STAGE(PG8_SA(0, 1), a2 + hstep, voffA);
            PG8_WAIT_V(8); PG8_WAIT_L(0); PG8_BAR; PG8_MMA(0, 0, At, B0); PG8_MMA(0, 1, At, B1); PG8_BAR; PG8_SCHED;
            PG8_LDA(At, 1, 1); PG8_STAGE(PG8_SB(1, 0), b3, voffB); PG8_STAGE(PG8_SB(1, 1), b3 + hstep, voffB); PG8_STAGE(PG8_SA(1, 0), a3, voffA);
            PG8_WAIT_V(8); PG8_WAIT_L(0); PG8_BAR; PG8_MMA(1, 0, At, B0); PG8_MMA(1, 1, At, B1); PG8_BAR; PG8_SCHED;
            } else {
            PG8_LDB(B0, 0, 0); PG8_SCHED; PG8_LDA(At, 0, 0); PG8_STAGE(PG8_SA(1, 1), a1 + hstep, voffA);
            PG8_WAIT_L(8); PG8_BAR; PG8_WAIT_L(0); PG8_MMA(0, 0, At, B0); PG8_BAR; PG8_SCHED;
            PG8_LDB(B1, 0, 1); PG8_STAGE(PG8_SB(0, 0), b2, voffB);
            PG8_BAR; PG8_WAIT_L(0); PG8_MMA(0, 1, At, B1); PG8_BAR;
            PG8_LDA(At, 0, 1); PG8_STAGE(PG8_SA(0, 0), a2, voffA);
            PG8_BAR; PG8_WAIT_L(0); PG8_MMA(1, 0, At, B0); PG8_BAR; PG8_SCHED;
            PG8_STAGE(PG8_SB(0, 1), b2 + hstep, voffB);
            PG8_WAIT_V(6); PG8_BAR; PG8_MMA(1, 1, At, B1); PG8_BAR;
            PG8_LDB(B0, 1, 0); PG8_SCHED; PG8_LDA(At, 1, 0); PG8_STAGE(PG8_SA(0, 1), a2 + hstep, voffA);
            PG8_WAIT_L(8); PG8_BAR; PG8_WAIT_L(0); PG8_MMA(0, 0, At, B0); PG8_BAR; PG8_SCHED;
            PG8_LDB(B1, 1, 1); PG8_STAGE(PG8_SB(1, 0), b3, voffB);
            PG8_BAR; PG8_WAIT_L(0); PG8_MMA(0, 1, At, B1); PG8_BAR;
            PG8_LDA(At, 1, 1); PG8_STAGE(PG8_SA(1, 0), a3, voffA);
            PG8_BAR; PG8_WAIT_L(0); PG8_MMA(1, 0, At, B0); PG8_BAR; PG8_SCHED;
            PG8_STAGE(PG8_SB(1, 1), b3 + hstep, voffB);
            PG8_WAIT_V(6); PG8_BAR; PG8_MMA(1, 1, At, B1); PG8_BAR;
            }
        }
        if constexpr (ALIGN_EPI) { if (wr == 0) PG8_BAR; }
        if constexpr (!Epi::AFTER_DRAIN) { E(acc, cur, wr, wc, fr, fq); S.done(cur); }
        if (!has_next) break;
#pragma unroll
        for (int a = 0; a < 2; ++a)
#pragma unroll
            for (int b = 0; b < 2; ++b)
#pragma unroll
                for (int m = 0; m < 4; ++m)
#pragma unroll
                    for (int n = 0; n < 2; ++n) acc[a][b][m][n] = (f32x4){0.f, 0.f, 0.f, 0.f};
        cur = nxt; cA = nA; cB = nB; ++ui;
        if constexpr (ALIGN_EPI) { if (wr == 1) PG8_BAR; }
    }
    PG8_WAIT_V(0);
    if constexpr (!ALIGN_EPI) { if (wr == 0) PG8_BAR; }
    PG8_BAR;
    if constexpr (Epi::AFTER_DRAIN) { E.fused(acc, cur, wr, wc, fr, fq, lds, wid, lane); S.done(cur); }
#undef PG8_SA
#undef PG8_SB
#undef PG8_STAGE
#undef PG8_LDA
#undef PG8_LDB
#undef PG8_MMA
#undef PG8_WAIT_V
#undef PG8_WAIT_L
#undef PG8_BAR
#undef PG8_SCHED
}
}

DI void prep_tile(const Params& p, int layer, int tile, int part, char* smem) {
  const int tid = otid(), lane = tid & 63, wave = tid >> 6, l31 = lane & 31, hi = lane >> 5;
  const int b = tile / 36, tb = tile % 36, p0 = tb * 64;
  const bool isctx = tb < 4;
  const int row0 = isctx ? (MROWS + b * CT + p0) : (b * SEQ + p0 - CT);
  const bf16_t* U = (const bf16_t*)(p.ws + OFF_U);
  const f32x2* ropeH = (const f32x2*)(p.ws + OFF_ROPEH);
  const f32x2* ropeD = (const f32x2*)(p.ws + OFF_ROPED);
  bf16_t* QD = (bf16_t*)(p.ws + OFF_QD); bf16_t* KD = (bf16_t*)(p.ws + OFF_KD); bf16_t* VTD = (bf16_t*)(p.ws + OFF_VTD);
  bf16_t* QG = (bf16_t*)(p.ws + OFF_QG); bf16_t* KG = (bf16_t*)(p.ws + OFF_KG); bf16_t* VTG = (bf16_t*)(p.ws + OFF_VTG);
  bf16_t* QM = (bf16_t*)(p.ws + OFF_QM); bf16_t* KM = (bf16_t*)(p.ws + OFF_KM); bf16_t* VTM = (bf16_t*)(p.ws + OFF_VTM);
  const float qsD = 0.17677669529663687f * LOG2E, qsG = 0.125f * LOG2E, qsM = 0.10206207261596575f * LOG2E;
  bf16_t* sT = (bf16_t*)smem; bf16_t* sCq = (bf16_t*)(smem + 9216); bf16_t* sCkv = (bf16_t*)(smem + 9216 + 25600);

  if (part == 0) {
#pragma unroll 1
  for (int i = 0; i < 4; ++i) {
    const int task = tid + 256 * i;
    if (task >= 15 * 64) break;
    const int g = task >> 6, tk = task & 63;
    const bf16_t* urow = U + (size_t)(row0 + tk) * INP;
    const int pos = p0 + tk, t = pos - CT;
    if (g < 14) {
      const bool isdiff = g < 8;
      const bool isq = isdiff ? (g < 4) : (g < 12);
      const int h = isdiff ? (g & 3) : (isq ? g - 8 : g - 12);
      const int col = isdiff ? ((isq ? U_DQ : U_DK) + h * 64) : ((isq ? U_GQ : U_GK) + h * 64);
      float x[64];
#pragma unroll
      for (int c = 0; c < 8; ++c) {
        const u32x4 v = *(const u32x4*)(urow + col + c * 8);
        x[c * 8 + 0] = bflo(v.x); x[c * 8 + 1] = bfhi(v.x); x[c * 8 + 2] = bflo(v.y); x[c * 8 + 3] = bfhi(v.y);
        x[c * 8 + 4] = bflo(v.z); x[c * 8 + 5] = bfhi(v.z); x[c * 8 + 6] = bflo(v.w); x[c * 8 + 7] = bfhi(v.w);
      }
      if (isdiff) {
        if (!isctx) {
#pragma unroll
          for (int m = 0; m < 2; ++m)
#pragma unroll
            for (int d = 0; d < 16; ++d) {
              const f32x2 cs = ropeD[t * 16 + d];
              const float x1 = x[m * 32 + d], x2 = x[m * 32 + 16 + d];
              x[m * 32 + d] = x1 * cs.x - x2 * cs.y; x[m * 32 + 16 + d] = x1 * cs.y + x2 * cs.x;
            }
        }
        const float sc_ = isq ? qsD : 1.f;
        bf16_t* dst = (isq ? QD : KD) + (((size_t)b * 8 + h * 2) * TT + pos) * 32;
#pragma unroll
        for (int m = 0; m < 2; ++m)
#pragma unroll
          for (int c = 0; c < 4; ++c) {
            u32x4 w; const int o = m * 32 + c * 8;
            w.x = pk_bf16(x[o] * sc_, x[o + 1] * sc_); w.y = pk_bf16(x[o + 2] * sc_, x[o + 3] * sc_); w.z = pk_bf16(x[o + 4] * sc_, x[o + 5] * sc_); w.w = pk_bf16(x[o + 6] * sc_, x[o + 7] * sc_);
            *(u32x4*)(dst + (size_t)m * TT * 32 + c * 8) = w;
          }
      } else {
        float ss = 0.f;
#pragma unroll
        for (int d = 0; d < 64; ++d) ss += x[d] * x[d];
        const float rstd = rsqrtf(ss * (1.f / 64.f) + EPS);
        const float* gn = (isq ? p.in[I_GQN] : p.in[I_GKN]) + layer * 64;
#pragma unroll
        for (int c = 0; c < 16; ++c) { const f32x4 gv = *(const f32x4*)(gn + c * 4); x[c * 4] *= rstd * gv[0]; x[c * 4 + 1] *= rstd * gv[1]; x[c * 4 + 2] *= rstd * gv[2]; x[c * 4 + 3] *= rstd * gv[3]; }
        if (!isctx) {
#pragma unroll
          for (int d = 0; d < 32; ++d) {
            const f32x2 cs = ropeH[t * 32 + d];
            const float x1 = x[d], x2 = x[32 + d];
            x[d] = x1 * cs.x - x2 * cs.y; x[32 + d] = x1 * cs.y + x2 * cs.x;
          }
        }
        const float sc_ = isq ? qsG : 1.f;
        bf16_t* dst = isq ? QG + (((size_t)b * 4 + h) * TT + pos) * 64 : KG + (((size_t)b * 2 + h) * TT + pos) * 64;
#pragma unroll
        for (int c = 0; c < 8; ++c) {
          u32x4 w; const int o = c * 8;
          w.x = pk_bf16(x[o] * sc_, x[o + 1] * sc_); w.y = pk_bf16(x[o + 2] * sc_, x[o + 3] * sc_); w.z = pk_bf16(x[o + 4] * sc_, x[o + 5] * sc_); w.w = pk_bf16(x[o + 6] * sc_, x[o + 7] * sc_);
          *(u32x4*)(dst + c * 8) = w;
        }
      }
    } else {
      float x[32];
#pragma unroll
      for (int c = 0; c < 4; ++c) {
        const u32x4 v = *(const u32x4*)(urow + U_MR + c * 8);
        x[c * 8 + 0] = bflo(v.x); x[c * 8 + 1] = bfhi(v.x); x[c * 8 + 2] = bflo(v.y); x[c * 8 + 3] = bfhi(v.y);
        x[c * 8 + 4] = bflo(v.z); x[c * 8 + 5] = bfhi(v.z); x[c * 8 + 6] = bflo(v.w); x[c * 8 + 7] = bfhi(v.w);
      }
      if (!isctx) {
#pragma unroll
        for (int d = 0; d < 16; ++d) {
          const f32x2 cs = ropeD[t * 16 + d];
          const float x1 = x[d], x2 = x[16 + d];
          x[d] = x1 * cs.x - x2 * cs.y; x[16 + d] = x1 * cs.y + x2 * cs.x;
        }
      }
      u32x4 w[4];
#pragma unroll
      for (int c = 0; c < 4; ++c) { const int o = c * 8; w[c].x = pk_bf16(x[o], x[o + 1]); w[c].y = pk_bf16(x[o + 2], x[o + 3]); w[c].z = pk_bf16(x[o + 4], x[o + 5]); w[c].w = pk_bf16(x[o + 6], x[o + 7]); }
#pragma unroll
      for (int hh = 0; hh < 4; ++hh)
#pragma unroll
        for (int c = 0; c < 4; ++c) *(u32x4*)(KM + (((size_t)b * 4 + hh) * TT + pos) * 96 + 64 + c * 8) = w[c];
    }
  }
  for (int g = 0; g < 6; ++g) {
    const int colbase = g < 4 ? U_DV + g * 64 : U_GV + (g - 4) * 64;
    bf16_t* dst = g < 4 ? VTD + ((size_t)(b * 4 + g) * 64) * TT : VTG + ((size_t)(b * 2 + g - 4) * 64) * TT;
#pragma unroll
    for (int i = 0; i < 2; ++i) {
      const int c = tid + 256 * i, tk0 = c >> 3, kc = c & 7;
      const u32x4 v = *(const u32x4*)(U + (size_t)(row0 + tk0) * INP + colbase + kc * 8);
      const int tk = (tk0 & ~12) | ((tk0 & 4) << 1) | ((tk0 & 8) >> 1);
      sT[(kc * 8 + 0) * 72 + tk] = (bf16_t)(v.x & 0xffff); sT[(kc * 8 + 1) * 72 + tk] = (bf16_t)(v.x >> 16);
      sT[(kc * 8 + 2) * 72 + tk] = (bf16_t)(v.y & 0xffff); sT[(kc * 8 + 3) * 72 + tk] = (bf16_t)(v.y >> 16);
      sT[(kc * 8 + 4) * 72 + tk] = (bf16_t)(v.z & 0xffff); sT[(kc * 8 + 5) * 72 + tk] = (bf16_t)(v.z >> 16);
      sT[(kc * 8 + 6) * 72 + tk] = (bf16_t)(v.w & 0xffff); sT[(kc * 8 + 7) * 72 + tk] = (bf16_t)(v.w >> 16);
    }
    __syncthreads();
    {
      const int dv = tid >> 2, part = tid & 3;
      const u32x4 a = *(const u32x4*)(sT + dv * 72 + part * 16), bq = *(const u32x4*)(sT + dv * 72 + part * 16 + 8);
      bf16_t* d = dst + (size_t)dv * TT + p0 + part * 16;
      *(u32x4*)d = a; *(u32x4*)(d + 8) = bq;
    }
    __syncthreads();
  }
  return;
  }
#pragma unroll 4
  for (int tk = wave; tk < 64; tk += 4) {
    const bf16_t* urow = U + (size_t)(row0 + tk) * INP;
    const float q0 = bf2f(urow[U_MQ + lane]), q1 = bf2f(urow[U_MQ + 64 + lane]), q2 = bf2f(urow[U_MQ + 128 + lane]);
    const float k0 = bf2f(urow[U_MKV + lane]), k1 = bf2f(urow[U_MKV + 64 + lane]);
    const float sq = wave_sum(q0 * q0 + q1 * q1 + q2 * q2), sk = wave_sum(k0 * k0 + k1 * k1);
    const float rq = rsqrtf(sq * (1.f / 192.f) + EPS), rk = rsqrtf(sk * (1.f / 128.f) + EPS);
    const float* gq = p.in[I_MQN] + layer * 192; const float* gk = p.in[I_MKVN] + layer * 128;
    sCq[tk * 200 + lane] = f2bf(q0 * rq * gq[lane]); sCq[tk * 200 + 64 + lane] = f2bf(q1 * rq * gq[64 + lane]); sCq[tk * 200 + 128 + lane] = f2bf(q2 * rq * gq[128 + lane]);
    sCkv[tk * 136 + lane] = f2bf(k0 * rk * gk[lane]); sCkv[tk * 136 + 64 + lane] = f2bf(k1 * rk * gk[64 + lane]);
  }
  __syncthreads();
  const bf16_t* Wkv = (const bf16_t*)(p.ws + OFF_WUKV) + (size_t)layer * 512 * 128;
  const bf16_t* Wq = (const bf16_t*)(p.ws + OFF_WUQ) + (size_t)layer * 384 * 192;
#pragma unroll 1
  for (int task = wave; task < 28; task += 4) {
    if (task < 16) {
      const int ct = task, head = ct >> 2, sub = ct & 3, n0 = head * 128 + sub * 32;
      const bf16_t* wrow = Wkv + (size_t)(n0 + l31) * 128 + hi * 8;
      bf16x8 wf[8];
#pragma unroll
      for (int ks = 0; ks < 8; ++ks) wf[ks] = *(const bf16x8*)(wrow + ks * 16);
      bf16x8 tf[2][8];
#pragma unroll
      for (int tt = 0; tt < 2; ++tt)
#pragma unroll
        for (int ks = 0; ks < 8; ++ks) tf[tt][ks] = *(const bf16x8*)(sCkv + (tt * 32 + l31) * 136 + hi * 8 + ks * 16);
      __builtin_amdgcn_sched_barrier(0);
      f32x16 acc[2]; acc[0] = zero16(); acc[1] = zero16();
      if (sub < 2) {
#pragma unroll
        for (int ks = 0; ks < 8; ++ks) { acc[0] = MFMA32(wf[ks], tf[0][ks], acc[0]); acc[1] = MFMA32(wf[ks], tf[1][ks], acc[1]); }
#pragma unroll
        for (int tt = 0; tt < 2; ++tt) {
          bf16_t* d = KM + (((size_t)b * 4 + head) * TT + p0 + tt * 32 + l31) * 96 + sub * 32 + 4 * hi;
#pragma unroll
          for (int r4 = 0; r4 < 4; ++r4) { u32x2 w; w.x = pk_bf16(acc[tt][4 * r4], acc[tt][4 * r4 + 1]); w.y = pk_bf16(acc[tt][4 * r4 + 2], acc[tt][4 * r4 + 3]); *(u32x2*)(d + 8 * r4) = w; }
        }
      } else {
#pragma unroll
        for (int ks = 0; ks < 8; ++ks) { acc[0] = MFMA32(tf[0][ks], wf[ks], acc[0]); acc[1] = MFMA32(tf[1][ks], wf[ks], acc[1]); }
#pragma unroll
        for (int tt = 0; tt < 2; ++tt) {
          bf16_t* d = VTM + (((size_t)b * 4 + head) * 64 + (sub - 2) * 32 + l31) * TT + p0 + tt * 32;
#pragma unroll
          for (int r4 = 0; r4 < 4; ++r4) { u32x2 w; w.x = pk_bf16(acc[tt][4 * r4], acc[tt][4 * r4 + 1]); w.y = pk_bf16(acc[tt][4 * r4 + 2], acc[tt][4 * r4 + 3]);
            *(u32x2*)(d + 16 * (r4 >> 1) + 4 * (2 * hi + (r4 & 1))) = w; }
        }
      }
    } else {
      const int ct = task - 16, head = ct / 3, sub = ct % 3, n0 = head * 96 + sub * 32;
      const bf16_t* wrow = Wq + (size_t)(n0 + l31) * 192 + hi * 8;
      bf16x8 wf[12];
#pragma unroll
      for (int ks = 0; ks < 12; ++ks) wf[ks] = *(const bf16x8*)(wrow + ks * 16);
      __builtin_amdgcn_sched_barrier(0);
#pragma unroll
      for (int tt = 0; tt < 2; ++tt) {
        bf16x8 tf[12];
#pragma unroll
        for (int ks = 0; ks < 12; ++ks) tf[ks] = *(const bf16x8*)(sCq + (tt * 32 + l31) * 200 + hi * 8 + ks * 16);
        __builtin_amdgcn_sched_barrier(0);
        f32x16 acc = zero16();
#pragma unroll
        for (int ks = 0; ks < 12; ++ks) acc = MFMA32(wf[ks], tf[ks], acc);
        const int pos = p0 + tt * 32 + l31;
        if (sub == 2 && !isctx) {
          const int t = pos - CT;
#pragma unroll
          for (int r = 0; r < 8; ++r) {
            const f32x2 cs = ropeD[t * 16 + crow(r, hi)];
            const float x1 = acc[r], x2 = acc[r + 8];
            acc[r] = x1 * cs.x - x2 * cs.y; acc[r + 8] = x1 * cs.y + x2 * cs.x;
          }
        }
        bf16_t* d = QM + (((size_t)b * 4 + head) * TT + pos) * 96 + sub * 32 + 4 * hi;
#pragma unroll
        for (int r4 = 0; r4 < 4; ++r4) { u32x2 w; w.x = pk_bf16(acc[4 * r4] * qsM, acc[4 * r4 + 1] * qsM); w.y = pk_bf16(acc[4 * r4 + 2] * qsM, acc[4 * r4 + 3] * qsM); *(u32x2*)(d + 8 * r4) = w; }
      }
    }
  }
  __syncthreads();
}

template <int DQK>
DI void attn_core(const bf16_t* __restrict__ Qb, const bf16_t* __restrict__ Kb, const bf16_t* __restrict__ Vt, int q0, int ntiles,
                  f32x16 (&O)[2], float& lsum, char* smem) {
  const int tid = otid_full(), lane = tid & 63, wave = tid >> 6, l31 = lane & 31, hi = lane >> 5;
  constexpr int KS = DQK / 16, KROW = DQK + 8, KCH = DQK / 8;
  constexpr int KBYTES = 64 * KROW * 2, BUFB = KBYTES + 9216;
  constexpr int NK = 64 * KCH, NKC = (NK + NTHREADS - 1) / NTHREADS;
  static_assert(2 * BUFB <= 49152, "attention LDS");
  bf16x8 qf[KS];
#pragma unroll
  for (int ks = 0; ks < KS; ++ks) qf[ks] = *(const bf16x8*)(Qb + (size_t)(q0 + wave * 32 + l31) * DQK + ks * 16 + hi * 8);
  float mrun = -1e30f; lsum = 0.f; O[0] = zero16(); O[1] = zero16();
  const bf16_t* kg[NKC]; int kl[NKC]; bool kok[NKC];
#pragma unroll
  for (int i = 0; i < NKC; ++i) {
    const int c = tid + NTHREADS * i, key = c / KCH, kc = c % KCH;
    kok[i] = c < NK;
    kg[i] = Kb + (size_t)key * DQK + kc * 8;
    kl[i] = (key * KROW + kc * 8) * 2;
  }
  const bf16_t* vg; int vl;
  { const int dv = tid >> 3, kc = tid & 7; vg = Vt + (size_t)dv * TT + kc * 8; vl = KBYTES + (dv * 72 + kc * 8) * 2; }
  u32x4 rk[NKC], rv;
#pragma unroll
  for (int i = 0; i < NKC; ++i) if (kok[i]) rk[i] = *(const u32x4*)(kg[i]);
  rv = *(const u32x4*)(vg);
#pragma unroll
  for (int i = 0; i < NKC; ++i) if (kok[i]) *(u32x4*)(smem + kl[i]) = rk[i];
  *(u32x4*)(smem + vl) = rv;
  __syncthreads();
  for (int kt = 0; kt < ntiles; ++kt) {
    const int cur = kt & 1; const bool more = kt + 1 < ntiles;
    if (more) {
#pragma unroll
      for (int i = 0; i < NKC; ++i) if (kok[i]) rk[i] = *(const u32x4*)(kg[i] + (size_t)(kt + 1) * 64 * DQK);
      rv = *(const u32x4*)(vg + (kt + 1) * 64);
    }
    const char* sb = smem + cur * BUFB;
    bf16x8 kf[2][KS];
#pragma unroll
    for (int kb = 0; kb < 2; ++kb)
#pragma unroll
      for (int ks = 0; ks < KS; ++ks) kf[kb][ks] = *(const bf16x8*)(sb + ((kb * 32 + l31) * KROW + hi * 8) * 2 + ks * 32);
    __builtin_amdgcn_sched_barrier(0);
    f32x16 s[2];
#pragma unroll
    for (int kb = 0; kb < 2; ++kb) {
      s[kb] = zero16();
#pragma unroll
      for (int ks = 0; ks < KS; ++ks) s[kb] = MFMA32(kf[kb][ks], qf[ks], s[kb]);
    }
    bf16x8 vf[4][2];
#pragma unroll
    for (int s4 = 0; s4 < 4; ++s4)
#pragma unroll
      for (int dvb = 0; dvb < 2; ++dvb) vf[s4][dvb] = *(const bf16x8*)(sb + KBYTES + ((dvb * 32 + l31) * 72 + s4 * 16 + hi * 8) * 2);
    __builtin_amdgcn_sched_barrier(0);
    float mx = s[0][0];
#pragma unroll
    for (int r = 0; r < 16; ++r) { mx = fmaxf(mx, s[0][r]); mx = fmaxf(mx, s[1][r]); }
    mx = fmaxf(mx, __shfl_xor(mx, 32));
    const float mnew = fmaxf(mrun, mx);
    const float alpha = __builtin_amdgcn_exp2f(mrun - mnew);
    mrun = mnew;
    float rs = 0.f;
#pragma unroll
    for (int kb = 0; kb < 2; ++kb)
#pragma unroll
      for (int r = 0; r < 16; ++r) { const float e = __builtin_amdgcn_exp2f(s[kb][r] - mnew); s[kb][r] = e; rs += e; }
    lsum = lsum * alpha + rs;
    O[0] *= alpha; O[1] *= alpha;
#pragma unroll
    for (int s4 = 0; s4 < 4; ++s4) {
      const int kb = s4 >> 1, hf = (s4 & 1) * 8;
      const bf16x8 pb = pack8(s[kb][hf + 0], s[kb][hf + 1], s[kb][hf + 2], s[kb][hf + 3], s[kb][hf + 4], s[kb][hf + 5], s[kb][hf + 6], s[kb][hf + 7]);
#pragma unroll
      for (int dvb = 0; dvb < 2; ++dvb) O[dvb] = MFMA32(vf[s4][dvb], pb, O[dvb]);
    }
    if (more) {
      char* db = smem + (cur ^ 1) * BUFB;
#pragma unroll
      for (int i = 0; i < NKC; ++i) if (kok[i]) *(u32x4*)(db + kl[i]) = rk[i];
      *(u32x4*)(db + vl) = rv;
    }
    __syncthreads();
  }
  lsum += __shfl_xor(lsum, 32);
}

DI void attn_unit(const Params& p, int layer, int b, int kind, int head, int qb, char* smem) {
  const int tid_ = otid_full(); const int lane = tid_ & 63, wave = tid_ >> 6, l31 = lane & 31, hi = lane >> 5;
  const int q0 = qb * 256;
  const int ntiles = qb == 0 ? 4 : 36;
  bf16_t* Y = (bf16_t*)(p.ws + OFF_Y);
  const int pos = q0 + wave * 32 + l31;
  bf16_t* yrow = Y + (size_t)hrow_of(b, pos) * DM;
  f32x16 O[2]; float ls;
  if (kind == 1) {
    attn_core<32>((const bf16_t*)(p.ws + OFF_QD) + ((size_t)b * 8 + head * 2) * TT * 32, (const bf16_t*)(p.ws + OFF_KD) + ((size_t)b * 8 + head * 2) * TT * 32,
                  (const bf16_t*)(p.ws + OFF_VTD) + ((size_t)b * 4 + head) * 64 * TT, q0, ntiles, O, ls, smem);
    float* st = (float*)(smem + 49152) + tid_;
    {
      const float i0 = 1.f / ls;
#pragma unroll
      for (int dvb = 0; dvb < 2; ++dvb)
#pragma unroll
        for (int r = 0; r < 16; ++r) st[(dvb * 16 + r) * NTHREADS] = O[dvb][r] * i0;
    }
    __syncthreads();
    attn_core<32>((const bf16_t*)(p.ws + OFF_QD) + ((size_t)b * 8 + head * 2 + 1) * TT * 32, (const bf16_t*)(p.ws + OFF_KD) + ((size_t)b * 8 + head * 2 + 1) * TT * 32,
                  (const bf16_t*)(p.ws + OFF_VTD) + ((size_t)b * 4 + head) * 64 * TT, q0, ntiles, O, ls, smem);
    const float* misc = (const float*)(p.ws + OFF_MISC);
    const float lam = misc[128 + layer], li = misc[136 + layer];
    const float i1 = lam / ls;
    float ss = 0.f;
#pragma unroll
    for (int dvb = 0; dvb < 2; ++dvb)
#pragma unroll
      for (int r = 0; r < 16; ++r) { const float o = st[(dvb * 16 + r) * NTHREADS] - O[dvb][r] * i1; O[dvb][r] = o; ss += o * o; }
    ss += __shfl_xor(ss, 32);
    const float rstd = rsqrtf(ss * (1.f / 64.f) + EPS) * (1.f - li);
    const float* g = p.in[I_DNG] + layer * 64;
    f32x4 gva[2][4];
#pragma unroll
    for (int dvb = 0; dvb < 2; ++dvb)
#pragma unroll
      for (int r4 = 0; r4 < 4; ++r4) gva[dvb][r4] = *(const f32x4*)(g + dvb * 32 + 8 * r4 + 4 * hi);
    __builtin_amdgcn_sched_barrier(0);
#pragma unroll
    for (int dvb = 0; dvb < 2; ++dvb)
#pragma unroll
      for (int r4 = 0; r4 < 4; ++r4) {
        const int dv = dvb * 32 + 8 * r4 + 4 * hi;
        const f32x4 gv = gva[dvb][r4];
        u32x2 w; w.x = pk_bf16(O[dvb][4 * r4] * rstd * gv[0], O[dvb][4 * r4 + 1] * rstd * gv[1]);
        w.y = pk_bf16(O[dvb][4 * r4 + 2] * rstd * gv[2], O[dvb][4 * r4 + 3] * rstd * gv[3]);
        *(u32x2*)(yrow + 256 + head * 64 + dv) = w;
      }
  } else {
    int ycol;
    if (kind == 2) {
      attn_core<64>((const bf16_t*)(p.ws + OFF_QG) + ((size_t)b * 4 + head) * TT * 64, (const bf16_t*)(p.ws + OFF_KG) + ((size_t)b * 2 + (head >> 1)) * TT * 64,
                    (const bf16_t*)(p.ws + OFF_VTG) + ((size_t)b * 2 + (head >> 1)) * 64 * TT, q0, ntiles, O, ls, smem);
      ycol = 512 + head * 64;
    } else {
      attn_core<96>((const bf16_t*)(p.ws + OFF_QM) + ((size_t)b * 4 + head) * TT * 96, (const bf16_t*)(p.ws + OFF_KM) + ((size_t)b * 4 + head) * TT * 96,
                    (const bf16_t*)(p.ws + OFF_VTM) + ((size_t)b * 4 + head) * 64 * TT, q0, ntiles, O, ls, smem);
      ycol = 768 + head * 64;
    }
    const float inv = 1.f / ls;
#pragma unroll
    for (int dvb = 0; dvb < 2; ++dvb)
#pragma unroll
      for (int r4 = 0; r4 < 4; ++r4) {
        const int dv = dvb * 32 + 8 * r4 + 4 * hi;
        u32x2 w; w.x = pk_bf16(O[dvb][4 * r4] * inv, O[dvb][4 * r4 + 1] * inv); w.y = pk_bf16(O[dvb][4 * r4 + 2] * inv, O[dvb][4 * r4 + 3] * inv);
        *(u32x2*)(yrow + ycol + dv) = w;
      }
  }
}

DI void ssd_chunk(const Params& p, int layer, int item, char* smem) {
  const int tid = otid(), lane = tid & 63, wave = tid >> 6, l31 = lane & 31, hi = lane >> 5;
  const int pi = wave >> 1, li = wave & 1;
  const int ck = item % 36, r_ = item / 36, d = r_ & 1, g = (r_ >> 1) & 1, b = r_ >> 2, h = 2 * g + half_id(), chain = (b * 4 + h) * 2 + d;
  const bf16_t* U = (const bf16_t*)(p.ws + OFF_U);
  bf16_t* Yssd = (bf16_t*)(p.ws + OFF_XN) + (size_t)d * ROWS * 256;
  bf16_t* sXT = (bf16_t*)smem;
  bf16_t* sB = (bf16_t*)(smem + 9216);
  bf16_t* sC = (bf16_t*)(smem + 18432);
  bf16_t* sBT = (bf16_t*)(smem + 27648);
  float* scs = (float*)(smem + 46080);
  float* sdt = (float*)(smem + 46336);
  float* sW = (float*)(smem + 46592);
  const bool isctx = ck < 4;
  const int Len = isctx ? CT : SEQ, base = isctx ? (MROWS + b * CT) : (b * SEQ), kl = isctx ? ck : ck - 4;
  if (tid < 192) {
    const int cc = tid >> 6, e = tid & 63;
    const int ch = cc == 0 ? (h * 64 + e) : (cc == 1 ? 256 + g * 64 + e : 384 + g * 64 + e);
    const float* cw = p.in[I_CONVW] + ((size_t)layer * 512 + ch) * 3;
    sW[tid * 4 + 0] = cw[0]; sW[tid * 4 + 1] = cw[1]; sW[tid * 4 + 2] = cw[2]; sW[tid * 4 + 3] = p.in[I_CONVB][layer * 512 + ch];
  }
  const bool wrC = (half_id() == 0) && (d == 0);
  bf16_t* CB = (bf16_t*)(p.ws + OFF_CB);
  float raw_dt = 0.f;
  if (wave == 1) {
    const int posj = kl * 64 + lane, t = d ? (Len - 1 - posj) : posj;
    raw_dt = bf2f(U[(size_t)(base + t) * INP + U_DT + d * 4 + h]);
  }
  u32x4 vm6[6], v06[6], vp6[6];
#pragma unroll
  for (int i = 0; i < 6; ++i) {
    const int task = tid + 256 * i, j = task / 24, cc = task % 24;
    const int posj = kl * 64 + j, t = d ? (Len - 1 - posj) : posj;
    const int grp = cc >> 3, c8 = (cc & 7) * 8;
    const int ucol = grp == 0 ? (U_X + h * 64 + c8) : (grp == 1 ? U_B + g * 64 + c8 : U_C + g * 64 + c8);
    const bf16_t* up = U + (size_t)(base + t) * INP + ucol;
    const u32x4 z4 = {0u, 0u, 0u, 0u};
    vm6[i] = (t > 0) ? *(const u32x4*)(up - INP) : z4;
    v06[i] = *(const u32x4*)up;
    vp6[i] = (t < Len - 1) ? *(const u32x4*)(up + INP) : z4;
  }
  if (wave == 1) {
    const float dtb = p.in[I_DTB][layer * 8 + d * 4 + h];
    const float aneg = -expf(p.in[I_ALOG][layer * 8 + d * 4 + h]);
    const int posj = kl * 64 + lane, t = d ? (Len - 1 - posj) : posj;
    const float raw = raw_dt + dtb;
    const float e_ = __expf(-fabsf(raw));
    const float dtv = fmaxf(raw, 0.f) + (e_ < 0.03f ? e_ * (1.f - e_ * (0.5f - e_ * 0.33333334f)) : __logf(1.f + e_));
    float c = dtv * aneg;
#pragma unroll
    for (int o = 1; o < 64; o <<= 1) { const float tv = __shfl_up(c, o); if (lane >= o) c += tv; }
    sdt[lane] = dtv; scs[lane] = c;
    ((float*)(p.ws + OFF_ECL))[(size_t)(d * 4 + h) * ROWS + base + t] = __expf(c);
    if (lane == 63) ((float*)(p.ws + OFF_DEC))[chain * 36 + ck] = __expf(c);
  }
  __syncthreads();
  const float c63 = scs[63];
#pragma unroll
  for (int i = 0; i < 6; ++i) {
    const int task = tid + 256 * i, j = task / 24, cc = task % 24;
    const int posj = kl * 64 + j, t = d ? (Len - 1 - posj) : posj;
    const int grp = cc >> 3, c8 = (cc & 7) * 8;
    const u32x4 vm = vm6[i], v0 = v06[i], vp = vp6[i];
    float o[8];
#pragma unroll
    for (int e2 = 0; e2 < 4; ++e2) {
      const unsigned wm_ = e2 == 0 ? vm.x : e2 == 1 ? vm.y : e2 == 2 ? vm.z : vm.w;
      const unsigned w0_ = e2 == 0 ? v0.x : e2 == 1 ? v0.y : e2 == 2 ? v0.z : v0.w;
      const unsigned wp_ = e2 == 0 ? vp.x : e2 == 1 ? vp.y : e2 == 2 ? vp.z : vp.w;
      const f32x4 wa = *(const f32x4*)(sW + (grp * 64 + c8 + 2 * e2) * 4), wb = *(const f32x4*)(sW + (grp * 64 + c8 + 2 * e2 + 1) * 4);
      o[2 * e2] = silu_f(wa[0] * bflo(wm_) + wa[1] * bflo(w0_) + wa[2] * bflo(wp_) + wa[3]);
      o[2 * e2 + 1] = silu_f(wb[0] * bfhi(wm_) + wb[1] * bfhi(w0_) + wb[2] * bfhi(wp_) + wb[3]);
    }
    if (grp == 0) {
      const float dtv = sdt[j];
#pragma unroll
      for (int e = 0; e < 8; ++e) sXT[(c8 + e) * 72 + j] = f2bf(o[e] * dtv);
    } else if (grp == 1) {
      const float sc_ = __expf(c63 - scs[j]);
      u32x4 w; w.x = pk_bf16(o[0], o[1]); w.y = pk_bf16(o[2], o[3]); w.z = pk_bf16(o[4], o[5]); w.w = pk_bf16(o[6], o[7]);
      *(u32x4*)(sB + j * 72 + c8) = w;
#pragma unroll
      for (int e = 0; e < 8; ++e) sBT[(c8 + e) * 72 + j] = f2bf(o[e] * sc_);
    } else {
      u32x4 w; w.x = pk_bf16(o[0], o[1]); w.y = pk_bf16(o[2], o[3]); w.z = pk_bf16(o[4], o[5]); w.w = pk_bf16(o[6], o[7]);
      *(u32x4*)(sC + j * 72 + c8) = w;
      if (wrC) *(u32x4*)(CB + (size_t)(base + t) * 128 + g * 64 + c8) = w;
    }
  }
  __syncthreads();
  const int lcol = 32 * li + l31;
  const float cl = scs[lcol];
  f32x16 y = zero16();
#pragma unroll
  for (int si = 0; si < 2; ++si) {
    if (si <= li) {
      f32x16 gt = zero16();
#pragma unroll
      for (int ks = 0; ks < 4; ++ks) gt = MFMA32(*(const bf16x8*)(sB + (32 * si + l31) * 72 + ks * 16 + hi * 8), *(const bf16x8*)(sC + lcol * 72 + ks * 16 + hi * 8), gt);
#pragma unroll
      for (int r = 0; r < 16; ++r) { const int s_ = 32 * si + crow(r, hi); gt[r] = (s_ <= lcol) ? gt[r] * __expf(cl - scs[s_]) : 0.f; }
#pragma unroll
      for (int kk = 0; kk < 2; ++kk) {
        const bf16x8 pb = pack8(gt[8 * kk], gt[8 * kk + 1], gt[8 * kk + 2], gt[8 * kk + 3], gt[8 * kk + 4], gt[8 * kk + 5], gt[8 * kk + 6], gt[8 * kk + 7]);
        const bf16_t* xr = sXT + (32 * pi + l31) * 72 + 32 * si + 16 * kk + 4 * hi;
        const s16x4 lo = *(const s16x4*)xr, h4 = *(const s16x4*)(xr + 8);
        y = MFMA32(__builtin_shufflevector(lo, h4, 0, 1, 2, 3, 4, 5, 6, 7), pb, y);
      }
    }
  }
  {
    const int posl = kl * 64 + lcol, t = d ? (Len - 1 - posl) : posl;
    bf16_t* yp = Yssd + (size_t)(base + t) * 256 + h * 64 + 32 * pi + 4 * hi;
#pragma unroll
    for (int r4 = 0; r4 < 4; ++r4) { u32x2 o; o.x = pk_bf16(y[4 * r4], y[4 * r4 + 1]); o.y = pk_bf16(y[4 * r4 + 2], y[4 * r4 + 3]); *(u32x2*)(yp + 8 * r4) = o; }
  }
  f32x16 sacc = zero16();
#pragma unroll
  for (int ks = 0; ks < 4; ++ks) sacc = MFMA32(*(const bf16x8*)(sXT + (32 * pi + l31) * 72 + ks * 16 + hi * 8), *(const bf16x8*)(sBT + (32 * li + l31) * 72 + ks * 16 + hi * 8), sacc);
  bf16_t* Sp = (bf16_t*)(p.ws + OFF_SS) + ((size_t)chain * 37 + ck + 1) * 4096;
#pragma unroll
  for (int r = 0; r < 16; ++r) Sp[(32 * pi + crow(r, hi)) * 64 + 32 * li + l31] = f2bf(sacc[r]);
  __syncthreads();
}

DI void ssd_scan(const Params& p, int chain) {
  const int tid = otid();
  char* slot0 = p.ws + OFF_SS + (size_t)chain * 37 * 8192 + tid * 32;
  const float* dec = (const float*)(p.ws + OFF_DEC) + chain * 36;
  float H[16];
#pragma unroll
  for (int i = 0; i < 16; ++i) H[i] = 0.f;
#pragma unroll 4
  for (int c = 0; c < 36; ++c) {
    const u32x4* sp = (const u32x4*)(slot0 + (size_t)(c + 1) * 8192);
    const u32x4 s0 = sp[0], s1 = sp[1];
    const float dc = dec[c];
    u32x4 w0, w1;
    w0.x = pk_bf16(H[0], H[1]); w0.y = pk_bf16(H[2], H[3]); w0.z = pk_bf16(H[4], H[5]); w0.w = pk_bf16(H[6], H[7]);
    w1.x = pk_bf16(H[8], H[9]); w1.y = pk_bf16(H[10], H[11]); w1.z = pk_bf16(H[12], H[13]); w1.w = pk_bf16(H[14], H[15]);
    u32x4* hp = (u32x4*)(slot0 + (size_t)c * 8192);
    hp[0] = w0; hp[1] = w1;
    H[0] = H[0] * dc + bflo(s0.x); H[1] = H[1] * dc + bfhi(s0.x); H[2] = H[2] * dc + bflo(s0.y); H[3] = H[3] * dc + bfhi(s0.y);
    H[4] = H[4] * dc + bflo(s0.z); H[5] = H[5] * dc + bfhi(s0.z); H[6] = H[6] * dc + bflo(s0.w); H[7] = H[7] * dc + bfhi(s0.w);
    H[8] = H[8] * dc + bflo(s1.x); H[9] = H[9] * dc + bfhi(s1.x); H[10] = H[10] * dc + bflo(s1.y); H[11] = H[11] * dc + bfhi(s1.y);
    H[12] = H[12] * dc + bflo(s1.z); H[13] = H[13] * dc + bfhi(s1.z); H[14] = H[14] * dc + bflo(s1.w); H[15] = H[15] * dc + bfhi(s1.w);
  }
}

DI void ssd_finish_tile(const Params& p, int layer, int tile, char* smem) {
  const int tid = otid(), lane = tid & 63, wave = tid >> 6, l31 = lane & 31, hi = lane >> 5;
  const int b = tile / 72, tb = tile % 72, p0 = tb * 32;
  const bool isctx = tb < 8;
  const int row0 = isctx ? (MROWS + b * CT + p0) : (b * SEQ + p0 - CT);
  const int T64 = tb >> 1, nch = isctx ? 4 : 32, Tl = isctx ? T64 : T64 - 4;
  const bf16_t* U = (const bf16_t*)(p.ws + OFF_U);
  const bf16_t* Y0 = (const bf16_t*)(p.ws + OFF_XN); const bf16_t* Y1 = Y0 + (size_t)ROWS * 256;
  const float* ECL = (const float*)(p.ws + OFF_ECL);
  bf16_t* Y = (bf16_t*)(p.ws + OFF_Y);
  bf16_t* sCc = (bf16_t*)smem;
  float* sY = (float*)(smem + 8704);
  {
    const bf16_t* CB = (const bf16_t*)(p.ws + OFF_CB) + (size_t)row0 * 128;
#pragma unroll
    for (int i = 0; i < 2; ++i) { const int c = tid + 256 * i, r = c >> 4, kc = c & 15; *(u32x4*)(sCc + r * 136 + kc * 8) = *(const u32x4*)(CB + r * 128 + kc * 8); }
  }
  __syncthreads();
  {
    const int pi = wave & 1, g = wave >> 1;
    const int row = row0 + l31;
    bf16x8 hf[2][2][4];
#pragma unroll
    for (int hh = 0; hh < 2; ++hh)
#pragma unroll
      for (int d = 0; d < 2; ++d) {
        const int h = g * 2 + hh;
        const int kl = d ? (nch - 1 - Tl) : Tl, ck = isctx ? kl : 4 + kl, chain = (b * 4 + h) * 2 + d;
        const char* Hs = p.ws + OFF_SS + ((size_t)chain * 37 + ck) * 8192 + (32 * pi + l31) * 128 + hi * 16;
#pragma unroll
        for (int ks = 0; ks < 4; ++ks) hf[hh][d][ks] = *(const bf16x8*)(Hs + ks * 32);
      }
    bf16x8 cfr[4];
#pragma unroll
    for (int ks = 0; ks < 4; ++ks) cfr[ks] = *(const bf16x8*)(sCc + l31 * 136 + g * 64 + ks * 16 + hi * 8);
    __builtin_amdgcn_sched_barrier(0);
#pragma unroll
    for (int hh = 0; hh < 2; ++hh) {
      const int h = g * 2 + hh;
      f32x16 ys = zero16();
#pragma unroll
      for (int d = 0; d < 2; ++d) {
        f32x16 acc = zero16();
#pragma unroll
        for (int ks = 0; ks < 4; ++ks) acc = MFMA32(hf[hh][d][ks], cfr[ks], acc);
        const float e = ECL[(size_t)(d * 4 + h) * ROWS + row];
        ys += acc * e;
      }
      const bf16_t* y0p = Y0 + (size_t)row * 256 + h * 64 + 32 * pi + 4 * hi; const bf16_t* y1p = Y1 + (size_t)row * 256 + h * 64 + 32 * pi + 4 * hi;
#pragma unroll
      for (int r4 = 0; r4 < 4; ++r4) {
        const u32x2 a_ = *(const u32x2*)(y0p + 8 * r4), c_ = *(const u32x2*)(y1p + 8 * r4);
        const f32x4 a = {bflo(a_.x), bfhi(a_.x), bflo(a_.y), bfhi(a_.y)}, c2 = {bflo(c_.x), bfhi(c_.x), bflo(c_.y), bfhi(c_.y)};
        f32x4 o; o[0] = ys[4 * r4] + a[0] + c2[0]; o[1] = ys[4 * r4 + 1] + a[1] + c2[1]; o[2] = ys[4 * r4 + 2] + a[2] + c2[2]; o[3] = ys[4 * r4 + 3] + a[3] + c2[3];
        *(f32x4*)(sY + l31 * 260 + h * 64 + 32 * pi + 8 * r4 + 4 * hi) = o;
      }
    }
  }
  __syncthreads();
  {
    const int ch = lane * 4, hd = lane >> 4;
    const float dsk = p.in[I_SSDD][layer * 8 + hd] + p.in[I_SSDD][layer * 8 + 4 + hd];
    f32x4 cw[3];
    {
      const float* w = p.in[I_CONVW] + ((size_t)layer * 512 + ch) * 3;
      const f32x4 a = *(const f32x4*)w, b2 = *(const f32x4*)(w + 4), c2 = *(const f32x4*)(w + 8);
      cw[0] = (f32x4){a[0], a[3], b2[2], c2[1]}; cw[1] = (f32x4){a[1], b2[0], b2[3], c2[2]}; cw[2] = (f32x4){a[2], b2[1], c2[0], c2[3]};
    }
    const f32x4 cb = *(const f32x4*)(p.in[I_CONVB] + layer * 512 + ch);
    const f32x4 ng = *(const f32x4*)(p.in[I_SSDNG] + layer * 256 + ch);
    const int Len = isctx ? CT : SEQ;
    u32x2 z2a[8], xma[8], x0a[8], xpa[8];
#pragma unroll
    for (int k = 0; k < 8; ++k) {
      const int rr = wave + 4 * k;
      const int t = isctx ? (p0 + rr) : (p0 - CT + rr);
      const bf16_t* up = U + (size_t)(row0 + rr) * INP;
      const u32x2 zz = {0u, 0u};
      z2a[k] = *(const u32x2*)(up + U_Z + ch);
      xma[k] = (t > 0) ? *(const u32x2*)(up - INP + U_X + ch) : zz;
      x0a[k] = *(const u32x2*)(up + U_X + ch);
      xpa[k] = (t < Len - 1) ? *(const u32x2*)(up + INP + U_X + ch) : zz;
    }
    __builtin_amdgcn_sched_barrier(0);
#pragma unroll
    for (int k = 0; k < 8; ++k) {
      const int rr = wave + 4 * k;
      const int row = row0 + rr;
      const u32x2 z2 = z2a[k], xm = xma[k], x0 = x0a[k], xp = xpa[k];
      const f32x4 xmf = {bflo(xm.x), bfhi(xm.x), bflo(xm.y), bfhi(xm.y)}, x0f = {bflo(x0.x), bfhi(x0.x), bflo(x0.y), bfhi(x0.y)}, xpf = {bflo(xp.x), bfhi(xp.x), bflo(xp.y), bfhi(xp.y)};
      const f32x4 zf = {bflo(z2.x), bfhi(z2.x), bflo(z2.y), bfhi(z2.y)};
      const f32x4 cv = cw[0] * xmf + cw[1] * x0f + cw[2] * xpf + cb;
      const f32x4 ya = *(const f32x4*)(sY + rr * 260 + ch);
      f32x4 gz; float ss = 0.f;
#pragma unroll
      for (int e = 0; e < 4; ++e) { const float xs = silu_f(cv[e]); const float yv = ya[e] + dsk * xs; gz[e] = yv * silu_f(zf[e]); ss += gz[e] * gz[e]; }
      ss = wave_sum(ss);
      const float rstd = rsqrtf(ss * (1.f / 256.f) + EPS);
      u32x2 w; w.x = pk_bf16(gz[0] * rstd * ng[0], gz[1] * rstd * ng[1]); w.y = pk_bf16(gz[2] * rstd * ng[2], gz[3] * rstd * ng[3]);
      *(u32x2*)(Y + (size_t)row * DM + ch) = w;
    }
  }
  __syncthreads();
}

DI void mixer_phase(const Params& p, int layer_c, char* smem, int* s_item) {
  const int layer = layer_c % DEPTH;
  const bool with_ctx = layer < DEPTH - 1;
  const int nqb = with_ctx ? 9 : 8;
  const int natt = 12 * nqb, nfin = with_ctx ? 36 : 32;
  const int nitems = 4 + natt + nfin;
  unsigned* cnt = (unsigned*)(p.ws + OFF_MISC) + layer_c * 8;
  unsigned* sdone = (unsigned*)(p.ws + OFF_MISC) + 72 + layer * 8;
  for (int qq = 0; qq < 8; ++qq) {
    const int q = (blockIdx.x + qq) & 7;
    for (;;) {
      if (threadIdx.x == 0) *s_item = (int)atomicAdd(&cnt[q], 1u);
      __syncthreads();
      const int it = *s_item;
      __syncthreads();
      if (it >= nitems) break;
      if (it < 4) {
        ssd_scan(p, q * 8 + it * 2 + half_id());
        asm volatile("s_waitcnt vmcnt(0)" ::: "memory");
        __syncthreads();
        if (threadIdx.x == 0) {
          __builtin_amdgcn_fence(__ATOMIC_RELEASE, "agent");
          asm volatile("s_waitcnt vmcnt(0)" ::: "memory");
          __hip_atomic_fetch_add(&sdone[q], 1u, __ATOMIC_RELAXED, __HIP_MEMORY_SCOPE_AGENT);
        }
      } else if (it < 4 + natt) {
        const int idx = it - 4;
        int kind, head, qb;
        if (idx < 96) { const int hidx = idx >> 3; qb = (idx & 7) + 1; const int ko = hidx >> 2; kind = ko == 0 ? 1 : (ko == 1 ? 0 : 2); head = hidx & 3; }
        else { const int hidx = idx - 96; qb = 0; const int ko = hidx >> 2; kind = ko == 0 ? 1 : (ko == 1 ? 0 : 2); head = hidx & 3; }
        attn_unit(p, layer, q, kind, head, qb, smem);
      } else {
        if (threadIdx.x == 0) {
          while (__hip_atomic_load(&sdone[q], __ATOMIC_RELAXED, __HIP_MEMORY_SCOPE_AGENT) < 4u) __builtin_amdgcn_s_sleep(2);
          __builtin_amdgcn_fence(__ATOMIC_ACQUIRE, "agent");
          asm volatile("s_waitcnt vmcnt(0)" ::: "memory");
        }
        __syncthreads();
        const int fi = it - 4 - natt;
        const int tile = q * 72 + (with_ctx ? 0 : 8) + fi * 2 + half_id();
        ssd_finish_tile(p, layer, tile, smem + half_id() * SMEM_BYTES);
      }
      __syncthreads();
    }
  }
}

#define XB_TMO      128
#define XB_XCNT(j)  (256  + 64 * (j))
#define XB_XSUB(j)  (1280 + 64 * (j))
#define XB_XGEN(j)  (2304 + 64 * (j))
#define XB_TOP      3328
#define XB_TOPGEN   3392
#define XCD_BAR_WORDS 3456
#define XB_SPIN_CAP (1u << 18)
#define LAS __attribute__((address_space(3)))

__device__ __forceinline__ unsigned xb_ld(unsigned* p)              { return __hip_atomic_load(p, __ATOMIC_RELAXED, __HIP_MEMORY_SCOPE_AGENT); }
__device__ __forceinline__ unsigned xb_add(unsigned* p, unsigned v) { return __hip_atomic_fetch_add(p, v, __ATOMIC_RELAXED, __HIP_MEMORY_SCOPE_AGENT); }
__device__ __forceinline__ unsigned xb_xcc_id() { return (unsigned)__builtin_amdgcn_s_getreg((3 << 11) | 20) & 0xFu; }
#define XB_SPIN(cond, bar) do { unsigned _sp = 0; while (cond) { __builtin_amdgcn_s_sleep(1); \
    if ((++_sp & 255u) == 0u) { if (xb_ld(&(bar)[XB_TMO])) break; if (_sp > XB_SPIN_CAP) { atomicAdd(&(bar)[XB_TMO], 1u); break; } } } } while (0)

struct XcdBarrier {
    unsigned* bar; unsigned x;
    volatile LAS unsigned* st;
};

__device__ __forceinline__ XcdBarrier xcd_barrier_post(unsigned* bar, volatile LAS unsigned* st) {
    XcdBarrier b; b.bar = bar; b.x = xb_xcc_id(); b.st = st;
    if (threadIdx.x == 0) (void)xb_add(&bar[XB_XCNT(b.x)], 1u);
    return b;
}
__device__ __forceinline__ void xcd_barrier_complete(unsigned* bar, unsigned x, unsigned& nloc, unsigned& nx) {
    const unsigned G = gridDim.x * gridDim.y * gridDim.z;
    unsigned sum, cnt, mine, sp = 0u;
    for (;;) {
        sum = 0u; cnt = 0u; mine = 0u;
#pragma unroll
        for (unsigned j = 0; j < 16; ++j) { const unsigned c = xb_ld(&bar[XB_XCNT(j)]); sum += c; cnt += (c > 0u) ? 1u : 0u; mine = (j == x) ? c : mine; }
        if (sum == G) break;
        __builtin_amdgcn_s_sleep(1);
        if ((++sp & 255u) == 0u) { if (xb_ld(&bar[XB_TMO])) break; if (sp > XB_SPIN_CAP) { atomicAdd(&bar[XB_TMO], 1u); break; } }
    }
    nloc = mine > 0u ? mine : 1u; nx = cnt > 0u ? cnt : 1u;
}

__device__ __forceinline__ void xcd_barrier(const XcdBarrier& b) {
    asm volatile("s_waitcnt vmcnt(0)" ::: "memory");
    __syncthreads();
    if (threadIdx.x == 0) {
        unsigned* bar = b.bar;
        __builtin_amdgcn_s_waitcnt(0);
        unsigned nloc = b.st[0], nx = b.st[1];
        if (nloc == 0u) { xcd_barrier_complete(bar, b.x, nloc, nx); b.st[0] = nloc; b.st[1] = nx; }
        const unsigned old = xb_add(&bar[XB_XSUB(b.x)], 1u);
        const unsigned gen = old / nloc;
        if (old + 1u == (gen + 1u) * nloc) {
            __builtin_amdgcn_fence(__ATOMIC_RELEASE, "agent");
            asm volatile("s_waitcnt vmcnt(0)" ::: "memory");
            const unsigned og = xb_add(&bar[XB_TOP], 1u);
            const unsigned tg = og / nx;
            if (og + 1u == (tg + 1u) * nx) xb_add(&bar[XB_TOPGEN], 1u);
            else XB_SPIN(xb_ld(&bar[XB_TOPGEN]) == tg, bar);
            __builtin_amdgcn_fence(__ATOMIC_ACQUIRE, "agent");
            xb_add(&bar[XB_XGEN(b.x)], 1u);
            asm volatile("s_waitcnt vmcnt(0)" ::: "memory");
        } else {
            XB_SPIN(xb_ld(&bar[XB_XGEN(b.x)]) == gen, bar);
            __builtin_amdgcn_fence(__ATOMIC_ACQUIRE, "agent");
            asm volatile("s_waitcnt vmcnt(0)" ::: "memory");
        }
    }
    __syncthreads();
}

DI void gbar(unsigned* bw, unsigned k) {
  asm volatile("s_waitcnt vmcnt(0)" ::: "memory");
  __syncthreads();
  if (threadIdx.x == 0) {
    __builtin_amdgcn_fence(__ATOMIC_RELEASE, "agent");
    asm volatile("s_waitcnt vmcnt(0)" ::: "memory");
    unsigned bx_ = blockIdx.x, gd_ = gridDim.x; asm volatile("" : "+s"(bx_), "+s"(gd_));
    const unsigned x = bx_ & 7u, nloc = (gd_ - x + 7u) >> 3;
    unsigned* sub = bw + 64 * (1 + x); unsigned* gen = bw + 64 * (9 + x); unsigned* top = bw + 64 * 17;
    const unsigned old = __hip_atomic_fetch_add(sub, 1u, __ATOMIC_RELAXED, __HIP_MEMORY_SCOPE_AGENT);
    if (old + 1u == k * nloc) {
      __hip_atomic_fetch_add(top, 1u, __ATOMIC_RELAXED, __HIP_MEMORY_SCOPE_AGENT);
      while (__hip_atomic_load(top, __ATOMIC_RELAXED, __HIP_MEMORY_SCOPE_AGENT) < 8u * k) __builtin_amdgcn_s_sleep(1);
      __hip_atomic_fetch_add(gen, 1u, __ATOMIC_RELAXED, __HIP_MEMORY_SCOPE_AGENT);
    } else {
      while (__hip_atomic_load(gen, __ATOMIC_RELAXED, __HIP_MEMORY_SCOPE_AGENT) < k) __builtin_amdgcn_s_sleep(1);
    }
    __builtin_amdgcn_fence(__ATOMIC_ACQUIRE, "agent");
    asm volatile("s_waitcnt vmcnt(0)" ::: "memory");
  }
  __syncthreads();
}

__global__ void __launch_bounds__(NTHREADS, 2) fwd_megakernel(Params p) {
  cg::grid_group grid = cg::this_grid();
  extern __shared__ __attribute__((aligned(16))) unsigned char lds_dyn[];
  __shared__ uint4 s_misc[2];
  int& s_item = *(int*)&s_misc[1];
  if (threadIdx.x == 0) s_misc[0] = make_uint4(0u, 0u, 0u, 0u);
  __syncthreads();
  (void)xcd_barrier_post((unsigned*)(p.ws + OFF_MISC + 16384), (volatile LAS unsigned*)&s_misc[0]);
#define GBAR() do { XcdBarrier xb_; xb_.bar = (unsigned*)(p.ws + OFF_MISC + 16384); xb_.x = xb_xcc_id(); xb_.st = (volatile LAS unsigned*)&s_misc[0]; xcd_barrier(xb_); } while (0)
  char* smem = (char*)lds_dyn;
  const int half = half_id();
  unsigned* bw = (unsigned*)(p.ws + OFF_MISC) + 256; unsigned bk = 0;
  phase0(p, smem);
  if (p.ws == nullptr) grid.sync();
  GBAR();
  mod_reduce(p);
  GBAR();
  const float* MOD = (const float*)(p.ws + OFF_MOD);
  bf16_t* XN = (bf16_t*)(p.ws + OFF_XN);
  bf16_t* U = (bf16_t*)(p.ws + OFF_U);
  bf16_t* Y = (bf16_t*)(p.ws + OFF_Y);
  bf16_t* HM = (bf16_t*)(p.ws + OFF_HM);
  float* HC = (float*)(p.ws + OFF_HC);
  PG8_LAS unsigned char* glds = (PG8_LAS unsigned char*)lds_dyn;
#pragma unroll 1
  for (int layer = 0; layer < DEPTH; ++layer) {
    const bool with_ctx = layer < DEPTH - 1;
    const int mrows = with_ctx ? ROWS : MROWS;
    int bx = (int)blockIdx.x; asm volatile("" : "+s"(bx));
    for (int rep = 0; rep < PROBE_N1; ++rep) { norm_phase(p, layer, 0, ROWS, layer > 0 ? MOD + (size_t)((layer - 1) * 9 + 8) * 6144 + 5120 : nullptr, HC);
    GBAR(); }
    for (int rep = 0; rep < PROBE_INPROJ; ++rep) { pg8::Gemm g{XN, (const bf16_t*)(p.ws + OFF_WIN) + (size_t)layer * INPW * DM, ROWS, INPW, DM, DM}; pg8::StaticOrder S; S.init(ROWS, INPW, (int)gridDim.x, bx);
      pg8::EpiStore<0> E{U, INP, INP};
      pg8::gemm_phase<pg8::EpiStore<0>, pg8::StaticOrder, true, true>(glds, g, S, E);
    GBAR(); }
    for (int rep = 0; rep < PROBE_PREP; ++rep) {
      unsigned* qc = (unsigned*)(p.ws + OFF_MISC) + 64 + layer + rep * DEPTH;
      for (;;) {
        if (threadIdx.x == 0) s_item = (int)atomicAdd(qc, 1u);
        __syncthreads();
        const int it = s_item;
        __syncthreads();
        if (it >= 1152 + 288) break;
        if (it < 144) prep_tile(p, layer, it * 2 + half, 0, smem + half * SMEM_BYTES);
        else if (it < 288) prep_tile(p, layer, (it - 144) * 2 + half, 1, smem + half * SMEM_BYTES);
        else ssd_chunk(p, layer, it - 288, smem + half * SMEM_BYTES);
      }
      GBAR();
    }
    for (int rep = 0; rep < PROBE_MIX; ++rep) { mixer_phase(p, layer + rep * DEPTH, smem, &s_item);
    GBAR(); }
    { const bf16_t* Wt = (const bf16_t*)(p.ws + OFF_WOUT) + (size_t)layer * DM * DM;
      { pg8::Gemm g{Y, Wt, MROWS, DM, DM, DM}; pg8::StaticOrder S; S.init(MROWS, DM, (int)gridDim.x, bx);
        pg8::EpiResid E{layer == 0 ? p.in[I_X] : p.out, nullptr, p.out, nullptr, MOD + (size_t)layer * 9 * 6144 + 2048, 1.f};
        pg8::gemm_phase<pg8::EpiResid, pg8::StaticOrder, true, true>(glds, g, S, E);
        for (int rep = 0; rep < PROBE_OUT; ++rep) { GBAR(); pg8::EpiResid E2{p.out, nullptr, p.out, nullptr, MOD + (size_t)layer * 9 * 6144 + 2048, 0.f}; pg8::gemm_phase<pg8::EpiResid, pg8::StaticOrder, true, true>(glds, g, S, E2); } }
      if (with_ctx) {
        const int ks = (bx >> 5) & 3;
        pg8::Gemm g{Y + (size_t)MROWS * DM + ks * (DM / 4), Wt + ks * (DM / 4), CROWS, DM, DM, DM / 4}; pg8::SplitOrder S{bx};
        pg8::EpiPartial E{(float*)(p.ws + OFF_SS) + (size_t)ks * CROWS * DM};
        pg8::gemm_phase<pg8::EpiPartial, pg8::SplitOrder, true, true>(glds, g, S, E); } }
    GBAR();
    norm_phase(p, layer, 1, mrows, with_ctx ? MOD + (size_t)(layer * 9 + 8) * 6144 + 2048 : nullptr, layer == 0 ? p.in[I_CTX] : HC);
    GBAR();
    for (int rep = 0; rep < PROBE_UP; ++rep) { pg8::Gemm g{XN, (const bf16_t*)(p.ws + OFF_W1) + (size_t)layer * DFF * DM, mrows, DFF, DM, DM}; pg8::StaticOrder S; S.init(mrows, DFF, (int)gridDim.x, bx);
      pg8::EpiStore<1> E{HM, DFF, DFF};
      pg8::gemm_phase<pg8::EpiStore<1>, pg8::StaticOrder, true, true>(glds, g, S, E);
    GBAR(); }
    { const bf16_t* Wt = (const bf16_t*)(p.ws + OFF_W2) + (size_t)layer * DM * DFF;
      { pg8::Gemm g{HM, Wt, MROWS, DM, DFF, DFF}; pg8::StaticOrder S; S.init(MROWS, DM, (int)gridDim.x, bx);
        pg8::EpiResid E{p.out, nullptr, p.out, nullptr, MOD + (size_t)layer * 9 * 6144 + 5120, 1.f};
        pg8::gemm_phase<pg8::EpiResid, pg8::StaticOrder, true, true>(glds, g, S, E);
        for (int rep = 0; rep < PROBE_DOWN; ++rep) { GBAR(); pg8::EpiResid E2{p.out, nullptr, p.out, nullptr, MOD + (size_t)layer * 9 * 6144 + 5120, 0.f}; pg8::gemm_phase<pg8::EpiResid, pg8::StaticOrder, true, true>(glds, g, S, E2); } }
      if (with_ctx) {
        const int ks = (bx >> 5) & 3;
        pg8::Gemm g{HM + (size_t)MROWS * DFF + ks * (DFF / 4), Wt + ks * (DFF / 4), CROWS, DM, DFF, DFF / 4}; pg8::SplitOrder S{bx};
        pg8::EpiPartial E{(float*)(p.ws + OFF_SS) + (size_t)ks * CROWS * DM};
        pg8::gemm_phase<pg8::EpiPartial, pg8::SplitOrder, true, true>(glds, g, S, E); } }
    GBAR();
  }
  norm_phase(p, 0, 2, MROWS);
}

extern "C" void kernel_launch(void* const* d_in, const int* in_sizes, int n_in, void* d_out, int out_size, void* d_ws, size_t ws_size, hipStream_t stream) {
  static int grid_blocks = 0;
  if (!grid_blocks) {
    int dev = 0, cus = 0, per_cu = 0;
    (void)hipGetDevice(&dev);
    (void)hipDeviceGetAttribute(&cus, hipDeviceAttributeMultiprocessorCount, dev);
    if (hipFuncSetAttribute((const void*)fwd_megakernel, hipFuncAttributeMaxDynamicSharedMemorySize, LDS_BYTES) != hipSuccess) fprintf(stderr, "hipFuncSetAttribute(max dynamic LDS) failed\n");
    (void)hipOccupancyMaxActiveBlocksPerMultiprocessor(&per_cu, (const void*)fwd_megakernel, NTHREADS, LDS_BYTES);
    if (per_cu < 1) { fprintf(stderr, "occupancy query says %d blocks/CU\n", per_cu); per_cu = 1; }
    grid_blocks = cus;
  }
  if (ws_size < OFF_END) { fprintf(stderr, "workspace too small: %zu < %zu\n", ws_size, (size_t)OFF_END); return; }
  Params p{};
  for (int i = 0; i < 27; ++i) p.in[i] = (const float*)d_in[i];
  p.out = (float*)d_out;
  p.ws = (char*)d_ws;
  (void)hipMemsetAsync((char*)d_ws + OFF_MISC, 0, SZ_MISC, stream);
  void* args[] = {&p};
  hipError_t e = hipLaunchCooperativeKernel((void*)fwd_megakernel, dim3(grid_blocks), dim3(NTHREADS), args, LDS_BYTES, stream);
  if (e != hipSuccess) fprintf(stderr, "cooperative launch failed: %s (grid %d)\n", hipGetErrorString(e), grid_blocks);
}
```

```cpp
#include <hip/hip_runtime.h>
#include <hip/hip_cooperative_groups.h>
#include <stdint.h>
#include <cstdio>
namespace cg = cooperative_groups;

typedef unsigned short bf16_t;
typedef short bf16x8 __attribute__((ext_vector_type(8)));
typedef short s16x4 __attribute__((ext_vector_type(4)));
typedef float f32x16 __attribute__((ext_vector_type(16)));
typedef float f32x4 __attribute__((ext_vector_type(4)));
typedef float f32x2 __attribute__((ext_vector_type(2)));
typedef unsigned u32x4 __attribute__((ext_vector_type(4)));
typedef unsigned u32x2 __attribute__((ext_vector_type(2)));
typedef __bf16 bf2_t __attribute__((ext_vector_type(2)));

#define DI __device__ __forceinline__
#define MFMA32(a, b, c) __builtin_amdgcn_mfma_f32_32x32x16_bf16((a), (b), (c), 0, 0, 0)

constexpr int DM = 1024, NB = 8, SEQ = 2048, DEPTH = 4, CT = 256, TT = 2304;
constexpr int MROWS = NB * SEQ, CROWS = NB * CT, ROWS = MROWS + CROWS;
constexpr int INC = 2408, INP = 2432, INPW = 2560, DFF = 4096;
constexpr float EPS = 1e-6f;
constexpr float LOG2E = 1.4426950408889634f;
constexpr int U_Z = 0, U_X = 256, U_B = 512, U_C = 640, U_DT = 768;
constexpr int U_DQ = 776, U_DK = 1032, U_DV = 1288;
constexpr int U_GQ = 1544, U_GK = 1800, U_GV = 1928;
constexpr int U_MQ = 2056, U_MKV = 2248, U_MR = 2376;

constexpr size_t al256(size_t x) { return (x + 255) & ~(size_t)255; }
constexpr size_t SZ_WIN = (size_t)DEPTH * INPW * DM * 2;
constexpr size_t SZ_WOUT = (size_t)DEPTH * DM * DM * 2;
constexpr size_t SZ_W1 = (size_t)DEPTH * DFF * DM * 2;
constexpr size_t SZ_W2 = (size_t)DEPTH * DM * DFF * 2;
constexpr size_t SZ_WUQ = (size_t)DEPTH * 384 * 192 * 2;
constexpr size_t SZ_WUKV = (size_t)DEPTH * 512 * 128 * 2;
constexpr size_t SZ_MOD = (size_t)DEPTH * 9 * 6144 * 4;
constexpr size_t SZ_MISC = 32768;
constexpr size_t SZ_ROPEH = (size_t)SEQ * 32 * 8;
constexpr size_t SZ_ROPED = (size_t)SEQ * 16 * 8;
constexpr size_t SZ_HC = (size_t)CROWS * DM * 4;
constexpr size_t SZ_XN = (size_t)ROWS * DM * 2;
constexpr size_t SZ_U = (size_t)ROWS * INP * 2;
constexpr size_t SZ_QD = (size_t)NB * 8 * TT * 32 * 2;
constexpr size_t SZ_VT4 = (size_t)NB * 4 * 64 * TT * 2;
constexpr size_t SZ_QG = (size_t)NB * 4 * TT * 64 * 2;
constexpr size_t SZ_KG = (size_t)NB * 2 * TT * 64 * 2;
constexpr size_t SZ_QM = (size_t)NB * 4 * TT * 96 * 2;
constexpr size_t SZ_Y = (size_t)ROWS * DM * 2;

constexpr size_t OFF_MOD = 0;
constexpr size_t OFF_MISC = OFF_MOD + al256(SZ_MOD);
constexpr size_t OFF_WIN = OFF_MISC + SZ_MISC;
constexpr size_t OFF_WOUT = OFF_WIN + al256(SZ_WIN);
constexpr size_t OFF_W1 = OFF_WOUT + al256(SZ_WOUT);
constexpr size_t OFF_W2 = OFF_W1 + al256(SZ_W1);
constexpr size_t OFF_WUQ = OFF_W2 + al256(SZ_W2);
constexpr size_t OFF_WUKV = OFF_WUQ + al256(SZ_WUQ);
constexpr size_t OFF_ROPEH = OFF_WUKV + al256(SZ_WUKV);
constexpr size_t OFF_ROPED = OFF_ROPEH + al256(SZ_ROPEH);
constexpr size_t OFF_HC = OFF_ROPED + al256(SZ_ROPED);
constexpr size_t OFF_XN = OFF_HC + al256(SZ_HC);
constexpr size_t OFF_BIG = OFF_XN + al256(SZ_XN);
constexpr size_t OFF_U = OFF_BIG;
constexpr size_t OFF_QD = OFF_U + al256(SZ_U);
constexpr size_t OFF_KD = OFF_QD + al256(SZ_QD);
constexpr size_t OFF_VTD = OFF_KD + al256(SZ_QD);
constexpr size_t OFF_QG = OFF_VTD + al256(SZ_VT4);
constexpr size_t OFF_KG = OFF_QG + al256(SZ_QG);
constexpr size_t OFF_VTG = OFF_KG + al256(SZ_KG);
constexpr size_t OFF_QM = OFF_VTG + al256(SZ_KG);
constexpr size_t OFF_KM = OFF_QM + al256(SZ_QM);
constexpr size_t OFF_VTM = OFF_KM + al256(SZ_QM);
constexpr size_t OFF_Y = OFF_VTM + al256(SZ_VT4);
constexpr size_t SZ_SS = (size_t)64 * 37 * 16384;
constexpr size_t SZ_DEC = (size_t)64 * 36 * 4;
constexpr size_t SZ_ECL = (size_t)8 * ROWS * 4;
constexpr size_t SZ_CB = (size_t)ROWS * 128 * 2;
constexpr size_t OFF_SS = OFF_Y + al256(SZ_Y);
constexpr size_t OFF_DEC = OFF_SS + al256(SZ_SS);
constexpr size_t OFF_ECL = OFF_DEC + al256(SZ_DEC);
constexpr size_t OFF_CB = OFF_ECL + al256(SZ_ECL);
constexpr size_t OFF_END = OFF_CB + al256(SZ_CB);
static_assert(OFF_END <= (size_t)402653184, "workspace budget (4 x mod_w)");
constexpr size_t OFF_HM = OFF_BIG;
static_assert((size_t)ROWS * DFF * 2 <= OFF_Y - OFF_BIG, "HM overlay must not reach Y");
static_assert((size_t)2 * ROWS * 256 * 4 <= SZ_XN, "Yssd overlay");

struct Params {
  const float* in[27];
  float* out;
  char* ws;
};
enum { I_X = 0, I_C, I_CTX, I_CCTX, I_MODW, I_MODB, I_N1G, I_N2G, I_WIN, I_CONVW, I_CONVB, I_DTB, I_ALOG, I_SSDD, I_SSDNG,
       I_DLAM, I_DNG, I_GQN, I_GKN, I_MQN, I_MKVN, I_WUQ, I_WUKV, I_WOUT, I_W1, I_W2, I_FNG };

constexpr int SMEM_BYTES = 65536;
constexpr int LDS_BYTES = 131072, NTHREADS = 512;
#ifndef PROBE_DOWN
#define PROBE_DOWN 0
#endif
#ifndef PROBE_OUT
#define PROBE_OUT 0
#endif
#ifndef PROBE_P0
#define PROBE_P0 1
#endif
#ifndef PROBE_N1
#define PROBE_N1 1
#endif
#ifndef PROBE_FIN
#define PROBE_FIN 1
#endif
#ifndef PROBE_UP
#define PROBE_UP 1
#endif
#ifndef PROBE_PREP
#define PROBE_PREP 1
#endif
#ifndef PROBE_MIX
#define PROBE_MIX 1
#endif
#ifndef PROBE_INPROJ
#define PROBE_INPROJ 1
#endif

DI unsigned pk_bf16(float a, float b) { f32x2 v = {a, b}; bf2_t r = __builtin_convertvector(v, bf2_t); return __builtin_bit_cast(unsigned, r); }
DI bf16_t f2bf(float a) { return (bf16_t)(pk_bf16(a, 0.f) & 0xffffu); }
DI float bf2f(bf16_t v) { return __uint_as_float((unsigned)v << 16); }
DI float bflo(unsigned w) { return __uint_as_float(w << 16); }
DI float bfhi(unsigned w) { return __uint_as_float(w & 0xffff0000u); }
DI float silu_f(float x) { return x / (1.f + __expf(-x)); }
DI float wave_sum(float v) {
#pragma unroll
  for (int o = 32; o >= 1; o >>= 1) v += __shfl_xor(v, o);
  return v;
}
DI int crow(int r, int hi) { return (r & 3) + 8 * (r >> 2) + 4 * hi; }
DI bf16x8 pack8(float a0, float a1, float a2, float a3, float a4, float a5, float a6, float a7) {
  u32x4 p; p.x = pk_bf16(a0, a1); p.y = pk_bf16(a2, a3); p.z = pk_bf16(a4, a5); p.w = pk_bf16(a6, a7);
  return __builtin_bit_cast(bf16x8, p);
}
DI f32x16 zero16() { f32x16 z;
#pragma unroll
  for (int i = 0; i < 16; ++i) z[i] = 0.f;
  return z; }
DI int otid() { int t = threadIdx.x & 255; asm volatile("" : "+v"(t)); return t; }
DI int otid_full() { int t = threadIdx.x; asm volatile("" : "+v"(t)); return t; }
DI int half_id() { return __builtin_amdgcn_readfirstlane((int)threadIdx.x >> 8); }
DI int hrow_of(int b, int pos) { return pos < CT ? (MROWS + b * CT + pos) : (b * SEQ + pos - CT); }

DI void tconv_tile(const float* __restrict__ src, int K, int N, bf16_t* __restrict__ dst, int kt, int nt, unsigned* sT) {
  const int tid = otid();
#pragma unroll
  for (int p = 0; p < 2; ++p) {
    const int idx = tid + 256 * p, kp = idx >> 4, nc = idx & 15;
    const int k = kt * 64 + 2 * kp, n = nt * 64 + nc * 4;
    f32x4 v0 = {0.f, 0.f, 0.f, 0.f}, v1 = {0.f, 0.f, 0.f, 0.f};
    if (n < N) { v0 = *(const f32x4*)(src + (size_t)k * N + n); v1 = *(const f32x4*)(src + (size_t)(k + 1) * N + n); }
#pragma unroll
    for (int e = 0; e < 4; ++e) sT[(nc * 4 + e) * 33 + kp] = pk_bf16(v0[e], v1[e]);
  }
  __syncthreads();
  {
    const int n = tid >> 2, part = tid & 3;
    u32x4 a, b;
    const unsigned* s = sT + n * 33 + part * 8;
    a.x = s[0]; a.y = s[1]; a.z = s[2]; a.w = s[3]; b.x = s[4]; b.y = s[5]; b.z = s[6]; b.w = s[7];
    bf16_t* d = dst + (size_t)(nt * 64 + n) * K + kt * 64 + part * 16;
    *(u32x4*)d = a; *(u32x4*)(d + 8) = b;
  }
  __syncthreads();
}

DI void mod_task(const Params& p, int task, float* sCond) {
  const int tid = otid();
  const int ks = task & 7, cb = (task >> 3) % 24, l = task / 192;
  for (int i = tid; i < 9 * 128; i += 256) {
    const int r = i >> 7, kk = i & 127;
    const float v = (r < 8) ? p.in[I_C][r * DM + ks * 128 + kk] : p.in[I_CCTX][ks * 128 + kk];
    sCond[i] = silu_f(v);
  }
  __syncthreads();
  const int col = cb * 256 + tid;
  const float* w = p.in[I_MODW] + ((size_t)l * DM + ks * 128) * 6144 + col;
  float acc[9];
#pragma unroll
  for (int r = 0; r < 9; ++r) acc[r] = 0.f;
#pragma unroll 8
  for (int kk = 0; kk < 128; ++kk) {
    const float wv = w[(size_t)kk * 6144];
#pragma unroll
    for (int r = 0; r < 9; ++r) acc[r] += sCond[r * 128 + kk] * wv;
  }
  const float bias = (ks == 0) ? p.in[I_MODB][l * 6144 + col] : 0.f;
  float* MODP = (float*)(p.ws + OFF_Y) + (size_t)ks * (DEPTH * 9 * 6144);
#pragma unroll
  for (int r = 0; r < 9; ++r) MODP[(size_t)(l * 9 + r) * 6144 + col] = acc[r] + bias;
  __syncthreads();
}

DI void phase0(const Params& p, char* smem) {
  constexpr int T_WIN = DEPTH * 16 * 38, T_WOUT = DEPTH * 16 * 16, T_W1 = DEPTH * 16 * 64, T_W2 = DEPTH * 64 * 16;
  constexpr int T_UQ = DEPTH * 3 * 6, T_UKV = DEPTH * 2 * 8, T_MOD = 768, T_ROPE = (SEQ * 48) / 256, T_MISC = 1;
  constexpr int E0 = T_WIN, E1 = E0 + T_WOUT, E2 = E1 + T_W1, E3 = E2 + T_W2, E4 = E3 + T_UQ, E5 = E4 + T_UKV, E6 = E5 + T_MOD, E7 = E6 + T_ROPE, E8 = E7 + T_MISC;
  const int tid = otid();
  const int half = half_id(); smem += half * SMEM_BYTES;
  static_assert(E0 % 2 == 0 && E1 % 2 == 0 && E2 % 2 == 0 && E3 % 2 == 0 && E4 % 2 == 0 && E5 % 2 == 0 && E6 % 2 == 0 && E7 % 2 == 0, "half-block pairs must not straddle task types");
  for (int t0 = blockIdx.x * 2; t0 < E8; t0 += gridDim.x * 2) {
    const int t = t0 + half;
    if (t >= E8) break;
    if (t < E0) { const int l = t / (16 * 38), r = t % (16 * 38); tconv_tile(p.in[I_WIN] + (size_t)l * DM * INC, DM, INC, (bf16_t*)(p.ws + OFF_WIN) + (size_t)l * INPW * DM, r / 38, r % 38, (unsigned*)smem); }
    else if (t < E1) { const int u = t - E0, l = u / 256, r = u % 256; tconv_tile(p.in[I_WOUT] + (size_t)l * DM * DM, DM, DM, (bf16_t*)(p.ws + OFF_WOUT) + (size_t)l * DM * DM, r / 16, r % 16, (unsigned*)smem); }
    else if (t < E2) { const int u = t - E1, l = u / 1024, r = u % 1024; tconv_tile(p.in[I_W1] + (size_t)l * DM * DFF, DM, DFF, (bf16_t*)(p.ws + OFF_W1) + (size_t)l * DFF * DM, r / 64, r % 64, (unsigned*)smem); }
    else if (t < E3) { const int u = t - E2, l = u / 1024, r = u % 1024; tconv_tile(p.in[I_W2] + (size_t)l * DFF * DM, DFF, DM, (bf16_t*)(p.ws + OFF_W2) + (size_t)l * DM * DFF, r / 16, r % 16, (unsigned*)smem); }
    else if (t < E4) { const int u = t - E3, l = u / 18, r = u % 18; tconv_tile(p.in[I_WUQ] + (size_t)l * 192 * 384, 192, 384, (bf16_t*)(p.ws + OFF_WUQ) + (size_t)l * 384 * 192, r / 6, r % 6, (unsigned*)smem); }
    else if (t < E5) { const int u = t - E4, l = u / 16, r = u % 16; tconv_tile(p.in[I_WUKV] + (size_t)l * 128 * 512, 128, 512, (bf16_t*)(p.ws + OFF_WUKV) + (size_t)l * 512 * 128, r / 8, r % 8, (unsigned*)smem); }
    else if (t < E6) { mod_task(p, t - E5, (float*)smem); }
    else if (t < E7) {
      const int idx = (t - E6) * 256 + tid;
      int tt, i, nf; f32x2* dst;
      if (idx < SEQ * 32) { tt = idx >> 5; i = idx & 31; nf = 16; dst = (f32x2*)(p.ws + OFF_ROPEH) + idx; }
      else { const int j = idx - SEQ * 32; tt = j >> 4; i = j & 15; nf = 8; dst = (f32x2*)(p.ws + OFF_ROPED) + j; }
      const int f = i & (nf - 1);
      const float pos = (float)((i < nf) ? (tt >> 6) : (tt & 63));
      const float inv = exp2f(-(float)f * (13.287712379549449f / (float)nf));
      float rv = pos * inv * 0.15915494309189535f; rv -= rintf(rv);
      f32x2 cs; cs.x = __builtin_amdgcn_cosf(rv); cs.y = __builtin_amdgcn_sinf(rv);
      *dst = cs;
    } else {
      if (tid < DEPTH) {
        const float* lp = p.in[I_DLAM] + tid * 128;
        float s1 = 0.f, s2 = 0.f;
        for (int i = 0; i < 32; ++i) { s1 += lp[i] * lp[32 + i]; s2 += lp[64 + i] * lp[96 + i]; }
        const float li = 0.8f - 0.6f * expf(-0.3f * (float)tid);
        float* misc = (float*)(p.ws + OFF_MISC);
        misc[128 + tid] = expf(s1) - expf(s2) + li;
        misc[136 + tid] = li;
      }
    }
  }
}

DI void mod_reduce(const Params& p) {
  const float* MODP = (const float*)(p.ws + OFF_Y);
  float* MOD = (float*)(p.ws + OFF_MOD);
  constexpr int NTOT = DEPTH * 9 * 6144;
  for (int i = blockIdx.x * NTHREADS + otid_full(); i < NTOT; i += gridDim.x * NTHREADS) {
    float a = 0.f;
#pragma unroll
    for (int ks = 0; ks < 8; ++ks) a += MODP[(size_t)ks * NTOT + i];
    MOD[i] = a;
  }
}

DI void norm_phase(const Params& p, int layer, int which, int nrows, const float* pend_gate = nullptr, const float* pend_hin = nullptr) {
  constexpr int NR = 3;
  const int tid_ = otid_full(); const int lane = tid_ & 63, wave = tid_ >> 6;
  const int gw = blockIdx.x * 8 + wave, nw = gridDim.x * 8;
  const float* MOD = (const float*)(p.ws + OFF_MOD);
  bf16_t* XN = (bf16_t*)(p.ws + OFF_XN);
  const float* g = (which == 0 ? p.in[I_N1G] : which == 1 ? p.in[I_N2G] : p.in[I_FNG]) + (which == 2 ? 0 : layer * DM);
  f32x4 gv[4];
#pragma unroll
  for (int i = 0; i < 4; ++i) gv[i] = *(const f32x4*)(g + i * 256 + lane * 4);
  for (int row0 = gw; row0 < nrows; row0 += nw * NR) {
    f32x4 v[NR][4], shv[NR][4], scv[NR][4];
    float ss[NR];
#pragma unroll
    for (int j = 0; j < NR; ++j) {
      const int row = row0 + j * nw;
      ss[j] = 0.f;
      if (which != 2 && row < nrows) {
        const int bidx = row < MROWS ? (row >> 11) : 8;
        const float* sh = MOD + (size_t)(layer * 9 + bidx) * 6144 + which * 3072;
#pragma unroll
        for (int i = 0; i < 4; ++i) { shv[j][i] = *(const f32x4*)(sh + i * 256 + lane * 4); scv[j][i] = *(const f32x4*)(sh + 1024 + i * 256 + lane * 4); }
      }
      if (row < nrows) {
        if (pend_gate != nullptr && row >= MROWS) {
          const size_t ro = (size_t)(row - MROWS) * DM;
          const float* P = (const float*)(p.ws + OFF_SS) + ro;
#pragma unroll
          for (int i = 0; i < 4; ++i) {
            const int c = i * 256 + lane * 4;
            const f32x4 a = *(const f32x4*)(P + c), b2 = *(const f32x4*)(P + (size_t)CROWS * DM + c), c2 = *(const f32x4*)(P + (size_t)2 * CROWS * DM + c), d2 = *(const f32x4*)(P + (size_t)3 * CROWS * DM + c);
            v[j][i] = *(const f32x4*)(pend_hin + ro + c) + *(const f32x4*)(pend_gate + c) * (((a + b2) + c2) + d2);
          }
        } else {
          const float* h;
          if (row < MROWS) h = ((which == 0 && layer == 0) ? p.in[I_X] : p.out) + (size_t)row * DM;
          else h = ((which == 0 && layer == 0) ? p.in[I_CTX] : (const float*)(p.ws + OFF_HC)) + (size_t)(row - MROWS) * DM;
#pragma unroll
          for (int i = 0; i < 4; ++i) v[j][i] = *(const f32x4*)(h + i * 256 + lane * 4);
        }
      } else {
#pragma unroll
        for (int i = 0; i < 4; ++i) v[j][i] = (f32x4){0.f, 0.f, 0.f, 0.f};
      }
    }
#pragma unroll
    for (int j = 0; j < NR; ++j) {
      const int row = row0 + j * nw;
      if (row >= nrows) continue;
      if (pend_gate != nullptr && row >= MROWS) {
        float* hc = (float*)(p.ws + OFF_HC) + (size_t)(row - MROWS) * DM;
#pragma unroll
        for (int i = 0; i < 4; ++i) *(f32x4*)(hc + i * 256 + lane * 4) = v[j][i];
      }
#pragma unroll
      for (int i = 0; i < 4; ++i) ss[j] += v[j][i][0] * v[j][i][0] + v[j][i][1] * v[j][i][1] + v[j][i][2] * v[j][i][2] + v[j][i][3] * v[j][i][3];
      const float rstd = rsqrtf(wave_sum(ss[j]) * (1.f / DM) + EPS);
      if (which == 2) {
#pragma unroll
        for (int i = 0; i < 4; ++i) { f32x4 o = v[j][i] * rstd * gv[i]; *(f32x4*)(p.out + (size_t)row * DM + i * 256 + lane * 4) = o; }
      } else {
#pragma unroll
        for (int i = 0; i < 4; ++i) {
          const int c = i * 256 + lane * 4;
          f32x4 o = v[j][i] * rstd * gv[i] * (1.f + scv[j][i]) + shv[j][i];
          u32x2 w; w.x = pk_bf16(o[0], o[1]); w.y = pk_bf16(o[2], o[3]);
          *(u32x2*)(XN + (size_t)row * DM + c) = w;
        }
      }
    }
  }
}

namespace pg8 {
#define PG8_LAS __attribute__((address_space(3)))
typedef unsigned short bf16_t;
typedef short bf16x8 __attribute__((ext_vector_type(8)));
typedef float f32x4 __attribute__((ext_vector_type(4)));
typedef unsigned u32x4 __attribute__((ext_vector_type(4)));
constexpr int BM = 256, BK = 64, HALF = 128, HTB = HALF * BK * 2  , STAGE_BYTES = 8 * HTB, NXCD = 8, WGM = 8;

__host__ __device__ __forceinline__ int lds_byte(int r, int c) { const int st = (r >> 4) * 2 + (c >> 5), rr = r & 15, cc = c & 31, ob = rr * 64 + cc * 2; return st * 1024 + (ob ^ (((ob >> 9) & 1) << 5)); }
__host__ __device__ __forceinline__ void stage_rc(int b, int& R, int& C) { const int st = b / 1024, sb = b % 1024, swz = sb ^ (((sb >> 9) & 1) << 5); R = (st >> 1) * 16 + swz / 64; C = (st & 1) * 32 + (swz % 64) / 2; }
__host__ __device__ __forceinline__ int perm32(int rho) { const int n = rho >> 4, i = rho & 15; return 8 * (i >> 2) + 4 * n + (i & 3); }

struct Unit { int pm, pn; };
struct Gemm { const bf16_t* A; const bf16_t* Bt; int M, N, K, Kloop; };

struct StaticOrder {
    int nM, nN, nwg, G, c;
    __host__ __device__ void init(int M, int N, int G_, int c_) { nM = M / BM; nN = N / BM; nwg = nM * nN; G = G_; c = c_; }
    __host__ __device__ bool next(int i, Unit& u) const {
        const long L = (long)i * G + c; if (L >= nwg) return false;
        int wgid = (int)L; { const int q = nwg / NXCD, r = nwg % NXCD, xcd = wgid % NXCD, off = wgid / NXCD; wgid = (xcd < r ? xcd * (q + 1) : r * (q + 1) + (xcd - r) * q) + off; }
        const int nig = WGM * nN, gid = wgid / nig, fm = gid * WGM, gsz = (nM - fm) < WGM ? (nM - fm) : WGM;
        u.pm = fm + ((wgid % nig) % gsz); u.pn = (wgid % nig) / gsz; return true;
    }
    __device__ __forceinline__ void a_ready(const Unit&) const {}
    __device__ __forceinline__ void done(const Unit&) const {}
};


struct SplitOrder {
    int c;
    __host__ __device__ bool next(int i, Unit& u) const { if (i != 0 || c >= 128) return false; const int q = c & 31; u.pm = q & 7; u.pn = q >> 3; return true; }
    __device__ __forceinline__ void a_ready(const Unit&) const {}
    __device__ __forceinline__ void done(const Unit&) const {}
};
struct EpiPartial {
    static constexpr bool PERM = false, AFTER_DRAIN = false;
    float* P;
    __device__ __forceinline__ void operator()(const f32x4 (&acc)[2][2][4][2], const Unit& u, int wr, int wc, int fr, int fq) const {
        float* base = P + (size_t)u.pm * BM * 1024;
        const int col0 = u.pn * BM + wc * 32 + 4 * fq;
#pragma unroll
        for (int bj = 0; bj < 2; ++bj)
#pragma unroll
            for (int n = 0; n < 2; ++n)
#pragma unroll
                for (int ai = 0; ai < 2; ++ai)
#pragma unroll
                    for (int m = 0; m < 4; ++m) *(f32x4*)(base + (size_t)(ai * HALF + wr * 64 + m * 16 + fr) * 1024 + col0 + bj * HALF + n * 16) = acc[ai][bj][m][n];
    }
};
template <int ACT> struct EpiStore {
    static constexpr bool PERM = true, AFTER_DRAIN = false;
    bf16_t* O; int ldc; int ncols;
    __device__ __forceinline__ void operator()(const f32x4 (&acc)[2][2][4][2], const Unit& u, int wr, int wc, int fr, int fq) const {
        const int row0 = u.pm * BM + wr * 64 + fr, col0 = u.pn * BM + wc * 32 + 8 * fq;
#pragma unroll
        for (int ai = 0; ai < 2; ++ai)
#pragma unroll
            for (int m = 0; m < 4; ++m) { bf16_t* rowp = O + (size_t)(row0 + ai * HALF + m * 16) * ldc + col0;
#pragma unroll
                for (int bj = 0; bj < 2; ++bj) { if (col0 + bj * HALF < ncols) { f32x4 v0 = acc[ai][bj][m][0], v1 = acc[ai][bj][m][1];
                    if (ACT == 1) { v0 = __builtin_elementwise_max(v0, (f32x4){0.f, 0.f, 0.f, 0.f}); v1 = __builtin_elementwise_max(v1, (f32x4){0.f, 0.f, 0.f, 0.f}); v0 = v0 * v0; v1 = v1 * v1; }
                    u32x4 w; w.x = ::pk_bf16(v0[0], v0[1]); w.y = ::pk_bf16(v0[2], v0[3]); w.z = ::pk_bf16(v1[0], v1[1]); w.w = ::pk_bf16(v1[2], v1[3]);
                    *(u32x4*)(rowp + bj * HALF) = w; } } }
    }
};
struct EpiResid {
    static constexpr bool PERM = false, AFTER_DRAIN = false;
    const float* hin_m; const float* hin_c; float* hout_m; float* hout_c; const float* gate; float gscale;
    __device__ __forceinline__ void operator()(const f32x4 (&acc)[2][2][4][2], const Unit& u, int wr, int wc, int fr, int fq) const {
        const bool ismain = u.pm < 64;
        const float* hin = ismain ? hin_m + (size_t)u.pm * BM * 1024 : hin_c + (size_t)(u.pm - 64) * BM * 1024;
        float* hout = ismain ? hout_m + (size_t)u.pm * BM * 1024 : hout_c + (size_t)(u.pm - 64) * BM * 1024;
        const float* g = gate + (size_t)(ismain ? (u.pm >> 3) : 8) * 6144;
        const int col0 = u.pn * BM + wc * 32 + 4 * fq;
        f32x4 gv[2][2];
#pragma unroll
        for (int bj = 0; bj < 2; ++bj)
#pragma unroll
            for (int n = 0; n < 2; ++n) gv[bj][n] = *(const f32x4*)(g + col0 + bj * HALF + n * 16) * gscale;
#pragma unroll
        for (int ai = 0; ai < 2; ++ai) {
            f32x4 hv[4][2][2];
#pragma unroll
            for (int m = 0; m < 4; ++m)
#pragma unroll
                for (int bj = 0; bj < 2; ++bj)
#pragma unroll
                    for (int n = 0; n < 2; ++n) hv[m][bj][n] = *(const f32x4*)(hin + (size_t)(ai * HALF + wr * 64 + m * 16 + fr) * 1024 + col0 + bj * HALF + n * 16);
            __builtin_amdgcn_sched_barrier(0);
#pragma unroll
            for (int m = 0; m < 4; ++m)
#pragma unroll
                for (int bj = 0; bj < 2; ++bj)
#pragma unroll
                    for (int n = 0; n < 2; ++n) *(f32x4*)(hout + (size_t)(ai * HALF + wr * 64 + m * 16 + fr) * 1024 + col0 + bj * HALF + n * 16) = hv[m][bj][n] + gv[bj][n] * acc[ai][bj][m][n];
            __builtin_amdgcn_sched_barrier(0);
        }
    }
};
template <class Epi, class Sched, bool ALIGN_EPI = false, bool SP2 = false>
__device__ __forceinline__ void gemm_phase(PG8_LAS unsigned char* lds, const Gemm g, const Sched& S, const Epi& E) {
    const int tid = ::otid_full(), wid = __builtin_amdgcn_readfirstlane(tid >> 6), lane = tid & 63, wr = wid >> 2, wc = wid & 3, fr = lane & 15, fq = lane >> 4;
    const int K = g.K, nt = g.Kloop / BK;
    unsigned voffA[2], voffB[2];
#pragma unroll
    for (int i = 0; i < 2; ++i) { int R, C; stage_rc(tid * 16 + i * 8192, R, C); const int Rb = Epi::PERM ? ((R & ~31) + perm32(R & 31)) : R;
        voffA[i] = (unsigned)(R * K + C) * 2u; voffB[i] = (unsigned)(Rb * K + C) * 2u; }
    const size_t kstep = (size_t)(BK * 2);
    const size_t hstep = (size_t)HALF * K * 2;
    const size_t tstep = 2 * hstep;
    const unsigned ldsw = (unsigned)wid * 1024u;
    const int aoff = lds_byte(wr * 64 + fr, fq * 8), boff = lds_byte(wc * 32 + fr, fq * 8);
#define PG8_SA(b, h) (((b) * 2 + (h)) * HTB)
#define PG8_SB(b, h) ((4 + (b) * 2 + (h)) * HTB)
#define PG8_STAGE(bufoff, gbase, voff) do { _Pragma("unroll") for (int _i = 0; _i < 2; ++_i) \
        __builtin_amdgcn_global_load_lds((const unsigned*)((const char*)(gbase) + (voff)[_i]), (PG8_LAS unsigned*)(lds + (bufoff) + ldsw + _i * 8192), 16, 0, 0); } while (0)
#define PG8_LDA(dst, b, h) do { _Pragma("unroll") for (int m = 0; m < 4; ++m) _Pragma("unroll") for (int k = 0; k < 2; ++k) dst[m][k] = *(const PG8_LAS bf16x8*)(lds + PG8_SA(b, h) + aoff + m * 2048 + k * 1024); } while (0)
#define PG8_LDB(dst, b, h) do { _Pragma("unroll") for (int n = 0; n < 2; ++n) _Pragma("unroll") for (int k = 0; k < 2; ++k) dst[n][k] = *(const PG8_LAS bf16x8*)(lds + PG8_SB(b, h) + boff + n * 2048 + k * 1024); } while (0)
#define PG8_MMA(ai, bj, At, Bt) do { __builtin_amdgcn_s_setprio(1); _Pragma("unroll") for (int m = 0; m < 4; ++m) _Pragma("unroll") for (int n = 0; n < 2; ++n) _Pragma("unroll") for (int k = 0; k < 2; ++k) \
        acc[ai][bj][m][n] = __builtin_amdgcn_mfma_f32_16x16x32_bf16(Bt[n][k], At[m][k], acc[ai][bj][m][n], 0, 0, 0); __builtin_amdgcn_s_setprio(0); } while (0)
#define PG8_WAIT_V(n) asm volatile("s_waitcnt vmcnt(" #n ")" ::: "memory")
#define PG8_WAIT_L(n) asm volatile("s_waitcnt lgkmcnt(" #n ")" ::: "memory")
#define PG8_BAR __builtin_amdgcn_s_barrier()
#define PG8_SCHED __builtin_amdgcn_sched_barrier(0)
    Unit cur, nxt; int ui = 0;
    if (!S.next(0, cur)) return;
    f32x4 acc[2][2][4][2];
#pragma unroll
    for (int a = 0; a < 2; ++a)
#pragma unroll
        for (int b = 0; b < 2; ++b)
#pragma unroll
            for (int m = 0; m < 4; ++m)
#pragma unroll
                for (int n = 0; n < 2; ++n) acc[a][b][m][n] = (f32x4){0.f, 0.f, 0.f, 0.f};
    bf16x8 At[4][2], B0[2][2], B1[2][2];
    const char* cA = (const char*)g.A + (size_t)cur.pm * tstep; const char* cB = (const char*)g.Bt + (size_t)cur.pn * tstep;
    S.a_ready(cur);
    if constexpr (SP2) {
        PG8_STAGE(PG8_SB(0, 0), cB, voffB); PG8_STAGE(PG8_SB(0, 1), cB + hstep, voffB); PG8_STAGE(PG8_SA(0, 0), cA, voffA); PG8_STAGE(PG8_SA(0, 1), cA + hstep, voffA);
        if (wr == 1) PG8_BAR;
        PG8_WAIT_V(2); PG8_BAR;
        PG8_STAGE(PG8_SB(1, 0), cB + kstep, voffB); PG8_STAGE(PG8_SA(1, 0), cA + kstep, voffA); PG8_STAGE(PG8_SB(1, 1), cB + hstep + kstep, voffB);
        PG8_WAIT_V(6); PG8_BAR;
    } else {
        PG8_STAGE(PG8_SB(0, 0), cB, voffB); PG8_STAGE(PG8_SA(0, 0), cA, voffA); PG8_STAGE(PG8_SB(0, 1), cB + hstep, voffB); PG8_STAGE(PG8_SA(0, 1), cA + hstep, voffA);
        if (wr == 1) PG8_BAR;
        PG8_WAIT_V(4); PG8_BAR;
        PG8_STAGE(PG8_SB(1, 0), cB + kstep, voffB); PG8_STAGE(PG8_SA(1, 0), cA + kstep, voffA); PG8_STAGE(PG8_SB(1, 1), cB + hstep + kstep, voffB);
        PG8_WAIT_V(6); PG8_BAR;
    }
    for (;;) {
        const bool has_next = S.next(ui + 1, nxt);
        const char* nA = has_next ? (const char*)g.A + (size_t)nxt.pm * tstep : cA; const char* nB = has_next ? (const char*)g.Bt + (size_t)nxt.pn * tstep : cB;
        for (int t = 0; t < nt; t += 2) {
            const bool last = (t == nt - 2);
            const char* a1 = cA + (size_t)(t + 1) * kstep;
            const char* a2 = last ? nA : cA + (size_t)(t + 2) * kstep; const char* b2 = last ? nB : cB + (size_t)(t + 2) * kstep;
            const char* a3 = a2 + kstep; const char* b3 = b2 + kstep;
            if (last && has_next) S.a_ready(nxt);
            if constexpr (SP2) {
            PG8_LDB(B0, 0, 0); PG8_LDB(B1, 0, 1); PG8_SCHED; PG8_LDA(At, 0, 0); PG8_STAGE(PG8_SA(1, 1), a1 + hstep, voffA);
            PG8_WAIT_V(8); PG8_WAIT_L(0); PG8_BAR; PG8_MMA(0, 0, At, B0); PG8_MMA(0, 1, At, B1); PG8_BAR; PG8_SCHED;
            PG8_LDA(At, 0, 1); PG8_STAGE(PG8_SB(0, 0), b2, voffB); PG8_STAGE(PG8_SB(0, 1), b2 + hstep, voffB); PG8_STAGE(PG8_SA(0, 0), a2, voffA);
            PG8_WAIT_V(8); PG8_WAIT_L(0); PG8_BAR; PG8_MMA(1, 0, At, B0); PG8_MMA(1, 1, At, B1); PG8_BAR; PG8_SCHED;
            PG8_LDB(B0, 1, 0); PG8_LDB(B1, 1, 1); PG8_SCHED; PG8_LDA(At, 1, 0); PG8_STAGE(PG8_SA(0, 1), a2 + hstep, voffA);
            PG8_WAIT_V(8); PG8_WAIT_L(0); PG8_BAR; PG8_MMA(0, 0, At, B0); PG8_MMA(0, 1, At, B1); PG8_BAR; PG8_SCHED;
            PG8_LDA(At, 1, 1); PG8_STAGE(PG8_SB(1, 0), b3, voffB); PG8_STAGE(PG8_SB(1, 1), b3 + hstep, voffB); PG8_STAGE(PG8_SA(1, 0), a3, voffA);
            PG8_WAIT_V(8); PG8_WAIT_L(0); PG8_BAR; PG8_MMA(1, 0, At, B0); PG8_MMA(1, 1, At, B1); PG8_BAR; PG8_SCHED;
            } else {
            PG8_LDB(B0, 0, 0); PG8_SCHED; PG8_LDA(At, 0, 0); PG8_STAGE(PG8_SA(1, 1), a1 + hstep, voffA);
            PG8_WAIT_L(8); PG8_BAR; PG8_WAIT_L(0); PG8_MMA(0, 0, At, B0); PG8_BAR; PG8_SCHED;
            PG8_LDB(B1, 0, 1); PG8_STAGE(PG8_SB(0, 0), b2, voffB);
            PG8_BAR; PG8_WAIT_L(0); PG8_MMA(0, 1, At, B1); PG8_BAR;
            PG8_LDA(At, 0, 1); PG8_STAGE(PG8_SA(0, 0), a2, voffA);
            PG8_BAR; PG8_WAIT_L(0); PG8_MMA(1, 0, At, B0); PG8_BAR; PG8_SCHED;
            PG8_STAGE(PG8_SB(0, 1), b2 + hstep, voffB);
            PG8_WAIT_V(6); PG8_BAR; PG8_MMA(1, 1, At, B1); PG8_BAR;
            PG8_LDB(B0, 1, 0); PG8_SCHED; PG8_LDA(At, 1, 0); PG8_STAGE(PG8_SA(0, 1), a2 + hstep, voffA);
            PG8_WAIT_L(8); PG8_BAR; PG8_WAIT_L(0); PG8_MMA(0, 0, At, B0); PG8_BAR; PG8_SCHED;
            PG8_LDB(B1, 1, 1); PG8_STAGE(PG8_SB(1, 0), b3, voffB);
            PG8_BAR; PG8_WAIT_L(0); PG8_MMA(0, 1, At, B1); PG8_BAR;
            PG8_LDA(At, 1, 1); PG8_STAGE(PG8_SA(1, 0), a3, voffA);
            PG8_BAR; PG8_WAIT_L(0); PG8_MMA(1, 0, At, B0); PG8_BAR; PG8_SCHED;
            PG8_STAGE(PG8_SB(1, 1), b3 + hstep, voffB);
            PG8_WAIT_V(6); PG8_BAR; PG8_MMA(1, 1, At, B1); PG8_BAR;
            }
        }
        if constexpr (ALIGN_EPI) { if (wr == 0) PG8_BAR; }
        if constexpr (!Epi::AFTER_DRAIN) { E(acc, cur, wr, wc, fr, fq); S.done(cur); }
        if (!has_next) break;
#pragma unroll
        for (int a = 0; a < 2; ++a)
#pragma unroll
            for (int b = 0; b < 2; ++b)
#pragma unroll
                for (int m = 0; m < 4; ++m)
#pragma unroll
                    for (int n = 0; n < 2; ++n) acc[a][b][m][n] = (f32x4){0.f, 0.f, 0.f, 0.f};
        cur = nxt; cA = nA; cB = nB; ++ui;
        if constexpr (ALIGN_EPI) { if (wr == 1) PG8_BAR; }
    }
    PG8_WAIT_V(0);
    if constexpr (!ALIGN_EPI) { if (wr == 0) PG8_BAR; }
    PG8_BAR;
    if constexpr (Epi::AFTER_DRAIN) { E.fused(acc, cur, wr, wc, fr, fq, lds, wid, lane); S.done(cur); }
#undef PG8_SA
#undef PG8_SB
#undef PG8_STAGE
#undef PG8_LDA
#undef PG8_LDB
#undef PG8_MMA
#undef PG8_WAIT_V
#undef PG8_WAIT_L
#undef PG8_BAR
#undef PG8_SCHED
}
}

DI void prep_tile(const Params& p, int layer, int tile, int part, char* smem) {
  const int tid = otid(), lane = tid & 63, wave = tid >> 6, l31 = lane & 31, hi = lane >> 5;
  const int b = tile / 36, tb = tile % 36, p0 = tb * 64;
  const bool isctx = tb < 4;
  const int row0 = isctx ? (MROWS + b * CT + p0) : (b * SEQ + p0 - CT);
  const bf16_t* U = (const bf16_t*)(p.ws + OFF_U);
  const f32x2* ropeH = (const f32x2*)(p.ws + OFF_ROPEH);
  const f32x2* ropeD = (const f32x2*)(p.ws + OFF_ROPED);
  bf16_t* QD = (bf16_t*)(p.ws + OFF_QD); bf16_t* KD = (bf16_t*)(p.ws + OFF_KD); bf16_t* VTD = (bf16_t*)(p.ws + OFF_VTD);
  bf16_t* QG = (bf16_t*)(p.ws + OFF_QG); bf16_t* KG = (bf16_t*)(p.ws + OFF_KG); bf16_t* VTG = (bf16_t*)(p.ws + OFF_VTG);
  bf16_t* QM = (bf16_t*)(p.ws + OFF_QM); bf16_t* KM = (bf16_t*)(p.ws + OFF_KM); bf16_t* VTM = (bf16_t*)(p.ws + OFF_VTM);
  const float qsD = 0.17677669529663687f * LOG2E, qsG = 0.125f * LOG2E, qsM = 0.10206207261596575f * LOG2E;
  bf16_t* sT = (bf16_t*)smem; bf16_t* sCq = (bf16_t*)(smem + 9216); bf16_t* sCkv = (bf16_t*)(smem + 9216 + 25600);

  if (part == 0) {
#pragma unroll 1
  for (int i = 0; i < 4; ++i) {
    const int task = tid + 256 * i;
    if (task >= 15 * 64) break;
    const int g = task >> 6, tk = task & 63;
    const bf16_t* urow = U + (size_t)(row0 + tk) * INP;
    const int pos = p0 + tk, t = pos - CT;
    if (g < 14) {
      const bool isdiff = g < 8;
      const bool isq = isdiff ? (g < 4) : (g < 12);
      const int h = isdiff ? (g & 3) : (isq ? g - 8 : g - 12);
      const int col = isdiff ? ((isq ? U_DQ : U_DK) + h * 64) : ((isq ? U_GQ : U_GK) + h * 64);
      float x[64];
#pragma unroll
      for (int c = 0; c < 8; ++c) {
        const u32x4 v = *(const u32x4*)(urow + col + c * 8);
        x[c * 8 + 0] = bflo(v.x); x[c * 8 + 1] = bfhi(v.x); x[c * 8 + 2] = bflo(v.y); x[c * 8 + 3] = bfhi(v.y);
        x[c * 8 + 4] = bflo(v.z); x[c * 8 + 5] = bfhi(v.z); x[c * 8 + 6] = bflo(v.w); x[c * 8 + 7] = bfhi(v.w);
      }
      if (isdiff) {
        if (!isctx) {
#pragma unroll
          for (int m = 0; m < 2; ++m)
#pragma unroll
            for (int d = 0; d < 16; ++d) {
              const f32x2 cs = ropeD[t * 16 + d];
              const float x1 = x[m * 32 + d], x2 = x[m * 32 + 16 + d];
              x[m * 32 + d] = x1 * cs.x - x2 * cs.y; x[m * 32 + 16 + d] = x1 * cs.y + x2 * cs.x;
            }
        }
        const float sc_ = isq ? qsD : 1.f;
        bf16_t* dst = (isq ? QD : KD) + (((size_t)b * 8 + h * 2) * TT + pos) * 32;
#pragma unroll
        for (int m = 0; m < 2; ++m)
#pragma unroll
          for (int c = 0; c < 4; ++c) {
            u32x4 w; const int o = m * 32 + c * 8;
            w.x = pk_bf16(x[o] * sc_, x[o + 1] * sc_); w.y = pk_bf16(x[o + 2] * sc_, x[o + 3] * sc_); w.z = pk_bf16(x[o + 4] * sc_, x[o + 5] * sc_); w.w = pk_bf16(x[o + 6] * sc_, x[o + 7] * sc_);
            *(u32x4*)(dst + (size_t)m * TT * 32 + c * 8) = w;
          }
      } else {
        float ss = 0.f;
#pragma unroll
        for (int d = 0; d < 64; ++d) ss += x[d] * x[d];
        const float rstd = rsqrtf(ss * (1.f / 64.f) + EPS);
        const float* gn = (isq ? p.in[I_GQN] : p.in[I_GKN]) + layer * 64;
#pragma unroll
        for (int c = 0; c < 16; ++c) { const f32x4 gv = *(const f32x4*)(gn + c * 4); x[c * 4] *= rstd * gv[0]; x[c * 4 + 1] *= rstd * gv[1]; x[c * 4 + 2] *= rstd * gv[2]; x[c * 4 + 3] *= rstd * gv[3]; }
        if (!isctx) {
#pragma unroll
          for (int d = 0; d < 32; ++d) {
            const f32x2 cs = ropeH[t * 32 + d];
            const float x1 = x[d], x2 = x[32 + d];
            x[d] = x1 * cs.x - x2 * cs.y; x[32 + d] = x1 * cs.y + x2 * cs.x;
          }
        }
        const float sc_ = isq ? qsG : 1.f;
        bf16_t* dst = isq ? QG + (((size_t)b * 4 + h) * TT + pos) * 64 : KG + (((size_t)b * 2 + h) * TT + pos) * 64;
#pragma unroll
        for (int c = 0; c < 8; ++c) {
          u32x4 w; const int o = c * 8;
          w.x = pk_bf16(x[o] * sc_, x[o + 1] * sc_); w.y = pk_bf16(x[o + 2] * sc_, x[o + 3] * sc_); w.z = pk_bf16(x[o + 4] * sc_, x[o + 5] * sc_); w.w = pk_bf16(x[o + 6] * sc_, x[o + 7] * sc_);
          *(u32x4*)(dst + c * 8) = w;
        }
      }
    } else {
      float x[32];
#pragma unroll
      for (int c = 0; c < 4; ++c) {
        const u32x4 v = *(const u32x4*)(urow + U_MR + c * 8);
        x[c * 8 + 0] = bflo(v.x); x[c * 8 + 1] = bfhi(v.x); x[c * 8 + 2] = bflo(v.y); x[c * 8 + 3] = bfhi(v.y);
        x[c * 8 + 4] = bflo(v.z); x[c * 8 + 5] = bfhi(v.z); x[c * 8 + 6] = bflo(v.w); x[c * 8 + 7] = bfhi(v.w);
      }
      if (!isctx) {
#pragma unroll
        for (int d = 0; d < 16; ++d) {
          const f32x2 cs = ropeD[t * 16 + d];
          const float x1 = x[d], x2 = x[16 + d];
          x[d] = x1 * cs.x - x2 * cs.y; x[16 + d] = x1 * cs.y + x2 * cs.x;
        }
      }
      u32x4 w[4];
#pragma unroll
      for (int c = 0; c < 4; ++c) { const int o = c * 8; w[c].x = pk_bf16(x[o], x[o + 1]); w[c].y = pk_bf16(x[o + 2], x[o + 3]); w[c].z = pk_bf16(x[o + 4], x[o + 5]); w[c].w = pk_bf16(x[o + 6], x[o + 7]); }
#pragma unroll
      for (int hh = 0; hh < 4; ++hh)
#pragma unroll
        for (int c = 0; c < 4; ++c) *(u32x4*)(KM + (((size_t)b * 4 + hh) * TT + pos) * 96 + 64 + c * 8) = w[c];
    }
  }
  for (int g = 0; g < 6; ++g) {
    const int colbase = g < 4 ? U_DV + g * 64 : U_GV + (g - 4) * 64;
    bf16_t* dst = g < 4 ? VTD + ((size_t)(b * 4 + g) * 64) * TT : VTG + ((size_t)(b * 2 + g - 4) * 64) * TT;
#pragma unroll
    for (int i = 0; i < 2; ++i) {
      const int c = tid + 256 * i, tk0 = c >> 3, kc = c & 7;
      const u32x4 v = *(const u32x4*)(U + (size_t)(row0 + tk0) * INP + colbase + kc * 8);
      const int tk = (tk0 & ~12) | ((tk0 & 4) << 1) | ((tk0 & 8) >> 1);
      sT[(kc * 8 + 0) * 72 + tk] = (bf16_t)(v.x & 0xffff); sT[(kc * 8 + 1) * 72 + tk] = (bf16_t)(v.x >> 16);
      sT[(kc * 8 + 2) * 72 + tk] = (bf16_t)(v.y & 0xffff); sT[(kc * 8 + 3) * 72 + tk] = (bf16_t)(v.y >> 16);
      sT[(kc * 8 + 4) * 72 + tk] = (bf16_t)(v.z & 0xffff); sT[(kc * 8 + 5) * 72 + tk] = (bf16_t)(v.z >> 16);
      sT[(kc * 8 + 6) * 72 + tk] = (bf16_t)(v.w & 0xffff); sT[(kc * 8 + 7) * 72 + tk] = (bf16_t)(v.w >> 16);
    }
    __syncthreads();
    {
      const int dv = tid >> 2, part = tid & 3;
      const u32x4 a = *(const u32x4*)(sT + dv * 72 + part * 16), bq = *(const u32x4*)(sT + dv * 72 + part * 16 + 8);
      bf16_t* d = dst + (size_t)dv * TT + p0 + part * 16;
      *(u32x4*)d = a; *(u32x4*)(d + 8) = bq;
    }
    __syncthreads();
  }
  return;
  }
#pragma unroll 4
  for (int tk = wave; tk < 64; tk += 4) {
    const bf16_t* urow = U + (size_t)(row0 + tk) * INP;
    const float q0 = bf2f(urow[U_MQ + lane]), q1 = bf2f(urow[U_MQ + 64 + lane]), q2 = bf2f(urow[U_MQ + 128 + lane]);
    const float k0 = bf2f(urow[U_MKV + lane]), k1 = bf2f(urow[U_MKV + 64 + lane]);
    const float sq = wave_sum(q0 * q0 + q1 * q1 + q2 * q2), sk = wave_sum(k0 * k0 + k1 * k1);
    const float rq = rsqrtf(sq * (1.f / 192.f) + EPS), rk = rsqrtf(sk * (1.f / 128.f) + EPS);
    const float* gq = p.in[I_MQN] + layer * 192; const float* gk = p.in[I_MKVN] + layer * 128;
    sCq[tk * 200 + lane] = f2bf(q0 * rq * gq[lane]); sCq[tk * 200 + 64 + lane] = f2bf(q1 * rq * gq[64 + lane]); sCq[tk * 200 + 128 + lane] = f2bf(q2 * rq * gq[128 + lane]);
    sCkv[tk * 136 + lane] = f2bf(k0 * rk * gk[lane]); sCkv[tk * 136 + 64 + lane] = f2bf(k1 * rk * gk[64 + lane]);
  }
  __syncthreads();
  const bf16_t* Wkv = (const bf16_t*)(p.ws + OFF_WUKV) + (size_t)layer * 512 * 128;
  const bf16_t* Wq = (const bf16_t*)(p.ws + OFF_WUQ) + (size_t)layer * 384 * 192;
#pragma unroll 1
  for (int task = wave; task < 28; task += 4) {
    if (task < 16) {
      const int ct = task, head = ct >> 2, sub = ct & 3, n0 = head * 128 + sub * 32;
      const bf16_t* wrow = Wkv + (size_t)(n0 + l31) * 128 + hi * 8;
      bf16x8 wf[8];
#pragma unroll
      for (int ks = 0; ks < 8; ++ks) wf[ks] = *(const bf16x8*)(wrow + ks * 16);
      bf16x8 tf[2][8];
#pragma unroll
      for (int tt = 0; tt < 2; ++tt)
#pragma unroll
        for (int ks = 0; ks < 8; ++ks) tf[tt][ks] = *(const bf16x8*)(sCkv + (tt * 32 + l31) * 136 + hi * 8 + ks * 16);
      __builtin_amdgcn_sched_barrier(0);
      f32x16 acc[2]; acc[0] = zero16(); acc[1] = zero16();
      if (sub < 2) {
#pragma unroll
        for (int ks = 0; ks < 8; ++ks) { acc[0] = MFMA32(wf[ks], tf[0][ks], acc[0]); acc[1] = MFMA32(wf[ks], tf[1][ks], acc[1]); }
#pragma unroll
        for (int tt = 0; tt < 2; ++tt) {
          bf16_t* d = KM + (((size_t)b * 4 + head) * TT + p0 + tt * 32 + l31) * 96 + sub * 32 + 4 * hi;
#pragma unroll
          for (int r4 = 0; r4 < 4; ++r4) { u32x2 w; w.x = pk_bf16(acc[tt][4 * r4], acc[tt][4 * r4 + 1]); w.y = pk_bf16(acc[tt][4 * r4 + 2], acc[tt][4 * r4 + 3]); *(u32x2*)(d + 8 * r4) = w; }
        }
      } else {
#pragma unroll
        for (int ks = 0; ks < 8; ++ks) { acc[0] = MFMA32(tf[0][ks], wf[ks], acc[0]); acc[1] = MFMA32(tf[1][ks], wf[ks], acc[1]); }
#pragma unroll
        for (int tt = 0; tt < 2; ++tt) {
          bf16_t* d = VTM + (((size_t)b * 4 + head) * 64 + (sub - 2) * 32 + l31) * TT + p0 + tt * 32;
#pragma unroll
          for (int r4 = 0; r4 < 4; ++r4) { u32x2 w; w.x = pk_bf16(acc[tt][4 * r4], acc[tt][4 * r4 + 1]); w.y = pk_bf16(acc[tt][4 * r4 + 2], acc[tt][4 * r4 + 3]);
            *(u32x2*)(d + 16 * (r4 >> 1) + 4 * (2 * hi + (r4 & 1))) = w; }
        }
      }
    } else {
      const int ct = task - 16, head = ct / 3, sub = ct % 3, n0 = head * 96 + sub * 32;
      const bf16_t* wrow = Wq + (size_t)(n0 + l31) * 192 + hi * 8;
      bf16x8 wf[12];
#pragma unroll
      for (int ks = 0; ks < 12; ++ks) wf[ks] = *(const bf16x8*)(wrow + ks * 16);
      __builtin_amdgcn_sched_barrier(0);
#pragma unroll
      for (int tt = 0; tt < 2; ++tt) {
        bf16x8 tf[12];
#pragma unroll
        for (int ks = 0; ks < 12; ++ks) tf[ks] = *(const bf16x8*)(sCq + (tt * 32 + l31) * 200 + hi * 8 + ks * 16);
        __builtin_amdgcn_sched_barrier(0);
        f32x16 acc = zero16();
#pragma unroll
        for (int ks = 0; ks < 12; ++ks) acc = MFMA32(wf[ks], tf[ks], acc);
        const int pos = p0 + tt * 32 + l31;
        if (sub == 2 && !isctx) {
          const int t = pos - CT;
#pragma unroll
          for (int r = 0; r < 8; ++r) {
            const f32x2 cs = ropeD[t * 16 + crow(r, hi)];
            const float x1 = acc[r], x2 = acc[r + 8];
            acc[r] = x1 * cs.x - x2 * cs.y; acc[r + 8] = x1 * cs.y + x2 * cs.x;
          }
        }
        bf16_t* d = QM + (((size_t)b * 4 + head) * TT + pos) * 96 + sub * 32 + 4 * hi;
#pragma unroll
        for (int r4 = 0; r4 < 4; ++r4) { u32x2 w; w.x = pk_bf16(acc[4 * r4] * qsM, acc[4 * r4 + 1] * qsM); w.y = pk_bf16(acc[4 * r4 + 2] * qsM, acc[4 * r4 + 3] * qsM); *(u32x2*)(d + 8 * r4) = w; }
      }
    }
  }
  __syncthreads();
}

template <int DQK>
DI void attn_core(const bf16_t* __restrict__ Qb, const bf16_t* __restrict__ Kb, const bf16_t* __restrict__ Vt, int q0, int ntiles,
                  f32x16 (&O)[2], float& lsum, char* smem) {
  const int tid = otid_full(), lane = tid & 63, wave = tid >> 6, l31 = lane & 31, hi = lane >> 5;
  constexpr int KS = DQK / 16, KROW = DQK + 8, KCH = DQK / 8;
  constexpr int KBYTES = 64 * KROW * 2, BUFB = KBYTES + 9216;
  constexpr int NK = 64 * KCH, NKC = (NK + NTHREADS - 1) / NTHREADS;
  static_assert(2 * BUFB <= 49152, "attention LDS");
  bf16x8 qf[KS];
#pragma unroll
  for (int ks = 0; ks < KS; ++ks) qf[ks] = *(const bf16x8*)(Qb + (size_t)(q0 + wave * 32 + l31) * DQK + ks * 16 + hi * 8);
  float mrun = -1e30f; lsum = 0.f; O[0] = zero16(); O[1] = zero16();
  const bf16_t* kg[NKC]; int kl[NKC]; bool kok[NKC];
#pragma unroll
  for (int i = 0; i < NKC; ++i) {
    const int c = tid + NTHREADS * i, key = c / KCH, kc = c % KCH;
    kok[i] = c < NK;
    kg[i] = Kb + (size_t)key * DQK + kc * 8;
    kl[i] = (key * KROW + kc * 8) * 2;
  }
  const bf16_t* vg; int vl;
  { const int dv = tid >> 3, kc = tid & 7; vg = Vt + (size_t)dv * TT + kc * 8; vl = KBYTES + (dv * 72 + kc * 8) * 2; }
  u32x4 rk[NKC], rv;
#pragma unroll
  for (int i = 0; i < NKC; ++i) if (kok[i]) rk[i] = *(const u32x4*)(kg[i]);
  rv = *(const u32x4*)(vg);
#pragma unroll
  for (int i = 0; i < NKC; ++i) if (kok[i]) *(u32x4*)(smem + kl[i]) = rk[i];
  *(u32x4*)(smem + vl) = rv;
  __syncthreads();
  for (int kt = 0; kt < ntiles; ++kt) {
    const int cur = kt & 1; const bool more = kt + 1 < ntiles;
    if (more) {
#pragma unroll
      for (int i = 0; i < NKC; ++i) if (kok[i]) rk[i] = *(const u32x4*)(kg[i] + (size_t)(kt + 1) * 64 * DQK);
      rv = *(const u32x4*)(vg + (kt + 1) * 64);
    }
    const char* sb = smem + cur * BUFB;
    bf16x8 kf[2][KS];
#pragma unroll
    for (int kb = 0; kb < 2; ++kb)
#pragma unroll
      for (int ks = 0; ks < KS; ++ks) kf[kb][ks] = *(const bf16x8*)(sb + ((kb * 32 + l31) * KROW + hi * 8) * 2 + ks * 32);
    __builtin_amdgcn_sched_barrier(0);
    f32x16 s[2];
#pragma unroll
    for (int kb = 0; kb < 2; ++kb) {
      s[kb] = zero16();
#pragma unroll
      for (int ks = 0; ks < KS; ++ks) s[kb] = MFMA32(kf[kb][ks], qf[ks], s[kb]);
    }
    bf16x8 vf[4][2];
#pragma unroll
    for (int s4 = 0; s4 < 4; ++s4)
#pragma unroll
      for (int dvb = 0; dvb < 2; ++dvb) vf[s4][dvb] = *(const bf16x8*)(sb + KBYTES + ((dvb * 32 + l31) * 72 + s4 * 16 + hi * 8) * 2);
    __builtin_amdgcn_sched_barrier(0);
    float mx = s[0][0];
#pragma unroll
    for (int r = 0; r < 16; ++r) { mx = fmaxf(mx, s[0][r]); mx = fmaxf(mx, s[1][r]); }
    mx = fmaxf(mx, __shfl_xor(mx, 32));
    const float mnew = fmaxf(mrun, mx);
    const float alpha = __builtin_amdgcn_exp2f(mrun - mnew);
    mrun = mnew;
    float rs = 0.f;
#pragma unroll
    for (int kb = 0; kb < 2; ++kb)
#pragma unroll
      for (int r = 0; r < 16; ++r) { const float e = __builtin_amdgcn_exp2f(s[kb][r] - mnew); s[kb][r] = e; rs += e; }
    lsum = lsum * alpha + rs;
    O[0] *= alpha; O[1] *= alpha;
#pragma unroll
    for (int s4 = 0; s4 < 4; ++s4) {
      const int kb = s4 >> 1, hf = (s4 & 1) * 8;
      const bf16x8 pb = pack8(s[kb][hf + 0], s[kb][hf + 1], s[kb][hf + 2], s[kb][hf + 3], s[kb][hf + 4], s[kb][hf + 5], s[kb][hf + 6], s[kb][hf + 7]);
#pragma unroll
      for (int dvb = 0; dvb < 2; ++dvb) O[dvb] = MFMA32(vf[s4][dvb], pb, O[dvb]);
    }
    if (more) {
      char* db = smem + (cur ^ 1) * BUFB;
#pragma unroll
      for (int i = 0; i < NKC; ++i) if (kok[i]) *(u32x4*)(db + kl[i]) = rk[i];
      *(u32x4*)(db + vl) = rv;
    }
    __syncthreads();
  }
  lsum += __shfl_xor(lsum, 32);
}

DI void attn_unit(const Params& p, int layer, int b, int kind, int head, int qb, char* smem) {
  const int tid_ = otid_full(); const int lane = tid_ & 63, wave = tid_ >> 6, l31 = lane & 31, hi = lane >> 5;
  const int q0 = qb * 256;
  const int ntiles = qb == 0 ? 4 : 36;
  bf16_t* Y = (bf16_t*)(p.ws + OFF_Y);
  const int pos = q0 + wave * 32 + l31;
  bf16_t* yrow = Y + (size_t)hrow_of(b, pos) * DM;
  f32x16 O[2]; float ls;
  if (kind == 1) {
    attn_core<32>((const bf16_t*)(p.ws + OFF_QD) + ((size_t)b * 8 + head * 2) * TT * 32, (const bf16_t*)(p.ws + OFF_KD) + ((size_t)b * 8 + head * 2) * TT * 32,
                  (const bf16_t*)(p.ws + OFF_VTD) + ((size_t)b * 4 + head) * 64 * TT, q0, ntiles, O, ls, smem);
    float* st = (float*)(smem + 49152) + tid_;
    {
      const float i0 = 1.f / ls;
#pragma unroll
      for (int dvb = 0; dvb < 2; ++dvb)
#pragma unroll
        for (int r = 0; r < 16; ++r) st[(dvb * 16 + r) * NTHREADS] = O[dvb][r] * i0;
    }
    __syncthreads();
    attn_core<32>((const bf16_t*)(p.ws + OFF_QD) + ((size_t)b * 8 + head * 2 + 1) * TT * 32, (const bf16_t*)(p.ws + OFF_KD) + ((size_t)b * 8 + head * 2 + 1) * TT * 32,
                  (const bf16_t*)(p.ws + OFF_VTD) + ((size_t)b * 4 + head) * 64 * TT, q0, ntiles, O, ls, smem);
    const float* misc = (const float*)(p.ws + OFF_MISC);
    const float lam = misc[128 + layer], li = misc[136 + layer];
    const float i1 = lam / ls;
    float ss = 0.f;
#pragma unroll
    for (int dvb = 0; dvb < 2; ++dvb)
#pragma unroll
      for (int r = 0; r < 16; ++r) { const float o = st[(dvb * 16 + r) * NTHREADS] - O[dvb][r] * i1; O[dvb][r] = o; ss += o * o; }
    ss += __shfl_xor(ss, 32);
    const float rstd = rsqrtf(ss * (1.f / 64.f) + EPS) * (1.f - li);
    const float* g = p.in[I_DNG] + layer * 64;
    f32x4 gva[2][4];
#pragma unroll
    for (int dvb = 0; dvb < 2; ++dvb)
#pragma unroll
      for (int r4 = 0; r4 < 4; ++r4) gva[dvb][r4] = *(const f32x4*)(g + dvb * 32 + 8 * r4 + 4 * hi);
    __builtin_amdgcn_sched_barrier(0);
#pragma unroll
    for (int dvb = 0; dvb < 2; ++dvb)
#pragma unroll
      for (int r4 = 0; r4 < 4; ++r4) {
        const int dv = dvb * 32 + 8 * r4 + 4 * hi;
        const f32x4 gv = gva[dvb][r4];
        u32x2 w; w.x = pk_bf16(O[dvb][4 * r4] * rstd * gv[0], O[dvb][4 * r4 + 1] * rstd * gv[1]);
        w.y = pk_bf16(O[dvb][4 * r4 + 2] * rstd * gv[2], O[dvb][4 * r4 + 3] * rstd * gv[3]);
        *(u32x2*)(yrow + 256 + head * 64 + dv) = w;
      }
  } else {
    int ycol;
    if (kind == 2) {
      attn_core<64>((const bf16_t*)(p.ws + OFF_QG) + ((size_t)b * 4 + head) * TT * 64, (const bf16_t*)(p.ws + OFF_KG) + ((size_t)b * 2 + (head >> 1)) * TT * 64,
                    (const bf16_t*)(p.ws + OFF_VTG) + ((size_t)b * 2 + (head >> 1)) * 64 * TT, q0, ntiles, O, ls, smem);
      ycol = 512 + head * 64;
    } else {
      attn_core<96>((const bf16_t*)(p.ws + OFF_QM) + ((size_t)b * 4 + head) * TT * 96, (const bf16_t*)(p.ws + OFF_KM) + ((size_t)b * 4 + head) * TT * 96,
                    (const bf16_t*)(p.ws + OFF_VTM) + ((size_t)b * 4 + head) * 64 * TT, q0, ntiles, O, ls, smem);
      ycol = 768 + head * 64;
    }
    const float inv = 1.f / ls;
#pragma unroll
    for (int dvb = 0; dvb < 2; ++dvb)
#pragma unroll
      for (int r4 = 0; r4 < 4; ++r4) {
        const int dv = dvb * 32 + 8 * r4 + 4 * hi;
        u32x2 w; w.x = pk_bf16(O[dvb][4 * r4] * inv, O[dvb][4 * r4 + 1] * inv); w.y = pk_bf16(O[dvb][4 * r4 + 2] * inv, O[dvb][4 * r4 + 3] * inv);
        *(u32x2*)(yrow + ycol + dv) = w;
      }
  }
}

DI void ssd_chunk(const Params& p, int layer, int item, char* smem) {
  const int tid = otid(), lane = tid & 63, wave = tid >> 6, l31 = lane & 31, hi = lane >> 5;
  const int pi = wave >> 1, li = wave & 1;
  const int ck = item % 36, r_ = item / 36, d = r_ & 1, g = (r_ >> 1) & 1, b = r_ >> 2, h = 2 * g + half_id(), chain = (b * 4 + h) * 2 + d;
  const bf16_t* U = (const bf16_t*)(p.ws + OFF_U);
  bf16_t* Yssd = (bf16_t*)(p.ws + OFF_XN) + (size_t)d * ROWS * 256;
  bf16_t* sXT = (bf16_t*)smem;
  bf16_t* sB = (bf16_t*)(smem + 9216);
  bf16_t* sC = (bf16_t*)(smem + 18432);
  bf16_t* sBT = (bf16_t*)(smem + 27648);
  float* scs = (float*)(smem + 46080);
  float* sdt = (float*)(smem + 46336);
  float* sW = (float*)(smem + 46592);
  const bool isctx = ck < 4;
  const int Len = isctx ? CT : SEQ, base = isctx ? (MROWS + b * CT) : (b * SEQ), kl = isctx ? ck : ck - 4;
  if (tid < 192) {
    const int cc = tid >> 6, e = tid & 63;
    const int ch = cc == 0 ? (h * 64 + e) : (cc == 1 ? 256 + g * 64 + e : 384 + g * 64 + e);
    const float* cw = p.in[I_CONVW] + ((size_t)layer * 512 + ch) * 3;
    sW[tid * 4 + 0] = cw[0]; sW[tid * 4 + 1] = cw[1]; sW[tid * 4 + 2] = cw[2]; sW[tid * 4 + 3] = p.in[I_CONVB][layer * 512 + ch];
  }
  const bool wrC = (half_id() == 0) && (d == 0);
  bf16_t* CB = (bf16_t*)(p.ws + OFF_CB);
  float raw_dt = 0.f;
  if (wave == 1) {
    const int posj = kl * 64 + lane, t = d ? (Len - 1 - posj) : posj;
    raw_dt = bf2f(U[(size_t)(base + t) * INP + U_DT + d * 4 + h]);
  }
  u32x4 vm6[6], v06[6], vp6[6];
#pragma unroll
  for (int i = 0; i < 6; ++i) {
    const int task = tid + 256 * i, j = task / 24, cc = task % 24;
    const int posj = kl * 64 + j, t = d ? (Len - 1 - posj) : posj;
    const int grp = cc >> 3, c8 = (cc & 7) * 8;
    const int ucol = grp == 0 ? (U_X + h * 64 + c8) : (grp == 1 ? U_B + g * 64 + c8 : U_C + g * 64 + c8);
    const bf16_t* up = U + (size_t)(base + t) * INP + ucol;
    vm6[i] = *(const u32x4*)(up - (t > 0 ? INP : 0));
    v06[i] = *(const u32x4*)up;
    vp6[i] = *(const u32x4*)(up + (t < Len - 1 ? INP : 0));
  }
  if (wave == 1) {
    const float dtb = p.in[I_DTB][layer * 8 + d * 4 + h];
    const float aneg = -expf(p.in[I_ALOG][layer * 8 + d * 4 + h]);
    const int posj = kl * 64 + lane, t = d ? (Len - 1 - posj) : posj;
    const float raw = raw_dt + dtb;
    const float e_ = __expf(-fabsf(raw));
    const float dtv = fmaxf(raw, 0.f) + (e_ < 0.03f ? e_ * (1.f - e_ * (0.5f - e_ * 0.33333334f)) : __logf(1.f + e_));
    float c = dtv * aneg;
#pragma unroll
    for (int o = 1; o < 64; o <<= 1) { const float tv = __shfl_up(c, o); if (lane >= o) c += tv; }
    sdt[lane] = dtv; scs[lane] = c;
    ((float*)(p.ws + OFF_ECL))[(size_t)(d * 4 + h) * ROWS + base + t] = __expf(c);
    if (lane == 63) ((float*)(p.ws + OFF_DEC))[chain * 36 + ck] = __expf(c);
  }
  __syncthreads();
  const float c63 = scs[63];
#pragma unroll
  for (int i = 0; i < 6; ++i) {
    const int task = tid + 256 * i, j = task / 24, cc = task % 24;
    const int posj = kl * 64 + j, t = d ? (Len - 1 - posj) : posj;
    const int grp = cc >> 3, c8 = (cc & 7) * 8;
    const u32x4 z4 = {0u, 0u, 0u, 0u};
    const u32x4 vm = (t > 0) ? vm6[i] : z4, v0 = v06[i], vp = (t < Len - 1) ? vp6[i] : z4;
    float o[8];
#pragma unroll
    for (int e2 = 0; e2 < 4; ++e2) {
      const unsigned wm_ = e2 == 0 ? vm.x : e2 == 1 ? vm.y : e2 == 2 ? vm.z : vm.w;
      const unsigned w0_ = e2 == 0 ? v0.x : e2 == 1 ? v0.y : e2 == 2 ? v0.z : v0.w;
      const unsigned wp_ = e2 == 0 ? vp.x : e2 == 1 ? vp.y : e2 == 2 ? vp.z : vp.w;
      const f32x4 wa = *(const f32x4*)(sW + (grp * 64 + c8 + 2 * e2) * 4), wb = *(const f32x4*)(sW + (grp * 64 + c8 + 2 * e2 + 1) * 4);
      o[2 * e2] = silu_f(wa[0] * bflo(wm_) + wa[1] * bflo(w0_) + wa[2] * bflo(wp_) + wa[3]);
      o[2 * e2 + 1] = silu_f(wb[0] * bfhi(wm_) + wb[1] * bfhi(w0_) + wb[2] * bfhi(wp_) + wb[3]);
    }
    if (grp == 0) {
      const float dtv = sdt[j];
#pragma unroll
      for (int e = 0; e < 8; ++e) sXT[(c8 + e) * 72 + j] = f2bf(o[e] * dtv);
    } else if (grp == 1) {
      const float sc_ = __expf(c63 - scs[j]);
      u32x4 w; w.x = pk_bf16(o[0], o[1]); w.y = pk_bf16(o[2], o[3]); w.z = pk_bf16(o[4], o[5]); w.w = pk_bf16(o[6], o[7]);
      *(u32x4*)(sB + j * 72 + c8) = w;
#pragma unroll
      for (int e = 0; e < 8; ++e) sBT[(c8 + e) * 72 + j] = f2bf(o[e] * sc_);
    } else {
      u32x4 w; w.x = pk_bf16(o[0], o[1]); w.y = pk_bf16(o[2], o[3]); w.z = pk_bf16(o[4], o[5]); w.w = pk_bf16(o[6], o[7]);
      *(u32x4*)(sC + j * 72 + c8) = w;
      if (wrC) *(u32x4*)(CB + (size_t)(base + t) * 128 + g * 64 + c8) = w;
    }
  }
  __syncthreads();
  const int lcol = 32 * li + l31;
  const float cl = scs[lcol];
  f32x16 y = zero16();
#pragma unroll
  for (int si = 0; si < 2; ++si) {
    if (si <= li) {
      f32x16 gt = zero16();
#pragma unroll
      for (int ks = 0; ks < 4; ++ks) gt = MFMA32(*(const bf16x8*)(sB + (32 * si + l31) * 72 + ks * 16 + hi * 8), *(const bf16x8*)(sC + lcol * 72 + ks * 16 + hi * 8), gt);
#pragma unroll
      for (int r = 0; r < 16; ++r) { const int s_ = 32 * si + crow(r, hi); gt[r] = (s_ <= lcol) ? gt[r] * __expf(cl - scs[s_]) : 0.f; }
#pragma unroll
      for (int kk = 0; kk < 2; ++kk) {
        const bf16x8 pb = pack8(gt[8 * kk], gt[8 * kk + 1], gt[8 * kk + 2], gt[8 * kk + 3], gt[8 * kk + 4], gt[8 * kk + 5], gt[8 * kk + 6], gt[8 * kk + 7]);
        const bf16_t* xr = sXT + (32 * pi + l31) * 72 + 32 * si + 16 * kk + 4 * hi;
        const s16x4 lo = *(const s16x4*)xr, h4 = *(const s16x4*)(xr + 8);
        y = MFMA32(__builtin_shufflevector(lo, h4, 0, 1, 2, 3, 4, 5, 6, 7), pb, y);
      }
    }
  }
  {
    const int posl = kl * 64 + lcol, t = d ? (Len - 1 - posl) : posl;
    bf16_t* yp = Yssd + (size_t)(base + t) * 256 + h * 64 + 32 * pi + 4 * hi;
#pragma unroll
    for (int r4 = 0; r4 < 4; ++r4) { u32x2 o; o.x = pk_bf16(y[4 * r4], y[4 * r4 + 1]); o.y = pk_bf16(y[4 * r4 + 2], y[4 * r4 + 3]); *(u32x2*)(yp + 8 * r4) = o; }
  }
  f32x16 sacc = zero16();
#pragma unroll
  for (int ks = 0; ks < 4; ++ks) sacc = MFMA32(*(const bf16x8*)(sXT + (32 * pi + l31) * 72 + ks * 16 + hi * 8), *(const bf16x8*)(sBT + (32 * li + l31) * 72 + ks * 16 + hi * 8), sacc);
  bf16_t* Sp = (bf16_t*)(p.ws + OFF_SS) + ((size_t)chain * 37 + ck + 1) * 4096;
#pragma unroll
  for (int r = 0; r < 16; ++r) Sp[(32 * pi + crow(r, hi)) * 64 + 32 * li + l31] = f2bf(sacc[r]);
  __syncthreads();
}

DI void ssd_scan(const Params& p, int chain) {
  const int tid = otid();
  char* slot0 = p.ws + OFF_SS + (size_t)chain * 37 * 8192 + tid * 32;
  const float* dec = (const float*)(p.ws + OFF_DEC) + chain * 36;
  float H[16];
#pragma unroll
  for (int i = 0; i < 16; ++i) H[i] = 0.f;
#pragma unroll 4
  for (int c = 0; c < 36; ++c) {
    const u32x4* sp = (const u32x4*)(slot0 + (size_t)(c + 1) * 8192);
    const u32x4 s0 = sp[0], s1 = sp[1];
    const float dc = dec[c];
    u32x4 w0, w1;
    w0.x = pk_bf16(H[0], H[1]); w0.y = pk_bf16(H[2], H[3]); w0.z = pk_bf16(H[4], H[5]); w0.w = pk_bf16(H[6], H[7]);
    w1.x = pk_bf16(H[8], H[9]); w1.y = pk_bf16(H[10], H[11]); w1.z = pk_bf16(H[12], H[13]); w1.w = pk_bf16(H[14], H[15]);
    u32x4* hp = (u32x4*)(slot0 + (size_t)c * 8192);
    hp[0] = w0; hp[1] = w1;
    H[0] = H[0] * dc + bflo(s0.x); H[1] = H[1] * dc + bfhi(s0.x); H[2] = H[2] * dc + bflo(s0.y); H[3] = H[3] * dc + bfhi(s0.y);
    H[4] = H[4] * dc + bflo(s0.z); H[5] = H[5] * dc + bfhi(s0.z); H[6] = H[6] * dc + bflo(s0.w); H[7] = H[7] * dc + bfhi(s0.w);
    H[8] = H[8] * dc + bflo(s1.x); H[9] = H[9] * dc + bfhi(s1.x); H[10] = H[10] * dc + bflo(s1.y); H[11] = H[11] * dc + bfhi(s1.y);
    H[12] = H[12] * dc + bflo(s1.z); H[13] = H[13] * dc + bfhi(s1.z); H[14] = H[14] * dc + bflo(s1.w); H[15] = H[15] * dc + bfhi(s1.w);
  }
}

DI void ssd_finish_tile(const Params& p, int layer, int tile, char* smem) {
  const int tid = otid(), lane = tid & 63, wave = tid >> 6, l31 = lane & 31, hi = lane >> 5;
  const int b = tile / 72, tb = tile % 72, p0 = tb * 32;
  const bool isctx = tb < 8;
  const int row0 = isctx ? (MROWS + b * CT + p0) : (b * SEQ + p0 - CT);
  const int T64 = tb >> 1, nch = isctx ? 4 : 32, Tl = isctx ? T64 : T64 - 4;
  const bf16_t* U = (const bf16_t*)(p.ws + OFF_U);
  const bf16_t* Y0 = (const bf16_t*)(p.ws + OFF_XN); const bf16_t* Y1 = Y0 + (size_t)ROWS * 256;
  const float* ECL = (const float*)(p.ws + OFF_ECL);
  bf16_t* Y = (bf16_t*)(p.ws + OFF_Y);
  bf16_t* sCc = (bf16_t*)smem;
  float* sY = (float*)(smem + 8704);
  {
    const bf16_t* CB = (const bf16_t*)(p.ws + OFF_CB) + (size_t)row0 * 128;
#pragma unroll
    for (int i = 0; i < 2; ++i) { const int c = tid + 256 * i, r = c >> 4, kc = c & 15; *(u32x4*)(sCc + r * 136 + kc * 8) = *(const u32x4*)(CB + r * 128 + kc * 8); }
  }
  __syncthreads();
  {
    const int pi = wave & 1, g = wave >> 1;
    const int row = row0 + l31;
    bf16x8 hf[2][2][4];
#pragma unroll
    for (int hh = 0; hh < 2; ++hh)
#pragma unroll
      for (int d = 0; d < 2; ++d) {
        const int h = g * 2 + hh;
        const int kl = d ? (nch - 1 - Tl) : Tl, ck = isctx ? kl : 4 + kl, chain = (b * 4 + h) * 2 + d;
        const char* Hs = p.ws + OFF_SS + ((size_t)chain * 37 + ck) * 8192 + (32 * pi + l31) * 128 + hi * 16;
#pragma unroll
        for (int ks = 0; ks < 4; ++ks) hf[hh][d][ks] = *(const bf16x8*)(Hs + ks * 32);
      }
    bf16x8 cfr[4];
#pragma unroll
    for (int ks = 0; ks < 4; ++ks) cfr[ks] = *(const bf16x8*)(sCc + l31 * 136 + g * 64 + ks * 16 + hi * 8);
    __builtin_amdgcn_sched_barrier(0);
#pragma unroll
    for (int hh = 0; hh < 2; ++hh) {
      const int h = g * 2 + hh;
      f32x16 ys = zero16();
#pragma unroll
      for (int d = 0; d < 2; ++d) {
        f32x16 acc = zero16();
#pragma unroll
        for (int ks = 0; ks < 4; ++ks) acc = MFMA32(hf[hh][d][ks], cfr[ks], acc);
        const float e = ECL[(size_t)(d * 4 + h) * ROWS + row];
        ys += acc * e;
      }
      const bf16_t* y0p = Y0 + (size_t)row * 256 + h * 64 + 32 * pi + 4 * hi; const bf16_t* y1p = Y1 + (size_t)row * 256 + h * 64 + 32 * pi + 4 * hi;
#pragma unroll
      for (int r4 = 0; r4 < 4; ++r4) {
        const u32x2 a_ = *(const u32x2*)(y0p + 8 * r4), c_ = *(const u32x2*)(y1p + 8 * r4);
        const f32x4 a = {bflo(a_.x), bfhi(a_.x), bflo(a_.y), bfhi(a_.y)}, c2 = {bflo(c_.x), bfhi(c_.x), bflo(c_.y), bfhi(c_.y)};
        f32x4 o; o[0] = ys[4 * r4] + a[0] + c2[0]; o[1] = ys[4 * r4 + 1] + a[1] + c2[1]; o[2] = ys[4 * r4 + 2] + a[2] + c2[2]; o[3] = ys[4 * r4 + 3] + a[3] + c2[3];
        *(f32x4*)(sY + l31 * 260 + h * 64 + 32 * pi + 8 * r4 + 4 * hi) = o;
      }
    }
  }
  __syncthreads();
  {
    const int ch = lane * 4, hd = lane >> 4;
    const float dsk = p.in[I_SSDD][layer * 8 + hd] + p.in[I_SSDD][layer * 8 + 4 + hd];
    f32x4 cw[3];
    {
      const float* w = p.in[I_CONVW] + ((size_t)layer * 512 + ch) * 3;
      const f32x4 a = *(const f32x4*)w, b2 = *(const f32x4*)(w + 4), c2 = *(const f32x4*)(w + 8);
      cw[0] = (f32x4){a[0], a[3], b2[2], c2[1]}; cw[1] = (f32x4){a[1], b2[0], b2[3], c2[2]}; cw[2] = (f32x4){a[2], b2[1], c2[0], c2[3]};
    }
    const f32x4 cb = *(const f32x4*)(p.in[I_CONVB] + layer * 512 + ch);
    const f32x4 ng = *(const f32x4*)(p.in[I_SSDNG] + layer * 256 + ch);
    const int Len = isctx ? CT : SEQ;
    u32x2 z2a[8], xma[8], x0a[8], xpa[8];
#pragma unroll
    for (int k = 0; k < 8; ++k) {
      const int rr = wave + 4 * k;
      const int t = isctx ? (p0 + rr) : (p0 - CT + rr);
      const bf16_t* up = U + (size_t)(row0 + rr) * INP;
      const u32x2 zz = {0u, 0u};
      z2a[k] = *(const u32x2*)(up + U_Z + ch);
      xma[k] = (t > 0) ? *(const u32x2*)(up - INP + U_X + ch) : zz;
      x0a[k] = *(const u32x2*)(up + U_X + ch);
      xpa[k] = (t < Len - 1) ? *(const u32x2*)(up + INP + U_X + ch) : zz;
    }
    __builtin_amdgcn_sched_barrier(0);
#pragma unroll
    for (int k = 0; k < 8; ++k) {
      const int rr = wave + 4 * k;
      const int row = row0 + rr;
      const u32x2 z2 = z2a[k], xm = xma[k], x0 = x0a[k], xp = xpa[k];
      const f32x4 xmf = {bflo(xm.x), bfhi(xm.x), bflo(xm.y), bfhi(xm.y)}, x0f = {bflo(x0.x), bfhi(x0.x), bflo(x0.y), bfhi(x0.y)}, xpf = {bflo(xp.x), bfhi(xp.x), bflo(xp.y), bfhi(xp.y)};
      const f32x4 zf = {bflo(z2.x), bfhi(z2.x), bflo(z2.y), bfhi(z2.y)};
      const f32x4 cv = cw[0] * xmf + cw[1] * x0f + cw[2] * xpf + cb;
      const f32x4 ya = *(const f32x4*)(sY + rr * 260 + ch);
      f32x4 gz; float ss = 0.f;
#pragma unroll
      for (int e = 0; e < 4; ++e) { const float xs = silu_f(cv[e]); const float yv = ya[e] + dsk * xs; gz[e] = yv * silu_f(zf[e]); ss += gz[e] * gz[e]; }
      ss = wave_sum(ss);
      const float rstd = rsqrtf(ss * (1.f / 256.f) + EPS);
      u32x2 w; w.x = pk_bf16(gz[0] * rstd * ng[0], gz[1] * rstd * ng[1]); w.y = pk_bf16(gz[2] * rstd * ng[2], gz[3] * rstd * ng[3]);
      *(u32x2*)(Y + (size_t)row * DM + ch) = w;
    }
  }
  __syncthreads();
}

DI void mixer_phase(const Params& p, int layer_c, char* smem, int* s_item) {
  const int layer = layer_c % DEPTH;
  const bool with_ctx = layer < DEPTH - 1;
  const int nqb = with_ctx ? 9 : 8;
  const int natt = 12 * nqb, nfin = with_ctx ? 36 : 32;
  const int nitems = 4 + natt + nfin;
  unsigned* cnt = (unsigned*)(p.ws + OFF_MISC) + layer_c * 8;
  unsigned* sdone = (unsigned*)(p.ws + OFF_MISC) + 72 + layer * 8;
  for (int qq = 0; qq < 8; ++qq) {
    const int q = (blockIdx.x + qq) & 7;
    for (;;) {
      if (threadIdx.x == 0) *s_item = (int)atomicAdd(&cnt[q], 1u);
      __syncthreads();
      const int it = *s_item;
      __syncthreads();
      if (it >= nitems) break;
      if (it < 4) {
        ssd_scan(p, q * 8 + it * 2 + half_id());
        asm volatile("s_waitcnt vmcnt(0)" ::: "memory");
        __syncthreads();
        if (threadIdx.x == 0) {
          __builtin_amdgcn_fence(__ATOMIC_RELEASE, "agent");
          asm volatile("s_waitcnt vmcnt(0)" ::: "memory");
          __hip_atomic_fetch_add(&sdone[q], 1u, __ATOMIC_RELAXED, __HIP_MEMORY_SCOPE_AGENT);
        }
      } else if (it < 4 + natt) {
        const int idx = it - 4;
        int kind, head, qb;
        if (idx < 96) { const int hidx = idx >> 3; qb = (idx & 7) + 1; const int ko = hidx >> 2; kind = ko == 0 ? 1 : (ko == 1 ? 0 : 2); head = hidx & 3; }
        else { const int hidx = idx - 96; qb = 0; const int ko = hidx >> 2; kind = ko == 0 ? 1 : (ko == 1 ? 0 : 2); head = hidx & 3; }
        attn_unit(p, layer, q, kind, head, qb, smem);
      } else {
        if (threadIdx.x == 0) {
          while (__hip_atomic_load(&sdone[q], __ATOMIC_RELAXED, __HIP_MEMORY_SCOPE_AGENT) < 4u) __builtin_amdgcn_s_sleep(2);
          __builtin_amdgcn_fence(__ATOMIC_ACQUIRE, "agent");
          asm volatile("s_waitcnt vmcnt(0)" ::: "memory");
        }
        __syncthreads();
        const int fi = it - 4 - natt;
        const int tile = q * 72 + (with_ctx ? 0 : 8) + fi * 2 + half_id();
        ssd_finish_tile(p, layer, tile, smem + half_id() * SMEM_BYTES);
      }
      __syncthreads();
    }
  }
}

#define XB_TMO      128
#define XB_XCNT(j)  (256  + 64 * (j))
#define XB_XSUB(j)  (1280 + 64 * (j))
#define XB_XGEN(j)  (2304 + 64 * (j))
#define XB_TOP      3328
#define XB_TOPGEN   3392
#define XCD_BAR_WORDS 3456
#define XB_SPIN_CAP (1u << 18)
#define LAS __attribute__((address_space(3)))

__device__ __forceinline__ unsigned xb_ld(unsigned* p)              { return __hip_atomic_load(p, __ATOMIC_RELAXED, __HIP_MEMORY_SCOPE_AGENT); }
__device__ __forceinline__ unsigned xb_add(unsigned* p, unsigned v) { return __hip_atomic_fetch_add(p, v, __ATOMIC_RELAXED, __HIP_MEMORY_SCOPE_AGENT); }
__device__ __forceinline__ unsigned xb_xcc_id() { return (unsigned)__builtin_amdgcn_s_getreg((3 << 11) | 20) & 0xFu; }
#define XB_SPIN(cond, bar) do { unsigned _sp = 0; while (cond) { __builtin_amdgcn_s_sleep(1); \
    if ((++_sp & 255u) == 0u) { if (xb_ld(&(bar)[XB_TMO])) break; if (_sp > XB_SPIN_CAP) { atomicAdd(&(bar)[XB_TMO], 1u); break; } } } } while (0)

struct XcdBarrier {
    unsigned* bar; unsigned x;
    volatile LAS unsigned* st;
};

__device__ __forceinline__ XcdBarrier xcd_barrier_post(unsigned* bar, volatile LAS unsigned* st) {
    XcdBarrier b; b.bar = bar; b.x = xb_xcc_id(); b.st = st;
    if (threadIdx.x == 0) (void)xb_add(&bar[XB_XCNT(b.x)], 1u);
    return b;
}
__device__ __forceinline__ void xcd_barrier_complete(unsigned* bar, unsigned x, unsigned& nloc, unsigned& nx) {
    const unsigned G = gridDim.x * gridDim.y * gridDim.z;
    unsigned sum, cnt, mine, sp = 0u;
    for (;;) {
        sum = 0u; cnt = 0u; mine = 0u;
#pragma unroll
        for (unsigned j = 0; j < 16; ++j) { const unsigned c = xb_ld(&bar[XB_XCNT(j)]); sum += c; cnt += (c > 0u) ? 1u : 0u; mine = (j == x) ? c : mine; }
        if (sum == G) break;
        __builtin_amdgcn_s_sleep(1);
        if ((++sp & 255u) == 0u) { if (xb_ld(&bar[XB_TMO])) break; if (sp > XB_SPIN_CAP) { atomicAdd(&bar[XB_TMO], 1u); break; } }
    }
    nloc = mine > 0u ? mine : 1u; nx = cnt > 0u ? cnt : 1u;
}

__device__ __forceinline__ void xcd_barrier(const XcdBarrier& b) {
    asm volatile("s_waitcnt vmcnt(0)" ::: "memory");
    __syncthreads();
    if (threadIdx.x == 0) {
        unsigned* bar = b.bar;
        __builtin_amdgcn_s_waitcnt(0);
        unsigned nloc = b.st[0], nx = b.st[1];
        if (nloc == 0u) { xcd_barrier_complete(bar, b.x, nloc, nx); b.st[0] = nloc; b.st[1] = nx; }
        const unsigned old = xb_add(&bar[XB_XSUB(b.x)], 1u);
        const unsigned gen = old / nloc;
        if (old + 1u == (gen + 1u) * nloc) {
            __builtin_amdgcn_fence(__ATOMIC_RELEASE, "agent");
            asm volatile("s_waitcnt vmcnt(0)" ::: "memory");
            const unsigned og = xb_add(&bar[XB_TOP], 1u);
            const unsigned tg = og / nx;
            if (og + 1u == (tg + 1u) * nx) xb_add(&bar[XB_TOPGEN], 1u);
            else XB_SPIN(xb_ld(&bar[XB_TOPGEN]) == tg, bar);
            __builtin_amdgcn_fence(__ATOMIC_ACQUIRE, "agent");
            xb_add(&bar[XB_XGEN(b.x)], 1u);
            asm volatile("s_waitcnt vmcnt(0)" ::: "memory");
        } else {
            XB_SPIN(xb_ld(&bar[XB_XGEN(b.x)]) == gen, bar);
            __builtin_amdgcn_fence(__ATOMIC_ACQUIRE, "agent");
            asm volatile("s_waitcnt vmcnt(0)" ::: "memory");
        }
    }
    __syncthreads();
}

DI void gbar(unsigned* bw, unsigned k) {
  asm volatile("s_waitcnt vmcnt(0)" ::: "memory");
  __syncthreads();
  if (threadIdx.x == 0) {
    __builtin_amdgcn_fence(__ATOMIC_RELEASE, "agent");
    asm volatile("s_waitcnt vmcnt(0)" ::: "memory");
    unsigned bx_ = blockIdx.x, gd_ = gridDim.x; asm volatile("" : "+s"(bx_), "+s"(gd_));
    const unsigned x = bx_ & 7u, nloc = (gd_ - x + 7u) >> 3;
    unsigned* sub = bw + 64 * (1 + x); unsigned* gen = bw + 64 * (9 + x); unsigned* top = bw + 64 * 17;
    const unsigned old = __hip_atomic_fetch_add(sub, 1u, __ATOMIC_RELAXED, __HIP_MEMORY_SCOPE_AGENT);
    if (old + 1u == k * nloc) {
      __hip_atomic_fetch_add(top, 1u, __ATOMIC_RELAXED, __HIP_MEMORY_SCOPE_AGENT);
      while (__hip_atomic_load(top, __ATOMIC_RELAXED, __HIP_MEMORY_SCOPE_AGENT) < 8u * k) __builtin_amdgcn_s_sleep(1);
      __hip_atomic_fetch_add(gen, 1u, __ATOMIC_RELAXED, __HIP_MEMORY_SCOPE_AGENT);
    } else {
      while (__hip_atomic_load(gen, __ATOMIC_RELAXED, __HIP_MEMORY_SCOPE_AGENT) < k) __builtin_amdgcn_s_sleep(1);
    }
    __builtin_amdgcn_fence(__ATOMIC_ACQUIRE, "agent");
    asm volatile("s_waitcnt vmcnt(0)" ::: "memory");
  }
  __syncthreads();
}

__global__ void __launch_bounds__(NTHREADS, 2) fwd_megakernel(Params p) {
  cg::grid_group grid = cg::this_grid();
  extern __shared__ __attribute__((aligned(16))) unsigned char lds_dyn[];
  __shared__ uint4 s_misc[2];
  int& s_item = *(int*)&s_misc[1];
  if (threadIdx.x == 0) s_misc[0] = make_uint4(0u, 0u, 0u, 0u);
  __syncthreads();
  (void)xcd_barrier_post((unsigned*)(p.ws + OFF_MISC + 16384), (volatile LAS unsigned*)&s_misc[0]);
#define GBAR() do { XcdBarrier xb_; xb_.bar = (unsigned*)(p.ws + OFF_MISC + 16384); xb_.x = xb_xcc_id(); xb_.st = (volatile LAS unsigned*)&s_misc[0]; xcd_barrier(xb_); } while (0)
  char* smem = (char*)lds_dyn;
  const int half = half_id();
  unsigned* bw = (unsigned*)(p.ws + OFF_MISC) + 256; unsigned bk = 0;
  phase0(p, smem);
  if (p.ws == nullptr) grid.sync();
  GBAR();
  mod_reduce(p);
  GBAR();
  const float* MOD = (const float*)(p.ws + OFF_MOD);
  bf16_t* XN = (bf16_t*)(p.ws + OFF_XN);
  bf16_t* U = (bf16_t*)(p.ws + OFF_U);
  bf16_t* Y = (bf16_t*)(p.ws + OFF_Y);
  bf16_t* HM = (bf16_t*)(p.ws + OFF_HM);
  float* HC = (float*)(p.ws + OFF_HC);
  PG8_LAS unsigned char* glds = (PG8_LAS unsigned char*)lds_dyn;
#pragma unroll 1
  for (int layer = 0; layer < DEPTH; ++layer) {
    const bool with_ctx = layer < DEPTH - 1;
    const int mrows = with_ctx ? ROWS : MROWS;
    int bx = (int)blockIdx.x; asm volatile("" : "+s"(bx));
    for (int rep = 0; rep < PROBE_N1; ++rep) { norm_phase(p, layer, 0, ROWS, layer > 0 ? MOD + (size_t)((layer - 1) * 9 + 8) * 6144 + 5120 : nullptr, HC);
    GBAR(); }
    for (int rep = 0; rep < PROBE_INPROJ; ++rep) { pg8::Gemm g{XN, (const bf16_t*)(p.ws + OFF_WIN) + (size_t)layer * INPW * DM, ROWS, INPW, DM, DM}; pg8::StaticOrder S; S.init(ROWS, INPW, (int)gridDim.x, bx);
      pg8::EpiStore<0> E{U, INP, INP};
      pg8::gemm_phase<pg8::EpiStore<0>, pg8::StaticOrder, true, true>(glds, g, S, E);
    GBAR(); }
    for (int rep = 0; rep < PROBE_PREP; ++rep) {
      unsigned* qc = (unsigned*)(p.ws + OFF_MISC) + 64 + layer + rep * DEPTH;
      for (;;) {
        if (threadIdx.x == 0) s_item = (int)atomicAdd(qc, 1u);
        __syncthreads();
        const int it = s_item;
        __syncthreads();
        if (it >= 1152 + 288) break;
        if (it < 144) prep_tile(p, layer, it * 2 + half, 0, smem + half * SMEM_BYTES);
        else if (it < 288) prep_tile(p, layer, (it - 144) * 2 + half, 1, smem + half * SMEM_BYTES);
        else ssd_chunk(p, layer, it - 288, smem + half * SMEM_BYTES);
      }
      GBAR();
    }
    for (int rep = 0; rep < PROBE_MIX; ++rep) { mixer_phase(p, layer + rep * DEPTH, smem, &s_item);
    GBAR(); }
    { const bf16_t* Wt = (const bf16_t*)(p.ws + OFF_WOUT) + (size_t)layer * DM * DM;
      { pg8::Gemm g{Y, Wt, MROWS, DM, DM, DM}; pg8::StaticOrder S; S.init(MROWS, DM, (int)gridDim.x, bx);
        pg8::EpiResid E{layer == 0 ? p.in[I_X] : p.out, nullptr, p.out, nullptr, MOD + (size_t)layer * 9 * 6144 + 2048, 1.f};
        pg8::gemm_phase<pg8::EpiResid, pg8::StaticOrder, true, true>(glds, g, S, E);
        for (int rep = 0; rep < PROBE_OUT; ++rep) { GBAR(); pg8::EpiResid E2{p.out, nullptr, p.out, nullptr, MOD + (size_t)layer * 9 * 6144 + 2048, 0.f}; pg8::gemm_phase<pg8::EpiResid, pg8::StaticOrder, true, true>(glds, g, S, E2); } }
      if (with_ctx) {
        const int ks = (bx >> 5) & 3;
        pg8::Gemm g{Y + (size_t)MROWS * DM + ks * (DM / 4), Wt + ks * (DM / 4), CROWS, DM, DM, DM / 4}; pg8::SplitOrder S{bx};
        pg8::EpiPartial E{(float*)(p.ws + OFF_SS) + (size_t)ks * CROWS * DM};
        pg8::gemm_phase<pg8::EpiPartial, pg8::SplitOrder, true, true>(glds, g, S, E); } }
    GBAR();
    norm_phase(p, layer, 1, mrows, with_ctx ? MOD + (size_t)(layer * 9 + 8) * 6144 + 2048 : nullptr, layer == 0 ? p.in[I_CTX] : HC);
    GBAR();
    for (int rep = 0; rep < PROBE_UP; ++rep) { pg8::Gemm g{XN, (const bf16_t*)(p.ws + OFF_W1) + (size_t)layer * DFF * DM, mrows, DFF, DM, DM}; pg8::StaticOrder S; S.init(mrows, DFF, (int)gridDim.x, bx);
      pg8::EpiStore<1> E{HM, DFF, DFF};
      pg8::gemm_phase<pg8::EpiStore<1>, pg8::StaticOrder, true, true>(glds, g, S, E);
    GBAR(); }
    { const bf16_t* Wt = (const bf16_t*)(p.ws + OFF_W2) + (size_t)layer * DM * DFF;
      { pg8::Gemm g{HM, Wt, MROWS, DM, DFF, DFF}; pg8::StaticOrder S; S.init(MROWS, DM, (int)gridDim.x, bx);
        pg8::EpiResid E{p.out, nullptr, p.out, nullptr, MOD + (size_t)layer * 9 * 6144 + 5120, 1.f};
        pg8::gemm_phase<pg8::EpiResid, pg8::StaticOrder, true, true>(glds, g, S, E);
        for (int rep = 0; rep < PROBE_DOWN; ++rep) { GBAR(); pg8::EpiResid E2{p.out, nullptr, p.out, nullptr, MOD + (size_t)layer * 9 * 6144 + 5120, 0.f}; pg8::gemm_phase<pg8::EpiResid, pg8::StaticOrder, true, true>(glds, g, S, E2); } }
      if (with_ctx) {
        const int ks = (bx >> 5) & 3;
        pg8::Gemm g{HM + (size_t)MROWS * DFF + ks * (DFF / 4), Wt + ks * (DFF / 4), CROWS, DM, DFF, DFF / 4}; pg8::SplitOrder S{bx};
        pg8::EpiPartial E{(float*)(p.ws + OFF_SS) + (size_t)ks * CROWS * DM};
        pg8::gemm_phase<pg8::EpiPartial, pg8::SplitOrder, true, true>(glds, g, S, E); } }
    GBAR();
  }
  norm_phase(p, 0, 2, MROWS);
}

extern "C" void kernel_launch(void* const* d_in, const int* in_sizes, int n_in, void* d_out, int out_size, void* d_ws, size_t ws_size, hipStream_t stream) {
  static int grid_blocks = 0;
  if (!grid_blocks) {
    int dev = 0, cus = 0, per_cu = 0;
    (void)hipGetDevice(&dev);
    (void)hipDeviceGetAttribute(&cus, hipDeviceAttributeMultiprocessorCount, dev);
    if (hipFuncSetAttribute((const void*)fwd_megakernel, hipFuncAttributeMaxDynamicSharedMemorySize, LDS_BYTES) != hipSuccess) fprintf(stderr, "hipFuncSetAttribute(max dynamic LDS) failed\n");
    (void)hipOccupancyMaxActiveBlocksPerMultiprocessor(&per_cu, (const void*)fwd_megakernel, NTHREADS, LDS_BYTES);
    if (per_cu < 1) { fprintf(stderr, "occupancy query says %d blocks/CU\n", per_cu); per_cu = 1; }
    grid_blocks = cus;
  }
  if (ws_size < OFF_END) { fprintf(stderr, "workspace too small: %zu < %zu\n", ws_size, (size_t)OFF_END); return; }
  Params p{};
  for (int i = 0; i < 27; ++i) p.in[i] = (const float*)d_in[i];
  p.out = (float*)d_out;
  p.ws = (char*)d_ws;
  (void)hipMemsetAsync((char*)d_ws + OFF_MISC, 0, SZ_MISC, stream);
  void* args[] = {&p};
  hipError_t e = hipLaunchCooperativeKernel((void*)fwd_megakernel, dim3(grid_blocks), dim3(NTHREADS), args, LDS_BYTES, stream);
  if (e != hipSuccess) fprintf(stderr, "cooperative launch failed: %s (grid %d)\n", hipGetErrorString(e), grid_blocks);
}
```
